# Optimizing an MI355X kernel written in HIP

```python
import numpy as np
import jax
import jax.numpy as jnp
from jax import lax

D_MODEL = 1024
BATCH = 16
SEQ = 2048
DEPTH = 2

EPS = 1e-6
NEG_BIG = -1e30
TINY = 1e-30
D_FF = ((8 * D_MODEL // 3 + 127) // 128) * 128
N_SUB = 3
N_BRANCH = 3

ML_WIDTH = D_MODEL
ML_HEADS = 4
ML_HD = ML_WIDTH // ML_HEADS
ML_CONV = 4
ML_CHUNK = 64

RW_WIDTH = D_MODEL
RW_HEAD = 64
RW_HEADS = RW_WIDTH // RW_HEAD
RW_DECAY_LORA = 64
RW_AAA_LORA = 64
RW_MV_LORA = 32
RW_GATE_LORA = 128
RW_LN_EPS = 64e-5
RW_SPLITS = (RW_WIDTH, RW_WIDTH, RW_WIDTH, RW_DECAY_LORA, RW_AAA_LORA, RW_GATE_LORA)
RW_SHIFT_COLS = 3 * RW_WIDTH + RW_DECAY_LORA + RW_AAA_LORA + RW_GATE_LORA

HG_WIDTH = D_MODEL
HG_EXPAND = 128
HG_HEADS = HG_WIDTH // HG_EXPAND
HG_CHUNK = 32

IN_SPLITS = (ML_WIDTH, ML_WIDTH, ML_HEADS, ML_HEADS, RW_SHIFT_COLS,
             HG_WIDTH, HG_WIDTH, HG_WIDTH, HG_WIDTH, N_BRANCH * D_MODEL)
N_IN = sum(IN_SPLITS)

kernel_name = 'hybrid_mlstm_rwkv7_hgrn2_macaron_adaln'


def rms_norm(x, w, eps=EPS):
    xf = x.astype(jnp.float32)
    y = xf * lax.rsqrt(jnp.mean(xf * xf, axis=-1, keepdims=True) + eps)
    return (y * w).astype(x.dtype)


def head_norm(x, n_heads, w, b=None, eps=EPS, center=False):
    shp = x.shape
    xf = x.astype(jnp.float32).reshape(*shp[:-1], n_heads, shp[-1] // n_heads)
    if center:
        xf = xf - jnp.mean(xf, axis=-1, keepdims=True)
    xf = xf * lax.rsqrt(jnp.mean(xf * xf, axis=-1, keepdims=True) + eps)
    y = xf.reshape(shp) * w
    if b is not None:
        y = y + b
    return y.astype(x.dtype)


def modulate(x, w, shift, scale):
    return rms_norm(x, w) * (1.0 + scale) + shift


def swiglu(h, w_up, w_down):
    a, b = jnp.split(h @ w_up, 2, axis=-1)
    return (jax.nn.silu(a) * b) @ w_down


def split_cols(z, sizes):
    return jnp.split(z, np.cumsum(sizes)[:-1].tolist(), axis=-1)


def split_heads(x, n):
    B, T, W = x.shape
    return x.reshape(B, T, n, W // n).transpose(0, 2, 1, 3)


def merge_heads(y):
    B, H, T, d = y.shape
    return y.transpose(0, 2, 1, 3).reshape(B, T, H * d)


def to_chunks(x, L):
    B, H, T = x.shape[:3]
    return jnp.moveaxis(x.reshape(B, H, T // L, L, *x.shape[3:]), 2, 0)


def from_chunks(y):
    y = jnp.moveaxis(y, 0, 2)
    return y.reshape(y.shape[0], y.shape[1], -1, y.shape[-1])


def token_shift(z, mu):
    prev = jnp.pad(z, ((0, 0), (1, 0), (0, 0)))[:, :-1]
    return z + mu * (prev - z)


def causal_conv(x, w, b):
    K, C = w.shape
    y = lax.conv_general_dilated(x, w.astype(x.dtype)[:, None, :], window_strides=(1,),
                                 padding=((K - 1, 0),), dimension_numbers=('NWC', 'WIO', 'NWC'),
                                 feature_group_count=C)
    return y + b


def mlstm_chunkwise(q, k, v, log_i, log_f):
    f32 = jnp.float32
    B, H, T, dk = q.shape
    dv = v.shape[-1]
    L = ML_CHUNK
    q, k, v, log_i, log_f = (t.astype(f32) for t in (q, k, v, log_i, log_f))
    k = k * (dk ** -0.5)
    causal = jnp.tril(jnp.ones((L, L), dtype=bool))

    def step(carry, inp):
        C, n, m = carry
        qc, kc, vc, li, lf = inp
        b = jnp.cumsum(lf, axis=-1)
        log_d = jnp.where(causal, b[..., :, None] - b[..., None, :] + li[..., None, :], NEG_BIG)
        log_inter = b + m[..., None]
        m_t = jnp.maximum(log_inter, jnp.max(log_d, axis=-1))
        w_intra = jnp.exp(log_d - m_t[..., None])
        w_inter = jnp.exp(log_inter - m_t)
        s = jnp.einsum('bhtd,bhsd->bhts', qc, kc) * w_intra
        num = (w_inter[..., None] * jnp.einsum('bhtd,bhde->bhte', qc, C)
               + jnp.einsum('bhts,bhse->bhte', s, vc))
        den = w_inter * jnp.einsum('bhtd,bhd->bht', qc, n) + jnp.sum(s, axis=-1)
        h = num / jnp.maximum(jnp.abs(den), jnp.exp(-m_t))[..., None]
        b_end = b[..., -1]
        log_ws = b_end[..., None] - b + li
        m_new = jnp.maximum(b_end + m, jnp.max(log_ws, axis=-1))
        ws = jnp.exp(log_ws - m_new[..., None])
        decay = jnp.exp(b_end + m - m_new)
        kw = kc * ws[..., None]
        C = decay[..., None, None] * C + jnp.einsum('bhsd,bhse->bhde', kw, vc)
        n = decay[..., None] * n + jnp.sum(kw, axis=2)
        return (C, n, m_new), h

    init = (jnp.zeros((B, H, dk, dv), f32), jnp.zeros((B, H, dk), f32), jnp.zeros((B, H), f32))
    xs = (to_chunks(q, L), to_chunks(k, L), to_chunks(v, L), to_chunks(log_i, L), to_chunks(log_f, L))
    _, h = lax.scan(step, init, xs)
    return from_chunks(h)


def mlstm_branch(x_m, o_pre, i_pre, f_pre, conv_w, conv_b, wq, wk, i_b, f_b, norm_w, skip):
    xc = jax.nn.silu(causal_conv(x_m, conv_w, conv_b))
    xc_h = split_heads(xc, ML_HEADS)
    q = jnp.einsum('bhtd,hde->bhte', xc_h, wq)
    k = jnp.einsum('bhtd,hde->bhte', xc_h, wk)
    v = split_heads(x_m, ML_HEADS)
    log_i = jnp.swapaxes(i_pre + i_b, 1, 2)
    log_f = jax.nn.log_sigmoid(jnp.swapaxes(f_pre + f_b, 1, 2).astype(jnp.float32))
    h = merge_heads(mlstm_chunkwise(q, k, v, log_i, log_f)).astype(x_m.dtype)
    return head_norm(h * jax.nn.sigmoid(o_pre), ML_HEADS, norm_w, center=True) + skip * xc


def wkv7_scan(r, log_w, k, v, kk, a):
    T, B, H, N = r.shape

    def step(S, inp):
        r_t, lw_t, k_t, v_t, kk_t, a_t = inp
        sa = jnp.einsum('bhvk,bhk->bhv', S, -kk_t)
        S = (S * jnp.exp(lw_t)[:, :, None, :]
             + sa[..., None] * (kk_t * a_t)[:, :, None, :]
             + v_t[..., None] * k_t[:, :, None, :])
        return S, jnp.einsum('bhvk,bhk->bhv', S, r_t)

    _, y = lax.scan(step, jnp.zeros((B, H, N, N), jnp.float32), (r, log_w, k, v, kk, a))
    return y


def rwkv7_branch(feats, vres, v_first, mu, w0, w2, a0, a2, g2, k_k, k_a, r_k, ln_w, ln_b):
    B, T, _ = feats.shape
    f32 = jnp.float32
    r, k, v, w_lo, a_lo, g_lo = split_cols(token_shift(feats, mu), RW_SPLITS)
    w_raw = -jax.nn.softplus(-(w0 + jnp.tanh(w_lo) @ w2).astype(f32)) - 0.5
    log_w = -jnp.exp(w_raw)
    a = jax.nn.sigmoid(a0 + a_lo @ a2)
    g = jax.nn.sigmoid(g_lo) @ g2
    if vres is None:
        v_first = v
    else:
        v_lo, mu_v, v0, v2 = vres
        v = v + (v_first - v) * jax.nn.sigmoid(v0 + token_shift(v_lo, mu_v) @ v2)

    def hl(t):
        return t.reshape(B, T, RW_HEADS, RW_HEAD)

    kk = hl(k * k_k).astype(f32)
    kk = kk / jnp.maximum(jnp.sqrt(jnp.sum(kk * kk, axis=-1, keepdims=True)), 1e-12)
    k = k * (1.0 + (a - 1.0) * k_a)

    def tm(t):
        return jnp.moveaxis(hl(t).astype(f32), 1, 0)

    y = wkv7_scan(tm(r), tm(log_w), tm(k), tm(v), jnp.moveaxis(kk, 1, 0), tm(a))
    y = jnp.moveaxis(y, 0, 1).reshape(B, T, RW_WIDTH).astype(feats.dtype)
    y = head_norm(y, RW_HEADS, ln_w, ln_b, eps=RW_LN_EPS, center=True)
    bonus = (jnp.sum(hl(r) * hl(k) * r_k, axis=-1, keepdims=True) * hl(v)).reshape(B, T, RW_WIDTH)
    return (y + bonus) * g, v_first


def gla_chunkwise(q, k, v, log_f):
    f32 = jnp.float32
    B, H, T, dk = q.shape
    dv = v.shape[-1]
    L = HG_CHUNK
    q, k, v, log_f = (t.astype(f32) for t in (q, k, v, log_f))
    causal = jnp.tril(jnp.ones((L, L), dtype=bool))

    def step(S, inp):
        qc, kc, vc, gc = inp
        b = jnp.cumsum(gc, axis=2)
        inter = jnp.einsum('bhtd,bhde->bhte', qc * jnp.exp(b), S)
        rel = jnp.minimum(b[:, :, :, None, :] - b[:, :, None, :, :], 0.0)
        decay = jnp.where(causal[:, :, None], jnp.exp(rel), 0.0)
        A = jnp.einsum('bhtd,bhtsd,bhsd->bhts', qc, decay, kc)
        o = inter + jnp.einsum('bhts,bhse->bhte', A, vc)
        b_end = b[:, :, -1:, :]
        S = (jnp.exp(b_end[:, :, 0, :])[..., None] * S
             + jnp.einsum('bhsd,bhse->bhde', kc * jnp.exp(b_end - b), vc))
        return S, o

    xs = (to_chunks(q, L), to_chunks(k, L), to_chunks(v, L), to_chunks(log_f, L))
    _, o = lax.scan(step, jnp.zeros((B, H, dk, dv), f32), xs)
    return from_chunks(o)


def hgrn2_branch(q_pre, f_pre, i_in, g_pre, lb, norm_w):
    fp = f_pre.astype(jnp.float32)
    q = jax.nn.silu(q_pre)
    sig = jax.nn.sigmoid(fp)
    k = (1.0 - lb) * (1.0 - sig)
    log_f = jnp.log(jnp.maximum(lb + (1.0 - lb) * sig, TINY))
    o = gla_chunkwise(split_heads(q, HG_HEADS), split_heads(k, HG_HEADS),
                      split_heads(i_in, HG_HEADS), split_heads(log_f, HG_HEADS))
    o = merge_heads(o).astype(q_pre.dtype)
    return head_norm(o, HG_HEADS, norm_w) * jax.nn.sigmoid(g_pre)


def setup_inputs(seed: int = 0) -> dict:
    key = jax.random.key(seed)
    ks = iter(jax.random.split(key, 48))

    def nrm(shape, s=1.0):
        return s * jax.random.normal(next(ks), shape, jnp.float32)

    L, D, Lv = DEPTH, D_MODEL, DEPTH - 1
    return {
        'x': nrm((BATCH, SEQ, D)),
        'c': nrm((BATCH, D)),
        'norm_w': 1.0 + nrm((L, N_SUB, D), 0.02),
        'final_norm_w': 1.0 + nrm((D,), 0.02),
        'ada_w': nrm((L, D, N_SUB * 3 * D), 0.1 * D ** -0.5),
        'ada_b': nrm((L, N_SUB * 3 * D), 0.02),
        'ffn_up': nrm((L, 2, D, 2 * D_FF), D ** -0.5),
        'ffn_down': nrm((L, 2, D_FF, D), D_FF ** -0.5),
        'w_in': nrm((L, D, N_IN), D ** -0.5),
        'w_in_vres': nrm((Lv, D, RW_MV_LORA), D ** -0.5),
        'ml_conv_w': nrm((L, ML_CONV, ML_WIDTH), ML_CONV ** -0.5),
        'ml_conv_b': nrm((L, ML_WIDTH), 0.02),
        'ml_wq': nrm((L, ML_HEADS, ML_HD, ML_HD), ML_HD ** -0.5),
        'ml_wk': nrm((L, ML_HEADS, ML_HD, ML_HD), ML_HD ** -0.5),
        'ml_i_b': nrm((L, ML_HEADS), 0.1),
        'ml_f_b': jnp.linspace(3.0, 6.0, ML_HEADS)[None] + nrm((L, ML_HEADS), 0.1),
        'ml_norm_w': 1.0 + nrm((L, ML_WIDTH), 0.02),
        'ml_skip': 1.0 + nrm((L, ML_WIDTH), 0.02),
        'rw_mu': jax.random.uniform(next(ks), (L, RW_SHIFT_COLS), jnp.float32),
        'rw_mu_vres': jax.random.uniform(next(ks), (Lv, RW_MV_LORA), jnp.float32),
        'rw_w0': jnp.linspace(-6.5, -1.5, RW_WIDTH)[None] + nrm((L, RW_WIDTH), 0.1),
        'rw_w2': nrm((L, RW_DECAY_LORA, RW_WIDTH), 0.1),
        'rw_a0': nrm((L, RW_WIDTH), 0.1),
        'rw_a2': nrm((L, RW_AAA_LORA, RW_WIDTH), 0.1),
        'rw_v0': 1.0 + nrm((Lv, RW_WIDTH), 0.1),
        'rw_v2': nrm((Lv, RW_MV_LORA, RW_WIDTH), 0.1),
        'rw_g2': nrm((L, RW_GATE_LORA, RW_WIDTH), RW_GATE_LORA ** -0.5),
        'rw_k_k': 0.85 + nrm((L, RW_WIDTH), 0.02),
        'rw_k_a': 1.0 + nrm((L, RW_WIDTH), 0.02),
        'rw_r_k': nrm((L, RW_HEADS, RW_HEAD), 0.1),
        'rw_ln_w': 1.0 + nrm((L, RW_WIDTH), 0.02),
        'rw_ln_b': nrm((L, RW_WIDTH), 0.02),
        'hg_lb_logits': nrm((L, HG_WIDTH), 0.5),
        'hg_norm_w': 1.0 + nrm((L, HG_WIDTH), 0.02),
        'w_branch': nrm((L, N_BRANCH, D, D), D ** -0.5),
        'w_out': nrm((L, D, D), D ** -0.5),
    }


def reference(x, c, norm_w, final_norm_w, ada_w, ada_b, ffn_up, ffn_down, w_in, w_in_vres,
              ml_conv_w, ml_conv_b, ml_wq, ml_wk, ml_i_b, ml_f_b, ml_norm_w, ml_skip,
              rw_mu, rw_mu_vres, rw_w0, rw_w2, rw_a0, rw_a2, rw_v0, rw_v2, rw_g2,
              rw_k_k, rw_k_a, rw_r_k, rw_ln_w, rw_ln_b, hg_lb_logits, hg_norm_w,
              w_branch, w_out):
    B, T, D = x.shape
    lb_soft = jax.nn.softmax(hg_lb_logits.astype(jnp.float32), axis=0)
    lower_bounds = jnp.cumsum(lb_soft, axis=0) - lb_soft[0]
    cond = jax.nn.silu(c)
    v_first = None
    for l in range(DEPTH):
        mod = (cond @ ada_w[l] + ada_b[l]).reshape(B, N_SUB, 3, 1, D)

        h = modulate(x, norm_w[l, 0], mod[:, 0, 0], mod[:, 0, 1])
        x = x + 0.5 * (1.0 + mod[:, 0, 2]) * swiglu(h, ffn_up[l, 0], ffn_down[l, 0])

        h = modulate(x, norm_w[l, 1], mod[:, 1, 0], mod[:, 1, 1])
        if l == 0:
            z = h @ w_in[l]
            parts = split_cols(z, IN_SPLITS)
            vres = None
        else:
            z = h @ jnp.concatenate([w_in[l], w_in_vres[l - 1]], axis=1)
            parts = split_cols(z, IN_SPLITS + (RW_MV_LORA,))
            vres = (parts[10], rw_mu_vres[l - 1], rw_v0[l - 1], rw_v2[l - 1])
        ml_x, ml_o, ml_i, ml_f, rw_feats, hg_q, hg_f, hg_i, hg_g, gate_pre = parts[:10]

        y_ml = mlstm_branch(ml_x, ml_o, ml_i, ml_f, ml_conv_w[l], ml_conv_b[l], ml_wq[l], ml_wk[l],
                            ml_i_b[l], ml_f_b[l], ml_norm_w[l], ml_skip[l])
        y_rw, v_first = rwkv7_branch(rw_feats, vres, v_first, rw_mu[l], rw_w0[l], rw_w2[l],
                                     rw_a0[l], rw_a2[l], rw_g2[l], rw_k_k[l], rw_k_a[l],
                                     rw_r_k[l], rw_ln_w[l], rw_ln_b[l])
        y_hg = hgrn2_branch(hg_q, hg_f, hg_i, hg_g, lower_bounds[l], hg_norm_w[l])

        y_br = jnp.einsum('btnw,nwd->btnd', jnp.stack([y_ml, y_rw, y_hg], axis=2), w_branch[l])
        gates = jax.nn.sigmoid(gate_pre.reshape(B, T, N_BRANCH, D))
        mixed = jnp.sum(gates * y_br, axis=2) @ w_out[l]
        x = x + (1.0 + mod[:, 1, 2]) * mixed

        h = modulate(x, norm_w[l, 2], mod[:, 2, 0], mod[:, 2, 1])
        x = x + 0.5 * (1.0 + mod[:, 2, 2]) * swiglu(h, ffn_up[l, 1], ffn_down[l, 1])
    return rms_norm(x, final_norm_w)
```

```cpp
#include <hip/hip_runtime.h>
#include <cstdio>
#include <cstdint>

#ifndef ONE_LAUNCH
#define ONE_LAUNCH 0
#endif

#define GAS __attribute__((address_space(1)))
#define LAS __attribute__((address_space(3)))
typedef unsigned short bf16;
typedef unsigned v4u __attribute__((ext_vector_type(4)));
typedef unsigned v2u __attribute__((ext_vector_type(2)));
typedef float f32x4 __attribute__((ext_vector_type(4)));
typedef float f32x2 __attribute__((ext_vector_type(2)));
typedef short bf16x8 __attribute__((ext_vector_type(8)));
#define DI __device__ __forceinline__

constexpr int D = 1024, NB = 16, T = 2048, M = NB * T, DFF = 2816, NUP = 2 * DFF;
constexpr int GB = 4, MG = GB * T, NGRP = NB / GB;
constexpr int NZ = 9472;
constexpr int ZC_MLX = 0, ZC_MLO = 1024, ZC_RW = 2048, ZC_HGQ = 5376, ZC_HGF = 6400, ZC_HGI = 7424, ZC_HGG = 8448;
constexpr int ZC_GATE = 5376;
constexpr int NWIN = 12544;
constexpr int WIN_SRC = 12552;
constexpr int NSIDE = 40, KLORA = 384, NLORA = 4096, NMOD = 9216;
constexpr int NTHREADS = 512, NWAVES = 8;

constexpr size_t MiB = 1u << 20;
constexpr size_t WS_CTL = 0, CTL_BYTES = 1 * MiB;
constexpr size_t WS_MOD = 1 * MiB;
constexpr size_t WS_WSIDE = 3 * MiB;
constexpr size_t WS_WUP = 4 * MiB;
constexpr size_t WS_WDN = 26 * MiB;
constexpr size_t WS_WIN = 37 * MiB;
constexpr size_t WS_WBR = 62 * MiB;
constexpr size_t WS_WOUT = 68 * MiB;
constexpr size_t WS_WQK = 70 * MiB;
constexpr size_t WS_WLORA = 71 * MiB;
constexpr size_t WS_VF = 74 * MiB;
constexpr size_t WS_ACT = 138 * MiB;
constexpr size_t WS_H = WS_ACT;
constexpr size_t WS_HID = WS_ACT + 64 * MiB;
constexpr size_t WS_HG = WS_ACT;
constexpr size_t WS_Z = WS_ACT + 16 * MiB;
constexpr size_t WS_XC = WS_ACT + 164 * MiB;
constexpr size_t WS_QK = WS_ACT + 180 * MiB;
constexpr size_t WS_LA = WS_ACT + 212 * MiB;
constexpr size_t WS_LO = WS_ACT + 218 * MiB;
constexpr size_t WS_SIDE = WS_ACT + 282 * MiB;
constexpr size_t WS_RAW = WS_ACT + 284 * MiB;
constexpr size_t WS_BON = WS_ACT + 332 * MiB;
constexpr size_t WS_END = WS_ACT + 348 * MiB;
static_assert(WS_HID + (size_t)M * DFF * 2 <= WS_END, "ffn view fits");
static_assert(WS_Z + (size_t)MG * NZ * 2 <= WS_XC, "z fits");

constexpr int CW_BAR = 4096;

constexpr int LDS_BYTES = 147456;
constexpr int MISC_OFF = 131072 + 320;

DI unsigned f2bf(float f) { unsigned u = __builtin_bit_cast(unsigned, f); return (u + 0x7fffu + ((u >> 16) & 1u)) >> 16; }
DI unsigned pk2(float lo, float hi) { unsigned r; asm("v_cvt_pk_bf16_f32 %0, %1, %2" : "=v"(r) : "v"(lo), "v"(hi)); return r; }
DI float bflo(unsigned w) { return __builtin_bit_cast(float, w << 16); }
DI float bfhi(unsigned w) { return __builtin_bit_cast(float, w & 0xffff0000u); }
DI float bf1(bf16 h) { return __builtin_bit_cast(float, (unsigned)h << 16); }
DI float sigmoidf_(float x) { return 1.0f / (1.0f + __expf(-x)); }
DI float siluf_(float x) { return x / (1.0f + __expf(-x)); }
DI float softplusf_(float x) { return fmaxf(x, 0.f) + log1pf(__expf(-fabsf(x))); }
DI float wave_sum(float v) {
#pragma unroll
    for (int o = 1; o < 64; o <<= 1) v += __shfl_xor(v, o);
    return v;
}
template <int CTRL> DI float dppf(float v) { return __builtin_bit_cast(float, __builtin_amdgcn_update_dpp(0, __builtin_bit_cast(int, v), CTRL, 0xF, 0xF, true)); }
DI float sum4(float v) { v += dppf<0xB1>(v); v += dppf<0x4E>(v); return v; }
DI float sum8(float v) { v = sum4(v); v += dppf<0x141>(v); return v; }
DI float sum16(float v) { v = sum8(v); v += dppf<0x140>(v); return v; }
#define LDS_WAIT() asm volatile("s_waitcnt lgkmcnt(0)" ::: "memory")
#define VM_WAIT() asm volatile("s_waitcnt vmcnt(0)" ::: "memory")
DI void unpack8(const v4u w, float (&o)[8]) { o[0] = bflo(w.x); o[1] = bfhi(w.x); o[2] = bflo(w.y); o[3] = bfhi(w.y); o[4] = bflo(w.z); o[5] = bfhi(w.z); o[6] = bflo(w.w); o[7] = bfhi(w.w); }
DI void unpack16(const bf16* p, float (&o)[16]) { const v4u a = *(const v4u*)p, b = *(const v4u*)(p + 8);
    o[0] = bflo(a.x); o[1] = bfhi(a.x); o[2] = bflo(a.y); o[3] = bfhi(a.y); o[4] = bflo(a.z); o[5] = bfhi(a.z); o[6] = bflo(a.w); o[7] = bfhi(a.w);
    o[8] = bflo(b.x); o[9] = bfhi(b.x); o[10] = bflo(b.y); o[11] = bfhi(b.y); o[12] = bflo(b.z); o[13] = bfhi(b.z); o[14] = bflo(b.w); o[15] = bfhi(b.w); }
DI void pack16(bf16* p, const float (&o)[16]) { v4u a, b; a.x = pk2(o[0], o[1]); a.y = pk2(o[2], o[3]); a.z = pk2(o[4], o[5]); a.w = pk2(o[6], o[7]);
    b.x = pk2(o[8], o[9]); b.y = pk2(o[10], o[11]); b.z = pk2(o[12], o[13]); b.w = pk2(o[14], o[15]); *(v4u*)p = a; *(v4u*)(p + 8) = b; }
DI v4u pack8(const float (&o)[8]) { v4u w; w.x = pk2(o[0], o[1]); w.y = pk2(o[2], o[3]); w.z = pk2(o[4], o[5]); w.w = pk2(o[6], o[7]); return w; }

#define XB_TMO      128
#define XB_XCNT(j)  (256  + 64 * (j))
#define XB_XSUB(j)  (1280 + 64 * (j))
#define XB_XGEN(j)  (2304 + 64 * (j))
#define XB_TOP      3328
#define XB_TOPGEN   3392
#define XCD_BAR_WORDS 3456
#define XB_SPIN_CAP (1u << 22)
__device__ __forceinline__ unsigned xb_ld(unsigned* p)              { return __hip_atomic_load(p, __ATOMIC_RELAXED, __HIP_MEMORY_SCOPE_AGENT); }
__device__ __forceinline__ unsigned xb_add(unsigned* p, unsigned v) { return __hip_atomic_fetch_add(p, v, __ATOMIC_RELAXED, __HIP_MEMORY_SCOPE_AGENT); }
__device__ __forceinline__ unsigned xb_xcc_id() { return (unsigned)__builtin_amdgcn_s_getreg((3 << 11) | 20) & 0xFu; }
#define XB_SPIN(cond, bar) do { unsigned _sp = 0; while (cond) { __builtin_amdgcn_s_sleep(1); \
    if ((++_sp & 255u) == 0u) { if (xb_ld(&(bar)[XB_TMO])) break; if (_sp > XB_SPIN_CAP) { atomicAdd(&(bar)[XB_TMO], 1u); break; } } } } while (0)
struct XcdBarrier { unsigned* bar; unsigned x; volatile LAS unsigned* st; };
__device__ __forceinline__ XcdBarrier xcd_barrier_post(unsigned* bar, volatile LAS unsigned* st) {
    XcdBarrier b; b.bar = bar; b.x = xb_xcc_id(); b.st = st;
    if (threadIdx.x == 0) (void)xb_add(&bar[XB_XCNT(b.x)], 1u);
    return b;
}
__device__ __forceinline__ void xcd_barrier_complete(unsigned* bar, unsigned x, unsigned& nloc, unsigned& nx) {
    const unsigned G = gridDim.x * gridDim.y * gridDim.z;
    unsigned sum, cnt, mine, sp = 0u;
    for (;;) {
        sum = 0u; cnt = 0u; mine = 0u;
#pragma unroll
        for (unsigned j = 0; j < 16; ++j) { const unsigned c = xb_ld(&bar[XB_XCNT(j)]); sum += c; cnt += (c > 0u) ? 1u : 0u; mine = (j == x) ? c : mine; }
        if (sum == G) break;
        __builtin_amdgcn_s_sleep(1);
        if ((++sp & 255u) == 0u) { if (xb_ld(&bar[XB_TMO])) break; if (sp > XB_SPIN_CAP) { atomicAdd(&bar[XB_TMO], 1u); break; } }
    }
    nloc = mine > 0u ? mine : 1u; nx = cnt > 0u ? cnt : 1u;
}
__device__ __forceinline__ void xcd_barrier(const XcdBarrier& b) {
    asm volatile("s_waitcnt vmcnt(0)" ::: "memory");
    __syncthreads();
    if (threadIdx.x == 0) {
        unsigned* bar = b.bar;
        __builtin_amdgcn_s_waitcnt(0);
        unsigned nloc = b.st[0], nx = b.st[1];
        if (nloc == 0u) { xcd_barrier_complete(bar, b.x, nloc, nx); b.st[0] = nloc; b.st[1] = nx; }
        const unsigned old = xb_add(&bar[XB_XSUB(b.x)], 1u);
        const unsigned gen = old / nloc;
        if (old + 1u == (gen + 1u) * nloc) {
            __builtin_amdgcn_fence(__ATOMIC_RELEASE, "agent");
            asm volatile("s_waitcnt vmcnt(0)" ::: "memory");
            const unsigned og = xb_add(&bar[XB_TOP], 1u);
            const unsigned tg = og / nx;
            if (og + 1u == (tg + 1u) * nx) xb_add(&bar[XB_TOPGEN], 1u);
            else XB_SPIN(xb_ld(&bar[XB_TOPGEN]) == tg, bar);
            __builtin_amdgcn_fence(__ATOMIC_ACQUIRE, "agent");
            xb_add(&bar[XB_XGEN(b.x)], 1u);
            asm volatile("s_waitcnt vmcnt(0)" ::: "memory");
        } else {
            XB_SPIN(xb_ld(&bar[XB_XGEN(b.x)]) == gen, bar);
            __builtin_amdgcn_fence(__ATOMIC_ACQUIRE, "agent");
            asm volatile("s_waitcnt vmcnt(0)" ::: "memory");
        }
    }
    __syncthreads();
}

namespace pg8 {
constexpr int BM = 256, BK = 64, HALF = 128, HTB = HALF * BK * 2, STAGE_BYTES = 8 * HTB, NXCD = 8, WGM = 8;
DI int lds_byte(int r, int c) { const int st = (r >> 4) * 2 + (c >> 5), rr = r & 15, cc = c & 31, ob = rr * 64 + cc * 2; return st * 1024 + (ob ^ (((ob >> 9) & 1) << 5)); }
DI void stage_rc(int b, int& R, int& C) { const int st = b / 1024, sb = b % 1024, swz = sb ^ (((sb >> 9) & 1) << 5); R = (st >> 1) * 16 + swz / 64; C = (st & 1) * 32 + (swz % 64) / 2; }
DI int perm32(int rho) { const int n = rho >> 4, i = rho & 15; return 8 * (i >> 2) + 4 * n + (i & 3); }

struct Unit { int pm, pn, pz; };
struct Gemm { const bf16* A; const bf16* Bt; int K, lda, ldb; size_t a_z, b_z; };

template <int MODE> struct Order {
    int nM, nN, nwg, G, c;
    DI void init(int nM_, int nN_, int G_, int c_) { nM = nM_; nN = nN_; nwg = nM * nN; G = G_; c = c_; }
    DI bool next(int i, Unit& u) const {
        const int ii = (MODE == 2) ? i / 3 : i;
        const long L = (long)ii * G + c; if (L >= nwg) return false;
        int wgid = (int)L; { const int q = nwg / NXCD, r = nwg % NXCD, xcd = wgid % NXCD, off = wgid / NXCD; wgid = (xcd < r ? xcd * (q + 1) : r * (q + 1) + (xcd - r) * q) + off; }
        const int nig = WGM * nN, gid = wgid / nig, fm = gid * WGM, gsz = (nM - fm) < WGM ? (nM - fm) : WGM;
        u.pm = fm + ((wgid % nig) % gsz); const int pn = (wgid % nig) / gsz;
        if (MODE == 1) { u.pz = pn >> 1; u.pn = pn & 1; } else if (MODE == 2) { u.pz = i - ii * 3; u.pn = pn; } else { u.pz = 0; u.pn = pn; }
        return true;
    }
};

struct EpiBf16 {
    static constexpr bool PERM = true;
    bf16* O; int ldc; int zcols;
    DI void operator()(const f32x4 (&acc)[2][2][4][2], const Unit& u, int wr, int wc, int fr, int fq) const {
        const int row0 = u.pm * BM + wr * 64 + fr; const int col0 = u.pz * zcols + u.pn * BM + wc * 32 + 8 * fq;
#pragma unroll
        for (int ai = 0; ai < 2; ++ai)
#pragma unroll
            for (int m = 0; m < 4; ++m) { bf16* rowp = O + (size_t)(row0 + ai * HALF + m * 16) * ldc + col0;
#pragma unroll
                for (int bj = 0; bj < 2; ++bj) { const f32x4 v0 = acc[ai][bj][m][0], v1 = acc[ai][bj][m][1];
                    v4u w; w.x = pk2(v0[0], v0[1]); w.y = pk2(v0[2], v0[3]); w.z = pk2(v1[0], v1[1]); w.w = pk2(v1[2], v1[3]);
                    *(v4u*)(rowp + bj * HALF) = w; } }
    }
};
struct EpiSwiGLU {
    static constexpr bool PERM = true;
    bf16* O; int ldc;
    DI void operator()(const f32x4 (&acc)[2][2][4][2], const Unit& u, int wr, int wc, int fr, int fq) const {
        const int row0 = u.pm * BM + wr * 64 + fr; const int col0 = u.pn * HALF + wc * 32 + 8 * fq;
#pragma unroll
        for (int ai = 0; ai < 2; ++ai)
#pragma unroll
            for (int m = 0; m < 4; ++m) { bf16* rowp = O + (size_t)(row0 + ai * HALF + m * 16) * ldc + col0;
                float o[8];
#pragma unroll
                for (int n = 0; n < 2; ++n)
#pragma unroll
                    for (int j = 0; j < 4; ++j) { const float a = acc[ai][0][m][n][j], b = acc[ai][1][m][n][j]; o[n * 4 + j] = a * b / (1.0f + __expf(-a)); }
                *(v4u*)rowp = pack8(o); }
    }
};
struct EpiResid {
    static constexpr bool PERM = false;
    const float* xin; float* xout; const float* gate; float mul; int b0;
    DI void operator()(const f32x4 (&acc)[2][2][4][2], const Unit& u, int wr, int wc, int fr, int fq) const {
        const int row0 = u.pm * BM + wr * 64 + fr, col0 = u.pn * BM + wc * 32 + 4 * fq;
        const float* gp = gate + (size_t)(b0 + (u.pm * BM) / T) * NMOD + col0;
        f32x4 cf[2][2];
#pragma unroll
        for (int bj = 0; bj < 2; ++bj)
#pragma unroll
            for (int n = 0; n < 2; ++n) cf[bj][n] = (*(const f32x4*)(gp + bj * HALF + n * 16) + 1.0f) * mul;
#pragma unroll
        for (int ai = 0; ai < 2; ++ai)
#pragma unroll
            for (int m = 0; m < 4; ++m) { const size_t off = (size_t)(row0 + ai * HALF + m * 16) * D + col0;
#pragma unroll
                for (int bj = 0; bj < 2; ++bj)
#pragma unroll
                    for (int n = 0; n < 2; ++n) { const f32x4 xi = *(const f32x4*)(xin + off + bj * HALF + n * 16);
                        *(f32x4*)(xout + off + bj * HALF + n * 16) = xi + cf[bj][n] * acc[ai][bj][m][n]; }
                asm volatile("" ::: "memory"); }
    }
};
struct EpiBranch {
    static constexpr bool PERM = false;
    const bf16* gates; int ldg; float* mixf; bf16* mixb;
    DI void operator()(const f32x4 (&acc)[2][2][4][2], const Unit& u, int wr, int wc, int fr, int fq) const {
        const int row0 = u.pm * BM + wr * 64 + fr, col0 = u.pn * BM + wc * 32 + 4 * fq;
#pragma unroll
        for (int ai = 0; ai < 2; ++ai)
#pragma unroll
            for (int m = 0; m < 4; ++m) { const int row = row0 + ai * HALF + m * 16; const size_t off = (size_t)row * D + col0; const bf16* gp = gates + (size_t)row * ldg + u.pz * D + col0;
#pragma unroll
                for (int bj = 0; bj < 2; ++bj)
#pragma unroll
                    for (int n = 0; n < 2; ++n) { const v2u gw = *(const v2u*)(gp + bj * HALF + n * 16);
                        f32x4 g; g[0] = sigmoidf_(bflo(gw.x)); g[1] = sigmoidf_(bfhi(gw.x)); g[2] = sigmoidf_(bflo(gw.y)); g[3] = sigmoidf_(bfhi(gw.y));
                        f32x4 v = g * acc[ai][bj][m][n];
                        if (u.pz > 0) v += *(const f32x4*)(mixf + off + bj * HALF + n * 16);
                        if (u.pz < 2) *(f32x4*)(mixf + off + bj * HALF + n * 16) = v;
                        else { v2u w; w.x = pk2(v[0], v[1]); w.y = pk2(v[2], v[3]); *(v2u*)(mixb + off + bj * HALF + n * 16) = w; } }
                asm volatile("" ::: "memory"); }
    }
};

template <class Epi, class Sched>
DI void gemm_phase(LAS unsigned char* lds, const Gemm g, const Sched& S, const Epi& E) {
    int tid_ = threadIdx.x; asm volatile("" : "+v"(tid_));
    const int tid = tid_, wid = __builtin_amdgcn_readfirstlane(tid >> 6), lane = tid & 63, wr = wid >> 2, wc = wid & 3, fr = lane & 15, fq = lane >> 4;
    int K_ = g.K; asm volatile("" : "+s"(K_));
    const int K = K_, nt = K / BK;
    unsigned voffA[2], voffB[2];
#pragma unroll
    for (int i = 0; i < 2; ++i) { int R, C; stage_rc(tid * 16 + i * 8192, R, C); const int Rb = Epi::PERM ? ((R & ~31) + perm32(R & 31)) : R;
        voffA[i] = (unsigned)(R * g.lda + C) * 2u; voffB[i] = (unsigned)(Rb * g.ldb + C) * 2u; }
    const size_t kstep = (size_t)(BK * 2);
    const size_t hstepA = (size_t)HALF * g.lda * 2, hstepB = (size_t)HALF * g.ldb * 2;
    const size_t tstepA = 2 * hstepA, tstepB = 2 * hstepB;
    const unsigned ldsw = (unsigned)wid * 1024u;
    const int aoff = lds_byte(wr * 64 + fr, fq * 8), boff = lds_byte(wc * 32 + fr, fq * 8);
#define PG8_SA(b, h) (((b) * 2 + (h)) * HTB)
#define PG8_SB(b, h) ((4 + (b) * 2 + (h)) * HTB)
#define PG8_STAGE(bufoff, gbase, voff) do { _Pragma("unroll") for (int _i = 0; _i < 2; ++_i) \
        __builtin_amdgcn_global_load_lds((const unsigned*)((const char*)(gbase) + (voff)[_i]), (LAS unsigned*)(lds + (bufoff) + ldsw + _i * 8192), 16, 0, 0); } while (0)
#define PG8_LDA(dst, b, h) do { _Pragma("unroll") for (int m = 0; m < 4; ++m) _Pragma("unroll") for (int k = 0; k < 2; ++k) dst[m][k] = *(const LAS bf16x8*)(lds + PG8_SA(b, h) + aoff + m * 2048 + k * 1024); } while (0)
#define PG8_LDB(dst, b, h) do { _Pragma("unroll") for (int n = 0; n < 2; ++n) _Pragma("unroll") for (int k = 0; k < 2; ++k) dst[n][k] = *(const LAS bf16x8*)(lds + PG8_SB(b, h) + boff + n * 2048 + k * 1024); } while (0)
#define PG8_MMA(ai, bj, At, Bt) do { __builtin_amdgcn_s_setprio(1); _Pragma("unroll") for (int m = 0; m < 4; ++m) _Pragma("unroll") for (int n = 0; n < 2; ++n) _Pragma("unroll") for (int k = 0; k < 2; ++k) \
        acc[ai][bj][m][n] = __builtin_amdgcn_mfma_f32_16x16x32_bf16(Bt[n][k], At[m][k], acc[ai][bj][m][n], 0, 0, 0); __builtin_amdgcn_s_setprio(0); } while (0)
#define PG8_WAIT_V(n) asm volatile("s_waitcnt vmcnt(" #n ")" ::: "memory")
#define PG8_WAIT_L(n) asm volatile("s_waitcnt lgkmcnt(" #n ")" ::: "memory")
#define PG8_BAR __builtin_amdgcn_s_barrier()
#define PG8_SCHED __builtin_amdgcn_sched_barrier(0)
    Unit cur, nxt; int ui = 0;
    if (!S.next(0, cur)) return;
    f32x4 acc[2][2][4][2];
#pragma unroll
    for (int a = 0; a < 2; ++a)
#pragma unroll
        for (int b = 0; b < 2; ++b)
#pragma unroll
            for (int m = 0; m < 4; ++m)
#pragma unroll
                for (int n = 0; n < 2; ++n) acc[a][b][m][n] = (f32x4){0.f, 0.f, 0.f, 0.f};
    bf16x8 At[4][2], B0[2][2], B1[2][2];
    const char* cA = (const char*)(g.A + (size_t)cur.pz * g.a_z) + (size_t)cur.pm * tstepA; const char* cB = (const char*)(g.Bt + (size_t)cur.pz * g.b_z) + (size_t)cur.pn * tstepB;
    PG8_STAGE(PG8_SB(0, 0), cB, voffB); PG8_STAGE(PG8_SB(0, 1), cB + hstepB, voffB); PG8_STAGE(PG8_SA(0, 0), cA, voffA); PG8_STAGE(PG8_SA(0, 1), cA + hstepA, voffA);
    if (wr == 1) PG8_BAR;
    PG8_WAIT_V(2); PG8_BAR;
    PG8_STAGE(PG8_SB(1, 0), cB + kstep, voffB); PG8_STAGE(PG8_SA(1, 0), cA + kstep, voffA); PG8_STAGE(PG8_SB(1, 1), cB + hstepB + kstep, voffB);
    PG8_WAIT_V(6); PG8_BAR;
    for (;;) {
        const bool has_next = S.next(ui + 1, nxt);
        const char* nA = has_next ? (const char*)(g.A + (size_t)nxt.pz * g.a_z) + (size_t)nxt.pm * tstepA : cA; const char* nB = has_next ? (const char*)(g.Bt + (size_t)nxt.pz * g.b_z) + (size_t)nxt.pn * tstepB : cB;
        for (int t = 0; t < nt; t += 2) {
            const bool last = (t == nt - 2);
            const char* a1 = cA + (size_t)(t + 1) * kstep;
            const char* a2 = last ? nA : cA + (size_t)(t + 2) * kstep; const char* b2 = last ? nB : cB + (size_t)(t + 2) * kstep;
            const char* a3 = a2 + kstep; const char* b3 = b2 + kstep;
            PG8_LDB(B0, 0, 0); PG8_LDB(B1, 0, 1); PG8_SCHED; PG8_LDA(At, 0, 0); PG8_STAGE(PG8_SA(1, 1), a1 + hstepA, voffA);
            PG8_WAIT_V(8); PG8_WAIT_L(0); PG8_BAR; PG8_MMA(0, 0, At, B0); PG8_MMA(0, 1, At, B1); PG8_BAR; PG8_SCHED;
            PG8_LDA(At, 0, 1); PG8_STAGE(PG8_SB(0, 0), b2, voffB); PG8_STAGE(PG8_SB(0, 1), b2 + hstepB, voffB); PG8_STAGE(PG8_SA(0, 0), a2, voffA);
            PG8_WAIT_V(8); PG8_WAIT_L(0); PG8_BAR; PG8_MMA(1, 0, At, B0); PG8_MMA(1, 1, At, B1); PG8_BAR; PG8_SCHED;
            PG8_LDB(B0, 1, 0); PG8_LDB(B1, 1, 1); PG8_SCHED; PG8_LDA(At, 1, 0); PG8_STAGE(PG8_SA(0, 1), a2 + hstepA, voffA);
            PG8_WAIT_V(8); PG8_WAIT_L(0); PG8_BAR; PG8_MMA(0, 0, At, B0); PG8_MMA(0, 1, At, B1); PG8_BAR; PG8_SCHED;
            PG8_LDA(At, 1, 1); PG8_STAGE(PG8_SB(1, 0), b3, voffB); PG8_STAGE(PG8_SB(1, 1), b3 + hstepB, voffB); PG8_STAGE(PG8_SA(1, 0), a3, voffA);
            PG8_WAIT_V(8); PG8_WAIT_L(0); PG8_BAR; PG8_MMA(1, 0, At, B0); PG8_MMA(1, 1, At, B1); PG8_BAR; PG8_SCHED;
        }
        if (wr == 0) PG8_BAR;
        E(acc, cur, wr, wc, fr, fq);
        if (!has_next) break;
#pragma unroll
        for (int a = 0; a < 2; ++a)
#pragma unroll
            for (int b = 0; b < 2; ++b)
#pragma unroll
                for (int m = 0; m < 4; ++m)
#pragma unroll
                    for (int n = 0; n < 2; ++n) acc[a][b][m][n] = (f32x4){0.f, 0.f, 0.f, 0.f};
        cur = nxt; cA = nA; cB = nB; ++ui;
        if (wr == 1) PG8_BAR;
    }
    PG8_WAIT_V(0);
    PG8_BAR;
#undef PG8_SA
#undef PG8_SB
#undef PG8_STAGE
#undef PG8_LDA
#undef PG8_LDB
#undef PG8_MMA
#undef PG8_WAIT_V
#undef PG8_WAIT_L
#undef PG8_BAR
#undef PG8_SCHED
}
}

struct Args {
    const float* in[36]; float* out; unsigned char* ws;
    int f_lo, f_hi, g_lo, g_hi, ph_lo, ph_hi, use_bar, pad;
};
struct Ctx {
    LAS unsigned char* lds;
    const float* const* in; float* out; unsigned char* ws;
    int tid, lane, wave, bid, G;
};
DI void refresh(Ctx& F) {
    asm volatile("" : "+v"(F.tid)); F.lane = F.tid & 63; F.wave = __builtin_amdgcn_readfirstlane(F.tid >> 6);
}
enum { I_X = 0, I_C, I_NORMW, I_FNORMW, I_ADAW, I_ADAB, I_FUP, I_FDN, I_WIN, I_WINV, I_CONVW, I_CONVB, I_WQ, I_WK, I_IB, I_FB, I_MLNW, I_MLSKIP,
       I_MU, I_MUV, I_W0, I_W2, I_A0, I_A2, I_V0, I_V2, I_G2, I_KK, I_KA, I_RK, I_LNW, I_LNB, I_LBL, I_HGNW, I_WBR, I_WOUT };

DI void transpose_item(const float* W, int ldw, int k0, int c0, bf16* WT, int ldt, int r0, float scale, LAS float* scr, int lane) {
#pragma unroll 8
    for (int i = 0; i < 32; ++i) { const int kk = 2 * i + (lane >> 5); scr[kk * 33 + (lane & 31)] = W[(size_t)(k0 + kk) * ldw + c0 + (lane & 31)]; }
    LDS_WAIT(); asm volatile("" ::: "memory");
    const int c = lane & 7;
#pragma unroll
    for (int j = 0; j < 4; ++j) { const int n = (lane >> 3) + 8 * j; const LAS float* s = scr + (8 * c) * 33 + n;
        v4u o; o.x = pk2(s[0 * 33] * scale, s[1 * 33] * scale); o.y = pk2(s[2 * 33] * scale, s[3 * 33] * scale); o.z = pk2(s[4 * 33] * scale, s[5 * 33] * scale); o.w = pk2(s[6 * 33] * scale, s[7 * 33] * scale);
        *(v4u*)(WT + (size_t)(r0 + n) * ldt + k0 + 8 * c) = o; }
    LDS_WAIT(); asm volatile("" ::: "memory");
}
DI void phase_weights(const Ctx& F, int l) {
    LAS float* scr = (LAS float*)(F.lds + F.wave * 16384);
    const int gw = F.bid * NWAVES + F.wave, NGW = F.G * NWAVES;
    constexpr int I_UP = 16 * 176, I_DN = 44 * 32, I_IN = 16 * 392, I_SQ = 16 * 32, I_QKI = 8 * 32;
    constexpr int NITEMS = 2 * I_UP + 2 * I_DN + I_IN + 4 * I_SQ + I_QKI;
    bf16* WUP = (bf16*)(F.ws + WS_WUP); bf16* WDN = (bf16*)(F.ws + WS_WDN); bf16* WIN = (bf16*)(F.ws + WS_WIN); bf16* WBR = (bf16*)(F.ws + WS_WBR);
    bf16* WOUT = (bf16*)(F.ws + WS_WOUT); bf16* WQK = (bf16*)(F.ws + WS_WQK);
    for (int it = gw; it < NITEMS; it += NGW) {
        int r = it;
        if (r < 2 * I_UP) { const int i = r / I_UP; r -= i * I_UP; const int kb = r / 176, nb = r % 176, c0 = 32 * nb; const int cc = c0 < DFF ? c0 : c0 - DFF;
            const int r0 = (cc / 128) * 256 + (c0 < DFF ? 0 : 128) + (cc % 128);
            transpose_item(F.in[I_FUP] + (size_t)(l * 2 + i) * D * NUP, NUP, 64 * kb, c0, WUP + (size_t)i * NUP * D, D, r0, 1.f, scr, F.lane); continue; }
        r -= 2 * I_UP;
        if (r < 2 * I_DN) { const int i = r / I_DN; r -= i * I_DN; const int kb = r / 32, nb = r % 32;
            transpose_item(F.in[I_FDN] + (size_t)(l * 2 + i) * DFF * D, D, 64 * kb, 32 * nb, WDN + (size_t)i * D * DFF, DFF, 32 * nb, 1.f, scr, F.lane); continue; }
        r -= 2 * I_DN;
        if (r < I_IN) { const int kb = r / 392, nb = r % 392, d0 = 32 * nb, c0 = d0 + (d0 >= 2048 ? 8 : 0);
            transpose_item(F.in[I_WIN] + (size_t)l * D * WIN_SRC, WIN_SRC, 64 * kb, c0, WIN, D, d0, 1.f, scr, F.lane); continue; }
        r -= I_IN;
        if (r < 3 * I_SQ) { const int n = r / I_SQ; r -= n * I_SQ; const int kb = r / 32, nb = r % 32;
            transpose_item(F.in[I_WBR] + (size_t)(l * 3 + n) * D * D, D, 64 * kb, 32 * nb, WBR + (size_t)n * D * D, D, 32 * nb, 1.f, scr, F.lane); continue; }
        r -= 3 * I_SQ;
        if (r < I_SQ) { const int kb = r / 32, nb = r % 32;
            transpose_item(F.in[I_WOUT] + (size_t)l * D * D, D, 64 * kb, 32 * nb, WOUT, D, 32 * nb, 1.f, scr, F.lane); continue; }
        r -= I_SQ;
        { const int mat = r / 32, rr = r % 32, h = mat >> 1, isk = mat & 1, kb = rr / 8, nb = rr % 8;
            transpose_item(F.in[isk ? I_WK : I_WQ] + (size_t)(l * 4 + h) * 256 * 256, 256, 64 * kb, 32 * nb, WQK + (size_t)(h * 512 + isk * 256) * 256, 256, 32 * nb, isk ? 0.0625f : 1.f, scr, F.lane); }
    }
    const int gt = F.bid * NTHREADS + F.tid, NT = F.G * NTHREADS;
    bf16* WL = (bf16*)(F.ws + WS_WLORA);
    for (int idx = gt; idx < NLORA * (KLORA / 8); idx += NT) {
        const int n = idx & (NLORA - 1), kc = idx >> 12, k0 = kc * 8, blk = n >> 10, nn = n & 1023;
        float o[8];
#pragma unroll
        for (int i = 0; i < 8; ++i) o[i] = 0.f;
        const float* src = nullptr; int kk = 0;
        if (blk == 0 && k0 < 64) { src = F.in[I_W2] + (size_t)l * 64 * D; kk = k0; }
        else if (blk == 1 && k0 >= 64 && k0 < 128) { src = F.in[I_A2] + (size_t)l * 64 * D; kk = k0 - 64; }
        else if (blk == 2 && k0 >= 128 && k0 < 256) { src = F.in[I_G2] + (size_t)l * 128 * D; kk = k0 - 128; }
        else if (blk == 3 && l == 1 && k0 >= 256 && k0 < 288) { src = F.in[I_V2]; kk = k0 - 256; }
        if (src) {
#pragma unroll
            for (int i = 0; i < 8; ++i) o[i] = src[(size_t)(kk + i) * D + nn]; }
        *(v4u*)(WL + (size_t)n * KLORA + k0) = pack8(o);
    }
    float* WS_ = (float*)(F.ws + WS_WSIDE);
    for (int idx = gt; idx < NSIDE * D; idx += NT) {
        const int j = idx >> 10, k = idx & 1023; float v = 0.f;
        if (j < 8) v = F.in[I_WIN][(size_t)l * D * WIN_SRC + (size_t)k * WIN_SRC + 2048 + j];
        else if (l == 1) v = F.in[I_WINV][(size_t)k * 32 + (j - 8)];
        WS_[idx] = v;
    }
}
DI void phase_mod(const Ctx& F) {
    LAS float* sc = (LAS float*)F.lds; LAS float* red = (LAS float*)(F.lds + 65536);
    float* mod = (float*)(F.ws + WS_MOD);
    bool loaded = false;
    for (int it = F.bid; it < 2 * 144; it += F.G) {
        if (!loaded) { for (int i = F.tid; i < NB * D; i += NTHREADS) sc[i] = siluf_(F.in[I_C][i]); loaded = true; __syncthreads(); }
        const int l = it / 144, n0 = (it % 144) * 64, n = F.tid & 63, ks = F.tid >> 6;
        float acc[16];
#pragma unroll
        for (int b = 0; b < 16; ++b) acc[b] = 0.f;
        const float* wp = F.in[I_ADAW] + (size_t)l * D * NMOD + n0 + n;
        for (int k = ks * 128; k < ks * 128 + 128; ++k) { const float w = wp[(size_t)k * NMOD];
#pragma unroll
            for (int b = 0; b < 16; ++b) acc[b] += sc[b * D + k] * w; }
#pragma unroll
        for (int b = 0; b < 16; ++b) red[(ks * 16 + b) * 64 + n] = acc[b];
        __syncthreads();
        for (int o = F.tid; o < 1024; o += NTHREADS) { const int b = o >> 6, nn = o & 63; float s = 0.f;
#pragma unroll
            for (int k8 = 0; k8 < 8; ++k8) s += red[(k8 * 16 + b) * 64 + nn];
            mod[(size_t)(l * 16 + b) * NMOD + n0 + nn] = s + F.in[I_ADAB][(size_t)l * NMOD + n0 + nn]; }
        __syncthreads();
    }
}

template <bool SIDE>
DI void phase_modulate(const Ctx& F, const float* x, bf16* hout, const float* nw, const float* modl, int sub, int r0, int nrows, float* side) {
    const int gw = F.bid * NWAVES + F.wave, NGW = F.G * NWAVES;
    const float* wside = (const float*)(F.ws + WS_WSIDE);
    for (int r = gw; r < nrows; r += NGW) {
        const int row = r0 + r, b = row / T;
        const f32x4* xr = (const f32x4*)(x + (size_t)row * D) + F.lane;
        f32x4 v[4]; float ss = 0.f;
#pragma unroll
        for (int j = 0; j < 4; ++j) { v[j] = xr[64 * j]; ss += (v[j].x * v[j].x + v[j].y * v[j].y) + (v[j].z * v[j].z + v[j].w * v[j].w); }
        const float rstd = 1.0f / sqrtf(wave_sum(ss) * (1.f / D) + 1e-6f);
        const f32x4* nwp = (const f32x4*)nw + F.lane;
        const f32x4* shp = (const f32x4*)(modl + (size_t)b * NMOD + (sub * 3 + 0) * D) + F.lane;
        const f32x4* scp = (const f32x4*)(modl + (size_t)b * NMOD + (sub * 3 + 1) * D) + F.lane;
        unsigned long long* o8 = (unsigned long long*)(hout + (size_t)r * D) + F.lane;
#pragma unroll
        for (int j = 0; j < 4; ++j) { v[j] = v[j] * rstd * nwp[64 * j] * (scp[64 * j] + 1.0f) + shp[64 * j];
            o8[64 * j] = (unsigned long long)pk2(v[j].x, v[j].y) | ((unsigned long long)pk2(v[j].z, v[j].w) << 32); }
        if (SIDE) {
            for (int jj = 0; jj < NSIDE; ++jj) { const f32x4* wp = (const f32x4*)(wside + jj * D) + F.lane; float s = 0.f;
#pragma unroll
                for (int j = 0; j < 4; ++j) { const f32x4 w = wp[64 * j]; s += (v[j].x * w.x + v[j].y * w.y) + (v[j].z * w.z + v[j].w * w.w); }
                s = wave_sum(s);
                if (F.lane == 0) side[(size_t)r * NSIDE + jj] = s; }
        }
    }
}
DI void phase_final_norm(const Ctx& F) {
    const int gw = F.bid * NWAVES + F.wave, NGW = F.G * NWAVES;
    for (int row = gw; row < M; row += NGW) {
        f32x4* xr = (f32x4*)(F.out + (size_t)row * D) + F.lane;
        f32x4 v[4]; float ss = 0.f;
#pragma unroll
        for (int j = 0; j < 4; ++j) { v[j] = xr[64 * j]; ss += (v[j].x * v[j].x + v[j].y * v[j].y) + (v[j].z * v[j].z + v[j].w * v[j].w); }
        const float rstd = 1.0f / sqrtf(wave_sum(ss) * (1.f / D) + 1e-6f);
        const f32x4* nwp = (const f32x4*)F.in[I_FNORMW] + F.lane;
#pragma unroll
        for (int j = 0; j < 4; ++j) xr[64 * j] = v[j] * rstd * nwp[64 * j];
    }
}

DI void phase_prep(const Ctx& F, int l) {
    const int gt = F.bid * NTHREADS + F.tid, NT = F.G * NTHREADS;
    const bf16* Z = (const bf16*)(F.ws + WS_Z); bf16* XC = (bf16*)(F.ws + WS_XC); bf16* LA = (bf16*)(F.ws + WS_LA); const float* SD = (const float*)(F.ws + WS_SIDE);
    const float* cw = F.in[I_CONVW] + (size_t)l * 4 * D; const float* cb = F.in[I_CONVB] + (size_t)l * D;
    const float* mu = F.in[I_MU] + (size_t)l * 3328;
    for (int idx = gt; idx < MG * 128; idx += NT) {
        const int row = idx >> 7, c8 = (idx & 127) * 8, t = row & (T - 1);
        float a[8], x[8];
#pragma unroll
        for (int i = 0; i < 8; ++i) a[i] = cb[c8 + i];
#pragma unroll
        for (int j = 0; j < 4; ++j) { if (t >= 3 - j) { unpack8(*(const v4u*)(Z + (size_t)(row - 3 + j) * NZ + ZC_MLX + c8), x);
#pragma unroll
                for (int i = 0; i < 8; ++i) a[i] += cw[j * D + c8 + i] * x[i]; } }
#pragma unroll
        for (int i = 0; i < 8; ++i) a[i] = siluf_(a[i]);
        *(v4u*)(XC + (size_t)row * D + c8) = pack8(a);
    }
    for (int idx = gt; idx < MG * 48; idx += NT) {
        const int row = idx / 48, k0 = (idx - row * 48) * 8, t = row & (T - 1);
        float o[8];
#pragma unroll
        for (int i = 0; i < 8; ++i) o[i] = 0.f;
        if (k0 < 256) { float cur[8], prv[8];
            unpack8(*(const v4u*)(Z + (size_t)row * NZ + ZC_RW + 3072 + k0), cur);
            if (t > 0) unpack8(*(const v4u*)(Z + (size_t)(row - 1) * NZ + ZC_RW + 3072 + k0), prv); else {
#pragma unroll
                for (int i = 0; i < 8; ++i) prv[i] = 0.f; }
#pragma unroll
            for (int i = 0; i < 8; ++i) { const float s = cur[i] + mu[3072 + k0 + i] * (prv[i] - cur[i]); o[i] = k0 < 64 ? tanhf(s) : (k0 < 128 ? s : sigmoidf_(s)); }
        } else if (l == 1 && k0 < 288) {
#pragma unroll
            for (int i = 0; i < 8; ++i) { const int j = k0 - 256 + i; const float cur = SD[(size_t)row * NSIDE + 8 + j], prv = t > 0 ? SD[(size_t)(row - 1) * NSIDE + 8 + j] : 0.f;
                o[i] = cur + F.in[I_MUV][j] * (prv - cur); }
        }
        *(v4u*)(LA + (size_t)row * KLORA + k0) = pack8(o);
    }
}

DI void scan_writeout(const Ctx& F, const LAS float* YT, bf16* dst  , int ld) {
    const int s = F.tid >> 4, r2 = (F.tid & 15) * 2;
    *(unsigned*)(dst + (size_t)s * ld + r2) = pk2(YT[s * 32 + r2], YT[s * 32 + r2 + 1]);
}
DI void scan_rwkv(const Ctx& F, int l, int g, int unit) {
    const int half = unit & 1, h = (unit >> 1) & 15, bl = unit >> 5;
    LAS float* TW = (LAS float*)F.lds; LAS float* TKP = TW + 2048; LAS float* TB = TW + 4096; LAS float* TKK = TW + 6144; LAS float* TR = TW + 8192; LAS float* TV = TW + 10240; LAS float* YT = TW + 12288;
    const bf16* Z = (const bf16*)(F.ws + WS_Z); const bf16* LO = (const bf16*)(F.ws + WS_LO); bf16* VF = (bf16*)(F.ws + WS_VF); bf16* BON = (bf16*)(F.ws + WS_BON);
    bf16* RAW = (bf16*)(F.ws + WS_RAW) + (size_t)1 * MG * D;
    const int gc = h * 64 + F.lane;
    const float mu_r = F.in[I_MU][l * 3328 + gc], mu_k = F.in[I_MU][l * 3328 + 1024 + gc], mu_v = F.in[I_MU][l * 3328 + 2048 + gc];
    const float w0 = F.in[I_W0][l * D + gc], a0 = F.in[I_A0][l * D + gc], kkc = F.in[I_KK][l * D + gc], kac = F.in[I_KA][l * D + gc], rk = F.in[I_RK][l * D + gc];
    const float v0 = l == 1 ? F.in[I_V0][gc] : 0.f;
    const int rowl = F.tid >> 4, ks = F.tid & 15;
    float s0 = 0.f, s1 = 0.f, s2 = 0.f, s3 = 0.f;
    for (int tt = 0; tt < T / 32; ++tt) {
        {
            const int sb = F.wave * 4, t0 = tt * 32 + sb; const size_t lrow0 = (size_t)bl * T + t0;
            float pr = 0.f, pk = 0.f, pv = 0.f;
            if (t0 > 0) { const bf16* zp = Z + (lrow0 - 1) * NZ + ZC_RW + gc; pr = bf1(zp[0]); pk = bf1(zp[1024]); pv = bf1(zp[2048]); }
#pragma unroll
            for (int j = 0; j < 4; ++j) {
                const size_t lrow = lrow0 + j; const bf16* zp = Z + lrow * NZ + ZC_RW + gc;
                const float zr = bf1(zp[0]), zk = bf1(zp[1024]), zv = bf1(zp[2048]);
                const float r = zr + mu_r * (pr - zr), k = zk + mu_k * (pk - zk); float v = zv + mu_v * (pv - zv);
                pr = zr; pk = zk; pv = zv;
                const bf16* lp = LO + lrow * NLORA + gc;
                const float xw = w0 + bf1(lp[0]); const float wraw = -softplusf_(-xw) - 0.5f; const float w = __expf(-__expf(wraw));
                const float a = sigmoidf_(a0 + bf1(lp[1024]));
                const size_t grow = (size_t)g * MG + lrow;
                if (l == 0) { if (half == 0) VF[grow * D + gc] = (bf16)f2bf(v); }
                else { const float vf = bf1(VF[grow * D + gc]); v = v + (vf - v) * sigmoidf_(v0 + bf1(lp[3072])); }
                const float kk = k * kkc; const float nrm = sqrtf(wave_sum(kk * kk)); const float kn = kk / fmaxf(nrm, 1e-12f);
                const float kp = k * (1.0f + (a - 1.0f) * kac);
                const float bsum = wave_sum(r * kp * rk);
                if (half == 0) BON[lrow * D + gc] = (bf16)f2bf(bsum * v);
                const int s = sb + j;
                TW[s * 64 + F.lane] = w; TKP[s * 64 + F.lane] = kp; TB[s * 64 + F.lane] = kn * a; TKK[s * 64 + F.lane] = kn; TR[s * 64 + F.lane] = r; TV[s * 64 + F.lane] = v;
            }
        }
        __syncthreads();
#pragma unroll 4
        for (int s = 0; s < 32; ++s) {
            const f32x4 kk = *(const LAS f32x4*)(TKK + s * 64 + ks * 4), w = *(const LAS f32x4*)(TW + s * 64 + ks * 4), b = *(const LAS f32x4*)(TB + s * 64 + ks * 4);
            const f32x4 kp = *(const LAS f32x4*)(TKP + s * 64 + ks * 4), r = *(const LAS f32x4*)(TR + s * 64 + ks * 4);
            const float vv = TV[s * 64 + half * 32 + rowl];
            const float u = sum16((s0 * kk.x + s1 * kk.y) + (s2 * kk.z + s3 * kk.w));
            s0 = s0 * w.x - u * b.x + vv * kp.x; s1 = s1 * w.y - u * b.y + vv * kp.y; s2 = s2 * w.z - u * b.z + vv * kp.z; s3 = s3 * w.w - u * b.w + vv * kp.w;
            const float y = sum16((s0 * r.x + s1 * r.y) + (s2 * r.z + s3 * r.w));
            if (ks == 0) YT[s * 32 + rowl] = y;
        }
        __syncthreads();
        scan_writeout(F, YT, RAW + ((size_t)bl * T + tt * 32) * D + h * 64 + half * 32, D);
    }
    __syncthreads();
}
DI void scan_hgrn(const Ctx& F, int l, int unit) {
    const int qt = unit & 3, h = (unit >> 2) & 7, bl = unit >> 5;
    LAS float* TQ = (LAS float*)F.lds; LAS float* TF = TQ + 4096; LAS float* TK = TQ + 8192; LAS float* TV = TQ + 12288; LAS float* YT = TQ + 13312;
    const bf16* Z = (const bf16*)(F.ws + WS_Z); bf16* RAW = (bf16*)(F.ws + WS_RAW) + (size_t)2 * MG * D;
    const int ps = F.tid >> 4, pc = (F.tid & 15) * 8;
    float lb[8];
#pragma unroll
    for (int i = 0; i < 8; ++i) lb[i] = l == 0 ? 0.f : sigmoidf_(F.in[I_LBL][D + h * 128 + pc + i] - F.in[I_LBL][h * 128 + pc + i]);
    const int el = F.tid >> 4, ds = F.tid & 15;
    float S[8];
#pragma unroll
    for (int i = 0; i < 8; ++i) S[i] = 0.f;
    for (int tt = 0; tt < T / 32; ++tt) {
        {
            const size_t lrow = (size_t)bl * T + tt * 32 + ps; float q[8], f[8], kk[8];
            unpack8(*(const v4u*)(Z + lrow * NZ + ZC_HGQ + h * 128 + pc), q); unpack8(*(const v4u*)(Z + lrow * NZ + ZC_HGF + h * 128 + pc), f);
#pragma unroll
            for (int i = 0; i < 8; ++i) { q[i] = siluf_(q[i]); const float sg = sigmoidf_(f[i]); kk[i] = (1.0f - lb[i]) * (1.0f - sg); f[i] = fmaxf(lb[i] + (1.0f - lb[i]) * sg, 1e-30f); }
            *(LAS f32x4*)(TQ + ps * 128 + pc) = (f32x4){q[0], q[1], q[2], q[3]}; *(LAS f32x4*)(TQ + ps * 128 + pc + 4) = (f32x4){q[4], q[5], q[6], q[7]};
            *(LAS f32x4*)(TF + ps * 128 + pc) = (f32x4){f[0], f[1], f[2], f[3]}; *(LAS f32x4*)(TF + ps * 128 + pc + 4) = (f32x4){f[4], f[5], f[6], f[7]};
            *(LAS f32x4*)(TK + ps * 128 + pc) = (f32x4){kk[0], kk[1], kk[2], kk[3]}; *(LAS f32x4*)(TK + ps * 128 + pc + 4) = (f32x4){kk[4], kk[5], kk[6], kk[7]};
            const unsigned vw = *(const unsigned*)(Z + lrow * NZ + ZC_HGI + h * 128 + qt * 32 + (F.tid & 15) * 2);
            TV[ps * 32 + (F.tid & 15) * 2] = bflo(vw); TV[ps * 32 + (F.tid & 15) * 2 + 1] = bfhi(vw);
        }
        __syncthreads();
#pragma unroll 4
        for (int s = 0; s < 32; ++s) {
            const float vv = TV[s * 32 + el]; float o = 0.f;
#pragma unroll
            for (int j = 0; j < 2; ++j) { const f32x4 q = *(const LAS f32x4*)(TQ + s * 128 + j * 64 + ds * 4), f = *(const LAS f32x4*)(TF + s * 128 + j * 64 + ds * 4), kk = *(const LAS f32x4*)(TK + s * 128 + j * 64 + ds * 4);
#pragma unroll
                for (int i = 0; i < 4; ++i) { S[j * 4 + i] = f[i] * S[j * 4 + i] + kk[i] * vv; o += S[j * 4 + i] * q[i]; } }
            o = sum16(o);
            if (ds == 0) YT[s * 32 + el] = o;
        }
        __syncthreads();
        scan_writeout(F, YT, RAW + ((size_t)bl * T + tt * 32) * D + h * 128 + qt * 32, D);
    }
    __syncthreads();
}
DI void scan_mlstm(const Ctx& F, int l, int unit) {
    const int e8 = unit & 7, h = (unit >> 3) & 3, bl = unit >> 5;
    LAS float* TQ = (LAS float*)F.lds; LAS float* TKI = TQ + 8192; LAS float* TV = TQ + 16384; LAS float* YT = TQ + 17408;
    LAS float* TLI = TQ + 18432; LAS float* TLF = TLI + 32; LAS float* TFG = TLI + 64; LAS float* TIG = TLI + 96; LAS float* TEM = TLI + 128; LAS float* MC = TLI + 160;
    const bf16* Z = (const bf16*)(F.ws + WS_Z); const bf16* QK = (const bf16*)(F.ws + WS_QK); const float* SD = (const float*)(F.ws + WS_SIDE);
    bf16* RAW = (bf16*)(F.ws + WS_RAW);
    const float ib = F.in[I_IB][l * 4 + h], fb = F.in[I_FB][l * 4 + h];
    const int ps = F.tid >> 4, pc = (F.tid & 15) * 16;
    const int el = F.tid >> 4, ds = F.tid & 15;
    float C[16], N[16];
#pragma unroll
    for (int i = 0; i < 16; ++i) { C[i] = 0.f; N[i] = 0.f; }
    if (F.tid == 0) MC[0] = 0.f;
    for (int tt = 0; tt < T / 32; ++tt) {
        if (F.wave == 0) {
            if (F.lane < 32) { const size_t lrow = (size_t)bl * T + tt * 32 + F.lane;
                TLI[F.lane] = SD[lrow * NSIDE + h] + ib; TLF[F.lane] = -softplusf_(-(SD[lrow * NSIDE + 4 + h] + fb)); }
            LDS_WAIT(); asm volatile("" ::: "memory");
            if (F.lane == 0) { float m = MC[0];
                for (int s = 0; s < 32; ++s) { const float lf = TLF[s], li = TLI[s], mp = m; m = fmaxf(mp + lf, li); TFG[s] = __expf(lf + mp - m); TIG[s] = __expf(li - m); TEM[s] = __expf(-m); }
                MC[0] = m; }
        }
        __syncthreads();
        {
            const size_t lrow = (size_t)bl * T + tt * 32 + ps; const float ig = TIG[ps]; float q[8], k[8];
#pragma unroll
            for (int hh = 0; hh < 2; ++hh) {
                unpack8(*(const v4u*)(QK + lrow * 2048 + h * 512 + pc + hh * 8), q); unpack8(*(const v4u*)(QK + lrow * 2048 + h * 512 + 256 + pc + hh * 8), k);
                *(LAS f32x4*)(TQ + ps * 256 + pc + hh * 8) = (f32x4){q[0], q[1], q[2], q[3]}; *(LAS f32x4*)(TQ + ps * 256 + pc + hh * 8 + 4) = (f32x4){q[4], q[5], q[6], q[7]};
                *(LAS f32x4*)(TKI + ps * 256 + pc + hh * 8) = (f32x4){k[0] * ig, k[1] * ig, k[2] * ig, k[3] * ig}; *(LAS f32x4*)(TKI + ps * 256 + pc + hh * 8 + 4) = (f32x4){k[4] * ig, k[5] * ig, k[6] * ig, k[7] * ig};
            }
            const unsigned vw = *(const unsigned*)(Z + lrow * NZ + ZC_MLX + h * 256 + e8 * 32 + (F.tid & 15) * 2);
            TV[ps * 32 + (F.tid & 15) * 2] = bflo(vw); TV[ps * 32 + (F.tid & 15) * 2 + 1] = bfhi(vw);
        }
        __syncthreads();
#pragma unroll 2
        for (int s = 0; s < 32; ++s) {
            const float vv = TV[s * 32 + el], fg = TFG[s], em = TEM[s]; float num = 0.f, den = 0.f;
#pragma unroll
            for (int j = 0; j < 4; ++j) { const f32x4 q = *(const LAS f32x4*)(TQ + s * 256 + j * 64 + ds * 4), ki = *(const LAS f32x4*)(TKI + s * 256 + j * 64 + ds * 4);
#pragma unroll
                for (int i = 0; i < 4; ++i) { C[j * 4 + i] = fg * C[j * 4 + i] + ki[i] * vv; N[j * 4 + i] = fg * N[j * 4 + i] + ki[i]; num += C[j * 4 + i] * q[i]; den += N[j * 4 + i] * q[i]; } }
            num = sum16(num); den = sum16(den);
            if (ds == 0) YT[s * 32 + el] = num / fmaxf(fabsf(den), em);
        }
        __syncthreads();
        scan_writeout(F, YT, RAW + ((size_t)bl * T + tt * 32) * D + h * 256 + e8 * 32, D);
    }
    __syncthreads();
}

DI void phase_post(const Ctx& F, int l) {
    const int gw = F.bid * NWAVES + F.wave, NGW = F.G * NWAVES;
    const bf16* Z = (const bf16*)(F.ws + WS_Z); const bf16* XC = (const bf16*)(F.ws + WS_XC); const bf16* LO = (const bf16*)(F.ws + WS_LO); const bf16* BON = (const bf16*)(F.ws + WS_BON);
    bf16* RAW = (bf16*)(F.ws + WS_RAW);
    const int c0 = F.lane * 16;
    for (int row = gw; row < MG; row += NGW) {
        float a[16], b[16], c[16];
        { bf16* rp = RAW + (size_t)row * D + c0;
            unpack16(rp, a);
            unpack16(Z + (size_t)row * NZ + ZC_MLO + c0, b);
            unpack16(XC + (size_t)row * D + c0, c);
            float s = 0.f;
#pragma unroll
            for (int i = 0; i < 16; ++i) { a[i] *= sigmoidf_(b[i]); s += a[i]; }
            const float mean = sum16(s) * (1.f / 256.f); float q = 0.f;
#pragma unroll
            for (int i = 0; i < 16; ++i) { a[i] -= mean; q += a[i] * a[i]; }
            const float rstd = 1.0f / sqrtf(sum16(q) * (1.f / 256.f) + 1e-6f);
#pragma unroll
            for (int i = 0; i < 16; ++i) a[i] = a[i] * rstd * F.in[I_MLNW][l * D + c0 + i] + F.in[I_MLSKIP][l * D + c0 + i] * c[i];
            pack16(rp, a); }
        { bf16* rp = RAW + (size_t)(MG + row) * D + c0;
            unpack16(rp, a);
            unpack16(BON + (size_t)row * D + c0, b);
            unpack16(LO + (size_t)row * NLORA + 2048 + c0, c);
            float s = 0.f;
#pragma unroll
            for (int i = 0; i < 16; ++i) s += a[i];
            const float mean = sum4(s) * (1.f / 64.f); float q = 0.f;
#pragma unroll
            for (int i = 0; i < 16; ++i) { a[i] -= mean; q += a[i] * a[i]; }
            const float rstd = 1.0f / sqrtf(sum4(q) * (1.f / 64.f) + 64e-5f);
#pragma unroll
            for (int i = 0; i < 16; ++i) a[i] = (a[i] * rstd * F.in[I_LNW][l * D + c0 + i] + F.in[I_LNB][l * D + c0 + i] + b[i]) * c[i];
            pack16(rp, a); }
        { bf16* rp = RAW + (size_t)(2 * MG + row) * D + c0;
            unpack16(rp, a);
            unpack16(Z + (size_t)row * NZ + ZC_HGG + c0, b);
            float q = 0.f;
#pragma unroll
            for (int i = 0; i < 16; ++i) q += a[i] * a[i];
            const float rstd = 1.0f / sqrtf(sum8(q) * (1.f / 128.f) + 1e-6f);
#pragma unroll
            for (int i = 0; i < 16; ++i) a[i] = a[i] * rstd * F.in[I_HGNW][l * D + c0 + i] * sigmoidf_(b[i]);
            pack16(rp, a); }
    }
}

enum { PH_W = 0, PH_A1, PH_A2, PH_A3, PH_B1, PH_B2, PH_B3, PH_B4, PH_B5, PH_B6, PH_B7, PH_B8, PH_FIN, PH_N };

__global__ void __launch_bounds__(NTHREADS, 2) fwd_kernel(Args args) {
    extern __shared__ __attribute__((aligned(16))) unsigned char lds_raw[];
    Ctx F;
    F.lds = (LAS unsigned char*)lds_raw; F.in = args.in; F.out = args.out; F.ws = args.ws;
    F.tid = threadIdx.x; F.lane = F.tid & 63; F.wave = __builtin_amdgcn_readfirstlane(F.tid >> 6); F.bid = blockIdx.x; F.G = gridDim.x;
    volatile LAS unsigned* MISC = (volatile LAS unsigned*)(F.lds + MISC_OFF);
    if (F.tid < 32) MISC[F.tid] = 0u;
    __syncthreads();
    XcdBarrier bar; bar.bar = (unsigned*)(F.ws + WS_CTL) + CW_BAR; bar.x = 0; bar.st = nullptr;
    if (args.use_bar) bar = xcd_barrier_post((unsigned*)(F.ws + WS_CTL) + CW_BAR, MISC + 8);
#ifndef PHMASK
#define PHMASK 0xFFFF
#endif
#define IN(k) (((PHMASK >> (k)) & 1) && args.ph_lo <= (k) && (k) < args.ph_hi)
#define PHASE(k) if (IN(k) && (refresh(F), true))
#define SEAM() do { if (args.use_bar) xcd_barrier(bar); } while (0)
    const float* MOD = (const float*)(F.ws + WS_MOD);
    for (int f = args.f_lo; f < args.f_hi; ++f) {
        const int l = f >> 1, fi = f & 1;
        const float* modl = MOD + (size_t)l * NB * NMOD;
        if (fi == 0) PHASE(PH_W) { phase_weights(F, l); if (l == 0) { __syncthreads(); phase_mod(F); } SEAM(); }
        const int sub = fi ? 2 : 0;
        const float* xsrc = (f == 0) ? F.in[I_X] : F.out;
        PHASE(PH_A1) { phase_modulate<false>(F, xsrc, (bf16*)(F.ws + WS_H), F.in[I_NORMW] + (size_t)(l * 3 + sub) * D, modl, sub, 0, M, nullptr); SEAM(); }
        PHASE(PH_A2) {
            pg8::Gemm gm{(const bf16*)(F.ws + WS_H), (const bf16*)(F.ws + WS_WUP) + (size_t)fi * NUP * D, D, D, D, 0, 0};
            pg8::Order<0> S; S.init(M / 256, NUP / 256, F.G, F.bid);
            pg8::EpiSwiGLU E{(bf16*)(F.ws + WS_HID), DFF};
            pg8::gemm_phase(F.lds, gm, S, E); SEAM(); }
        PHASE(PH_A3) {
            pg8::Gemm gm{(const bf16*)(F.ws + WS_HID), (const bf16*)(F.ws + WS_WDN) + (size_t)fi * D * DFF, DFF, DFF, DFF, 0, 0};
            pg8::Order<0> S; S.init(M / 256, D / 256, F.G, F.bid);
            pg8::EpiResid E{xsrc, F.out, modl + (sub * 3 + 2) * D, 0.5f, 0};
            pg8::gemm_phase(F.lds, gm, S, E); SEAM(); }
        if (fi == 0) {
            for (int g = args.g_lo; g < args.g_hi; ++g) {
                float* xg = F.out + (size_t)g * MG * D;
                PHASE(PH_B1) { phase_modulate<true>(F, F.out, (bf16*)(F.ws + WS_HG), F.in[I_NORMW] + (size_t)(l * 3 + 1) * D, modl, 1, g * MG, MG, (float*)(F.ws + WS_SIDE)); SEAM(); }
                PHASE(PH_B2) {
                    pg8::Gemm gm{(const bf16*)(F.ws + WS_HG), (const bf16*)(F.ws + WS_WIN), D, D, D, 0, 0};
                    pg8::Order<0> S; S.init(MG / 256, NZ / 256, F.G, F.bid);
                    pg8::EpiBf16 E{(bf16*)(F.ws + WS_Z), NZ, 0};
                    pg8::gemm_phase(F.lds, gm, S, E); SEAM(); }
                PHASE(PH_B3) { phase_prep(F, l); SEAM(); }
                PHASE(PH_B4) {
                    { pg8::Gemm gm{(const bf16*)(F.ws + WS_XC), (const bf16*)(F.ws + WS_WQK), 256, D, 256, 256, (size_t)512 * 256};
                      pg8::Order<1> S; S.init(MG / 256, 8, F.G, F.bid);
                      pg8::EpiBf16 E{(bf16*)(F.ws + WS_QK), 2048, 512};
                      pg8::gemm_phase(F.lds, gm, S, E); }
                    __syncthreads();
                    { pg8::Gemm gm{(const bf16*)(F.ws + WS_LA), (const bf16*)(F.ws + WS_WLORA), l == 0 ? 256 : 384, KLORA, KLORA, 0, 0};
                      pg8::Order<0> S; S.init(MG / 256, l == 0 ? 12 : 16, F.G, F.bid);
                      pg8::EpiBf16 E{(bf16*)(F.ws + WS_LO), NLORA, 0};
                      pg8::gemm_phase(F.lds, gm, S, E); }
                    SEAM(); }
                PHASE(PH_B5) {
                    for (int u = F.bid; u < 384; u += F.G) {
                        if (u < 128) scan_rwkv(F, l, g, u); else if (u < 256) scan_mlstm(F, l, u - 128); else scan_hgrn(F, l, u - 256);
                    }
                    SEAM(); }
                PHASE(PH_B6) {
                    phase_post(F, l);
                    __syncthreads();
                    { pg8::Gemm gm{(const bf16*)(F.ws + WS_HG), (const bf16*)(F.ws + WS_WIN) + (size_t)NZ * D, D, D, D, 0, 0};
                      pg8::Order<0> S; S.init(MG / 256, 12, F.G, F.bid);
                      pg8::EpiBf16 E{(bf16*)(F.ws + WS_Z) + ZC_GATE, NZ, 0};
                      pg8::gemm_phase(F.lds, gm, S, E); }
                    SEAM(); }
                PHASE(PH_B7) {
                    pg8::Gemm gm{(const bf16*)(F.ws + WS_RAW), (const bf16*)(F.ws + WS_WBR), D, D, D, (size_t)MG * D, (size_t)D * D};
                    pg8::Order<2> S; S.init(MG / 256, 4, F.G, F.bid);
                    pg8::EpiBranch E{(const bf16*)(F.ws + WS_Z) + ZC_GATE, NZ, (float*)(F.ws + WS_QK), (bf16*)(F.ws + WS_XC)};
                    pg8::gemm_phase(F.lds, gm, S, E); SEAM(); }
                PHASE(PH_B8) {
                    pg8::Gemm gm{(const bf16*)(F.ws + WS_XC), (const bf16*)(F.ws + WS_WOUT), D, D, D, 0, 0};
                    pg8::Order<0> S; S.init(MG / 256, 4, F.G, F.bid);
                    pg8::EpiResid E{xg, xg, modl + (1 * 3 + 2) * D, 1.0f, g * GB};
                    pg8::gemm_phase(F.lds, gm, S, E); SEAM(); }
            }
        }
    }
    PHASE(PH_FIN) phase_final_norm(F);
#undef IN
#undef PHASE
#undef SEAM
}

extern "C" void kernel_launch(void* const* d_in, const int* in_sizes, int n_in, void* d_out, int out_size, void* d_ws, size_t ws_size, hipStream_t stream) {
    static int grid = 0;
    if (grid == 0) {
        if (n_in != 36 || out_size != M * D || ws_size < WS_END) { fprintf(stderr, "kernel_launch: unexpected problem (n_in %d out %d ws %zu, need %zu)\n", n_in, out_size, ws_size, (size_t)WS_END); grid = -1; return; }
        int dev = 0, cus = 0;
        if (hipGetDevice(&dev) != hipSuccess || hipDeviceGetAttribute(&cus, hipDeviceAttributeMultiprocessorCount, dev) != hipSuccess) { grid = -1; return; }
        if (hipFuncSetAttribute((const void*)fwd_kernel, hipFuncAttributeMaxDynamicSharedMemorySize, LDS_BYTES) != hipSuccess) { fprintf(stderr, "kernel_launch: hipFuncSetAttribute failed\n"); grid = -1; return; }
        int per_cu = 0;
        if (hipOccupancyMaxActiveBlocksPerMultiprocessor(&per_cu, (const void*)fwd_kernel, NTHREADS, LDS_BYTES) != hipSuccess || per_cu < 1) { fprintf(stderr, "kernel_launch: occupancy query says %d\n", per_cu); }
        (void)hipGetLastError();
        grid = cus;
    }
    if (grid < 0) return;
    (void)hipMemsetAsync((char*)d_ws + WS_CTL, 0, CTL_BYTES, stream);
    Args a{};
    for (int i = 0; i < 36; ++i) a.in[i] = (const float*)d_in[i];
    a.out = (float*)d_out; a.ws = (unsigned char*)d_ws; a.pad = 0;
#if ONE_LAUNCH
    a.f_lo = 0; a.f_hi = 4; a.g_lo = 0; a.g_hi = NGRP; a.ph_lo = 0; a.ph_hi = PH_N; a.use_bar = 1;
    hipLaunchKernelGGL(fwd_kernel, dim3(grid), dim3(NTHREADS), LDS_BYTES, stream, a);
#else
    a.use_bar = 0;
    for (int f = 0; f < 4; ++f) {
        a.f_lo = f; a.f_hi = f + 1;
        for (int ph = PH_W; ph <= PH_A3; ++ph) {
            if (ph == PH_W && (f & 1)) continue;
            a.ph_lo = ph; a.ph_hi = ph + 1; a.g_lo = 0; a.g_hi = 0;
            hipLaunchKernelGGL(fwd_kernel, dim3(grid), dim3(NTHREADS), LDS_BYTES, stream, a);
        }
        if ((f & 1) == 0)
            for (int g = 0; g < NGRP; ++g)
                for (int ph = PH_B1; ph <= PH_B8; ++ph) { a.ph_lo = ph; a.ph_hi = ph + 1; a.g_lo = g; a.g_hi = g + 1;
                    hipLaunchKernelGGL(fwd_kernel, dim3(grid), dim3(NTHREADS), LDS_BYTES, stream, a); }
    }
    a.f_lo = 0; a.f_hi = 0; a.g_lo = 0; a.g_hi = 0; a.ph_lo = PH_FIN; a.ph_hi = PH_FIN + 1;
    hipLaunchKernelGGL(fwd_kernel, dim3(grid), dim3(NTHREADS), LDS_BYTES, stream, a);
#endif
}
```

```cpp
#include <hip/hip_runtime.h>
#include <cstdio>
#include <cstdint>

#ifndef ONE_LAUNCH
#define ONE_LAUNCH 1
#endif

#define GAS __attribute__((address_space(1)))
#define LAS __attribute__((address_space(3)))
typedef unsigned short bf16;
typedef unsigned v4u __attribute__((ext_vector_type(4)));
typedef unsigned v2u __attribute__((ext_vector_type(2)));
typedef float f32x4 __attribute__((ext_vector_type(4)));
typedef float f32x2 __attribute__((ext_vector_type(2)));
typedef short bf16x8 __attribute__((ext_vector_type(8)));
#define DI __device__ __forceinline__

constexpr int D = 1024, NB = 16, T = 2048, M = NB * T, DFF = 2816, NUP = 2 * DFF;
constexpr int GB = 4, MG = GB * T, NGRP = NB / GB;
constexpr int NZ = 9472;
constexpr int ZC_MLX = 0, ZC_MLO = 1024, ZC_RW = 2048, ZC_HGQ = 5376, ZC_HGF = 6400, ZC_HGI = 7424, ZC_HGG = 8448;
constexpr int ZC_GATE = 5376;
constexpr int NWIN = 12544;
constexpr int WIN_SRC = 12552;
constexpr int NSIDE = 40, KLORA = 384, NLORA = 4096, NMOD = 9216;
constexpr int NTHREADS = 512, NWAVES = 8;

constexpr size_t MiB = 1u << 20;
constexpr size_t WS_CTL = 0, CTL_BYTES = 1 * MiB;
constexpr size_t WS_MOD = 1 * MiB;
constexpr size_t WS_WSIDE = 3 * MiB;
constexpr size_t WS_WUP = 4 * MiB;
constexpr size_t WS_WDN = 26 * MiB;
constexpr size_t WS_WIN = 37 * MiB;
constexpr size_t WS_WBR = 62 * MiB;
constexpr size_t WS_WOUT = 68 * MiB;
constexpr size_t WS_WQK = 70 * MiB;
constexpr size_t WS_WLORA = 71 * MiB;
constexpr size_t WS_VF = 74 * MiB;
constexpr size_t WS_ACT = 138 * MiB;
constexpr size_t WS_H = WS_ACT;
constexpr size_t WS_HID = WS_ACT + 64 * MiB;
constexpr size_t WS_HG = WS_ACT;
constexpr size_t WS_Z = WS_ACT + 16 * MiB;
constexpr size_t WS_XC = WS_ACT + 164 * MiB;
constexpr size_t WS_QK = WS_ACT + 180 * MiB;
constexpr size_t WS_LA = WS_ACT + 212 * MiB;
constexpr size_t WS_LO = WS_ACT + 218 * MiB;
constexpr size_t WS_SIDE = WS_ACT + 282 * MiB;
constexpr size_t WS_RAW = WS_ACT + 284 * MiB;
constexpr size_t WS_BON = WS_ACT + 332 * MiB;
constexpr size_t WS_END = WS_ACT + 348 * MiB;
static_assert(WS_HID + (size_t)M * DFF * 2 <= WS_END, "ffn view fits");
static_assert(WS_Z + (size_t)MG * NZ * 2 <= WS_XC, "z fits");

constexpr int CW_BAR = 4096;

constexpr int LDS_BYTES = 147456;
constexpr int MISC_OFF = 131072 + 320;

DI unsigned f2bf(float f) { unsigned u = __builtin_bit_cast(unsigned, f); return (u + 0x7fffu + ((u >> 16) & 1u)) >> 16; }
DI unsigned pk2(float lo, float hi) { unsigned r; asm("v_cvt_pk_bf16_f32 %0, %1, %2" : "=v"(r) : "v"(lo), "v"(hi)); return r; }
DI float bflo(unsigned w) { return __builtin_bit_cast(float, w << 16); }
DI float bfhi(unsigned w) { return __builtin_bit_cast(float, w & 0xffff0000u); }
DI float bf1(bf16 h) { return __builtin_bit_cast(float, (unsigned)h << 16); }
DI float sigmoidf_(float x) { return 1.0f / (1.0f + __expf(-x)); }
DI float siluf_(float x) { return x / (1.0f + __expf(-x)); }
DI float softplusf_(float x) { return fmaxf(x, 0.f) + log1pf(__expf(-fabsf(x))); }
DI float wave_sum(float v) {
#pragma unroll
    for (int o = 1; o < 64; o <<= 1) v += __shfl_xor(v, o);
    return v;
}
template <int CTRL> DI float dppf(float v) { return __builtin_bit_cast(float, __builtin_amdgcn_update_dpp(0, __builtin_bit_cast(int, v), CTRL, 0xF, 0xF, true)); }
DI float sum4(float v) { v += dppf<0xB1>(v); v += dppf<0x4E>(v); return v; }
DI float sum8(float v) { v = sum4(v); v += dppf<0x141>(v); return v; }
DI float sum16(float v) { v = sum8(v); v += dppf<0x140>(v); return v; }
#define LDS_WAIT() asm volatile("s_waitcnt lgkmcnt(0)" ::: "memory")
#define VM_WAIT() asm volatile("s_waitcnt vmcnt(0)" ::: "memory")
DI void unpack8(const v4u w, float (&o)[8]) { o[0] = bflo(w.x); o[1] = bfhi(w.x); o[2] = bflo(w.y); o[3] = bfhi(w.y); o[4] = bflo(w.z); o[5] = bfhi(w.z); o[6] = bflo(w.w); o[7] = bfhi(w.w); }
DI void unpack16(const bf16* p, float (&o)[16]) { const v4u a = *(const v4u*)p, b = *(const v4u*)(p + 8);
    o[0] = bflo(a.x); o[1] = bfhi(a.x); o[2] = bflo(a.y); o[3] = bfhi(a.y); o[4] = bflo(a.z); o[5] = bfhi(a.z); o[6] = bflo(a.w); o[7] = bfhi(a.w);
    o[8] = bflo(b.x); o[9] = bfhi(b.x); o[10] = bflo(b.y); o[11] = bfhi(b.y); o[12] = bflo(b.z); o[13] = bfhi(b.z); o[14] = bflo(b.w); o[15] = bfhi(b.w); }
DI void pack16(bf16* p, const float (&o)[16]) { v4u a, b; a.x = pk2(o[0], o[1]); a.y = pk2(o[2], o[3]); a.z = pk2(o[4], o[5]); a.w = pk2(o[6], o[7]);
    b.x = pk2(o[8], o[9]); b.y = pk2(o[10], o[11]); b.z = pk2(o[12], o[13]); b.w = pk2(o[14], o[15]); *(v4u*)p = a; *(v4u*)(p + 8) = b; }
DI v4u pack8(const float (&o)[8]) { v4u w; w.x = pk2(o[0], o[1]); w.y = pk2(o[2], o[3]); w.z = pk2(o[4], o[5]); w.w = pk2(o[6], o[7]); return w; }

#define XB_TMO      128
#define XB_XCNT(j)  (256  + 64 * (j))
#define XB_XSUB(j)  (1280 + 64 * (j))
#define XB_XGEN(j)  (2304 + 64 * (j))
#define XB_TOP      3328
#define XB_TOPGEN   3392
#define XCD_BAR_WORDS 3456
#define XB_SPIN_CAP (1u << 22)
__device__ __forceinline__ unsigned xb_ld(unsigned* p)              { return __hip_atomic_load(p, __ATOMIC_RELAXED, __HIP_MEMORY_SCOPE_AGENT); }
__device__ __forceinline__ unsigned xb_add(unsigned* p, unsigned v) { return __hip_atomic_fetch_add(p, v, __ATOMIC_RELAXED, __HIP_MEMORY_SCOPE_AGENT); }
__device__ __forceinline__ unsigned xb_xcc_id() { return (unsigned)__builtin_amdgcn_s_getreg((3 << 11) | 20) & 0xFu; }
#define XB_SPIN(cond, bar) do { unsigned _sp = 0; while (cond) { __builtin_amdgcn_s_sleep(1); \
    if ((++_sp & 255u) == 0u) { if (xb_ld(&(bar)[XB_TMO])) break; if (_sp > XB_SPIN_CAP) { atomicAdd(&(bar)[XB_TMO], 1u); break; } } } } while (0)
struct XcdBarrier { unsigned* bar; unsigned x; volatile LAS unsigned* st; };
__device__ __forceinline__ XcdBarrier xcd_barrier_post(unsigned* bar, volatile LAS unsigned* st) {
    XcdBarrier b; b.bar = bar; b.x = xb_xcc_id(); b.st = st;
    if (threadIdx.x == 0) (void)xb_add(&bar[XB_XCNT(b.x)], 1u);
    return b;
}
__device__ __forceinline__ void xcd_barrier_complete(unsigned* bar, unsigned x, unsigned& nloc, unsigned& nx) {
    const unsigned G = gridDim.x * gridDim.y * gridDim.z;
    unsigned sum, cnt, mine, sp = 0u;
    for (;;) {
        sum = 0u; cnt = 0u; mine = 0u;
#pragma unroll
        for (unsigned j = 0; j < 16; ++j) { const unsigned c = xb_ld(&bar[XB_XCNT(j)]); sum += c; cnt += (c > 0u) ? 1u : 0u; mine = (j == x) ? c : mine; }
        if (sum == G) break;
        __builtin_amdgcn_s_sleep(1);
        if ((++sp & 255u) == 0u) { if (xb_ld(&bar[XB_TMO])) break; if (sp > XB_SPIN_CAP) { atomicAdd(&bar[XB_TMO], 1u); break; } }
    }
    nloc = mine > 0u ? mine : 1u; nx = cnt > 0u ? cnt : 1u;
}
__device__ __forceinline__ void xcd_barrier(const XcdBarrier& b) {
    asm volatile("s_waitcnt vmcnt(0)" ::: "memory");
    __syncthreads();
    if (threadIdx.x == 0) {
        unsigned* bar = b.bar;
        __builtin_amdgcn_s_waitcnt(0);
        unsigned nloc = b.st[0], nx = b.st[1];
        if (nloc == 0u) { xcd_barrier_complete(bar, b.x, nloc, nx); b.st[0] = nloc; b.st[1] = nx; }
        const unsigned old = xb_add(&bar[XB_XSUB(b.x)], 1u);
        const unsigned gen = old / nloc;
        if (old + 1u == (gen + 1u) * nloc) {
            __builtin_amdgcn_fence(__ATOMIC_RELEASE, "agent");
            asm volatile("s_waitcnt vmcnt(0)" ::: "memory");
            const unsigned og = xb_add(&bar[XB_TOP], 1u);
            const unsigned tg = og / nx;
            if (og + 1u == (tg + 1u) * nx) xb_add(&bar[XB_TOPGEN], 1u);
            else XB_SPIN(xb_ld(&bar[XB_TOPGEN]) == tg, bar);
            __builtin_amdgcn_fence(__ATOMIC_ACQUIRE, "agent");
            xb_add(&bar[XB_XGEN(b.x)], 1u);
            asm volatile("s_waitcnt vmcnt(0)" ::: "memory");
        } else {
            XB_SPIN(xb_ld(&bar[XB_XGEN(b.x)]) == gen, bar);
            __builtin_amdgcn_fence(__ATOMIC_ACQUIRE, "agent");
            asm volatile("s_waitcnt vmcnt(0)" ::: "memory");
        }
    }
    __syncthreads();
}

namespace pg8 {
constexpr int BM = 256, BK = 64, HALF = 128, HTB = HALF * BK * 2, STAGE_BYTES = 8 * HTB, NXCD = 8, WGM = 8;
DI int lds_byte(int r, int c) { const int st = (r >> 4) * 2 + (c >> 5), rr = r & 15, cc = c & 31, ob = rr * 64 + cc * 2; return st * 1024 + (ob ^ (((ob >> 9) & 1) << 5)); }
DI void stage_rc(int b, int& R, int& C) { const int st = b / 1024, sb = b % 1024, swz = sb ^ (((sb >> 9) & 1) << 5); R = (st >> 1) * 16 + swz / 64; C = (st & 1) * 32 + (swz % 64) / 2; }
DI int perm32(int rho) { const int n = rho >> 4, i = rho & 15; return 8 * (i >> 2) + 4 * n + (i & 3); }

struct Unit { int pm, pn, pz; };
struct Gemm { const bf16* A; const bf16* Bt; int K, lda, ldb; size_t a_z, b_z; };

template <int MODE> struct Order {
    int nM, nN, nwg, G, c;
    DI void init(int nM_, int nN_, int G_, int c_) { nM = nM_; nN = nN_; nwg = nM * nN; G = G_; c = c_; }
    DI bool next(int i, Unit& u) const {
        const int ii = (MODE == 2) ? i / 3 : i;
        const long L = (long)ii * G + c; if (L >= nwg) return false;
        int wgid = (int)L; { const int q = nwg / NXCD, r = nwg % NXCD, xcd = wgid % NXCD, off = wgid / NXCD; wgid = (xcd < r ? xcd * (q + 1) : r * (q + 1) + (xcd - r) * q) + off; }
        const int nig = WGM * nN, gid = wgid / nig, fm = gid * WGM, gsz = (nM - fm) < WGM ? (nM - fm) : WGM;
        u.pm = fm + ((wgid % nig) % gsz); const int pn = (wgid % nig) / gsz;
        if (MODE == 1) { u.pz = pn >> 1; u.pn = pn & 1; } else if (MODE == 2) { u.pz = i - ii * 3; u.pn = pn; } else { u.pz = 0; u.pn = pn; }
        return true;
    }
};

struct EpiBf16 {
    static constexpr bool PERM = true;
    bf16* O; int ldc; int zcols;
    DI void operator()(const f32x4 (&acc)[2][2][4][2], const Unit& u, int wr, int wc, int fr, int fq) const {
        const int row0 = u.pm * BM + wr * 64 + fr; const int col0 = u.pz * zcols + u.pn * BM + wc * 32 + 8 * fq;
#pragma unroll
        for (int ai = 0; ai < 2; ++ai)
#pragma unroll
            for (int m = 0; m < 4; ++m) { bf16* rowp = O + (size_t)(row0 + ai * HALF + m * 16) * ldc + col0;
#pragma unroll
                for (int bj = 0; bj < 2; ++bj) { const f32x4 v0 = acc[ai][bj][m][0], v1 = acc[ai][bj][m][1];
                    v4u w; w.x = pk2(v0[0], v0[1]); w.y = pk2(v0[2], v0[3]); w.z = pk2(v1[0], v1[1]); w.w = pk2(v1[2], v1[3]);
                    *(v4u*)(rowp + bj * HALF) = w; } }
    }
};
struct EpiSwiGLU {
    static constexpr bool PERM = true;
    bf16* O; int ldc;
    DI void operator()(const f32x4 (&acc)[2][2][4][2], const Unit& u, int wr, int wc, int fr, int fq) const {
        const int row0 = u.pm * BM + wr * 64 + fr; const int col0 = u.pn * HALF + wc * 32 + 8 * fq;
#pragma unroll
        for (int ai = 0; ai < 2; ++ai)
#pragma unroll
            for (int m = 0; m < 4; ++m) { bf16* rowp = O + (size_t)(row0 + ai * HALF + m * 16) * ldc + col0;
                float o[8];
#pragma unroll
                for (int n = 0; n < 2; ++n)
#pragma unroll
                    for (int j = 0; j < 4; ++j) { const float a = acc[ai][0][m][n][j], b = acc[ai][1][m][n][j]; o[n * 4 + j] = a * b / (1.0f + __expf(-a)); }
                *(v4u*)rowp = pack8(o); }
    }
};
struct EpiResid {
    static constexpr bool PERM = false;
    const float* xin; float* xout; const float* gate; float mul; int b0;
    DI void operator()(const f32x4 (&acc)[2][2][4][2], const Unit& u, int wr, int wc, int fr, int fq) const {
        const int row0 = u.pm * BM + wr * 64 + fr, col0 = u.pn * BM + wc * 32 + 4 * fq;
        const float* gp = gate + (size_t)(b0 + (u.pm * BM) / T) * NMOD + col0;
        f32x4 cf[2][2];
#pragma unroll
        for (int bj = 0; bj < 2; ++bj)
#pragma unroll
            for (int n = 0; n < 2; ++n) cf[bj][n] = (*(const f32x4*)(gp + bj * HALF + n * 16) + 1.0f) * mul;
#pragma unroll
        for (int ai = 0; ai < 2; ++ai)
#pragma unroll
            for (int m = 0; m < 4; ++m) { const size_t off = (size_t)(row0 + ai * HALF + m * 16) * D + col0;
#pragma unroll
                for (int bj = 0; bj < 2; ++bj)
#pragma unroll
                    for (int n = 0; n < 2; ++n) { const f32x4 xi = *(const f32x4*)(xin + off + bj * HALF + n * 16);
                        *(f32x4*)(xout + off + bj * HALF + n * 16) = xi + cf[bj][n] * acc[ai][bj][m][n]; }
                asm volatile("" ::: "memory"); }
    }
};
struct EpiBranch {
    static constexpr bool PERM = false;
    const bf16* gates; int ldg; float* mixf; bf16* mixb;
    DI void operator()(const f32x4 (&acc)[2][2][4][2], const Unit& u, int wr, int wc, int fr, int fq) const {
        const int row0 = u.pm * BM + wr * 64 + fr, col0 = u.pn * BM + wc * 32 + 4 * fq;
#pragma unroll
        for (int ai = 0; ai < 2; ++ai)
#pragma unroll
            for (int m = 0; m < 4; ++m) { const int row = row0 + ai * HALF + m * 16; const size_t off = (size_t)row * D + col0; const bf16* gp = gates + (size_t)row * ldg + u.pz * D + col0;
#pragma unroll
                for (int bj = 0; bj < 2; ++bj)
#pragma unroll
                    for (int n = 0; n < 2; ++n) { const v2u gw = *(const v2u*)(gp + bj * HALF + n * 16);
                        f32x4 g; g[0] = sigmoidf_(bflo(gw.x)); g[1] = sigmoidf_(bfhi(gw.x)); g[2] = sigmoidf_(bflo(gw.y)); g[3] = sigmoidf_(bfhi(gw.y));
                        f32x4 v = g * acc[ai][bj][m][n];
                        if (u.pz > 0) v += *(const f32x4*)(mixf + off + bj * HALF + n * 16);
                        if (u.pz < 2) *(f32x4*)(mixf + off + bj * HALF + n * 16) = v;
                        else { v2u w; w.x = pk2(v[0], v[1]); w.y = pk2(v[2], v[3]); *(v2u*)(mixb + off + bj * HALF + n * 16) = w; } }
                asm volatile("" ::: "memory"); }
    }
};

template <class Epi, class Sched>
DI void gemm_phase(LAS unsigned char* lds, const Gemm g, const Sched& S, const Epi& E) {
    int tid_ = threadIdx.x; asm volatile("" : "+v"(tid_));
    const int tid = tid_, wid = __builtin_amdgcn_readfirstlane(tid >> 6), lane = tid & 63, wr = wid >> 2, wc = wid & 3, fr = lane & 15, fq = lane >> 4;
    int K_ = g.K; asm volatile("" : "+s"(K_));
    const int K = K_, nt = K / BK;
    unsigned voffA[2], voffB[2];
#pragma unroll
    for (int i = 0; i < 2; ++i) { int R, C; stage_rc(tid * 16 + i * 8192, R, C); const int Rb = Epi::PERM ? ((R & ~31) + perm32(R & 31)) : R;
        voffA[i] = (unsigned)(R * g.lda + C) * 2u; voffB[i] = (unsigned)(Rb * g.ldb + C) * 2u; }
    const size_t kstep = (size_t)(BK * 2);
    const size_t hstepA = (size_t)HALF * g.lda * 2, hstepB = (size_t)HALF * g.ldb * 2;
    const size_t tstepA = 2 * hstepA, tstepB = 2 * hstepB;
    const unsigned ldsw = (unsigned)wid * 1024u;
    const int aoff = lds_byte(wr * 64 + fr, fq * 8), boff = lds_byte(wc * 32 + fr, fq * 8);
#define PG8_SA(b, h) (((b) * 2 + (h)) * HTB)
#define PG8_SB(b, h) ((4 + (b) * 2 + (h)) * HTB)
#define PG8_STAGE(bufoff, gbase, voff) do { _Pragma("unroll") for (int _i = 0; _i < 2; ++_i) \
        __builtin_amdgcn_global_load_lds((const unsigned*)((const char*)(gbase) + (voff)[_i]), (LAS unsigned*)(lds + (bufoff) + ldsw + _i * 8192), 16, 0, 0); } while (0)
#define PG8_LDA(dst, b, h) do { _Pragma("unroll") for (int m = 0; m < 4; ++m) _Pragma("unroll") for (int k = 0; k < 2; ++k) dst[m][k] = *(const LAS bf16x8*)(lds + PG8_SA(b, h) + aoff + m * 2048 + k * 1024); } while (0)
#define PG8_LDB(dst, b, h) do { _Pragma("unroll") for (int n = 0; n < 2; ++n) _Pragma("unroll") for (int k = 0; k < 2; ++k) dst[n][k] = *(const LAS bf16x8*)(lds + PG8_SB(b, h) + boff + n * 2048 + k * 1024); } while (0)
#define PG8_MMA(ai, bj, At, Bt) do { __builtin_amdgcn_s_setprio(1); _Pragma("unroll") for (int m = 0; m < 4; ++m) _Pragma("unroll") for (int n = 0; n < 2; ++n) _Pragma("unroll") for (int k = 0; k < 2; ++k) \
        acc[ai][bj][m][n] = __builtin_amdgcn_mfma_f32_16x16x32_bf16(Bt[n][k], At[m][k], acc[ai][bj][m][n], 0, 0, 0); __builtin_amdgcn_s_setprio(0); } while (0)
#define PG8_WAIT_V(n) asm volatile("s_waitcnt vmcnt(" #n ")" ::: "memory")
#define PG8_WAIT_L(n) asm volatile("s_waitcnt lgkmcnt(" #n ")" ::: "memory")
#define PG8_BAR __builtin_amdgcn_s_barrier()
#define PG8_SCHED __builtin_amdgcn_sched_barrier(0)
    Unit cur, nxt; int ui = 0;
    if (!S.next(0, cur)) return;
    f32x4 acc[2][2][4][2];
#pragma unroll
    for (int a = 0; a < 2; ++a)
#pragma unroll
        for (int b = 0; b < 2; ++b)
#pragma unroll
            for (int m = 0; m < 4; ++m)
#pragma unroll
                for (int n = 0; n < 2; ++n) acc[a][b][m][n] = (f32x4){0.f, 0.f, 0.f, 0.f};
    bf16x8 At[4][2], B0[2][2], B1[2][2];
    const char* cA = (const char*)(g.A + (size_t)cur.pz * g.a_z) + (size_t)cur.pm * tstepA; const char* cB = (const char*)(g.Bt + (size_t)cur.pz * g.b_z) + (size_t)cur.pn * tstepB;
    PG8_STAGE(PG8_SB(0, 0), cB, voffB); PG8_STAGE(PG8_SB(0, 1), cB + hstepB, voffB); PG8_STAGE(PG8_SA(0, 0), cA, voffA); PG8_STAGE(PG8_SA(0, 1), cA + hstepA, voffA);
    if (wr == 1) PG8_BAR;
    PG8_WAIT_V(2); PG8_BAR;
    PG8_STAGE(PG8_SB(1, 0), cB + kstep, voffB); PG8_STAGE(PG8_SA(1, 0), cA + kstep, voffA); PG8_STAGE(PG8_SB(1, 1), cB + hstepB + kstep, voffB);
    PG8_WAIT_V(6); PG8_BAR;
    for (;;) {
        const bool has_next = S.next(ui + 1, nxt);
        const char* nA = has_next ? (const char*)(g.A + (size_t)nxt.pz * g.a_z) + (size_t)nxt.pm * tstepA : cA; const char* nB = has_next ? (const char*)(g.Bt + (size_t)nxt.pz * g.b_z) + (size_t)nxt.pn * tstepB : cB;
        for (int t = 0; t < nt; t += 2) {
            const bool last = (t == nt - 2);
            const char* a1 = cA + (size_t)(t + 1) * kstep;
            const char* a2 = last ? nA : cA + (size_t)(t + 2) * kstep; const char* b2 = last ? nB : cB + (size_t)(t + 2) * kstep;
            const char* a3 = a2 + kstep; const char* b3 = b2 + kstep;
            PG8_LDB(B0, 0, 0); PG8_LDB(B1, 0, 1); PG8_SCHED; PG8_LDA(At, 0, 0); PG8_STAGE(PG8_SA(1, 1), a1 + hstepA, voffA);
            PG8_WAIT_V(8); PG8_WAIT_L(0); PG8_BAR; PG8_MMA(0, 0, At, B0); PG8_MMA(0, 1, At, B1); PG8_BAR; PG8_SCHED;
            PG8_LDA(At, 0, 1); PG8_STAGE(PG8_SB(0, 0), b2, voffB); PG8_STAGE(PG8_SB(0, 1), b2 + hstepB, voffB); PG8_STAGE(PG8_SA(0, 0), a2, voffA);
            PG8_WAIT_V(8); PG8_WAIT_L(0); PG8_BAR; PG8_MMA(1, 0, At, B0); PG8_MMA(1, 1, At, B1); PG8_BAR; PG8_SCHED;
            PG8_LDB(B0, 1, 0); PG8_LDB(B1, 1, 1); PG8_SCHED; PG8_LDA(At, 1, 0); PG8_STAGE(PG8_SA(0, 1), a2 + hstepA, voffA);
            PG8_WAIT_V(8); PG8_WAIT_L(0); PG8_BAR; PG8_MMA(0, 0, At, B0); PG8_MMA(0, 1, At, B1); PG8_BAR; PG8_SCHED;
            PG8_LDA(At, 1, 1); PG8_STAGE(PG8_SB(1, 0), b3, voffB); PG8_STAGE(PG8_SB(1, 1), b3 + hstepB, voffB); PG8_STAGE(PG8_SA(1, 0), a3, voffA);
            PG8_WAIT_V(8); PG8_WAIT_L(0); PG8_BAR; PG8_MMA(1, 0, At, B0); PG8_MMA(1, 1, At, B1); PG8_BAR; PG8_SCHED;
        }
        if (wr == 0) PG8_BAR;
        E(acc, cur, wr, wc, fr, fq);
        if (!has_next) break;
#pragma unroll
        for (int a = 0; a < 2; ++a)
#pragma unroll
            for (int b = 0; b < 2; ++b)
#pragma unroll
                for (int m = 0; m < 4; ++m)
#pragma unroll
                    for (int n = 0; n < 2; ++n) acc[a][b][m][n] = (f32x4){0.f, 0.f, 0.f, 0.f};
        cur = nxt; cA = nA; cB = nB; ++ui;
        if (wr == 1) PG8_BAR;
    }
    PG8_WAIT_V(0);
    PG8_BAR;
#undef PG8_SA
#undef PG8_SB
#undef PG8_STAGE
#undef PG8_LDA
#undef PG8_LDB
#undef PG8_MMA
#undef PG8_WAIT_V
#undef PG8_WAIT_L
#undef PG8_BAR
#undef PG8_SCHED
}
}

struct Args {
    const float* in[36]; float* out; unsigned char* ws;
    int f_lo, f_hi, g_lo, g_hi, ph_lo, ph_hi, use_bar, pad;
};
struct Ctx {
    LAS unsigned char* lds;
    const float* const* in; float* out; unsigned char* ws;
    int tid, lane, wave, bid, G;
};
DI void refresh(Ctx& F) {
    asm volatile("" : "+v"(F.tid)); F.lane = F.tid & 63; F.wave = __builtin_amdgcn_readfirstlane(F.tid >> 6);
}
enum { I_X = 0, I_C, I_NORMW, I_FNORMW, I_ADAW, I_ADAB, I_FUP, I_FDN, I_WIN, I_WINV, I_CONVW, I_CONVB, I_WQ, I_WK, I_IB, I_FB, I_MLNW, I_MLSKIP,
       I_MU, I_MUV, I_W0, I_W2, I_A0, I_A2, I_V0, I_V2, I_G2, I_KK, I_KA, I_RK, I_LNW, I_LNB, I_LBL, I_HGNW, I_WBR, I_WOUT };

DI void transpose_item(const float* W, int ldw, int k0, int c0, bf16* WT, int ldt, int r0, float scale, LAS float* scr, int lane) {
#pragma unroll 8
    for (int i = 0; i < 32; ++i) { const int kk = 2 * i + (lane >> 5); scr[kk * 33 + (lane & 31)] = W[(size_t)(k0 + kk) * ldw + c0 + (lane & 31)]; }
    LDS_WAIT(); asm volatile("" ::: "memory");
    const int c = lane & 7;
#pragma unroll
    for (int j = 0; j < 4; ++j) { const int n = (lane >> 3) + 8 * j; const LAS float* s = scr + (8 * c) * 33 + n;
        v4u o; o.x = pk2(s[0 * 33] * scale, s[1 * 33] * scale); o.y = pk2(s[2 * 33] * scale, s[3 * 33] * scale); o.z = pk2(s[4 * 33] * scale, s[5 * 33] * scale); o.w = pk2(s[6 * 33] * scale, s[7 * 33] * scale);
        *(v4u*)(WT + (size_t)(r0 + n) * ldt + k0 + 8 * c) = o; }
    LDS_WAIT(); asm volatile("" ::: "memory");
}
DI void phase_weights(const Ctx& F, int l) {
    LAS float* scr = (LAS float*)(F.lds + F.wave * 16384);
    const int gw = F.bid * NWAVES + F.wave, NGW = F.G * NWAVES;
    constexpr int I_UP = 16 * 176, I_DN = 44 * 32, I_IN = 16 * 392, I_SQ = 16 * 32, I_QKI = 8 * 32;
    constexpr int NITEMS = 2 * I_UP + 2 * I_DN + I_IN + 4 * I_SQ + I_QKI;
    bf16* WUP = (bf16*)(F.ws + WS_WUP); bf16* WDN = (bf16*)(F.ws + WS_WDN); bf16* WIN = (bf16*)(F.ws + WS_WIN); bf16* WBR = (bf16*)(F.ws + WS_WBR);
    bf16* WOUT = (bf16*)(F.ws + WS_WOUT); bf16* WQK = (bf16*)(F.ws + WS_WQK);
    for (int it = gw; it < NITEMS; it += NGW) {
        int r = it;
        if (r < 2 * I_UP) { const int i = r / I_UP; r -= i * I_UP; const int kb = r / 176, nb = r % 176, c0 = 32 * nb; const int cc = c0 < DFF ? c0 : c0 - DFF;
            const int r0 = (cc / 128) * 256 + (c0 < DFF ? 0 : 128) + (cc % 128);
            transpose_item(F.in[I_FUP] + (size_t)(l * 2 + i) * D * NUP, NUP, 64 * kb, c0, WUP + (size_t)i * NUP * D, D, r0, 1.f, scr, F.lane); continue; }
        r -= 2 * I_UP;
        if (r < 2 * I_DN) { const int i = r / I_DN; r -= i * I_DN; const int kb = r / 32, nb = r % 32;
            transpose_item(F.in[I_FDN] + (size_t)(l * 2 + i) * DFF * D, D, 64 * kb, 32 * nb, WDN + (size_t)i * D * DFF, DFF, 32 * nb, 1.f, scr, F.lane); continue; }
        r -= 2 * I_DN;
        if (r < I_IN) { const int kb = r / 392, nb = r % 392, d0 = 32 * nb, c0 = d0 + (d0 >= 2048 ? 8 : 0);
            transpose_item(F.in[I_WIN] + (size_t)l * D * WIN_SRC, WIN_SRC, 64 * kb, c0, WIN, D, d0, 1.f, scr, F.lane); continue; }
        r -= I_IN;
        if (r < 3 * I_SQ) { const int n = r / I_SQ; r -= n * I_SQ; const int kb = r / 32, nb = r % 32;
            transpose_item(F.in[I_WBR] + (size_t)(l * 3 + n) * D * D, D, 64 * kb, 32 * nb, WBR + (size_t)n * D * D, D, 32 * nb, 1.f, scr, F.lane); continue; }
        r -= 3 * I_SQ;
        if (r < I_SQ) { const int kb = r / 32, nb = r % 32;
            transpose_item(F.in[I_WOUT] + (size_t)l * D * D, D, 64 * kb, 32 * nb, WOUT, D, 32 * nb, 1.f, scr, F.lane); continue; }
        r -= I_SQ;
        { const int mat = r / 32, rr = r % 32, h = mat >> 1, isk = mat & 1, kb = rr / 8, nb = rr % 8;
            transpose_item(F.in[isk ? I_WK : I_WQ] + (size_t)(l * 4 + h) * 256 * 256, 256, 64 * kb, 32 * nb, WQK + (size_t)(h * 512 + isk * 256) * 256, 256, 32 * nb, isk ? 0.0625f : 1.f, scr, F.lane); }
    }
    const int gt = F.bid * NTHREADS + F.tid, NT = F.G * NTHREADS;
    bf16* WL = (bf16*)(F.ws + WS_WLORA);
    for (int idx = gt; idx < NLORA * (KLORA / 8); idx += NT) {
        const int n = idx & (NLORA - 1), kc = idx >> 12, k0 = kc * 8, blk = n >> 10, nn = n & 1023;
        float o[8];
#pragma unroll
        for (int i = 0; i < 8; ++i) o[i] = 0.f;
        const float* src = nullptr; int kk = 0;
        if (blk == 0 && k0 < 64) { src = F.in[I_W2] + (size_t)l * 64 * D; kk = k0; }
        else if (blk == 1 && k0 >= 64 && k0 < 128) { src = F.in[I_A2] + (size_t)l * 64 * D; kk = k0 - 64; }
        else if (blk == 2 && k0 >= 128 && k0 < 256) { src = F.in[I_G2] + (size_t)l * 128 * D; kk = k0 - 128; }
        else if (blk == 3 && l == 1 && k0 >= 256 && k0 < 288) { src = F.in[I_V2]; kk = k0 - 256; }
        if (src) {
#pragma unroll
            for (int i = 0; i < 8; ++i) o[i] = src[(size_t)(kk + i) * D + nn]; }
        *(v4u*)(WL + (size_t)n * KLORA + k0) = pack8(o);
    }
    float* WS_ = (float*)(F.ws + WS_WSIDE);
    for (int idx = gt; idx < NSIDE * D; idx += NT) {
        const int j = idx >> 10, k = idx & 1023; float v = 0.f;
        if (j < 8) v = F.in[I_WIN][(size_t)l * D * WIN_SRC + (size_t)k * WIN_SRC + 2048 + j];
        else if (l == 1) v = F.in[I_WINV][(size_t)k * 32 + (j - 8)];
        WS_[idx] = v;
    }
}
DI void phase_mod(const Ctx& F) {
    LAS float* sc = (LAS float*)F.lds; LAS float* red = (LAS float*)(F.lds + 65536);
    float* mod = (float*)(F.ws + WS_MOD);
    bool loaded = false;
    for (int it = F.bid; it < 2 * 144; it += F.G) {
        if (!loaded) { for (int i = F.tid; i < NB * D; i += NTHREADS) sc[i] = siluf_(F.in[I_C][i]); loaded = true; __syncthreads(); }
        const int l = it / 144, n0 = (it % 144) * 64, n = F.tid & 63, ks = F.tid >> 6;
        float acc[16];
#pragma unroll
        for (int b = 0; b < 16; ++b) acc[b] = 0.f;
        const float* wp = F.in[I_ADAW] + (size_t)l * D * NMOD + n0 + n;
        for (int k = ks * 128; k < ks * 128 + 128; ++k) { const float w = wp[(size_t)k * NMOD];
#pragma unroll
            for (int b = 0; b < 16; ++b) acc[b] += sc[b * D + k] * w; }
#pragma unroll
        for (int b = 0; b < 16; ++b) red[(ks * 16 + b) * 64 + n] = acc[b];
        __syncthreads();
        for (int o = F.tid; o < 1024; o += NTHREADS) { const int b = o >> 6, nn = o & 63; float s = 0.f;
#pragma unroll
            for (int k8 = 0; k8 < 8; ++k8) s += red[(k8 * 16 + b) * 64 + nn];
            mod[(size_t)(l * 16 + b) * NMOD + n0 + nn] = s + F.in[I_ADAB][(size_t)l * NMOD + n0 + nn]; }
        __syncthreads();
    }
}

template <bool SIDE>
DI void phase_modulate(const Ctx& F, const float* x, bf16* hout, const float* nw, const float* modl, int sub, int r0, int nrows, float* side) {
    const int gw = F.bid * NWAVES + F.wave, NGW = F.G * NWAVES;
    const float* wside = (const float*)(F.ws + WS_WSIDE);
    for (int r = gw; r < nrows; r += NGW) {
        const int row = r0 + r, b = row / T;
        const f32x4* xr = (const f32x4*)(x + (size_t)row * D) + F.lane;
        f32x4 v[4]; float ss = 0.f;
#pragma unroll
        for (int j = 0; j < 4; ++j) { v[j] = xr[64 * j]; ss += (v[j].x * v[j].x + v[j].y * v[j].y) + (v[j].z * v[j].z + v[j].w * v[j].w); }
        const float rstd = 1.0f / sqrtf(wave_sum(ss) * (1.f / D) + 1e-6f);
        const f32x4* nwp = (const f32x4*)nw + F.lane;
        const f32x4* shp = (const f32x4*)(modl + (size_t)b * NMOD + (sub * 3 + 0) * D) + F.lane;
        const f32x4* scp = (const f32x4*)(modl + (size_t)b * NMOD + (sub * 3 + 1) * D) + F.lane;
        unsigned long long* o8 = (unsigned long long*)(hout + (size_t)r * D) + F.lane;
#pragma unroll
        for (int j = 0; j < 4; ++j) { v[j] = v[j] * rstd * nwp[64 * j] * (scp[64 * j] + 1.0f) + shp[64 * j];
            o8[64 * j] = (unsigned long long)pk2(v[j].x, v[j].y) | ((unsigned long long)pk2(v[j].z, v[j].w) << 32); }
        if (SIDE) {
            for (int jj = 0; jj < NSIDE; ++jj) { const f32x4* wp = (const f32x4*)(wside + jj * D) + F.lane; float s = 0.f;
#pragma unroll
                for (int j = 0; j < 4; ++j) { const f32x4 w = wp[64 * j]; s += (v[j].x * w.x + v[j].y * w.y) + (v[j].z * w.z + v[j].w * w.w); }
                s = wave_sum(s);
                if (F.lane == 0) side[(size_t)r * NSIDE + jj] = s; }
        }
    }
}
DI void phase_final_norm(const Ctx& F) {
    const int gw = F.bid * NWAVES + F.wave, NGW = F.G * NWAVES;
    for (int row = gw; row < M; row += NGW) {
        f32x4* xr = (f32x4*)(F.out + (size_t)row * D) + F.lane;
        f32x4 v[4]; float ss = 0.f;
#pragma unroll
        for (int j = 0; j < 4; ++j) { v[j] = xr[64 * j]; ss += (v[j].x * v[j].x + v[j].y * v[j].y) + (v[j].z * v[j].z + v[j].w * v[j].w); }
        const float rstd = 1.0f / sqrtf(wave_sum(ss) * (1.f / D) + 1e-6f);
        const f32x4* nwp = (const f32x4*)F.in[I_FNORMW] + F.lane;
#pragma unroll
        for (int j = 0; j < 4; ++j) xr[64 * j] = v[j] * rstd * nwp[64 * j];
    }
}

DI void phase_prep(const Ctx& F, int l) {
    const int gt = F.bid * NTHREADS + F.tid, NT = F.G * NTHREADS;
    const bf16* Z = (const bf16*)(F.ws + WS_Z); bf16* XC = (bf16*)(F.ws + WS_XC); bf16* LA = (bf16*)(F.ws + WS_LA); const float* SD = (const float*)(F.ws + WS_SIDE);
    const float* cw = F.in[I_CONVW] + (size_t)l * 4 * D; const float* cb = F.in[I_CONVB] + (size_t)l * D;
    const float* mu = F.in[I_MU] + (size_t)l * 3328;
    for (int idx = gt; idx < MG * 128; idx += NT) {
        const int row = idx >> 7, c8 = (idx & 127) * 8, t = row & (T - 1);
        float a[8], x[8];
#pragma unroll
        for (int i = 0; i < 8; ++i) a[i] = cb[c8 + i];
#pragma unroll
        for (int j = 0; j < 4; ++j) { if (t >= 3 - j) { unpack8(*(const v4u*)(Z + (size_t)(row - 3 + j) * NZ + ZC_MLX + c8), x);
#pragma unroll
                for (int i = 0; i < 8; ++i) a[i] += cw[j * D + c8 + i] * x[i]; } }
#pragma unroll
        for (int i = 0; i < 8; ++i) a[i] = siluf_(a[i]);
        *(v4u*)(XC + (size_t)row * D + c8) = pack8(a);
    }
    for (int idx = gt; idx < MG * 48; idx += NT) {
        const int row = idx / 48, k0 = (idx - row * 48) * 8, t = row & (T - 1);
        float o[8];
#pragma unroll
        for (int i = 0; i < 8; ++i) o[i] = 0.f;
        if (k0 < 256) { float cur[8], prv[8];
            unpack8(*(const v4u*)(Z + (size_t)row * NZ + ZC_RW + 3072 + k0), cur);
            if (t > 0) unpack8(*(const v4u*)(Z + (size_t)(row - 1) * NZ + ZC_RW + 3072 + k0), prv); else {
#pragma unroll
                for (int i = 0; i < 8; ++i) prv[i] = 0.f; }
#pragma unroll
            for (int i = 0; i < 8; ++i) { const float s = cur[i] + mu[3072 + k0 + i] * (prv[i] - cur[i]); o[i] = k0 < 64 ? tanhf(s) : (k0 < 128 ? s : sigmoidf_(s)); }
        } else if (l == 1 && k0 < 288) {
#pragma unroll
            for (int i = 0; i < 8; ++i) { const int j = k0 - 256 + i; const float cur = SD[(size_t)row * NSIDE + 8 + j], prv = t > 0 ? SD[(size_t)(row - 1) * NSIDE + 8 + j] : 0.f;
                o[i] = cur + F.in[I_MUV][j] * (prv - cur); }
        }
        *(v4u*)(LA + (size_t)row * KLORA + k0) = pack8(o);
    }
}

DI void scan_writeout(const Ctx& F, const LAS float* YT, bf16* dst  , int ld) {
    const int s = F.tid >> 4, r2 = (F.tid & 15) * 2;
    *(unsigned*)(dst + (size_t)s * ld + r2) = pk2(YT[s * 32 + r2], YT[s * 32 + r2 + 1]);
}
DI void scan_rwkv(const Ctx& F, int l, int g, int unit) {
    const int half = unit & 1, h = (unit >> 1) & 15, bl = unit >> 5;
    LAS float* TW = (LAS float*)F.lds; LAS float* TKP = TW + 2048; LAS float* TB = TW + 4096; LAS float* TKK = TW + 6144; LAS float* TR = TW + 8192; LAS float* TV = TW + 10240; LAS float* YT = TW + 12288;
    const bf16* Z = (const bf16*)(F.ws + WS_Z); const bf16* LO = (const bf16*)(F.ws + WS_LO); bf16* VF = (bf16*)(F.ws + WS_VF); bf16* BON = (bf16*)(F.ws + WS_BON);
    bf16* RAW = (bf16*)(F.ws + WS_RAW) + (size_t)1 * MG * D;
    const int gc = h * 64 + F.lane;
    const float mu_r = F.in[I_MU][l * 3328 + gc], mu_k = F.in[I_MU][l * 3328 + 1024 + gc], mu_v = F.in[I_MU][l * 3328 + 2048 + gc];
    const float w0 = F.in[I_W0][l * D + gc], a0 = F.in[I_A0][l * D + gc], kkc = F.in[I_KK][l * D + gc], kac = F.in[I_KA][l * D + gc], rk = F.in[I_RK][l * D + gc];
    const float v0 = l == 1 ? F.in[I_V0][gc] : 0.f;
    const int rowl = F.tid >> 4, ks = F.tid & 15;
    float s0 = 0.f, s1 = 0.f, s2 = 0.f, s3 = 0.f;
    for (int tt = 0; tt < T / 32; ++tt) {
        {
            const int sb = F.wave * 4, t0 = tt * 32 + sb; const size_t lrow0 = (size_t)bl * T + t0;
            float pr = 0.f, pk = 0.f, pv = 0.f;
            if (t0 > 0) { const bf16* zp = Z + (lrow0 - 1) * NZ + ZC_RW + gc; pr = bf1(zp[0]); pk = bf1(zp[1024]); pv = bf1(zp[2048]); }
#pragma unroll
            for (int j = 0; j < 4; ++j) {
                const size_t lrow = lrow0 + j; const bf16* zp = Z + lrow * NZ + ZC_RW + gc;
                const float zr = bf1(zp[0]), zk = bf1(zp[1024]), zv = bf1(zp[2048]);
                const float r = zr + mu_r * (pr - zr), k = zk + mu_k * (pk - zk); float v = zv + mu_v * (pv - zv);
                pr = zr; pk = zk; pv = zv;
                const bf16* lp = LO + lrow * NLORA + gc;
                const float xw = w0 + bf1(lp[0]); const float wraw = -softplusf_(-xw) - 0.5f; const float w = __expf(-__expf(wraw));
                const float a = sigmoidf_(a0 + bf1(lp[1024]));
                const size_t grow = (size_t)g * MG + lrow;
                if (l == 0) { if (half == 0) VF[grow * D + gc] = (bf16)f2bf(v); }
                else { const float vf = bf1(VF[grow * D + gc]); v = v + (vf - v) * sigmoidf_(v0 + bf1(lp[3072])); }
                const float kk = k * kkc; const float nrm = sqrtf(wave_sum(kk * kk)); const float kn = kk / fmaxf(nrm, 1e-12f);
                const float kp = k * (1.0f + (a - 1.0f) * kac);
                const float bsum = wave_sum(r * kp * rk);
                if (half == 0) BON[lrow * D + gc] = (bf16)f2bf(bsum * v);
                const int s = sb + j;
                TW[s * 64 + F.lane] = w; TKP[s * 64 + F.lane] = kp; TB[s * 64 + F.lane] = kn * a; TKK[s * 64 + F.lane] = kn; TR[s * 64 + F.lane] = r; TV[s * 64 + F.lane] = v;
            }
        }
        __syncthreads();
#pragma unroll 4
        for (int s = 0; s < 32; ++s) {
            const f32x4 kk = *(const LAS f32x4*)(TKK + s * 64 + ks * 4), w = *(const LAS f32x4*)(TW + s * 64 + ks * 4), b = *(const LAS f32x4*)(TB + s * 64 + ks * 4);
            const f32x4 kp = *(const LAS f32x4*)(TKP + s * 64 + ks * 4), r = *(const LAS f32x4*)(TR + s * 64 + ks * 4);
            const float vv = TV[s * 64 + half * 32 + rowl];
            const float u = sum16((s0 * kk.x + s1 * kk.y) + (s2 * kk.z + s3 * kk.w));
            s0 = s0 * w.x - u * b.x + vv * kp.x; s1 = s1 * w.y - u * b.y + vv * kp.y; s2 = s2 * w.z - u * b.z + vv * kp.z; s3 = s3 * w.w - u * b.w + vv * kp.w;
            const float y = sum16((s0 * r.x + s1 * r.y) + (s2 * r.z + s3 * r.w));
            if (ks == 0) YT[s * 32 + rowl] = y;
        }
        __syncthreads();
        scan_writeout(F, YT, RAW + ((size_t)bl * T + tt * 32) * D + h * 64 + half * 32, D);
    }
    __syncthreads();
}
DI void scan_hgrn(const Ctx& F, int l, int unit) {
    const int qt = unit & 3, h = (unit >> 2) & 7, bl = unit >> 5;
    LAS float* TQ = (LAS float*)F.lds; LAS float* TF = TQ + 4096; LAS float* TK = TQ + 8192; LAS float* TV = TQ + 12288; LAS float* YT = TQ + 13312;
    const bf16* Z = (const bf16*)(F.ws + WS_Z); bf16* RAW = (bf16*)(F.ws + WS_RAW) + (size_t)2 * MG * D;
    const int ps = F.tid >> 4, pc = (F.tid & 15) * 8;
    float lb[8];
#pragma unroll
    for (int i = 0; i < 8; ++i) lb[i] = l == 0 ? 0.f : sigmoidf_(F.in[I_LBL][D + h * 128 + pc + i] - F.in[I_LBL][h * 128 + pc + i]);
    const int el = F.tid >> 4, ds = F.tid & 15;
    float S[8];
#pragma unroll
    for (int i = 0; i < 8; ++i) S[i] = 0.f;
    for (int tt = 0; tt < T / 32; ++tt) {
        {
            const size_t lrow = (size_t)bl * T + tt * 32 + ps; float q[8], f[8], kk[8];
            unpack8(*(const v4u*)(Z + lrow * NZ + ZC_HGQ + h * 128 + pc), q); unpack8(*(const v4u*)(Z + lrow * NZ + ZC_HGF + h * 128 + pc), f);
#pragma unroll
            for (int i = 0; i < 8; ++i) { q[i] = siluf_(q[i]); const float sg = sigmoidf_(f[i]); kk[i] = (1.0f - lb[i]) * (1.0f - sg); f[i] = fmaxf(lb[i] + (1.0f - lb[i]) * sg, 1e-30f); }
            *(LAS f32x4*)(TQ + ps * 128 + pc) = (f32x4){q[0], q[1], q[2], q[3]}; *(LAS f32x4*)(TQ + ps * 128 + pc + 4) = (f32x4){q[4], q[5], q[6], q[7]};
            *(LAS f32x4*)(TF + ps * 128 + pc) = (f32x4){f[0], f[1], f[2], f[3]}; *(LAS f32x4*)(TF + ps * 128 + pc + 4) = (f32x4){f[4], f[5], f[6], f[7]};
            *(LAS f32x4*)(TK + ps * 128 + pc) = (f32x4){kk[0], kk[1], kk[2], kk[3]}; *(LAS f32x4*)(TK + ps * 128 + pc + 4) = (f32x4){kk[4], kk[5], kk[6], kk[7]};
            const unsigned vw = *(const unsigned*)(Z + lrow * NZ + ZC_HGI + h * 128 + qt * 32 + (F.tid & 15) * 2);
            TV[ps * 32 + (F.tid & 15) * 2] = bflo(vw); TV[ps * 32 + (F.tid & 15) * 2 + 1] = bfhi(vw);
        }
        __syncthreads();
#pragma unroll 4
        for (int s = 0; s < 32; ++s) {
            const float vv = TV[s * 32 + el]; float o = 0.f;
#pragma unroll
            for (int j = 0; j < 2; ++j) { const f32x4 q = *(const LAS f32x4*)(TQ + s * 128 + j * 64 + ds * 4), f = *(const LAS f32x4*)(TF + s * 128 + j * 64 + ds * 4), kk = *(const LAS f32x4*)(TK + s * 128 + j * 64 + ds * 4);
#pragma unroll
                for (int i = 0; i < 4; ++i) { S[j * 4 + i] = f[i] * S[j * 4 + i] + kk[i] * vv; o += S[j * 4 + i] * q[i]; } }
            o = sum16(o);
            if (ds == 0) YT[s * 32 + el] = o;
        }
        __syncthreads();
        scan_writeout(F, YT, RAW + ((size_t)bl * T + tt * 32) * D + h * 128 + qt * 32, D);
    }
    __syncthreads();
}
DI void scan_mlstm(const Ctx& F, int l, int unit) {
    const int e8 = unit & 7, h = (unit >> 3) & 3, bl = unit >> 5;
    LAS float* TQ = (LAS float*)F.lds; LAS float* TKI = TQ + 8192; LAS float* TV = TQ + 16384; LAS float* YT = TQ + 17408;
    LAS float* TLI = TQ + 18432; LAS float* TLF = TLI + 32; LAS float* TFG = TLI + 64; LAS float* TIG = TLI + 96; LAS float* TEM = TLI + 128; LAS float* MC = TLI + 160;
    const bf16* Z = (const bf16*)(F.ws + WS_Z); const bf16* QK = (const bf16*)(F.ws + WS_QK); const float* SD = (const float*)(F.ws + WS_SIDE);
    bf16* RAW = (bf16*)(F.ws + WS_RAW);
    const float ib = F.in[I_IB][l * 4 + h], fb = F.in[I_FB][l * 4 + h];
    const int ps = F.tid >> 4, pc = (F.tid & 15) * 16;
    const int el = F.tid >> 4, ds = F.tid & 15;
    float C[16], N[16];
#pragma unroll
    for (int i = 0; i < 16; ++i) { C[i] = 0.f; N[i] = 0.f; }
    if (F.tid == 0) MC[0] = 0.f;
    for (int tt = 0; tt < T / 32; ++tt) {
        if (F.wave == 0) {
            if (F.lane < 32) { const size_t lrow = (size_t)bl * T + tt * 32 + F.lane;
                TLI[F.lane] = SD[lrow * NSIDE + h] + ib; TLF[F.lane] = -softplusf_(-(SD[lrow * NSIDE + 4 + h] + fb)); }
            LDS_WAIT(); asm volatile("" ::: "memory");
            if (F.lane == 0) { float m = MC[0];
                for (int s = 0; s < 32; ++s) { const float lf = TLF[s], li = TLI[s], mp = m; m = fmaxf(mp + lf, li); TFG[s] = __expf(lf + mp - m); TIG[s] = __expf(li - m); TEM[s] = __expf(-m); }
                MC[0] = m; }
        }
        __syncthreads();
        {
            const size_t lrow = (size_t)bl * T + tt * 32 + ps; const float ig = TIG[ps]; float q[8], k[8];
#pragma unroll
            for (int hh = 0; hh < 2; ++hh) {
                unpack8(*(const v4u*)(QK + lrow * 2048 + h * 512 + pc + hh * 8), q); unpack8(*(const v4u*)(QK + lrow * 2048 + h * 512 + 256 + pc + hh * 8), k);
                *(LAS f32x4*)(TQ + ps * 256 + pc + hh * 8) = (f32x4){q[0], q[1], q[2], q[3]}; *(LAS f32x4*)(TQ + ps * 256 + pc + hh * 8 + 4) = (f32x4){q[4], q[5], q[6], q[7]};
                *(LAS f32x4*)(TKI + ps * 256 + pc + hh * 8) = (f32x4){k[0] * ig, k[1] * ig, k[2] * ig, k[3] * ig}; *(LAS f32x4*)(TKI + ps * 256 + pc + hh * 8 + 4) = (f32x4){k[4] * ig, k[5] * ig, k[6] * ig, k[7] * ig};
            }
            const unsigned vw = *(const unsigned*)(Z + lrow * NZ + ZC_MLX + h * 256 + e8 * 32 + (F.tid & 15) * 2);
            TV[ps * 32 + (F.tid & 15) * 2] = bflo(vw); TV[ps * 32 + (F.tid & 15) * 2 + 1] = bfhi(vw);
        }
        __syncthreads();
#pragma unroll 2
        for (int s = 0; s < 32; ++s) {
            const float vv = TV[s * 32 + el], fg = TFG[s], em = TEM[s]; float num = 0.f, den = 0.f;
#pragma unroll
            for (int j = 0; j < 4; ++j) { const f32x4 q = *(const LAS f32x4*)(TQ + s * 256 + j * 64 + ds * 4), ki = *(const LAS f32x4*)(TKI + s * 256 + j * 64 + ds * 4);
#pragma unroll
                for (int i = 0; i < 4; ++i) { C[j * 4 + i] = fg * C[j * 4 + i] + ki[i] * vv; N[j * 4 + i] = fg * N[j * 4 + i] + ki[i]; num += C[j * 4 + i] * q[i]; den += N[j * 4 + i] * q[i]; } }
            num = sum16(num); den = sum16(den);
            if (ds == 0) YT[s * 32 + el] = num / fmaxf(fabsf(den), em);
        }
        __syncthreads();
        scan_writeout(F, YT, RAW + ((size_t)bl * T + tt * 32) * D + h * 256 + e8 * 32, D);
    }
    __syncthreads();
}

DI void phase_post(const Ctx& F, int l) {
    const int gw = F.bid * NWAVES + F.wave, NGW = F.G * NWAVES;
    const bf16* Z = (const bf16*)(F.ws + WS_Z); const bf16* XC = (const bf16*)(F.ws + WS_XC); const bf16* LO = (const bf16*)(F.ws + WS_LO); const bf16* BON = (const bf16*)(F.ws + WS_BON);
    bf16* RAW = (bf16*)(F.ws + WS_RAW);
    const int c0 = F.lane * 16;
    for (int row = gw; row < MG; row += NGW) {
        float a[16], b[16], c[16];
        { bf16* rp = RAW + (size_t)row * D + c0;
            unpack16(rp, a);
            unpack16(Z + (size_t)row * NZ + ZC_MLO + c0, b);
            unpack16(XC + (size_t)row * D + c0, c);
            float s = 0.f;
#pragma unroll
            for (int i = 0; i < 16; ++i) { a[i] *= sigmoidf_(b[i]); s += a[i]; }
            const float mean = sum16(s) * (1.f / 256.f); float q = 0.f;
#pragma unroll
            for (int i = 0; i < 16; ++i) { a[i] -= mean; q += a[i] * a[i]; }
            const float rstd = 1.0f / sqrtf(sum16(q) * (1.f / 256.f) + 1e-6f);
#pragma unroll
            for (int i = 0; i < 16; ++i) a[i] = a[i] * rstd * F.in[I_MLNW][l * D + c0 + i] + F.in[I_MLSKIP][l * D + c0 + i] * c[i];
            pack16(rp, a); }
        { bf16* rp = RAW + (size_t)(MG + row) * D + c0;
            unpack16(rp, a);
            unpack16(BON + (size_t)row * D + c0, b);
            unpack16(LO + (size_t)row * NLORA + 2048 + c0, c);
            float s = 0.f;
#pragma unroll
            for (int i = 0; i < 16; ++i) s += a[i];
            const float mean = sum4(s) * (1.f / 64.f); float q = 0.f;
#pragma unroll
            for (int i = 0; i < 16; ++i) { a[i] -= mean; q += a[i] * a[i]; }
            const float rstd = 1.0f / sqrtf(sum4(q) * (1.f / 64.f) + 64e-5f);
#pragma unroll
            for (int i = 0; i < 16; ++i) a[i] = (a[i] * rstd * F.in[I_LNW][l * D + c0 + i] + F.in[I_LNB][l * D + c0 + i] + b[i]) * c[i];
            pack16(rp, a); }
        { bf16* rp = RAW + (size_t)(2 * MG + row) * D + c0;
            unpack16(rp, a);
            unpack16(Z + (size_t)row * NZ + ZC_HGG + c0, b);
            float q = 0.f;
#pragma unroll
            for (int i = 0; i < 16; ++i) q += a[i] * a[i];
            const float rstd = 1.0f / sqrtf(sum8(q) * (1.f / 128.f) + 1e-6f);
#pragma unroll
            for (int i = 0; i < 16; ++i) a[i] = a[i] * rstd * F.in[I_HGNW][l * D + c0 + i] * sigmoidf_(b[i]);
            pack16(rp, a); }
    }
}

enum { PH_W = 0, PH_A1, PH_A2, PH_A3, PH_B1, PH_B2, PH_B3, PH_B4, PH_B5, PH_B6, PH_B7, PH_B8, PH_FIN, PH_N };

__global__ void __launch_bounds__(NTHREADS, 2) fwd_kernel(Args args) {
    extern __shared__ __attribute__((aligned(16))) unsigned char lds_raw[];
    Ctx F;
    F.lds = (LAS unsigned char*)lds_raw; F.in = args.in; F.out = args.out; F.ws = args.ws;
    F.tid = threadIdx.x; F.lane = F.tid & 63; F.wave = __builtin_amdgcn_readfirstlane(F.tid >> 6); F.bid = blockIdx.x; F.G = gridDim.x;
    volatile LAS unsigned* MISC = (volatile LAS unsigned*)(F.lds + MISC_OFF);
    if (F.tid < 32) MISC[F.tid] = 0u;
    __syncthreads();
    XcdBarrier bar; bar.bar = (unsigned*)(F.ws + WS_CTL) + CW_BAR; bar.x = 0; bar.st = nullptr;
    if (args.use_bar) bar = xcd_barrier_post((unsigned*)(F.ws + WS_CTL) + CW_BAR, MISC + 8);
#ifndef PHMASK
#define PHMASK 0xFFFF
#endif
#define IN(k) (((PHMASK >> (k)) & 1) && args.ph_lo <= (k) && (k) < args.ph_hi)
#define PHASE(k) if (IN(k) && (refresh(F), true))
#define SEAM() do { if (args.use_bar) xcd_barrier(bar); } while (0)
    const float* MOD = (const float*)(F.ws + WS_MOD);
    for (int f = args.f_lo; f < args.f_hi; ++f) {
        const int l = f >> 1, fi = f & 1;
        const float* modl = MOD + (size_t)l * NB * NMOD;
        if (fi == 0) PHASE(PH_W) { phase_weights(F, l); if (l == 0) { __syncthreads(); phase_mod(F); } SEAM(); }
        const int sub = fi ? 2 : 0;
        const float* xsrc = (f == 0) ? F.in[I_X] : F.out;
        PHASE(PH_A1) { phase_modulate<false>(F, xsrc, (bf16*)(F.ws + WS_H), F.in[I_NORMW] + (size_t)(l * 3 + sub) * D, modl, sub, 0, M, nullptr); SEAM(); }
        PHASE(PH_A2) {
            pg8::Gemm gm{(const bf16*)(F.ws + WS_H), (const bf16*)(F.ws + WS_WUP) + (size_t)fi * NUP * D, D, D, D, 0, 0};
            pg8::Order<0> S; S.init(M / 256, NUP / 256, F.G, F.bid);
            pg8::EpiSwiGLU E{(bf16*)(F.ws + WS_HID), DFF};
            pg8::gemm_phase(F.lds, gm, S, E); SEAM(); }
        PHASE(PH_A3) {
            pg8::Gemm gm{(const bf16*)(F.ws + WS_HID), (const bf16*)(F.ws + WS_WDN) + (size_t)fi * D * DFF, DFF, DFF, DFF, 0, 0};
            pg8::Order<0> S; S.init(M / 256, D / 256, F.G, F.bid);
            pg8::EpiResid E{xsrc, F.out, modl + (sub * 3 + 2) * D, 0.5f, 0};
            pg8::gemm_phase(F.lds, gm, S, E); SEAM(); }
        if (fi == 0) {
            for (int g = args.g_lo; g < args.g_hi; ++g) {
                float* xg = F.out + (size_t)g * MG * D;
                PHASE(PH_B1) { phase_modulate<true>(F, F.out, (bf16*)(F.ws + WS_HG), F.in[I_NORMW] + (size_t)(l * 3 + 1) * D, modl, 1, g * MG, MG, (float*)(F.ws + WS_SIDE)); SEAM(); }
                PHASE(PH_B2) {
                    pg8::Gemm gm{(const bf16*)(F.ws + WS_HG), (const bf16*)(F.ws + WS_WIN), D, D, D, 0, 0};
                    pg8::Order<0> S; S.init(MG / 256, NZ / 256, F.G, F.bid);
                    pg8::EpiBf16 E{(bf16*)(F.ws + WS_Z), NZ, 0};
                    pg8::gemm_phase(F.lds, gm, S, E); SEAM(); }
                PHASE(PH_B3) { phase_prep(F, l); SEAM(); }
                PHASE(PH_B4) {
                    { pg8::Gemm gm{(const bf16*)(F.ws + WS_XC), (const bf16*)(F.ws + WS_WQK), 256, D, 256, 256, (size_t)512 * 256};
                      pg8::Order<1> S; S.init(MG / 256, 8, F.G, F.bid);
                      pg8::EpiBf16 E{(bf16*)(F.ws + WS_QK), 2048, 512};
                      pg8::gemm_phase(F.lds, gm, S, E); }
                    __syncthreads();
                    { pg8::Gemm gm{(const bf16*)(F.ws + WS_LA), (const bf16*)(F.ws + WS_WLORA), l == 0 ? 256 : 384, KLORA, KLORA, 0, 0};
                      pg8::Order<0> S; S.init(MG / 256, l == 0 ? 12 : 16, F.G, F.bid);
                      pg8::EpiBf16 E{(bf16*)(F.ws + WS_LO), NLORA, 0};
                      pg8::gemm_phase(F.lds, gm, S, E); }
                    SEAM(); }
                PHASE(PH_B5) {
                    for (int u = F.bid; u < 384; u += F.G) {
                        if (u < 128) scan_rwkv(F, l, g, u); else if (u < 256) scan_mlstm(F, l, u - 128); else scan_hgrn(F, l, u - 256);
                    }
                    SEAM(); }
                PHASE(PH_B6) {
                    phase_post(F, l);
                    __syncthreads();
                    { pg8::Gemm gm{(const bf16*)(F.ws + WS_HG), (const bf16*)(F.ws + WS_WIN) + (size_t)NZ * D, D, D, D, 0, 0};
                      pg8::Order<0> S; S.init(MG / 256, 12, F.G, F.bid);
                      pg8::EpiBf16 E{(bf16*)(F.ws + WS_Z) + ZC_GATE, NZ, 0};
                      pg8::gemm_phase(F.lds, gm, S, E); }
                    SEAM(); }
                PHASE(PH_B7) {
                    pg8::Gemm gm{(const bf16*)(F.ws + WS_RAW), (const bf16*)(F.ws + WS_WBR), D, D, D, (size_t)MG * D, (size_t)D * D};
                    pg8::Order<2> S; S.init(MG / 256, 4, F.G, F.bid);
                    pg8::EpiBranch E{(const bf16*)(F.ws + WS_Z) + ZC_GATE, NZ, (float*)(F.ws + WS_QK), (bf16*)(F.ws + WS_XC)};
                    pg8::gemm_phase(F.lds, gm, S, E); SEAM(); }
                PHASE(PH_B8) {
                    pg8::Gemm gm{(const bf16*)(F.ws + WS_XC), (const bf16*)(F.ws + WS_WOUT), D, D, D, 0, 0};
                    pg8::Order<0> S; S.init(MG / 256, 4, F.G, F.bid);
                    pg8::EpiResid E{xg, xg, modl + (1 * 3 + 2) * D, 1.0f, g * GB};
                    pg8::gemm_phase(F.lds, gm, S, E); SEAM(); }
            }
        }
    }
    PHASE(PH_FIN) phase_final_norm(F);
#undef IN
#undef PHASE
#undef SEAM
}

extern "C" void kernel_launch(void* const* d_in, const int* in_sizes, int n_in, void* d_out, int out_size, void* d_ws, size_t ws_size, hipStream_t stream) {
    static int grid = 0;
    if (grid == 0) {
        if (n_in != 36 || out_size != M * D || ws_size < WS_END) { fprintf(stderr, "kernel_launch: unexpected problem (n_in %d out %d ws %zu, need %zu)\n", n_in, out_size, ws_size, (size_t)WS_END); grid = -1; return; }
        int dev = 0, cus = 0;
        if (hipGetDevice(&dev) != hipSuccess || hipDeviceGetAttribute(&cus, hipDeviceAttributeMultiprocessorCount, dev) != hipSuccess) { grid = -1; return; }
        if (hipFuncSetAttribute((const void*)fwd_kernel, hipFuncAttributeMaxDynamicSharedMemorySize, LDS_BYTES) != hipSuccess) { fprintf(stderr, "kernel_launch: hipFuncSetAttribute failed\n"); grid = -1; return; }
        int per_cu = 0;
        if (hipOccupancyMaxActiveBlocksPerMultiprocessor(&per_cu, (const void*)fwd_kernel, NTHREADS, LDS_BYTES) != hipSuccess || per_cu < 1) { fprintf(stderr, "kernel_launch: occupancy query says %d\n", per_cu); }
        (void)hipGetLastError();
        grid = cus;
    }
    if (grid < 0) return;
    (void)hipMemsetAsync((char*)d_ws + WS_CTL, 0, CTL_BYTES, stream);
    Args a{};
    for (int i = 0; i < 36; ++i) a.in[i] = (const float*)d_in[i];
    a.out = (float*)d_out; a.ws = (unsigned char*)d_ws; a.pad = 0;
#if ONE_LAUNCH
    a.f_lo = 0; a.f_hi = 4; a.g_lo = 0; a.g_hi = NGRP; a.ph_lo = 0; a.ph_hi = PH_N; a.use_bar = 1;
    hipLaunchKernelGGL(fwd_kernel, dim3(grid), dim3(NTHREADS), LDS_BYTES, stream, a);
#else
    a.use_bar = 0;
    for (int f = 0; f < 4; ++f) {
        a.f_lo = f; a.f_hi = f + 1;
        for (int ph = PH_W; ph <= PH_A3; ++ph) {
            if (ph == PH_W && (f & 1)) continue;
            a.ph_lo = ph; a.ph_hi = ph + 1; a.g_lo = 0; a.g_hi = 0;
            hipLaunchKernelGGL(fwd_kernel, dim3(grid), dim3(NTHREADS), LDS_BYTES, stream, a);
        }
        if ((f & 1) == 0)
            for (int g = 0; g < NGRP; ++g)
                for (int ph = PH_B1; ph <= PH_B8; ++ph) { a.ph_lo = ph; a.ph_hi = ph + 1; a.g_lo = g; a.g_hi = g + 1;
                    hipLaunchKernelGGL(fwd_kernel, dim3(grid), dim3(NTHREADS), LDS_BYTES, stream, a); }
    }
    a.f_lo = 0; a.f_hi = 0; a.g_lo = 0; a.g_hi = 0; a.ph_lo = PH_FIN; a.ph_hi = PH_FIN + 1;
    hipLaunchKernelGGL(fwd_kernel, dim3(grid), dim3(NTHREADS), LDS_BYTES, stream, a);
#endif
}
```

```cpp
#include <hip/hip_runtime.h>
#include <cstdio>
#include <cstdint>

#ifndef ONE_LAUNCH
#define ONE_LAUNCH 1
#endif

#define GAS __attribute__((address_space(1)))
#define LAS __attribute__((address_space(3)))
typedef unsigned short bf16;
typedef unsigned v4u __attribute__((ext_vector_type(4)));
typedef unsigned v2u __attribute__((ext_vector_type(2)));
typedef float f32x4 __attribute__((ext_vector_type(4)));
typedef float f32x2 __attribute__((ext_vector_type(2)));
typedef short bf16x8 __attribute__((ext_vector_type(8)));
#define DI __device__ __forceinline__

constexpr int D = 1024, NB = 16, T = 2048, M = NB * T, DFF = 2816, NUP = 2 * DFF;
constexpr int GB = 4, MG = GB * T, NGRP = NB / GB;
constexpr int NZ = 9472;
constexpr int ZC_MLX = 0, ZC_MLO = 1024, ZC_RW = 2048, ZC_HGQ = 5376, ZC_HGF = 6400, ZC_HGI = 7424, ZC_HGG = 8448;
constexpr int ZC_GATE = 5376;
constexpr int NWIN = 12544;
constexpr int WIN_SRC = 12552;
constexpr int NSIDE = 40, KLORA = 384, NLORA = 4096, NMOD = 9216;
constexpr int NTHREADS = 512, NWAVES = 8;

constexpr size_t MiB = 1u << 20;
constexpr size_t WS_CTL = 0, CTL_BYTES = 1 * MiB;
constexpr size_t WS_MOD = 1 * MiB;
constexpr size_t WS_WSIDE = 3 * MiB;
constexpr size_t WS_WUP = 4 * MiB;
constexpr size_t WS_WDN = 26 * MiB;
constexpr size_t WS_WIN = 37 * MiB;
constexpr size_t WS_WBR = 62 * MiB;
constexpr size_t WS_WOUT = 68 * MiB;
constexpr size_t WS_WQK = 70 * MiB;
constexpr size_t WS_WLORA = 71 * MiB;
constexpr size_t WS_VF = 74 * MiB;
constexpr size_t WS_ACT = 138 * MiB;
constexpr size_t WS_H = WS_ACT;
constexpr size_t WS_HID = WS_ACT + 64 * MiB;
constexpr size_t WS_HG = WS_ACT;
constexpr size_t WS_Z = WS_ACT + 16 * MiB;
constexpr size_t WS_XC = WS_ACT + 164 * MiB;
constexpr size_t WS_QK = WS_ACT + 180 * MiB;
constexpr size_t WS_LA = WS_ACT + 212 * MiB;
constexpr size_t WS_LO = WS_ACT + 218 * MiB;
constexpr size_t WS_SIDE = WS_ACT + 282 * MiB;
constexpr size_t WS_RAW = WS_ACT + 284 * MiB;
constexpr size_t WS_BON = WS_ACT + 332 * MiB;
constexpr size_t WS_END = WS_ACT + 348 * MiB;
static_assert(WS_HID + (size_t)M * DFF * 2 <= WS_END, "ffn view fits");
static_assert(WS_Z + (size_t)MG * NZ * 2 <= WS_XC, "z fits");

constexpr int CW_BAR = 4096;

constexpr int LDS_BYTES = 147456;
constexpr int MISC_OFF = 131072 + 320;

DI unsigned f2bf(float f) { unsigned u = __builtin_bit_cast(unsigned, f); return (u + 0x7fffu + ((u >> 16) & 1u)) >> 16; }
DI unsigned pk2(float lo, float hi) { unsigned r; asm("v_cvt_pk_bf16_f32 %0, %1, %2" : "=v"(r) : "v"(lo), "v"(hi)); return r; }
DI float bflo(unsigned w) { return __builtin_bit_cast(float, w << 16); }
DI float bfhi(unsigned w) { return __builtin_bit_cast(float, w & 0xffff0000u); }
DI float bf1(bf16 h) { return __builtin_bit_cast(float, (unsigned)h << 16); }
DI float sigmoidf_(float x) { return __builtin_amdgcn_rcpf(1.0f + __expf(-x)); }
DI float siluf_(float x) { return x * __builtin_amdgcn_rcpf(1.0f + __expf(-x)); }
DI float softplusf_(float x) { return fmaxf(x, 0.f) + __logf(1.0f + __expf(-fabsf(x))); }
template <int CTRL> DI float dppf(float v) { return __builtin_bit_cast(float, __builtin_amdgcn_update_dpp(0, __builtin_bit_cast(int, v), CTRL, 0xF, 0xF, true)); }
DI float sum4(float v) { v += dppf<0xB1>(v); v += dppf<0x4E>(v); return v; }
DI float sum8(float v) { v = sum4(v); v += dppf<0x141>(v); return v; }
DI float sum16(float v) { v = sum8(v); v += dppf<0x140>(v); return v; }
DI float wave_sum(float v) {
    v = sum16(v);
    const float a = __builtin_bit_cast(float, __builtin_amdgcn_readlane(__builtin_bit_cast(int, v), 0)), b = __builtin_bit_cast(float, __builtin_amdgcn_readlane(__builtin_bit_cast(int, v), 16));
    const float c = __builtin_bit_cast(float, __builtin_amdgcn_readlane(__builtin_bit_cast(int, v), 32)), d = __builtin_bit_cast(float, __builtin_amdgcn_readlane(__builtin_bit_cast(int, v), 48));
    return (a + b) + (c + d);
}
#define LDS_WAIT() asm volatile("s_waitcnt lgkmcnt(0)" ::: "memory")
#define VM_WAIT() asm volatile("s_waitcnt vmcnt(0)" ::: "memory")
DI void unpack8(const v4u w, float (&o)[8]) { o[0] = bflo(w.x); o[1] = bfhi(w.x); o[2] = bflo(w.y); o[3] = bfhi(w.y); o[4] = bflo(w.z); o[5] = bfhi(w.z); o[6] = bflo(w.w); o[7] = bfhi(w.w); }
DI void unpack16(const bf16* p, float (&o)[16]) { const v4u a = *(const v4u*)p, b = *(const v4u*)(p + 8);
    o[0] = bflo(a.x); o[1] = bfhi(a.x); o[2] = bflo(a.y); o[3] = bfhi(a.y); o[4] = bflo(a.z); o[5] = bfhi(a.z); o[6] = bflo(a.w); o[7] = bfhi(a.w);
    o[8] = bflo(b.x); o[9] = bfhi(b.x); o[10] = bflo(b.y); o[11] = bfhi(b.y); o[12] = bflo(b.z); o[13] = bfhi(b.z); o[14] = bflo(b.w); o[15] = bfhi(b.w); }
DI void pack16(bf16* p, const float (&o)[16]) { v4u a, b; a.x = pk2(o[0], o[1]); a.y = pk2(o[2], o[3]); a.z = pk2(o[4], o[5]); a.w = pk2(o[6], o[7]);
    b.x = pk2(o[8], o[9]); b.y = pk2(o[10], o[11]); b.z = pk2(o[12], o[13]); b.w = pk2(o[14], o[15]); *(v4u*)p = a; *(v4u*)(p + 8) = b; }
DI v4u pack8(const float (&o)[8]) { v4u w; w.x = pk2(o[0], o[1]); w.y = pk2(o[2], o[3]); w.z = pk2(o[4], o[5]); w.w = pk2(o[6], o[7]); return w; }

#define XB_TMO      128
#define XB_XCNT(j)  (256  + 64 * (j))
#define XB_XSUB(j)  (1280 + 64 * (j))
#define XB_XGEN(j)  (2304 + 64 * (j))
#define XB_TOP      3328
#define XB_TOPGEN   3392
#define XCD_BAR_WORDS 3456
#define XB_SPIN_CAP (1u << 22)
__device__ __forceinline__ unsigned xb_ld(unsigned* p)              { return __hip_atomic_load(p, __ATOMIC_RELAXED, __HIP_MEMORY_SCOPE_AGENT); }
__device__ __forceinline__ unsigned xb_add(unsigned* p, unsigned v) { return __hip_atomic_fetch_add(p, v, __ATOMIC_RELAXED, __HIP_MEMORY_SCOPE_AGENT); }
__device__ __forceinline__ unsigned xb_xcc_id() { return (unsigned)__builtin_amdgcn_s_getreg((3 << 11) | 20) & 0xFu; }
#define XB_SPIN(cond, bar) do { unsigned _sp = 0; while (cond) { __builtin_amdgcn_s_sleep(1); \
    if ((++_sp & 255u) == 0u) { if (xb_ld(&(bar)[XB_TMO])) break; if (_sp > XB_SPIN_CAP) { atomicAdd(&(bar)[XB_TMO], 1u); break; } } } } while (0)
struct XcdBarrier { unsigned* bar; unsigned x; volatile LAS unsigned* st; };
__device__ __forceinline__ XcdBarrier xcd_barrier_post(unsigned* bar, volatile LAS unsigned* st) {
    XcdBarrier b; b.bar = bar; b.x = xb_xcc_id(); b.st = st;
    if (threadIdx.x == 0) (void)xb_add(&bar[XB_XCNT(b.x)], 1u);
    return b;
}
__device__ __forceinline__ void xcd_barrier_complete(unsigned* bar, unsigned x, unsigned& nloc, unsigned& nx) {
    const unsigned G = gridDim.x * gridDim.y * gridDim.z;
    unsigned sum, cnt, mine, sp = 0u;
    for (;;) {
        sum = 0u; cnt = 0u; mine = 0u;
#pragma unroll
        for (unsigned j = 0; j < 16; ++j) { const unsigned c = xb_ld(&bar[XB_XCNT(j)]); sum += c; cnt += (c > 0u) ? 1u : 0u; mine = (j == x) ? c : mine; }
        if (sum == G) break;
        __builtin_amdgcn_s_sleep(1);
        if ((++sp & 255u) == 0u) { if (xb_ld(&bar[XB_TMO])) break; if (sp > XB_SPIN_CAP) { atomicAdd(&bar[XB_TMO], 1u); break; } }
    }
    nloc = mine > 0u ? mine : 1u; nx = cnt > 0u ? cnt : 1u;
}
__device__ __forceinline__ void xcd_barrier(const XcdBarrier& b) {
    asm volatile("s_waitcnt vmcnt(0)" ::: "memory");
    __syncthreads();
    if (threadIdx.x == 0) {
        unsigned* bar = b.bar;
        __builtin_amdgcn_s_waitcnt(0);
        unsigned nloc = b.st[0], nx = b.st[1];
        if (nloc == 0u) { xcd_barrier_complete(bar, b.x, nloc, nx); b.st[0] = nloc; b.st[1] = nx; }
        const unsigned old = xb_add(&bar[XB_XSUB(b.x)], 1u);
        const unsigned gen = old / nloc;
        if (old + 1u == (gen + 1u) * nloc) {
            __builtin_amdgcn_fence(__ATOMIC_RELEASE, "agent");
            asm volatile("s_waitcnt vmcnt(0)" ::: "memory");
            const unsigned og = xb_add(&bar[XB_TOP], 1u);
            const unsigned tg = og / nx;
            if (og + 1u == (tg + 1u) * nx) xb_add(&bar[XB_TOPGEN], 1u);
            else XB_SPIN(xb_ld(&bar[XB_TOPGEN]) == tg, bar);
            __builtin_amdgcn_fence(__ATOMIC_ACQUIRE, "agent");
            xb_add(&bar[XB_XGEN(b.x)], 1u);
            asm volatile("s_waitcnt vmcnt(0)" ::: "memory");
        } else {
            XB_SPIN(xb_ld(&bar[XB_XGEN(b.x)]) == gen, bar);
            __builtin_amdgcn_fence(__ATOMIC_ACQUIRE, "agent");
            asm volatile("s_waitcnt vmcnt(0)" ::: "memory");
        }
    }
    __syncthreads();
}

namespace pg8 {
constexpr int BM = 256, BK = 64, HALF = 128, HTB = HALF * BK * 2, STAGE_BYTES = 8 * HTB, NXCD = 8, WGM = 8;
DI int lds_byte(int r, int c) { const int st = (r >> 4) * 2 + (c >> 5), rr = r & 15, cc = c & 31, ob = rr * 64 + cc * 2; return st * 1024 + (ob ^ (((ob >> 9) & 1) << 5)); }
DI void stage_rc(int b, int& R, int& C) { const int st = b / 1024, sb = b % 1024, swz = sb ^ (((sb >> 9) & 1) << 5); R = (st >> 1) * 16 + swz / 64; C = (st & 1) * 32 + (swz % 64) / 2; }
DI int perm32(int rho) { const int n = rho >> 4, i = rho & 15; return 8 * (i >> 2) + 4 * n + (i & 3); }

struct Unit { int pm, pn, pz; };
struct Gemm { const bf16* A; const bf16* Bt; int K, lda, ldb; size_t a_z, b_z; };

template <int MODE> struct Order {
    int nM, nN, nwg, G, c;
    DI void init(int nM_, int nN_, int G_, int c_) { nM = nM_; nN = nN_; nwg = nM * nN; G = G_; c = c_; }
    DI bool next(int i, Unit& u) const {
        const int ii = (MODE == 2) ? i / 3 : i;
        const long L = (long)ii * G + c; if (L >= nwg) return false;
        int wgid = (int)L; { const int q = nwg / NXCD, r = nwg % NXCD, xcd = wgid % NXCD, off = wgid / NXCD; wgid = (xcd < r ? xcd * (q + 1) : r * (q + 1) + (xcd - r) * q) + off; }
        const int nig = WGM * nN, gid = wgid / nig, fm = gid * WGM, gsz = (nM - fm) < WGM ? (nM - fm) : WGM;
        u.pm = fm + ((wgid % nig) % gsz); const int pn = (wgid % nig) / gsz;
        if (MODE == 1) { u.pz = pn >> 1; u.pn = pn & 1; } else if (MODE == 2) { u.pz = i - ii * 3; u.pn = pn; } else { u.pz = 0; u.pn = pn; }
        return true;
    }
};

struct EpiBf16 {
    static constexpr bool PERM = true;
    bf16* O; int ldc; int zcols;
    DI void operator()(const f32x4 (&acc)[2][2][4][2], const Unit& u, int wr, int wc, int fr, int fq) const {
        const int row0 = u.pm * BM + wr * 64 + fr; const int col0 = u.pz * zcols + u.pn * BM + wc * 32 + 8 * fq;
#pragma unroll
        for (int ai = 0; ai < 2; ++ai)
#pragma unroll
            for (int m = 0; m < 4; ++m) { bf16* rowp = O + (size_t)(row0 + ai * HALF + m * 16) * ldc + col0;
#pragma unroll
                for (int bj = 0; bj < 2; ++bj) { const f32x4 v0 = acc[ai][bj][m][0], v1 = acc[ai][bj][m][1];
                    v4u w; w.x = pk2(v0[0], v0[1]); w.y = pk2(v0[2], v0[3]); w.z = pk2(v1[0], v1[1]); w.w = pk2(v1[2], v1[3]);
                    *(v4u*)(rowp + bj * HALF) = w; } }
    }
};
struct EpiSwiGLU {
    static constexpr bool PERM = true;
    bf16* O; int ldc;
    DI void operator()(const f32x4 (&acc)[2][2][4][2], const Unit& u, int wr, int wc, int fr, int fq) const {
        const int row0 = u.pm * BM + wr * 64 + fr; const int col0 = u.pn * HALF + wc * 32 + 8 * fq;
#pragma unroll
        for (int ai = 0; ai < 2; ++ai)
#pragma unroll
            for (int m = 0; m < 4; ++m) { bf16* rowp = O + (size_t)(row0 + ai * HALF + m * 16) * ldc + col0;
                float o[8];
#pragma unroll
                for (int n = 0; n < 2; ++n)
#pragma unroll
                    for (int j = 0; j < 4; ++j) { const float a = acc[ai][0][m][n][j], b = acc[ai][1][m][n][j]; o[n * 4 + j] = a * b * __builtin_amdgcn_rcpf(1.0f + __expf(-a)); }
                *(v4u*)rowp = pack8(o); }
    }
};
struct EpiResid {
    static constexpr bool PERM = false;
    const float* xin; float* xout; const float* gate; float mul; int b0;
    DI void operator()(const f32x4 (&acc)[2][2][4][2], const Unit& u, int wr, int wc, int fr, int fq) const {
        const int row0 = u.pm * BM + wr * 64 + fr, col0 = u.pn * BM + wc * 32 + 4 * fq;
        const float* gp = gate + (size_t)(b0 + (u.pm * BM) / T) * NMOD + col0;
        f32x4 cf[2][2];
#pragma unroll
        for (int bj = 0; bj < 2; ++bj)
#pragma unroll
            for (int n = 0; n < 2; ++n) cf[bj][n] = (*(const f32x4*)(gp + bj * HALF + n * 16) + 1.0f) * mul;
#pragma unroll
        for (int ai = 0; ai < 2; ++ai)
#pragma unroll
            for (int m = 0; m < 4; ++m) { const size_t off = (size_t)(row0 + ai * HALF + m * 16) * D + col0;
#pragma unroll
                for (int bj = 0; bj < 2; ++bj)
#pragma unroll
                    for (int n = 0; n < 2; ++n) { const f32x4 xi = *(const f32x4*)(xin + off + bj * HALF + n * 16);
                        *(f32x4*)(xout + off + bj * HALF + n * 16) = xi + cf[bj][n] * acc[ai][bj][m][n]; }
                asm volatile("" ::: "memory"); }
    }
};
struct EpiBranch {
    static constexpr bool PERM = false;
    const bf16* gates; int ldg; float* mixf; bf16* mixb;
    DI void operator()(const f32x4 (&acc)[2][2][4][2], const Unit& u, int wr, int wc, int fr, int fq) const {
        const int row0 = u.pm * BM + wr * 64 + fr, col0 = u.pn * BM + wc * 32 + 4 * fq;
#pragma unroll
        for (int ai = 0; ai < 2; ++ai)
#pragma unroll
            for (int m = 0; m < 4; ++m) { const int row = row0 + ai * HALF + m * 16; const size_t off = (size_t)row * D + col0; const bf16* gp = gates + (size_t)row * ldg + u.pz * D + col0;
#pragma unroll
                for (int bj = 0; bj < 2; ++bj)
#pragma unroll
                    for (int n = 0; n < 2; ++n) { const v2u gw = *(const v2u*)(gp + bj * HALF + n * 16);
                        f32x4 g; g[0] = sigmoidf_(bflo(gw.x)); g[1] = sigmoidf_(bfhi(gw.x)); g[2] = sigmoidf_(bflo(gw.y)); g[3] = sigmoidf_(bfhi(gw.y));
                        f32x4 v = g * acc[ai][bj][m][n];
                        if (u.pz > 0) v += *(const f32x4*)(mixf + off + bj * HALF + n * 16);
                        if (u.pz < 2) *(f32x4*)(mixf + off + bj * HALF + n * 16) = v;
                        else { v2u w; w.x = pk2(v[0], v[1]); w.y = pk2(v[2], v[3]); *(v2u*)(mixb + off + bj * HALF + n * 16) = w; } }
                asm volatile("" ::: "memory"); }
    }
};

template <class Epi, class Sched>
DI void gemm_phase(LAS unsigned char* lds, const Gemm g, const Sched& S, const Epi& E, int tid_) {
    asm volatile("" : "+v"(tid_));
    const int tid = tid_, wid = __builtin_amdgcn_readfirstlane(tid >> 6), lane = tid & 63, wr = wid >> 2, wc = wid & 3, fr = lane & 15, fq = lane >> 4;
    int K_ = g.K; asm volatile("" : "+s"(K_));
    const int K = K_, nt = K / BK;
    unsigned voffA[2], voffB[2];
#pragma unroll
    for (int i = 0; i < 2; ++i) { int R, C; stage_rc(tid * 16 + i * 8192, R, C); const int Rb = Epi::PERM ? ((R & ~31) + perm32(R & 31)) : R;
        voffA[i] = (unsigned)(R * g.lda + C) * 2u; voffB[i] = (unsigned)(Rb * g.ldb + C) * 2u; }
    const size_t kstep = (size_t)(BK * 2);
    const size_t hstepA = (size_t)HALF * g.lda * 2, hstepB = (size_t)HALF * g.ldb * 2;
    const size_t tstepA = 2 * hstepA, tstepB = 2 * hstepB;
    const unsigned ldsw = (unsigned)wid * 1024u;
    const int aoff = lds_byte(wr * 64 + fr, fq * 8), boff = lds_byte(wc * 32 + fr, fq * 8);
#define PG8_SA(b, h) (((b) * 2 + (h)) * HTB)
#define PG8_SB(b, h) ((4 + (b) * 2 + (h)) * HTB)
#define PG8_STAGE(bufoff, gbase, voff) do { _Pragma("unroll") for (int _i = 0; _i < 2; ++_i) \
        __builtin_amdgcn_global_load_lds((const unsigned*)((const char*)(gbase) + (voff)[_i]), (LAS unsigned*)(lds + (bufoff) + ldsw + _i * 8192), 16, 0, 0); } while (0)
#define PG8_LDA(dst, b, h) do { _Pragma("unroll") for (int m = 0; m < 4; ++m) _Pragma("unroll") for (int k = 0; k < 2; ++k) dst[m][k] = *(const LAS bf16x8*)(lds + PG8_SA(b, h) + aoff + m * 2048 + k * 1024); } while (0)
#define PG8_LDB(dst, b, h) do { _Pragma("unroll") for (int n = 0; n < 2; ++n) _Pragma("unroll") for (int k = 0; k < 2; ++k) dst[n][k] = *(const LAS bf16x8*)(lds + PG8_SB(b, h) + boff + n * 2048 + k * 1024); } while (0)
#define PG8_MMA(ai, bj, At, Bt) do { __builtin_amdgcn_s_setprio(1); _Pragma("unroll") for (int m = 0; m < 4; ++m) _Pragma("unroll") for (int n = 0; n < 2; ++n) _Pragma("unroll") for (int k = 0; k < 2; ++k) \
        acc[ai][bj][m][n] = __builtin_amdgcn_mfma_f32_16x16x32_bf16(Bt[n][k], At[m][k], acc[ai][bj][m][n], 0, 0, 0); __builtin_amdgcn_s_setprio(0); } while (0)
#define PG8_WAIT_V(n) asm volatile("s_waitcnt vmcnt(" #n ")" ::: "memory")
#define PG8_WAIT_L(n) asm volatile("s_waitcnt lgkmcnt(" #n ")" ::: "memory")
#define PG8_BAR __builtin_amdgcn_s_barrier()
#define PG8_SCHED __builtin_amdgcn_sched_barrier(0)
    Unit cur, nxt; int ui = 0;
    if (!S.next(0, cur)) return;
    f32x4 acc[2][2][4][2];
#pragma unroll
    for (int a = 0; a < 2; ++a)
#pragma unroll
        for (int b = 0; b < 2; ++b)
#pragma unroll
            for (int m = 0; m < 4; ++m)
#pragma unroll
                for (int n = 0; n < 2; ++n) acc[a][b][m][n] = (f32x4){0.f, 0.f, 0.f, 0.f};
    bf16x8 At[4][2], B0[2][2], B1[2][2];
    const char* cA = (const char*)(g.A + (size_t)cur.pz * g.a_z) + (size_t)cur.pm * tstepA; const char* cB = (const char*)(g.Bt + (size_t)cur.pz * g.b_z) + (size_t)cur.pn * tstepB;
    PG8_STAGE(PG8_SB(0, 0), cB, voffB); PG8_STAGE(PG8_SB(0, 1), cB + hstepB, voffB); PG8_STAGE(PG8_SA(0, 0), cA, voffA); PG8_STAGE(PG8_SA(0, 1), cA + hstepA, voffA);
    if (wr == 1) PG8_BAR;
    PG8_WAIT_V(2); PG8_BAR;
    PG8_STAGE(PG8_SB(1, 0), cB + kstep, voffB); PG8_STAGE(PG8_SA(1, 0), cA + kstep, voffA); PG8_STAGE(PG8_SB(1, 1), cB + hstepB + kstep, voffB);
    PG8_WAIT_V(6); PG8_BAR;
    for (;;) {
        const bool has_next = S.next(ui + 1, nxt);
        const char* nA = has_next ? (const char*)(g.A + (size_t)nxt.pz * g.a_z) + (size_t)nxt.pm * tstepA : cA; const char* nB = has_next ? (const char*)(g.Bt + (size_t)nxt.pz * g.b_z) + (size_t)nxt.pn * tstepB : cB;
        for (int t = 0; t < nt; t += 2) {
            const bool last = (t == nt - 2);
            const char* a1 = cA + (size_t)(t + 1) * kstep;
            const char* a2 = last ? nA : cA + (size_t)(t + 2) * kstep; const char* b2 = last ? nB : cB + (size_t)(t + 2) * kstep;
            const char* a3 = a2 + kstep; const char* b3 = b2 + kstep;
            PG8_LDB(B0, 0, 0); PG8_LDB(B1, 0, 1); PG8_SCHED; PG8_LDA(At, 0, 0); PG8_STAGE(PG8_SA(1, 1), a1 + hstepA, voffA);
            PG8_WAIT_V(8); PG8_WAIT_L(0); PG8_BAR; PG8_MMA(0, 0, At, B0); PG8_MMA(0, 1, At, B1); PG8_BAR; PG8_SCHED;
            PG8_LDA(At, 0, 1); PG8_STAGE(PG8_SB(0, 0), b2, voffB); PG8_STAGE(PG8_SB(0, 1), b2 + hstepB, voffB); PG8_STAGE(PG8_SA(0, 0), a2, voffA);
            PG8_WAIT_V(8); PG8_WAIT_L(0); PG8_BAR; PG8_MMA(1, 0, At, B0); PG8_MMA(1, 1, At, B1); PG8_BAR; PG8_SCHED;
            PG8_LDB(B0, 1, 0); PG8_LDB(B1, 1, 1); PG8_SCHED; PG8_LDA(At, 1, 0); PG8_STAGE(PG8_SA(0, 1), a2 + hstepA, voffA);
            PG8_WAIT_V(8); PG8_WAIT_L(0); PG8_BAR; PG8_MMA(0, 0, At, B0); PG8_MMA(0, 1, At, B1); PG8_BAR; PG8_SCHED;
            PG8_LDA(At, 1, 1); PG8_STAGE(PG8_SB(1, 0), b3, voffB); PG8_STAGE(PG8_SB(1, 1), b3 + hstepB, voffB); PG8_STAGE(PG8_SA(1, 0), a3, voffA);
            PG8_WAIT_V(8); PG8_WAIT_L(0); PG8_BAR; PG8_MMA(1, 0, At, B0); PG8_MMA(1, 1, At, B1); PG8_BAR; PG8_SCHED;
        }
        if (wr == 0) PG8_BAR;
        E(acc, cur, wr, wc, fr, fq);
        if (!has_next) break;
#pragma unroll
        for (int a = 0; a < 2; ++a)
#pragma unroll
            for (int b = 0; b < 2; ++b)
#pragma unroll
                for (int m = 0; m < 4; ++m)
#pragma unroll
                    for (int n = 0; n < 2; ++n) acc[a][b][m][n] = (f32x4){0.f, 0.f, 0.f, 0.f};
        cur = nxt; cA = nA; cB = nB; ++ui;
        if (wr == 1) PG8_BAR;
    }
    PG8_WAIT_V(0);
    PG8_BAR;
#undef PG8_SA
#undef PG8_SB
#undef PG8_STAGE
#undef PG8_LDA
#undef PG8_LDB
#undef PG8_MMA
#undef PG8_WAIT_V
#undef PG8_WAIT_L
#undef PG8_BAR
#undef PG8_SCHED
}
}

struct Args {
    const float* in[36]; float* out; unsigned char* ws;
    int f_lo, f_hi, g_lo, g_hi, ph_lo, ph_hi, use_bar, pad;
};
struct Ctx {
    LAS unsigned char* lds;
    const float* const* in; float* out; unsigned char* ws;
    int tid, lane, wave, bid, G, z;
};
DI void refresh(Ctx& F) {
    { int z_ = 0; asm volatile("" : "+s"(z_)); F.z = z_; }
    asm volatile("" : "+v"(F.tid)); F.lane = F.tid & 63; F.wave = __builtin_amdgcn_readfirstlane(F.tid >> 6);
}
enum { I_X = 0, I_C, I_NORMW, I_FNORMW, I_ADAW, I_ADAB, I_FUP, I_FDN, I_WIN, I_WINV, I_CONVW, I_CONVB, I_WQ, I_WK, I_IB, I_FB, I_MLNW, I_MLSKIP,
       I_MU, I_MUV, I_W0, I_W2, I_A0, I_A2, I_V0, I_V2, I_G2, I_KK, I_KA, I_RK, I_LNW, I_LNB, I_LBL, I_HGNW, I_WBR, I_WOUT };

DI void transpose_item(const float* W, int ldw, int k0, int c0, bf16* WT, int ldt, int r0, float scale, LAS float* scr, int lane) {
#pragma unroll 8
    for (int i = 0; i < 32; ++i) { const int kk = 2 * i + (lane >> 5); scr[kk * 33 + (lane & 31)] = W[(size_t)(k0 + kk) * ldw + c0 + (lane & 31)]; }
    LDS_WAIT(); asm volatile("" ::: "memory");
    const int c = lane & 7;
#pragma unroll
    for (int j = 0; j < 4; ++j) { const int n = (lane >> 3) + 8 * j; const LAS float* s = scr + (8 * c) * 33 + n;
        v4u o; o.x = pk2(s[0 * 33] * scale, s[1 * 33] * scale); o.y = pk2(s[2 * 33] * scale, s[3 * 33] * scale); o.z = pk2(s[4 * 33] * scale, s[5 * 33] * scale); o.w = pk2(s[6 * 33] * scale, s[7 * 33] * scale);
        *(v4u*)(WT + (size_t)(r0 + n) * ldt + k0 + 8 * c) = o; }
    LDS_WAIT(); asm volatile("" ::: "memory");
}
DI void phase_weights(const Ctx& F, int l) {
    LAS float* scr = (LAS float*)(F.lds + F.wave * 16384);
    const int gw = F.bid * NWAVES + F.wave, NGW = F.G * NWAVES;
    constexpr int I_UP = 16 * 176, I_DN = 44 * 32, I_IN = 16 * 392, I_SQ = 16 * 32, I_QKI = 8 * 32;
    constexpr int NITEMS = 2 * I_UP + 2 * I_DN + I_IN + 4 * I_SQ + I_QKI;
    bf16* WUP = (bf16*)(F.ws + WS_WUP); bf16* WDN = (bf16*)(F.ws + WS_WDN); bf16* WIN = (bf16*)(F.ws + WS_WIN); bf16* WBR = (bf16*)(F.ws + WS_WBR);
    bf16* WOUT = (bf16*)(F.ws + WS_WOUT); bf16* WQK = (bf16*)(F.ws + WS_WQK);
    for (int it = gw; it < NITEMS; it += NGW) {
        int r = it;
        if (r < 2 * I_UP) { const int i = r / I_UP; r -= i * I_UP; const int kb = r / 176, nb = r % 176, c0 = 32 * nb; const int cc = c0 < DFF ? c0 : c0 - DFF;
            const int r0 = (cc / 128) * 256 + (c0 < DFF ? 0 : 128) + (cc % 128);
            transpose_item(F.in[F.z + I_FUP] + (size_t)(l * 2 + i) * D * NUP, NUP, 64 * kb, c0, WUP + (size_t)i * NUP * D, D, r0, 1.f, scr, F.lane); continue; }
        r -= 2 * I_UP;
        if (r < 2 * I_DN) { const int i = r / I_DN; r -= i * I_DN; const int kb = r / 32, nb = r % 32;
            transpose_item(F.in[F.z + I_FDN] + (size_t)(l * 2 + i) * DFF * D, D, 64 * kb, 32 * nb, WDN + (size_t)i * D * DFF, DFF, 32 * nb, 1.f, scr, F.lane); continue; }
        r -= 2 * I_DN;
        if (r < I_IN) { const int kb = r / 392, nb = r % 392, d0 = 32 * nb, c0 = d0 + (d0 >= 2048 ? 8 : 0);
            transpose_item(F.in[F.z + I_WIN] + (size_t)l * D * WIN_SRC, WIN_SRC, 64 * kb, c0, WIN, D, d0, 1.f, scr, F.lane); continue; }
        r -= I_IN;
        if (r < 3 * I_SQ) { const int n = r / I_SQ; r -= n * I_SQ; const int kb = r / 32, nb = r % 32;
            transpose_item(F.in[F.z + I_WBR] + (size_t)(l * 3 + n) * D * D, D, 64 * kb, 32 * nb, WBR + (size_t)n * D * D, D, 32 * nb, 1.f, scr, F.lane); continue; }
        r -= 3 * I_SQ;
        if (r < I_SQ) { const int kb = r / 32, nb = r % 32;
            transpose_item(F.in[F.z + I_WOUT] + (size_t)l * D * D, D, 64 * kb, 32 * nb, WOUT, D, 32 * nb, 1.f, scr, F.lane); continue; }
        r -= I_SQ;
        { const int mat = r / 32, rr = r % 32, h = mat >> 1, isk = mat & 1, kb = rr / 8, nb = rr % 8;
            transpose_item(F.in[F.z + isk ? I_WK : I_WQ] + (size_t)(l * 4 + h) * 256 * 256, 256, 64 * kb, 32 * nb, WQK + (size_t)(h * 512 + isk * 256) * 256, 256, 32 * nb, isk ? 0.0625f : 1.f, scr, F.lane); }
    }
    const int gt = F.bid * NTHREADS + F.tid, NT = F.G * NTHREADS;
    bf16* WL = (bf16*)(F.ws + WS_WLORA);
    for (int idx = gt; idx < NLORA * (KLORA / 8); idx += NT) {
        const int n = idx & (NLORA - 1), kc = idx >> 12, k0 = kc * 8, blk = n >> 10, nn = n & 1023;
        float o[8];
#pragma unroll
        for (int i = 0; i < 8; ++i) o[i] = 0.f;
        const float* src = nullptr; int kk = 0;
        if (blk == 0 && k0 < 64) { src = F.in[F.z + I_W2] + (size_t)l * 64 * D; kk = k0; }
        else if (blk == 1 && k0 >= 64 && k0 < 128) { src = F.in[F.z + I_A2] + (size_t)l * 64 * D; kk = k0 - 64; }
        else if (blk == 2 && k0 >= 128 && k0 < 256) { src = F.in[F.z + I_G2] + (size_t)l * 128 * D; kk = k0 - 128; }
        else if (blk == 3 && l == 1 && k0 >= 256 && k0 < 288) { src = F.in[F.z + I_V2]; kk = k0 - 256; }
        if (src) {
#pragma unroll
            for (int i = 0; i < 8; ++i) o[i] = src[(size_t)(kk + i) * D + nn]; }
        *(v4u*)(WL + (size_t)n * KLORA + k0) = pack8(o);
    }
    float* WS_ = (float*)(F.ws + WS_WSIDE);
    for (int idx = gt; idx < NSIDE * D; idx += NT) {
        const int j = idx >> 10, k = idx & 1023; float v = 0.f;
        if (j < 8) v = F.in[F.z + I_WIN][(size_t)l * D * WIN_SRC + (size_t)k * WIN_SRC + 2048 + j];
        else if (l == 1) v = F.in[F.z + I_WINV][(size_t)k * 32 + (j - 8)];
        WS_[idx] = v;
    }
}
DI void phase_mod(const Ctx& F) {
    LAS float* sc = (LAS float*)F.lds; LAS float* red = (LAS float*)(F.lds + 65536);
    float* mod = (float*)(F.ws + WS_MOD);
    bool loaded = false;
    for (int it = F.bid; it < 2 * 144; it += F.G) {
        if (!loaded) { for (int i = F.tid; i < NB * D; i += NTHREADS) sc[i] = siluf_(F.in[F.z + I_C][i]); loaded = true; __syncthreads(); }
        const int l = it / 144, n0 = (it % 144) * 64, n = F.tid & 63, ks = F.tid >> 6;
        float acc[16];
#pragma unroll
        for (int b = 0; b < 16; ++b) acc[b] = 0.f;
        const float* wp = F.in[F.z + I_ADAW] + (size_t)l * D * NMOD + n0 + n;
        for (int k = ks * 128; k < ks * 128 + 128; ++k) { const float w = wp[(size_t)k * NMOD];
#pragma unroll
            for (int b = 0; b < 16; ++b) acc[b] += sc[b * D + k] * w; }
#pragma unroll
        for (int b = 0; b < 16; ++b) red[(ks * 16 + b) * 64 + n] = acc[b];
        __syncthreads();
        for (int o = F.tid; o < 1024; o += NTHREADS) { const int b = o >> 6, nn = o & 63; float s = 0.f;
#pragma unroll
            for (int k8 = 0; k8 < 8; ++k8) s += red[(k8 * 16 + b) * 64 + nn];
            mod[(size_t)(l * 16 + b) * NMOD + n0 + nn] = s + F.in[F.z + I_ADAB][(size_t)l * NMOD + n0 + nn]; }
        __syncthreads();
    }
}

template <bool SIDE>
DI void phase_modulate(const Ctx& F, const float* x, bf16* hout, const float* nw, const float* modl, int sub, int r0, int nrows, float* side) {
    const int gw = F.bid * NWAVES + F.wave, NGW = F.G * NWAVES;
    const float* wside = (const float*)(F.ws + WS_WSIDE);
    for (int r = gw; r < nrows; r += NGW) {
        const int row = r0 + r, b = row / T;
        const f32x4* xr = (const f32x4*)(x + (size_t)row * D) + F.lane;
        f32x4 v[4]; float ss = 0.f;
#pragma unroll
        for (int j = 0; j < 4; ++j) { v[j] = xr[64 * j]; ss += (v[j].x * v[j].x + v[j].y * v[j].y) + (v[j].z * v[j].z + v[j].w * v[j].w); }
        const float rstd = 1.0f / sqrtf(wave_sum(ss) * (1.f / D) + 1e-6f);
        const f32x4* nwp = (const f32x4*)nw + F.lane;
        const f32x4* shp = (const f32x4*)(modl + (size_t)b * NMOD + (sub * 3 + 0) * D) + F.lane;
        const f32x4* scp = (const f32x4*)(modl + (size_t)b * NMOD + (sub * 3 + 1) * D) + F.lane;
        unsigned long long* o8 = (unsigned long long*)(hout + (size_t)r * D) + F.lane;
#pragma unroll
        for (int j = 0; j < 4; ++j) { v[j] = v[j] * rstd * nwp[64 * j] * (scp[64 * j] + 1.0f) + shp[64 * j];
            o8[64 * j] = (unsigned long long)pk2(v[j].x, v[j].y) | ((unsigned long long)pk2(v[j].z, v[j].w) << 32); }
        if (SIDE) {
            for (int jj = 0; jj < NSIDE; ++jj) { const f32x4* wp = (const f32x4*)(wside + jj * D) + F.lane; float s = 0.f;
#pragma unroll
                for (int j = 0; j < 4; ++j) { const f32x4 w = wp[64 * j]; s += (v[j].x * w.x + v[j].y * w.y) + (v[j].z * w.z + v[j].w * w.w); }
                s = wave_sum(s);
                if (F.lane == 0) side[(size_t)r * NSIDE + jj] = s; }
        }
    }
}
DI void phase_final_norm(const Ctx& F) {
    const int gw = F.bid * NWAVES + F.wave, NGW = F.G * NWAVES;
    for (int row = gw; row < M; row += NGW) {
        f32x4* xr = (f32x4*)(F.out + (size_t)row * D) + F.lane;
        f32x4 v[4]; float ss = 0.f;
#pragma unroll
        for (int j = 0; j < 4; ++j) { v[j] = xr[64 * j]; ss += (v[j].x * v[j].x + v[j].y * v[j].y) + (v[j].z * v[j].z + v[j].w * v[j].w); }
        const float rstd = 1.0f / sqrtf(wave_sum(ss) * (1.f / D) + 1e-6f);
        const f32x4* nwp = (const f32x4*)F.in[F.z + I_FNORMW] + F.lane;
#pragma unroll
        for (int j = 0; j < 4; ++j) xr[64 * j] = v[j] * rstd * nwp[64 * j];
    }
}

DI void phase_prep(const Ctx& F, int l) {
    const int gt = F.bid * NTHREADS + F.tid, NT = F.G * NTHREADS;
    const bf16* Z = (const bf16*)(F.ws + WS_Z); bf16* XC = (bf16*)(F.ws + WS_XC); bf16* LA = (bf16*)(F.ws + WS_LA); const float* SD = (const float*)(F.ws + WS_SIDE);
    const float* cw = F.in[F.z + I_CONVW] + (size_t)l * 4 * D; const float* cb = F.in[F.z + I_CONVB] + (size_t)l * D;
    const float* mu = F.in[F.z + I_MU] + (size_t)l * 3328;
    for (int idx = gt; idx < MG * 128; idx += NT) {
        const int row = idx >> 7, c8 = (idx & 127) * 8, t = row & (T - 1);
        float a[8], x[8];
#pragma unroll
        for (int i = 0; i < 8; ++i) a[i] = cb[c8 + i];
#pragma unroll
        for (int j = 0; j < 4; ++j) { if (t >= 3 - j) { unpack8(*(const v4u*)(Z + (size_t)(row - 3 + j) * NZ + ZC_MLX + c8), x);
#pragma unroll
                for (int i = 0; i < 8; ++i) a[i] += cw[j * D + c8 + i] * x[i]; } }
#pragma unroll
        for (int i = 0; i < 8; ++i) a[i] = siluf_(a[i]);
        *(v4u*)(XC + (size_t)row * D + c8) = pack8(a);
    }
    for (int idx = gt; idx < MG * 48; idx += NT) {
        const int row = idx / 48, k0 = (idx - row * 48) * 8, t = row & (T - 1);
        float o[8];
#pragma unroll
        for (int i = 0; i < 8; ++i) o[i] = 0.f;
        if (k0 < 256) { float cur[8], prv[8];
            unpack8(*(const v4u*)(Z + (size_t)row * NZ + ZC_RW + 3072 + k0), cur);
            if (t > 0) unpack8(*(const v4u*)(Z + (size_t)(row - 1) * NZ + ZC_RW + 3072 + k0), prv); else {
#pragma unroll
                for (int i = 0; i < 8; ++i) prv[i] = 0.f; }
#pragma unroll
            for (int i = 0; i < 8; ++i) { const float s = cur[i] + mu[3072 + k0 + i] * (prv[i] - cur[i]); o[i] = k0 < 64 ? tanhf(s) : (k0 < 128 ? s : sigmoidf_(s)); }
        } else if (l == 1 && k0 < 288) {
#pragma unroll
            for (int i = 0; i < 8; ++i) { const int j = k0 - 256 + i; const float cur = SD[(size_t)row * NSIDE + 8 + j], prv = t > 0 ? SD[(size_t)(row - 1) * NSIDE + 8 + j] : 0.f;
                o[i] = cur + F.in[F.z + I_MUV][j] * (prv - cur); }
        }
        *(v4u*)(LA + (size_t)row * KLORA + k0) = pack8(o);
    }
}

DI void scan_writeout(const Ctx& F, const LAS float* YT, bf16* dst  , int ld) {
    const int s = F.tid >> 4, r2 = (F.tid & 15) * 2;
    *(unsigned*)(dst + (size_t)s * ld + r2) = pk2(YT[s * 32 + r2], YT[s * 32 + r2 + 1]);
}
DI void scan_rwkv(const Ctx& F, int l, int g, int unit) {
    const int half = unit & 1, h = (unit >> 1) & 15, bl = unit >> 5;
    LAS float* TW = (LAS float*)F.lds; LAS float* TKP = TW + 2048; LAS float* TB = TW + 4096; LAS float* TKK = TW + 6144; LAS float* TR = TW + 8192; LAS float* TV = TW + 10240; LAS float* YT = TW + 12288;
    const bf16* Z = (const bf16*)(F.ws + WS_Z); const bf16* LO = (const bf16*)(F.ws + WS_LO); bf16* VF = (bf16*)(F.ws + WS_VF); bf16* BON = (bf16*)(F.ws + WS_BON);
    bf16* RAW = (bf16*)(F.ws + WS_RAW) + (size_t)1 * MG * D;
    const int gc = h * 64 + F.lane;
    const float mu_r = F.in[F.z + I_MU][l * 3328 + gc], mu_k = F.in[F.z + I_MU][l * 3328 + 1024 + gc], mu_v = F.in[F.z + I_MU][l * 3328 + 2048 + gc];
    const float w0 = F.in[F.z + I_W0][l * D + gc], a0 = F.in[F.z + I_A0][l * D + gc], kkc = F.in[F.z + I_KK][l * D + gc], kac = F.in[F.z + I_KA][l * D + gc], rk = F.in[F.z + I_RK][l * D + gc];
    const float v0 = l == 1 ? F.in[F.z + I_V0][gc] : 0.f;
    const int rowl = F.tid >> 4, ks = F.tid & 15;
    float s0 = 0.f, s1 = 0.f, s2 = 0.f, s3 = 0.f;
    for (int tt = 0; tt < T / 32; ++tt) {
        {
            const int sb = F.wave * 4, t0 = tt * 32 + sb; const size_t lrow0 = (size_t)bl * T + t0;
            float pr = 0.f, pk = 0.f, pv = 0.f;
            if (t0 > 0) { const bf16* zp = Z + (lrow0 - 1) * NZ + ZC_RW + gc; pr = bf1(zp[0]); pk = bf1(zp[1024]); pv = bf1(zp[2048]); }
#pragma unroll
            for (int j = 0; j < 4; ++j) {
                const size_t lrow = lrow0 + j; const bf16* zp = Z + lrow * NZ + ZC_RW + gc;
                const float zr = bf1(zp[0]), zk = bf1(zp[1024]), zv = bf1(zp[2048]);
                const float r = zr + mu_r * (pr - zr), k = zk + mu_k * (pk - zk); float v = zv + mu_v * (pv - zv);
                pr = zr; pk = zk; pv = zv;
                const bf16* lp = LO + lrow * NLORA + gc;
                const float xw = w0 + bf1(lp[0]); const float wraw = -softplusf_(-xw) - 0.5f; const float w = __expf(-__expf(wraw));
                const float a = sigmoidf_(a0 + bf1(lp[1024]));
                const size_t grow = (size_t)g * MG + lrow;
                if (l == 0) { if (half == 0) VF[grow * D + gc] = (bf16)f2bf(v); }
                else { const float vf = bf1(VF[grow * D + gc]); v = v + (vf - v) * sigmoidf_(v0 + bf1(lp[3072])); }
                const float kk = k * kkc; const float nrm = sqrtf(wave_sum(kk * kk)); const float kn = kk / fmaxf(nrm, 1e-12f);
                const float kp = k * (1.0f + (a - 1.0f) * kac);
                const float bsum = wave_sum(r * kp * rk);
                if (half == 0) BON[lrow * D + gc] = (bf16)f2bf(bsum * v);
                const int s = sb + j;
                TW[s * 64 + F.lane] = w; TKP[s * 64 + F.lane] = kp; TB[s * 64 + F.lane] = kn * a; TKK[s * 64 + F.lane] = kn; TR[s * 64 + F.lane] = r; TV[s * 64 + F.lane] = v;
            }
        }
        __syncthreads();
#pragma unroll 4
        for (int s = 0; s < 32; ++s) {
            const f32x4 kk = *(const LAS f32x4*)(TKK + s * 64 + ks * 4), w = *(const LAS f32x4*)(TW + s * 64 + ks * 4), b = *(const LAS f32x4*)(TB + s * 64 + ks * 4);
            const f32x4 kp = *(const LAS f32x4*)(TKP + s * 64 + ks * 4), r = *(const LAS f32x4*)(TR + s * 64 + ks * 4);
            const float vv = TV[s * 64 + half * 32 + rowl];
            const float u = sum16((s0 * kk.x + s1 * kk.y) + (s2 * kk.z + s3 * kk.w));
            s0 = s0 * w.x - u * b.x + vv * kp.x; s1 = s1 * w.y - u * b.y + vv * kp.y; s2 = s2 * w.z - u * b.z + vv * kp.z; s3 = s3 * w.w - u * b.w + vv * kp.w;
            const float y = sum16((s0 * r.x + s1 * r.y) + (s2 * r.z + s3 * r.w));
            if (ks == 0) YT[s * 32 + rowl] = y;
        }
        __syncthreads();
        scan_writeout(F, YT, RAW + ((size_t)bl * T + tt * 32) * D + h * 64 + half * 32, D);
    }
    __syncthreads();
}
DI void scan_hgrn(const Ctx& F, int l, int unit) {
    const int qt = unit & 3, h = (unit >> 2) & 7, bl = unit >> 5;
    LAS float* TQ = (LAS float*)F.lds; LAS float* TF = TQ + 4096; LAS float* TK = TQ + 8192; LAS float* TV = TQ + 12288; LAS float* YT = TQ + 13312;
    const bf16* Z = (const bf16*)(F.ws + WS_Z); bf16* RAW = (bf16*)(F.ws + WS_RAW) + (size_t)2 * MG * D;
    const int ps = F.tid >> 4, pc = (F.tid & 15) * 8;
    float lb[8];
#pragma unroll
    for (int i = 0; i < 8; ++i) lb[i] = l == 0 ? 0.f : sigmoidf_(F.in[F.z + I_LBL][D + h * 128 + pc + i] - F.in[F.z + I_LBL][h * 128 + pc + i]);
    const int el = F.tid >> 4, ds = F.tid & 15;
    float S[8];
#pragma unroll
    for (int i = 0; i < 8; ++i) S[i] = 0.f;
    for (int tt = 0; tt < T / 32; ++tt) {
        {
            const size_t lrow = (size_t)bl * T + tt * 32 + ps; float q[8], f[8], kk[8];
            unpack8(*(const v4u*)(Z + lrow * NZ + ZC_HGQ + h * 128 + pc), q); unpack8(*(const v4u*)(Z + lrow * NZ + ZC_HGF + h * 128 + pc), f);
#pragma unroll
            for (int i = 0; i < 8; ++i) { q[i] = siluf_(q[i]); const float sg = sigmoidf_(f[i]); kk[i] = (1.0f - lb[i]) * (1.0f - sg); f[i] = fmaxf(lb[i] + (1.0f - lb[i]) * sg, 1e-30f); }
            *(LAS f32x4*)(TQ + ps * 128 + pc) = (f32x4){q[0], q[1], q[2], q[3]}; *(LAS f32x4*)(TQ + ps * 128 + pc + 4) = (f32x4){q[4], q[5], q[6], q[7]};
            *(LAS f32x4*)(TF + ps * 128 + pc) = (f32x4){f[0], f[1], f[2], f[3]}; *(LAS f32x4*)(TF + ps * 128 + pc + 4) = (f32x4){f[4], f[5], f[6], f[7]};
            *(LAS f32x4*)(TK + ps * 128 + pc) = (f32x4){kk[0], kk[1], kk[2], kk[3]}; *(LAS f32x4*)(TK + ps * 128 + pc + 4) = (f32x4){kk[4], kk[5], kk[6], kk[7]};
            const unsigned vw = *(const unsigned*)(Z + lrow * NZ + ZC_HGI + h * 128 + qt * 32 + (F.tid & 15) * 2);
            TV[ps * 32 + (F.tid & 15) * 2] = bflo(vw); TV[ps * 32 + (F.tid & 15) * 2 + 1] = bfhi(vw);
        }
        __syncthreads();
#pragma unroll 4
        for (int s = 0; s < 32; ++s) {
            const float vv = TV[s * 32 + el]; float o = 0.f;
#pragma unroll
            for (int j = 0; j < 2; ++j) { const f32x4 q = *(const LAS f32x4*)(TQ + s * 128 + j * 64 + ds * 4), f = *(const LAS f32x4*)(TF + s * 128 + j * 64 + ds * 4), kk = *(const LAS f32x4*)(TK + s * 128 + j * 64 + ds * 4);
#pragma unroll
                for (int i = 0; i < 4; ++i) { S[j * 4 + i] = f[i] * S[j * 4 + i] + kk[i] * vv; o += S[j * 4 + i] * q[i]; } }
            o = sum16(o);
            if (ds == 0) YT[s * 32 + el] = o;
        }
        __syncthreads();
        scan_writeout(F, YT, RAW + ((size_t)bl * T + tt * 32) * D + h * 128 + qt * 32, D);
    }
    __syncthreads();
}
DI void scan_mlstm(const Ctx& F, int l, int unit) {
    const int e8 = unit & 7, h = (unit >> 3) & 3, bl = unit >> 5;
    LAS float* TQ = (LAS float*)F.lds; LAS float* TKI = TQ + 8192; LAS float* TV = TQ + 16384; LAS float* YT = TQ + 17408;
    LAS float* TLI = TQ + 18432; LAS float* TLF = TLI + 32; LAS float* TFG = TLI + 64; LAS float* TIG = TLI + 96; LAS float* TEM = TLI + 128; LAS float* MC = TLI + 160;
    const bf16* Z = (const bf16*)(F.ws + WS_Z); const bf16* QK = (const bf16*)(F.ws + WS_QK); const float* SD = (const float*)(F.ws + WS_SIDE);
    bf16* RAW = (bf16*)(F.ws + WS_RAW);
    const float ib = F.in[F.z + I_IB][l * 4 + h], fb = F.in[F.z + I_FB][l * 4 + h];
    const int ps = F.tid >> 4, pc = (F.tid & 15) * 16;
    const int el = F.tid >> 4, ds = F.tid & 15;
    float C[16], N[16];
#pragma unroll
    for (int i = 0; i < 16; ++i) { C[i] = 0.f; N[i] = 0.f; }
    if (F.tid == 0) MC[0] = 0.f;
    for (int tt = 0; tt < T / 32; ++tt) {
        if (F.wave == 0) {
            if (F.lane < 32) { const size_t lrow = (size_t)bl * T + tt * 32 + F.lane;
                TLI[F.lane] = SD[lrow * NSIDE + h] + ib; TLF[F.lane] = -softplusf_(-(SD[lrow * NSIDE + 4 + h] + fb)); }
            LDS_WAIT(); asm volatile("" ::: "memory");
            if (F.lane == 0) { float m = MC[0];
                for (int s = 0; s < 32; ++s) { const float lf = TLF[s], li = TLI[s], mp = m; m = fmaxf(mp + lf, li); TFG[s] = __expf(lf + mp - m); TIG[s] = __expf(li - m); TEM[s] = __expf(-m); }
                MC[0] = m; }
        }
        __syncthreads();
        {
            const size_t lrow = (size_t)bl * T + tt * 32 + ps; const float ig = TIG[ps]; float q[8], k[8];
#pragma unroll
            for (int hh = 0; hh < 2; ++hh) {
                unpack8(*(const v4u*)(QK + lrow * 2048 + h * 512 + pc + hh * 8), q); unpack8(*(const v4u*)(QK + lrow * 2048 + h * 512 + 256 + pc + hh * 8), k);
                *(LAS f32x4*)(TQ + ps * 256 + pc + hh * 8) = (f32x4){q[0], q[1], q[2], q[3]}; *(LAS f32x4*)(TQ + ps * 256 + pc + hh * 8 + 4) = (f32x4){q[4], q[5], q[6], q[7]};
                *(LAS f32x4*)(TKI + ps * 256 + pc + hh * 8) = (f32x4){k[0] * ig, k[1] * ig, k[2] * ig, k[3] * ig}; *(LAS f32x4*)(TKI + ps * 256 + pc + hh * 8 + 4) = (f32x4){k[4] * ig, k[5] * ig, k[6] * ig, k[7] * ig};
            }
            const unsigned vw = *(const unsigned*)(Z + lrow * NZ + ZC_MLX + h * 256 + e8 * 32 + (F.tid & 15) * 2);
            TV[ps * 32 + (F.tid & 15) * 2] = bflo(vw); TV[ps * 32 + (F.tid & 15) * 2 + 1] = bfhi(vw);
        }
        __syncthreads();
#pragma unroll 2
        for (int s = 0; s < 32; ++s) {
            const float vv = TV[s * 32 + el], fg = TFG[s], em = TEM[s]; float num = 0.f, den = 0.f;
#pragma unroll
            for (int j = 0; j < 4; ++j) { const f32x4 q = *(const LAS f32x4*)(TQ + s * 256 + j * 64 + ds * 4), ki = *(const LAS f32x4*)(TKI + s * 256 + j * 64 + ds * 4);
#pragma unroll
                for (int i = 0; i < 4; ++i) { C[j * 4 + i] = fg * C[j * 4 + i] + ki[i] * vv; N[j * 4 + i] = fg * N[j * 4 + i] + ki[i]; num += C[j * 4 + i] * q[i]; den += N[j * 4 + i] * q[i]; } }
            num = sum16(num); den = sum16(den);
            if (ds == 0) YT[s * 32 + el] = num / fmaxf(fabsf(den), em);
        }
        __syncthreads();
        scan_writeout(F, YT, RAW + ((size_t)bl * T + tt * 32) * D + h * 256 + e8 * 32, D);
    }
    __syncthreads();
}


typedef short s16x4 __attribute__((ext_vector_type(4)));
DI bf16x8 tr8(const LAS unsigned char* p0, const LAS unsigned char* p1) {
    const s16x4 lo = __builtin_amdgcn_ds_read_tr16_b64_v4i16((LAS s16x4*)p0), hi = __builtin_amdgcn_ds_read_tr16_b64_v4i16((LAS s16x4*)p1);
    return (bf16x8){lo[0], lo[1], lo[2], lo[3], hi[0], hi[1], hi[2], hi[3]};
}
DI float wave_incl_sum(float v, int lane) {
#pragma unroll
    for (int o = 1; o < 64; o <<= 1) { const float t = __shfl_up(v, o); if (lane >= o) v += t; }
    return v;
}
DI float wave_incl_max(float v, int lane) {
#pragma unroll
    for (int o = 1; o < 64; o <<= 1) { const float t = __shfl_up(v, o); if (lane >= o) v = fmaxf(v, t); }
    return v;
}
#define WG_SYNC() do { asm volatile("s_waitcnt lgkmcnt(0)" ::: "memory"); __builtin_amdgcn_s_barrier(); asm volatile("" ::: "memory"); } while (0)
DI void scan_mlstm_mfma(const Ctx& F, int l, int unit) {
    constexpr int QP = 528, PP = 144, VP = 96;
    constexpr int O_QS = 0, O_KS = 33792, O_CB = 67584, O_PS = 92928, O_VS = 102144, O_GT = 108288;
    const int e8 = unit & 7, h = (unit >> 3) & 3, bl = unit >> 5;
    LAS unsigned char* Qs = F.lds + O_QS; LAS unsigned char* Ks = F.lds + O_KS; LAS unsigned char* Cb = F.lds + O_CB; LAS unsigned char* Ps = F.lds + O_PS; LAS unsigned char* Vs = F.lds + O_VS;
    LAS float* RT = (LAS float*)(F.lds + O_GT); LAS float* CS = RT + 64; LAS float* WI = RT + 128; LAS float* EM = RT + 192; LAS float* WS = RT + 256; LAS float* SC = RT + 320;
    const bf16* QKp = (const bf16*)(F.ws + WS_QK) + (size_t)bl * T * 2048 + h * 512;
    const bf16* Vp = (const bf16*)(F.ws + WS_Z) + (size_t)bl * T * NZ + ZC_MLX + h * 256 + e8 * 32;
    const float* SD = (const float*)(F.ws + WS_SIDE) + (size_t)bl * T * NSIDE;
    bf16* OUT = (bf16*)(F.ws + WS_RAW) + (size_t)bl * T * D + h * 256 + e8 * 32;
    const float ib = F.in[F.z + I_IB][l * 4 + h], fb = F.in[F.z + I_FB][l * 4 + h];
    const int tid = F.tid, lane = F.lane, w = F.wave, g = lane >> 4, r = lane & 15, q = r >> 2, p = lane & 3;
    const int srow = tid >> 3, scj = tid & 7, vrow = tid >> 2, vc = tid & 3;
    v4u pq[4], pk[4], pv; float pli = 0.f, plf = 0.f; float m_prev = 0.f;
    f32x4 C[2][3];
#pragma unroll
    for (int a = 0; a < 2; ++a)
#pragma unroll
        for (int b = 0; b < 3; ++b) C[a][b] = (f32x4){0.f, 0.f, 0.f, 0.f};
    for (int i = tid; i < 25344 / 16; i += NTHREADS) *(LAS v4u*)(Cb + i * 16) = (v4u){0u, 0u, 0u, 0u};
    if (tid >= 256 && tid < 384) { const int rr = (tid - 256) >> 1, hh = tid & 1; unsigned one2 = 0x3F803F80u; asm volatile("" : "+v"(one2)); *(LAS v4u*)(Vs + rr * VP + 64 + hh * 16) = (v4u){one2, one2, one2, one2}; }
#define ML_LOAD(c) do { \
        _Pragma("unroll") for (int j = 0; j < 4; ++j) { pq[j] = *(const v4u*)(QKp + (size_t)((c) * 64 + srow) * 2048 + (scj + 8 * j) * 8); pk[j] = *(const v4u*)(QKp + (size_t)((c) * 64 + srow) * 2048 + 256 + (scj + 8 * j) * 8); } \
        if (tid < 256) pv = *(const v4u*)(Vp + (size_t)((c) * 64 + vrow) * NZ + vc * 8); \
        if (w == 0) { pli = SD[(size_t)((c) * 64 + lane) * NSIDE + h]; plf = SD[(size_t)((c) * 64 + lane) * NSIDE + 4 + h]; } } while (0)
#define ML_STORE() do { \
        _Pragma("unroll") for (int j = 0; j < 4; ++j) { *(LAS v4u*)(Qs + srow * QP + (scj + 8 * j) * 16) = pq[j]; *(LAS v4u*)(Ks + srow * QP + (scj + 8 * j) * 16) = pk[j]; } \
        if (tid < 256) *(LAS v4u*)(Vs + vrow * VP + vc * 16) = pv; \
        if (w == 0) { const float li = pli + ib, lf = -softplusf_(-(plf + fb)); const float bc = wave_incl_sum(lf, lane), cs = li - bc, pm = wave_incl_max(cs, lane), mx = fmaxf(m_prev, pm); \
            const float mx63 = __shfl(mx, 63), b63 = __shfl(bc, 63); \
            RT[lane] = -mx; CS[lane] = cs; WI[lane] = __expf(m_prev - mx); EM[lane] = __expf(-(bc + mx)); WS[lane] = __expf(cs - mx63); if (lane == 0) SC[0] = __expf(m_prev - mx63); m_prev = b63 + mx63; } } while (0)
    ML_LOAD(0); ML_STORE();
    WG_SYNC();
    const int tb = w >> 1, wh = w & 1;
    for (int c = 0; c < T / 64; ++c) {
        if (c + 1 < T / 64) ML_LOAD(c + 1);
#pragma unroll
        for (int si = 0; si < 2; ++si) {
            const int sb = wh * 2 + si; const int t = tb * 16 + r, s0 = sb * 16 + 4 * g;
            v2u pw = (v2u){0u, 0u};
            if (sb <= tb) {
                f32x4 acc = (f32x4){0.f, 0.f, 0.f, 0.f};
#pragma unroll
                for (int ks = 0; ks < 8; ++ks) { const bf16x8 a = *(const LAS bf16x8*)(Ks + (sb * 16 + r) * QP + (ks * 32 + 8 * g) * 2), b = *(const LAS bf16x8*)(Qs + (tb * 16 + r) * QP + (ks * 32 + 8 * g) * 2);
                    acc = __builtin_amdgcn_mfma_f32_16x16x32_bf16(a, b, acc, 0, 0, 0); }
                const float rt = RT[t]; const f32x4 cs4 = *(const LAS f32x4*)(CS + s0);
                float o[4];
#pragma unroll
                for (int i = 0; i < 4; ++i) o[i] = (s0 + i <= t) ? acc[i] * __expf(rt + cs4[i]) : 0.f;
                pw.x = pk2(o[0], o[1]); pw.y = pk2(o[2], o[3]);
            }
            *(LAS v2u*)(Ps + t * PP + s0 * 2) = pw;
        }
        { const float gm = SC[0];
#pragma unroll
            for (int a = 0; a < 2; ++a)
#pragma unroll
                for (int b = 0; b < 3; ++b) C[a][b] *= gm;
#pragma unroll
            for (int ks = 0; ks < 2; ++ks) {
                const f32x4 wsA = *(const LAS f32x4*)(WS + ks * 32 + 8 * g), wsB = *(const LAS f32x4*)(WS + ks * 32 + 8 * g + 4);
                bf16x8 bfr[3], afr[2];
#pragma unroll
                for (int et = 0; et < 3; ++et) { const LAS unsigned char* pa = Vs + (ks * 32 + 8 * g + q) * VP + (et * 16 + 4 * p) * 2; const bf16x8 raw = tr8(pa, pa + 4 * VP);
                    const v4u rw = __builtin_bit_cast(v4u, raw); v4u sw;
                    sw.x = pk2(bflo(rw.x) * wsA[0], bfhi(rw.x) * wsA[1]); sw.y = pk2(bflo(rw.y) * wsA[2], bfhi(rw.y) * wsA[3]);
                    sw.z = pk2(bflo(rw.z) * wsB[0], bfhi(rw.z) * wsB[1]); sw.w = pk2(bflo(rw.w) * wsB[2], bfhi(rw.w) * wsB[3]);
                    bfr[et] = __builtin_bit_cast(bf16x8, sw); }
#pragma unroll
                for (int a = 0; a < 2; ++a) { const LAS unsigned char* pa = Ks + (ks * 32 + 8 * g + q) * QP + ((2 * w + a) * 16 + 4 * p) * 2; afr[a] = tr8(pa, pa + 4 * QP); }
#pragma unroll
                for (int a = 0; a < 2; ++a)
#pragma unroll
                    for (int et = 0; et < 3; ++et) C[a][et] = __builtin_amdgcn_mfma_f32_16x16x32_bf16(afr[a], bfr[et], C[a][et], 0, 0, 0);
            } }
        WG_SYNC();
        {
            f32x4 oi[2], oc[2];
#pragma unroll
            for (int j = 0; j < 2; ++j) { oi[j] = (f32x4){0.f, 0.f, 0.f, 0.f}; oc[j] = (f32x4){0.f, 0.f, 0.f, 0.f}; }
#pragma unroll
            for (int ks = 0; ks < 2; ++ks) { const bf16x8 a = *(const LAS bf16x8*)(Ps + (tb * 16 + r) * PP + (ks * 32 + 8 * g) * 2);
#pragma unroll
                for (int j = 0; j < 2; ++j) { const int et = j == 0 ? wh : 2; const LAS unsigned char* pa = Vs + (ks * 32 + 8 * g + q) * VP + (et * 16 + 4 * p) * 2;
                    oi[j] = __builtin_amdgcn_mfma_f32_16x16x32_bf16(a, tr8(pa, pa + 4 * VP), oi[j], 0, 0, 0); } }
#pragma unroll
            for (int ks = 0; ks < 8; ++ks) { const bf16x8 a = *(const LAS bf16x8*)(Qs + (tb * 16 + r) * QP + (ks * 32 + 8 * g) * 2);
#pragma unroll
                for (int j = 0; j < 2; ++j) { const int et = j == 0 ? wh : 2; const bf16x8 b = *(const LAS bf16x8*)(Cb + (et * 16 + r) * QP + (ks * 32 + 8 * g) * 2);
                    oc[j] = __builtin_amdgcn_mfma_f32_16x16x32_bf16(a, b, oc[j], 0, 0, 0); } }
            const f32x4 wi4 = *(const LAS f32x4*)(WI + tb * 16 + 4 * g), em4 = *(const LAS f32x4*)(EM + tb * 16 + 4 * g);
#pragma unroll
            for (int i = 0; i < 4; ++i) { const float num = oi[0][i] + wi4[i] * oc[0][i], den = oi[1][i] + wi4[i] * oc[1][i];
                OUT[(size_t)(c * 64 + tb * 16 + 4 * g + i) * D + wh * 16 + r] = (bf16)f2bf(num / fmaxf(fabsf(den), em4[i])); }
        }
        WG_SYNC();
#pragma unroll
        for (int a = 0; a < 2; ++a)
#pragma unroll
            for (int et = 0; et < 3; ++et) { v2u cw; cw.x = pk2(C[a][et][0], C[a][et][1]); cw.y = pk2(C[a][et][2], C[a][et][3]);
                *(LAS v2u*)(Cb + (et * 16 + r) * QP + ((2 * w + a) * 16 + 4 * g) * 2) = cw; }
        if (c + 1 < T / 64) ML_STORE();
        WG_SYNC();
    }
#undef ML_LOAD
#undef ML_STORE
}


DI void scan_rwkv2(const Ctx& F, int l, int g, int unit) {
    const int half = unit & 1, h = (unit >> 1) & 15, bl = unit >> 5;
    LAS float* TW = (LAS float*)F.lds; LAS float* TKP = TW + 2048; LAS float* TB = TW + 4096; LAS float* TKK = TW + 6144; LAS float* TR = TW + 8192; LAS float* TV = TW + 10240; LAS float* YT = TW + 12288;
    const bf16* Z = (const bf16*)(F.ws + WS_Z); const bf16* LO = (const bf16*)(F.ws + WS_LO); bf16* VF = (bf16*)(F.ws + WS_VF); bf16* BON = (bf16*)(F.ws + WS_BON);
    bf16* RAW = (bf16*)(F.ws + WS_RAW) + (size_t)1 * MG * D;
    const int lane = F.lane, wave = F.wave;
    const int gc = h * 64 + lane;
    const float mu_r = F.in[F.z + I_MU][l * 3328 + gc], mu_k = F.in[F.z + I_MU][l * 3328 + 1024 + gc], mu_v = F.in[F.z + I_MU][l * 3328 + 2048 + gc];
    const float w0 = F.in[F.z + I_W0][l * D + gc], a0 = F.in[F.z + I_A0][l * D + gc], kkc = F.in[F.z + I_KK][l * D + gc], kac = F.in[F.z + I_KA][l * D + gc], rk = F.in[F.z + I_RK][l * D + gc];
    const float v0 = l == 1 ? F.in[F.z + I_V0][gc] : 0.f;
    const int rowl = F.tid >> 4, ks = F.tid & 15;
    float s0 = 0.f, s1 = 0.f, s2 = 0.f, s3 = 0.f;
    bf16 rz[4][3], rl[4][2], rv[4][2], rp[3];
#define RW_LOAD(tt) do { const int t0_ = (tt) * 32 + wave * 4; const size_t lrow0_ = (size_t)bl * T + t0_; \
        _Pragma("unroll") for (int i = 0; i < 3; ++i) rp[i] = t0_ > 0 ? Z[(lrow0_ - 1) * NZ + ZC_RW + gc + 1024 * i] : (bf16)0; \
        _Pragma("unroll") for (int j = 0; j < 4; ++j) { const bf16* zp = Z + (lrow0_ + j) * NZ + ZC_RW + gc; const bf16* lp = LO + (lrow0_ + j) * NLORA + gc; \
            rz[j][0] = zp[0]; rz[j][1] = zp[1024]; rz[j][2] = zp[2048]; rl[j][0] = lp[0]; rl[j][1] = lp[1024]; \
            if (l == 1) { rv[j][0] = lp[3072]; rv[j][1] = VF[((size_t)g * MG + lrow0_ + j) * D + gc]; } } } while (0)
#define RW_PREP(tt) do { const int sb_ = wave * 4; const size_t lrow0_ = (size_t)bl * T + (tt) * 32 + sb_; \
        float pr = bf1(rp[0]), pk = bf1(rp[1]), pv = bf1(rp[2]); \
        _Pragma("unroll") for (int j = 0; j < 4; ++j) { const size_t lrow = lrow0_ + j; \
            const float zr = bf1(rz[j][0]), zk = bf1(rz[j][1]), zv = bf1(rz[j][2]); \
            const float r = zr + mu_r * (pr - zr), k = zk + mu_k * (pk - zk); float v = zv + mu_v * (pv - zv); \
            pr = zr; pk = zk; pv = zv; \
            const float xw = w0 + bf1(rl[j][0]); const float wraw = -softplusf_(-xw) - 0.5f; const float w = __expf(-__expf(wraw)); \
            const float a = sigmoidf_(a0 + bf1(rl[j][1])); \
            if (l == 0) { if (half == 0) VF[((size_t)g * MG + lrow) * D + gc] = (bf16)f2bf(v); } \
            else { const float vf = bf1(rv[j][1]); v = v + (vf - v) * sigmoidf_(v0 + bf1(rv[j][0])); } \
            const float kk = k * kkc; const float kn = kk * __builtin_amdgcn_rsqf(fmaxf(wave_sum(kk * kk), 1e-24f)); \
            const float kp = k * (1.0f + (a - 1.0f) * kac); \
            const float bsum = wave_sum(r * kp * rk); \
            if (half == 0) BON[lrow * D + gc] = (bf16)f2bf(bsum * v); \
            const int s = sb_ + j; \
            TW[s * 64 + lane] = w; TKP[s * 64 + lane] = kp; TB[s * 64 + lane] = kn * a; TKK[s * 64 + lane] = kn; TR[s * 64 + lane] = r; TV[s * 64 + lane] = v; } } while (0)
    RW_LOAD(0); RW_PREP(0);
    WG_SYNC();
    for (int tt = 0; tt < T / 32; ++tt) {
        if (tt + 1 < T / 32) RW_LOAD(tt + 1);
        {
            f32x4 nkk = *(const LAS f32x4*)(TKK + ks * 4), nw = *(const LAS f32x4*)(TW + ks * 4), nb = *(const LAS f32x4*)(TB + ks * 4), nkp = *(const LAS f32x4*)(TKP + ks * 4), nr = *(const LAS f32x4*)(TR + ks * 4);
            float nvv = TV[half * 32 + rowl];
#pragma unroll 1
            for (int hh = 0; hh < 2; ++hh) {
                float ysel = 0.f;
#pragma unroll
                for (int s16 = 0; s16 < 16; ++s16) {
                    const int s = hh * 16 + s16;
                    const f32x4 kk = nkk, w = nw, b = nb, kp = nkp, r = nr; const float vv = nvv;
                    const int sn = (s + 1) & 31;
                    nkk = *(const LAS f32x4*)(TKK + sn * 64 + ks * 4); nw = *(const LAS f32x4*)(TW + sn * 64 + ks * 4); nb = *(const LAS f32x4*)(TB + sn * 64 + ks * 4);
                    nkp = *(const LAS f32x4*)(TKP + sn * 64 + ks * 4); nr = *(const LAS f32x4*)(TR + sn * 64 + ks * 4); nvv = TV[sn * 64 + half * 32 + rowl];
                    const float u = sum16((s0 * kk.x + s1 * kk.y) + (s2 * kk.z + s3 * kk.w));
                    s0 = s0 * w.x - u * b.x + vv * kp.x; s1 = s1 * w.y - u * b.y + vv * kp.y; s2 = s2 * w.z - u * b.z + vv * kp.z; s3 = s3 * w.w - u * b.w + vv * kp.w;
                    const float y = sum16((s0 * r.x + s1 * r.y) + (s2 * r.z + s3 * r.w));
                    ysel = (s16 == ks) ? y : ysel;
                }
                YT[(hh * 16 + ks) * 32 + rowl] = ysel;
            }
        }
        WG_SYNC();
        scan_writeout(F, YT, RAW + ((size_t)bl * T + tt * 32) * D + h * 64 + half * 32, D);
        if (tt + 1 < T / 32) RW_PREP(tt + 1);
        WG_SYNC();
    }
#undef RW_LOAD
#undef RW_PREP
}


DI void scan_hgrn_mfma(const Ctx& F, int l, int unit) {
    constexpr int QP = 272, VP = 80, PP = 80;
    constexpr int O_QA = 0, O_KA = 8704, O_SB = 17408, O_V = 26112, O_P = 28672, O_QT = 31232, O_E15 = 33280, O_GM = 33792, O_HH = 34304;
    const int qt = unit & 3, h = (unit >> 2) & 7, bl = unit >> 5;
    LAS unsigned char* Qa = F.lds + O_QA; LAS unsigned char* Ka = F.lds + O_KA; LAS unsigned char* Sb = F.lds + O_SB; LAS unsigned char* Vs = F.lds + O_V; LAS unsigned char* Ps = F.lds + O_P;
    LAS float* QT = (LAS float*)(F.lds + O_QT); LAS float* E15 = (LAS float*)(F.lds + O_E15); LAS float* GM = (LAS float*)(F.lds + O_GM); LAS float* HH = (LAS float*)(F.lds + O_HH);
    const bf16* Zq = (const bf16*)(F.ws + WS_Z) + (size_t)bl * T * NZ + ZC_HGQ + h * 128;
    const bf16* Zf = (const bf16*)(F.ws + WS_Z) + (size_t)bl * T * NZ + ZC_HGF + h * 128;
    const bf16* Zv = (const bf16*)(F.ws + WS_Z) + (size_t)bl * T * NZ + ZC_HGI + h * 128 + qt * 32;
    bf16* OUT = (bf16*)(F.ws + WS_RAW) + (size_t)2 * MG * D + (size_t)bl * T * D + h * 128 + qt * 32;
    const int tid = F.tid, lane = F.lane, w = F.wave, g = lane >> 4, r = lane & 15, q = r >> 2, p = lane & 3;
    const int pd = tid & 127, tq = tid >> 7;
    const float lb = l == 0 ? 0.f : sigmoidf_(F.in[F.z + I_LBL][D + h * 128 + pd] - F.in[F.z + I_LBL][h * 128 + pd]);
    const int vrow = tid >> 2, vc = tid & 3;
    bf16 rq[8], rf[8]; v4u pv;
    f32x4 S[2];
    S[0] = (f32x4){0.f, 0.f, 0.f, 0.f}; S[1] = (f32x4){0.f, 0.f, 0.f, 0.f};
#define HG_LOAD(c) do { _Pragma("unroll") for (int i = 0; i < 8; ++i) { rq[i] = Zq[(size_t)((c) * 32 + tq * 8 + i) * NZ + pd]; rf[i] = Zf[(size_t)((c) * 32 + tq * 8 + i) * NZ + pd]; } \
        if (tid < 128) pv = *(const v4u*)(Zv + (size_t)((c) * 32 + vrow) * NZ + vc * 8); } while (0)
    HG_LOAD(0);
    for (int c = 0; c < T / 32; ++c) {
        float qv[8], kv[8], cb[8]; float run = 0.f;
#pragma unroll
        for (int i = 0; i < 8; ++i) { const float x = bf1(rq[i]), fp = bf1(rf[i]); qv[i] = siluf_(x); const float sg = sigmoidf_(fp);
            kv[i] = (1.0f - lb) * (1.0f - sg); run += __logf(fmaxf(lb + (1.0f - lb) * sg, 1e-30f)); cb[i] = run; }
        QT[tq * 128 + pd] = run;
        if (tid < 128) *(LAS v4u*)(Vs + vrow * VP + vc * 16) = pv;
        if (c + 1 < T / 32) HG_LOAD(c + 1);
        WG_SYNC();
        { const float q0 = QT[pd], q1 = QT[128 + pd], q2 = QT[256 + pd], q3 = QT[384 + pd];
            const float off = (tq > 0 ? q0 : 0.f) + (tq > 1 ? q1 : 0.f) + (tq > 2 ? q2 : 0.f); const float b15 = q0 + q1, b31 = (q0 + q1) + (q2 + q3);
#pragma unroll
            for (int i = 0; i < 8; ++i) { const float bt = off + cb[i]; const float ea = __expf(fminf(bt - b15, 80.f)), ek = __expf(fminf(b15 - bt, 80.f));
                *(LAS bf16*)(Qa + (tq * 8 + i) * QP + pd * 2) = (bf16)f2bf(qv[i] * ea); *(LAS bf16*)(Ka + (tq * 8 + i) * QP + pd * 2) = (bf16)f2bf(kv[i] * ek); }
            if (tq == 0) { E15[pd] = __expf(b15); GM[pd] = __expf(b31); HH[pd] = __expf(b31 - b15); } }
        WG_SYNC();
        { const f32x4 e4 = *(const LAS f32x4*)(E15 + w * 16 + 4 * g), g4 = *(const LAS f32x4*)(GM + w * 16 + 4 * g), h4 = *(const LAS f32x4*)(HH + w * 16 + 4 * g);
            const LAS unsigned char* pa = Ka + (8 * g + q) * QP + (w * 16 + 4 * p) * 2; const bf16x8 afr = tr8(pa, pa + 4 * QP);
#pragma unroll
            for (int et = 0; et < 2; ++et) { v2u sw; sw.x = pk2(S[et][0] * e4[0], S[et][1] * e4[1]); sw.y = pk2(S[et][2] * e4[2], S[et][3] * e4[3]);
                *(LAS v2u*)(Sb + (et * 16 + r) * QP + (w * 16 + 4 * g) * 2) = sw;
                const LAS unsigned char* pb = Vs + (8 * g + q) * VP + (et * 16 + 4 * p) * 2;
                const f32x4 kvp = __builtin_amdgcn_mfma_f32_16x16x32_bf16(afr, tr8(pb, pb + 4 * VP), (f32x4){0.f, 0.f, 0.f, 0.f}, 0, 0, 0);
                S[et] = g4 * S[et] + h4 * kvp; } }
        if (w < 4) { const int sb = w >> 1, tb = (w & 1) ^ sb;
            const int t = tb * 16 + r, s0 = sb * 16 + 4 * g; v2u pw = (v2u){0u, 0u};
            if (sb <= tb) { f32x4 acc = (f32x4){0.f, 0.f, 0.f, 0.f};
#pragma unroll
                for (int ks = 0; ks < 4; ++ks) { const bf16x8 a = *(const LAS bf16x8*)(Ka + (sb * 16 + r) * QP + (ks * 32 + 8 * g) * 2), b = *(const LAS bf16x8*)(Qa + (tb * 16 + r) * QP + (ks * 32 + 8 * g) * 2);
                    acc = __builtin_amdgcn_mfma_f32_16x16x32_bf16(a, b, acc, 0, 0, 0); }
                pw.x = pk2(s0 + 0 <= t ? acc[0] : 0.f, s0 + 1 <= t ? acc[1] : 0.f); pw.y = pk2(s0 + 2 <= t ? acc[2] : 0.f, s0 + 3 <= t ? acc[3] : 0.f); }
            *(LAS v2u*)(Ps + t * PP + s0 * 2) = pw; }
        WG_SYNC();
        if (w < 4) { const int tb = w >> 1, et = w & 1;
            const LAS unsigned char* pb = Vs + (8 * g + q) * VP + (et * 16 + 4 * p) * 2;
            f32x4 o = __builtin_amdgcn_mfma_f32_16x16x32_bf16(*(const LAS bf16x8*)(Ps + (tb * 16 + r) * PP + 8 * g * 2), tr8(pb, pb + 4 * VP), (f32x4){0.f, 0.f, 0.f, 0.f}, 0, 0, 0);
#pragma unroll
            for (int ks = 0; ks < 4; ++ks) { const bf16x8 a = *(const LAS bf16x8*)(Qa + (tb * 16 + r) * QP + (ks * 32 + 8 * g) * 2), b = *(const LAS bf16x8*)(Sb + (et * 16 + r) * QP + (ks * 32 + 8 * g) * 2);
                o = __builtin_amdgcn_mfma_f32_16x16x32_bf16(a, b, o, 0, 0, 0); }
#pragma unroll
            for (int i = 0; i < 4; ++i) OUT[(size_t)(c * 32 + tb * 16 + 4 * g + i) * D + et * 16 + r] = (bf16)f2bf(o[i]); }
        WG_SYNC();
    }
#undef HG_LOAD
}

DI void phase_post(const Ctx& F, int l) {
    const int gw = F.bid * NWAVES + F.wave, NGW = F.G * NWAVES;
    const bf16* Z = (const bf16*)(F.ws + WS_Z); const bf16* XC = (const bf16*)(F.ws + WS_XC); const bf16* LO = (const bf16*)(F.ws + WS_LO); const bf16* BON = (const bf16*)(F.ws + WS_BON);
    bf16* RAW = (bf16*)(F.ws + WS_RAW);
    const int c0 = F.lane * 16;
    for (int row = gw; row < MG; row += NGW) {
        float a[16], b[16], c[16];
        { bf16* rp = RAW + (size_t)row * D + c0;
            unpack16(rp, a);
            unpack16(Z + (size_t)row * NZ + ZC_MLO + c0, b);
            unpack16(XC + (size_t)row * D + c0, c);
            float s = 0.f;
#pragma unroll
            for (int i = 0; i < 16; ++i) { a[i] *= sigmoidf_(b[i]); s += a[i]; }
            const float mean = sum16(s) * (1.f / 256.f); float q = 0.f;
#pragma unroll
            for (int i = 0; i < 16; ++i) { a[i] -= mean; q += a[i] * a[i]; }
            const float rstd = 1.0f / sqrtf(sum16(q) * (1.f / 256.f) + 1e-6f);
#pragma unroll
            for (int i = 0; i < 16; ++i) a[i] = a[i] * rstd * F.in[F.z + I_MLNW][l * D + c0 + i] + F.in[F.z + I_MLSKIP][l * D + c0 + i] * c[i];
            pack16(rp, a); }
        { bf16* rp = RAW + (size_t)(MG + row) * D + c0;
            unpack16(rp, a);
            unpack16(BON + (size_t)row * D + c0, b);
            unpack16(LO + (size_t)row * NLORA + 2048 + c0, c);
            float s = 0.f;
#pragma unroll
            for (int i = 0; i < 16; ++i) s += a[i];
            const float mean = sum4(s) * (1.f / 64.f); float q = 0.f;
#pragma unroll
            for (int i = 0; i < 16; ++i) { a[i] -= mean; q += a[i] * a[i]; }
            const float rstd = 1.0f / sqrtf(sum4(q) * (1.f / 64.f) + 64e-5f);
#pragma unroll
            for (int i = 0; i < 16; ++i) a[i] = (a[i] * rstd * F.in[F.z + I_LNW][l * D + c0 + i] + F.in[F.z + I_LNB][l * D + c0 + i] + b[i]) * c[i];
            pack16(rp, a); }
        { bf16* rp = RAW + (size_t)(2 * MG + row) * D + c0;
            unpack16(rp, a);
            unpack16(Z + (size_t)row * NZ + ZC_HGG + c0, b);
            float q = 0.f;
#pragma unroll
            for (int i = 0; i < 16; ++i) q += a[i] * a[i];
            const float rstd = 1.0f / sqrtf(sum8(q) * (1.f / 128.f) + 1e-6f);
#pragma unroll
            for (int i = 0; i < 16; ++i) a[i] = a[i] * rstd * F.in[F.z + I_HGNW][l * D + c0 + i] * sigmoidf_(b[i]);
            pack16(rp, a); }
    }
}

enum { PH_W = 0, PH_A1, PH_A2, PH_A3, PH_B1, PH_B2, PH_B3, PH_B4, PH_B5, PH_B6, PH_B7, PH_B8, PH_FIN, PH_N };

__global__ void __launch_bounds__(NTHREADS, 2) fwd_kernel(Args args) {
    extern __shared__ __attribute__((aligned(16))) unsigned char lds_raw[];
    Ctx F;
    F.lds = (LAS unsigned char*)lds_raw; F.in = args.in; F.out = args.out; F.ws = args.ws;
    F.z = 0; F.tid = threadIdx.x; F.lane = F.tid & 63; F.wave = __builtin_amdgcn_readfirstlane(F.tid >> 6); F.bid = blockIdx.x; F.G = gridDim.x;
    volatile LAS unsigned* MISC = (volatile LAS unsigned*)(F.lds + MISC_OFF);
    if (F.tid < 32) MISC[F.tid] = 0u;
    __syncthreads();
    XcdBarrier bar; bar.bar = (unsigned*)(F.ws + WS_CTL) + CW_BAR; bar.x = 0; bar.st = nullptr;
    if (args.use_bar) bar = xcd_barrier_post((unsigned*)(F.ws + WS_CTL) + CW_BAR, MISC + 8);
#ifndef PHMASK
#define PHMASK 0xFFFF
#endif
#define IN(k) (((PHMASK >> (k)) & 1) && args.ph_lo <= (k) && (k) < args.ph_hi)
#ifndef REPEAT_PH
#define REPEAT_PH -1
#endif
#define PHASE(k) if (IN(k)) for (int rep_ = 0; rep_ < ((k) == REPEAT_PH ? 2 : 1); ++rep_) if (refresh(F), true)
#define SEAM() do { if (args.use_bar) xcd_barrier(bar); } while (0)
    const float* MOD = (const float*)(F.ws + WS_MOD);
    for (int f = args.f_lo; f < args.f_hi; ++f) {
        const int l = f >> 1, fi = f & 1;
        const float* modl = MOD + (size_t)l * NB * NMOD;
        if (fi == 0) PHASE(PH_W) { phase_weights(F, l); if (l == 0) { __syncthreads(); phase_mod(F); } SEAM(); }
        const int sub = fi ? 2 : 0;
        const float* xsrc = (f == 0) ? F.in[F.z + I_X] : F.out;
        PHASE(PH_A1) { phase_modulate<false>(F, xsrc, (bf16*)(F.ws + WS_H), F.in[F.z + I_NORMW] + (size_t)(l * 3 + sub) * D, modl, sub, 0, M, nullptr); SEAM(); }
        PHASE(PH_A2) {
            pg8::Gemm gm{(const bf16*)(F.ws + WS_H), (const bf16*)(F.ws + WS_WUP) + (size_t)fi * NUP * D, D, D, D, 0, 0};
            pg8::Order<0> S; S.init(M / 256, NUP / 256, F.G, F.bid);
            pg8::EpiSwiGLU E{(bf16*)(F.ws + WS_HID), DFF};
            pg8::gemm_phase(F.lds, gm, S, E, F.tid); SEAM(); }
        PHASE(PH_A3) {
            pg8::Gemm gm{(const bf16*)(F.ws + WS_HID), (const bf16*)(F.ws + WS_WDN) + (size_t)fi * D * DFF, DFF, DFF, DFF, 0, 0};
            pg8::Order<0> S; S.init(M / 256, D / 256, F.G, F.bid);
            pg8::EpiResid E{xsrc, F.out, modl + (sub * 3 + 2) * D, 0.5f, 0};
            pg8::gemm_phase(F.lds, gm, S, E, F.tid); SEAM(); }
        if (fi == 0) {
            for (int g = args.g_lo; g < args.g_hi; ++g) {
                float* xg = F.out + (size_t)g * MG * D;
                PHASE(PH_B1) { phase_modulate<true>(F, F.out, (bf16*)(F.ws + WS_HG), F.in[F.z + I_NORMW] + (size_t)(l * 3 + 1) * D, modl, 1, g * MG, MG, (float*)(F.ws + WS_SIDE)); SEAM(); }
                PHASE(PH_B2) {
                    pg8::Gemm gm{(const bf16*)(F.ws + WS_HG), (const bf16*)(F.ws + WS_WIN), D, D, D, 0, 0};
                    pg8::Order<0> S; S.init(MG / 256, NZ / 256, F.G, F.bid);
                    pg8::EpiBf16 E{(bf16*)(F.ws + WS_Z), NZ, 0};
                    pg8::gemm_phase(F.lds, gm, S, E, F.tid); SEAM(); }
                PHASE(PH_B3) { phase_prep(F, l); SEAM(); }
                PHASE(PH_B4) {
                    { pg8::Gemm gm{(const bf16*)(F.ws + WS_XC), (const bf16*)(F.ws + WS_WQK), 256, D, 256, 256, (size_t)512 * 256};
                      pg8::Order<1> S; S.init(MG / 256, 8, F.G, F.bid);
                      pg8::EpiBf16 E{(bf16*)(F.ws + WS_QK), 2048, 512};
                      pg8::gemm_phase(F.lds, gm, S, E, F.tid); }
                    __syncthreads();
                    { pg8::Gemm gm{(const bf16*)(F.ws + WS_LA), (const bf16*)(F.ws + WS_WLORA), l == 0 ? 256 : 384, KLORA, KLORA, 0, 0};
                      pg8::Order<0> S; S.init(MG / 256, l == 0 ? 12 : 16, F.G, F.bid);
                      pg8::EpiBf16 E{(bf16*)(F.ws + WS_LO), NLORA, 0};
                      pg8::gemm_phase(F.lds, gm, S, E, F.tid); }
                    SEAM(); }
                PHASE(PH_B5) {
#ifndef SCAN_SCHED
#define SCAN_SCHED 0
#endif
                    { int lo0, lo1, lo2, st = 128;
                      if (F.G == 256) { const int a = F.bid < 128 ? F.bid : 128, b = F.bid >= 128 ? F.bid - 128 : 128;
                          lo0 = a; lo1 = SCAN_SCHED == 2 ? a : b; lo2 = SCAN_SCHED == 1 ? b : a; }
                      else { lo0 = lo1 = lo2 = F.bid; st = F.G; }
                      for (int i = lo0; i < 128; i += st) scan_mlstm_mfma(F, l, i);
                      for (int i = lo1; i < 128; i += st) scan_rwkv2(F, l, g, i);
                      for (int i = lo2; i < 128; i += st) scan_hgrn_mfma(F, l, i); }
                    SEAM(); }
                PHASE(PH_B6) {
                    phase_post(F, l);
                    __syncthreads();
                    { pg8::Gemm gm{(const bf16*)(F.ws + WS_HG), (const bf16*)(F.ws + WS_WIN) + (size_t)NZ * D, D, D, D, 0, 0};
                      pg8::Order<0> S; S.init(MG / 256, 12, F.G, F.bid);
                      pg8::EpiBf16 E{(bf16*)(F.ws + WS_Z) + ZC_GATE, NZ, 0};
                      pg8::gemm_phase(F.lds, gm, S, E, F.tid); }
                    SEAM(); }
                PHASE(PH_B7) {
                    pg8::Gemm gm{(const bf16*)(F.ws + WS_RAW), (const bf16*)(F.ws + WS_WBR), D, D, D, (size_t)MG * D, (size_t)D * D};
                    pg8::Order<2> S; S.init(MG / 256, 4, F.G, F.bid);
                    pg8::EpiBranch E{(const bf16*)(F.ws + WS_Z) + ZC_GATE, NZ, (float*)(F.ws + WS_QK), (bf16*)(F.ws + WS_XC)};
                    pg8::gemm_phase(F.lds, gm, S, E, F.tid); SEAM(); }
                PHASE(PH_B8) {
                    pg8::Gemm gm{(const bf16*)(F.ws + WS_XC), (const bf16*)(F.ws + WS_WOUT), D, D, D, 0, 0};
                    pg8::Order<0> S; S.init(MG / 256, 4, F.G, F.bid);
                    pg8::EpiResid E{xg, xg, modl + (1 * 3 + 2) * D, 1.0f, g * GB};
                    pg8::gemm_phase(F.lds, gm, S, E, F.tid); SEAM(); }
            }
        }
    }
    PHASE(PH_FIN) phase_final_norm(F);
#undef IN
#undef PHASE
#undef SEAM
}

extern "C" void kernel_launch(void* const* d_in, const int* in_sizes, int n_in, void* d_out, int out_size, void* d_ws, size_t ws_size, hipStream_t stream) {
    static int grid = 0;
    if (grid == 0) {
        if (n_in != 36 || out_size != M * D || ws_size < WS_END) { fprintf(stderr, "kernel_launch: unexpected problem (n_in %d out %d ws %zu, need %zu)\n", n_in, out_size, ws_size, (size_t)WS_END); grid = -1; return; }
        int dev = 0, cus = 0;
        if (hipGetDevice(&dev) != hipSuccess || hipDeviceGetAttribute(&cus, hipDeviceAttributeMultiprocessorCount, dev) != hipSuccess) { grid = -1; return; }
        if (hipFuncSetAttribute((const void*)fwd_kernel, hipFuncAttributeMaxDynamicSharedMemorySize, LDS_BYTES) != hipSuccess) { fprintf(stderr, "kernel_launch: hipFuncSetAttribute failed\n"); grid = -1; return; }
        int per_cu = 0;
        if (hipOccupancyMaxActiveBlocksPerMultiprocessor(&per_cu, (const void*)fwd_kernel, NTHREADS, LDS_BYTES) != hipSuccess || per_cu < 1) { fprintf(stderr, "kernel_launch: occupancy query says %d\n", per_cu); }
        (void)hipGetLastError();
        grid = cus;
    }
    if (grid < 0) return;
    (void)hipMemsetAsync((char*)d_ws + WS_CTL, 0, CTL_BYTES, stream);
    Args a{};
    for (int i = 0; i < 36; ++i) a.in[i] = (const float*)d_in[i];
    a.out = (float*)d_out; a.ws = (unsigned char*)d_ws; a.pad = 0;
#if ONE_LAUNCH
    a.f_lo = 0; a.f_hi = 4; a.g_lo = 0; a.g_hi = NGRP; a.ph_lo = 0; a.ph_hi = PH_N; a.use_bar = 1;
    hipLaunchKernelGGL(fwd_kernel, dim3(grid), dim3(NTHREADS), LDS_BYTES, stream, a);
#else
    a.use_bar = 0;
    for (int f = 0; f < 4; ++f) {
        a.f_lo = f; a.f_hi = f + 1;
        for (int ph = PH_W; ph <= PH_A3; ++ph) {
            if (ph == PH_W && (f & 1)) continue;
            a.ph_lo = ph; a.ph_hi = ph + 1; a.g_lo = 0; a.g_hi = 0;
            hipLaunchKernelGGL(fwd_kernel, dim3(grid), dim3(NTHREADS), LDS_BYTES, stream, a);
        }
        if ((f & 1) == 0)
            for (int g = 0; g < NGRP; ++g)
                for (int ph = PH_B1; ph <= PH_B8; ++ph) { a.ph_lo = ph; a.ph_hi = ph + 1; a.g_lo = g; a.g_hi = g + 1;
                    hipLaunchKernelGGL(fwd_kernel, dim3(grid), dim3(NTHREADS), LDS_BYTES, stream, a); }
    }
    a.f_lo = 0; a.f_hi = 0; a.g_lo = 0; a.g_hi = 0; a.ph_lo = PH_FIN; a.ph_hi = PH_FIN + 1;
    hipLaunchKernelGGL(fwd_kernel, dim3(grid), dim3(NTHREADS), LDS_BYTES, stream, a);
#endif
}
```

```cpp
#include <hip/hip_runtime.h>
#include <cstdio>
#include <cstdint>

#ifndef ONE_LAUNCH
#define ONE_LAUNCH 1
#endif

#define GAS __attribute__((address_space(1)))
#define LAS __attribute__((address_space(3)))
typedef unsigned short bf16;
typedef unsigned v4u __attribute__((ext_vector_type(4)));
typedef unsigned v2u __attribute__((ext_vector_type(2)));
typedef float f32x4 __attribute__((ext_vector_type(4)));
typedef float f32x2 __attribute__((ext_vector_type(2)));
typedef short bf16x8 __attribute__((ext_vector_type(8)));
#define DI __device__ __forceinline__

constexpr int D = 1024, NB = 16, T = 2048, M = NB * T, DFF = 2816, NUP = 2 * DFF;
constexpr int GB = 4, MG = GB * T, NGRP = NB / GB;
constexpr int NZ = 9472;
constexpr int ZC_MLX = 0, ZC_MLO = 1024, ZC_RW = 2048, ZC_HGQ = 5376, ZC_HGF = 6400, ZC_HGI = 7424, ZC_HGG = 8448;
constexpr int ZC_GATE = 5376;
constexpr int NWIN = 12544;
constexpr int WIN_SRC = 12552;
constexpr int NSIDE = 40, KLORA = 384, NLORA = 4096, NMOD = 9216;
constexpr int NTHREADS = 512, NWAVES = 8;

constexpr size_t MiB = 1u << 20;
constexpr size_t WS_CTL = 0, CTL_BYTES = 1 * MiB;
constexpr size_t WS_MOD = 1 * MiB;
constexpr size_t WS_WSIDE = 3 * MiB;
constexpr size_t WS_WUP = 4 * MiB;
constexpr size_t WS_WDN = 26 * MiB;
constexpr size_t WS_WIN = 37 * MiB;
constexpr size_t WS_WBR = 62 * MiB;
constexpr size_t WS_WOUT = 68 * MiB;
constexpr size_t WS_WQK = 70 * MiB;
constexpr size_t WS_WLORA = 71 * MiB;
constexpr size_t WS_VF = 74 * MiB;
constexpr size_t WS_ACT = 138 * MiB;
constexpr size_t WS_H = WS_ACT;
constexpr size_t WS_HID = WS_ACT + 64 * MiB;
constexpr size_t WS_HG = WS_ACT;
constexpr size_t WS_Z = WS_ACT + 16 * MiB;
constexpr size_t WS_XC = WS_ACT + 164 * MiB;
constexpr size_t WS_QK = WS_ACT + 180 * MiB;
constexpr size_t WS_LA = WS_ACT + 212 * MiB;
constexpr size_t WS_LO = WS_ACT + 218 * MiB;
constexpr size_t WS_SIDE = WS_ACT + 282 * MiB;
constexpr size_t WS_RAW = WS_ACT + 284 * MiB;
constexpr size_t WS_BON = WS_ACT + 332 * MiB;
constexpr size_t WS_END = WS_ACT + 348 * MiB;
static_assert(WS_HID + (size_t)M * DFF * 2 <= WS_END, "ffn view fits");
static_assert(WS_Z + (size_t)MG * NZ * 2 <= WS_XC, "z fits");

constexpr int CW_BAR = 4096, CW_HGDONE = 16384;

constexpr int LDS_BYTES = 147456;
constexpr int MISC_OFF = 131072 + 320;

DI unsigned f2bf(float f) { unsigned u = __builtin_bit_cast(unsigned, f); return (u + 0x7fffu + ((u >> 16) & 1u)) >> 16; }
DI unsigned pk2(float lo, float hi) { unsigned r; asm("v_cvt_pk_bf16_f32 %0, %1, %2" : "=v"(r) : "v"(lo), "v"(hi)); return r; }
DI float bflo(unsigned w) { return __builtin_bit_cast(float, w << 16); }
DI float bfhi(unsigned w) { return __builtin_bit_cast(float, w & 0xffff0000u); }
DI float bf1(bf16 h) { return __builtin_bit_cast(float, (unsigned)h << 16); }
DI float sigmoidf_(float x) { return __builtin_amdgcn_rcpf(1.0f + __expf(-x)); }
DI float siluf_(float x) { return x * __builtin_amdgcn_rcpf(1.0f + __expf(-x)); }
DI float softplusf_(float x) { return fmaxf(x, 0.f) + __logf(1.0f + __expf(-fabsf(x))); }
template <int CTRL> DI float dppf(float v) { return __builtin_bit_cast(float, __builtin_amdgcn_update_dpp(0, __builtin_bit_cast(int, v), CTRL, 0xF, 0xF, true)); }
DI float sum4(float v) { v += dppf<0xB1>(v); v += dppf<0x4E>(v); return v; }
DI float sum8(float v) { v = sum4(v); v += dppf<0x141>(v); return v; }
DI float sum16(float v) { v = sum8(v); v += dppf<0x140>(v); return v; }
DI float wave_sum(float v) {
    v = sum16(v);
    const float a = __builtin_bit_cast(float, __builtin_amdgcn_readlane(__builtin_bit_cast(int, v), 0)), b = __builtin_bit_cast(float, __builtin_amdgcn_readlane(__builtin_bit_cast(int, v), 16));
    const float c = __builtin_bit_cast(float, __builtin_amdgcn_readlane(__builtin_bit_cast(int, v), 32)), d = __builtin_bit_cast(float, __builtin_amdgcn_readlane(__builtin_bit_cast(int, v), 48));
    return (a + b) + (c + d);
}
#define LDS_WAIT() asm volatile("s_waitcnt lgkmcnt(0)" ::: "memory")
#define VM_WAIT() asm volatile("s_waitcnt vmcnt(0)" ::: "memory")
DI void unpack8(const v4u w, float (&o)[8]) { o[0] = bflo(w.x); o[1] = bfhi(w.x); o[2] = bflo(w.y); o[3] = bfhi(w.y); o[4] = bflo(w.z); o[5] = bfhi(w.z); o[6] = bflo(w.w); o[7] = bfhi(w.w); }
DI void unpack16(const bf16* p, float (&o)[16]) { const v4u a = *(const v4u*)p, b = *(const v4u*)(p + 8);
    o[0] = bflo(a.x); o[1] = bfhi(a.x); o[2] = bflo(a.y); o[3] = bfhi(a.y); o[4] = bflo(a.z); o[5] = bfhi(a.z); o[6] = bflo(a.w); o[7] = bfhi(a.w);
    o[8] = bflo(b.x); o[9] = bfhi(b.x); o[10] = bflo(b.y); o[11] = bfhi(b.y); o[12] = bflo(b.z); o[13] = bfhi(b.z); o[14] = bflo(b.w); o[15] = bfhi(b.w); }
DI void pack16(bf16* p, const float (&o)[16]) { v4u a, b; a.x = pk2(o[0], o[1]); a.y = pk2(o[2], o[3]); a.z = pk2(o[4], o[5]); a.w = pk2(o[6], o[7]);
    b.x = pk2(o[8], o[9]); b.y = pk2(o[10], o[11]); b.z = pk2(o[12], o[13]); b.w = pk2(o[14], o[15]); *(v4u*)p = a; *(v4u*)(p + 8) = b; }
DI v4u pack8(const float (&o)[8]) { v4u w; w.x = pk2(o[0], o[1]); w.y = pk2(o[2], o[3]); w.z = pk2(o[4], o[5]); w.w = pk2(o[6], o[7]); return w; }

#define XB_TMO      128
#define XB_XCNT(j)  (256  + 64 * (j))
#define XB_XSUB(j)  (1280 + 64 * (j))
#define XB_XGEN(j)  (2304 + 64 * (j))
#define XB_TOP      3328
#define XB_TOPGEN   3392
#define XCD_BAR_WORDS 3456
#define XB_SPIN_CAP (1u << 22)
__device__ __forceinline__ unsigned xb_ld(unsigned* p)              { return __hip_atomic_load(p, __ATOMIC_RELAXED, __HIP_MEMORY_SCOPE_AGENT); }
__device__ __forceinline__ unsigned xb_add(unsigned* p, unsigned v) { return __hip_atomic_fetch_add(p, v, __ATOMIC_RELAXED, __HIP_MEMORY_SCOPE_AGENT); }
__device__ __forceinline__ unsigned xb_xcc_id() { return (unsigned)__builtin_amdgcn_s_getreg((3 << 11) | 20) & 0xFu; }
#define XB_SPIN(cond, bar) do { unsigned _sp = 0; while (cond) { __builtin_amdgcn_s_sleep(1); \
    if ((++_sp & 255u) == 0u) { if (xb_ld(&(bar)[XB_TMO])) break; if (_sp > XB_SPIN_CAP) { atomicAdd(&(bar)[XB_TMO], 1u); break; } } } } while (0)
struct XcdBarrier { unsigned* bar; unsigned x; volatile LAS unsigned* st; };
__device__ __forceinline__ XcdBarrier xcd_barrier_post(unsigned* bar, volatile LAS unsigned* st) {
    XcdBarrier b; b.bar = bar; b.x = xb_xcc_id(); b.st = st;
    if (threadIdx.x == 0) (void)xb_add(&bar[XB_XCNT(b.x)], 1u);
    return b;
}
__device__ __forceinline__ void xcd_barrier_complete(unsigned* bar, unsigned x, unsigned& nloc, unsigned& nx) {
    const unsigned G = gridDim.x * gridDim.y * gridDim.z;
    unsigned sum, cnt, mine, sp = 0u;
    for (;;) {
        sum = 0u; cnt = 0u; mine = 0u;
#pragma unroll
        for (unsigned j = 0; j < 16; ++j) { const unsigned c = xb_ld(&bar[XB_XCNT(j)]); sum += c; cnt += (c > 0u) ? 1u : 0u; mine = (j == x) ? c : mine; }
        if (sum == G) break;
        __builtin_amdgcn_s_sleep(1);
        if ((++sp & 255u) == 0u) { if (xb_ld(&bar[XB_TMO])) break; if (sp > XB_SPIN_CAP) { atomicAdd(&bar[XB_TMO], 1u); break; } }
    }
    nloc = mine > 0u ? mine : 1u; nx = cnt > 0u ? cnt : 1u;
}
__device__ __forceinline__ void xcd_barrier(const XcdBarrier& b) {
    asm volatile("s_waitcnt vmcnt(0)" ::: "memory");
    __syncthreads();
    if (threadIdx.x == 0) {
        unsigned* bar = b.bar;
        __builtin_amdgcn_s_waitcnt(0);
        unsigned nloc = b.st[0], nx = b.st[1];
        if (nloc == 0u) { xcd_barrier_complete(bar, b.x, nloc, nx); b.st[0] = nloc; b.st[1] = nx; }
        const unsigned old = xb_add(&bar[XB_XSUB(b.x)], 1u);
        const unsigned gen = old / nloc;
        if (old + 1u == (gen + 1u) * nloc) {
            __builtin_amdgcn_fence(__ATOMIC_RELEASE, "agent");
            asm volatile("s_waitcnt vmcnt(0)" ::: "memory");
            const unsigned og = xb_add(&bar[XB_TOP], 1u);
            const unsigned tg = og / nx;
            if (og + 1u == (tg + 1u) * nx) xb_add(&bar[XB_TOPGEN], 1u);
            else XB_SPIN(xb_ld(&bar[XB_TOPGEN]) == tg, bar);
            __builtin_amdgcn_fence(__ATOMIC_ACQUIRE, "agent");
            xb_add(&bar[XB_XGEN(b.x)], 1u);
            asm volatile("s_waitcnt vmcnt(0)" ::: "memory");
        } else {
            XB_SPIN(xb_ld(&bar[XB_XGEN(b.x)]) == gen, bar);
            __builtin_amdgcn_fence(__ATOMIC_ACQUIRE, "agent");
            asm volatile("s_waitcnt vmcnt(0)" ::: "memory");
        }
    }
    __syncthreads();
}

namespace pg8 {
constexpr int BM = 256, BK = 64, HALF = 128, HTB = HALF * BK * 2, STAGE_BYTES = 8 * HTB, NXCD = 8, WGM = 8;
DI int lds_byte(int r, int c) { const int st = (r >> 4) * 2 + (c >> 5), rr = r & 15, cc = c & 31, ob = rr * 64 + cc * 2; return st * 1024 + (ob ^ (((ob >> 9) & 1) << 5)); }
DI void stage_rc(int b, int& R, int& C) { const int st = b / 1024, sb = b % 1024, swz = sb ^ (((sb >> 9) & 1) << 5); R = (st >> 1) * 16 + swz / 64; C = (st & 1) * 32 + (swz % 64) / 2; }
DI int perm32(int rho) { const int n = rho >> 4, i = rho & 15; return 8 * (i >> 2) + 4 * n + (i & 3); }

struct Unit { int pm, pn, pz; };
struct Gemm { const bf16* A; const bf16* Bt; int K, lda, ldb; size_t a_z, b_z; };

template <int MODE> struct Order {
    int nM, nN, nwg, G, c;
    DI void init(int nM_, int nN_, int G_, int c_) { nM = nM_; nN = nN_; nwg = nM * nN; G = G_; c = c_; }
    DI bool next(int i, Unit& u) const {
        const int ii = (MODE == 2) ? i / 3 : i;
        const long L = (long)ii * G + c; if (L >= nwg) return false;
        int wgid = (int)L; { const int q = nwg / NXCD, r = nwg % NXCD, xcd = wgid % NXCD, off = wgid / NXCD; wgid = (xcd < r ? xcd * (q + 1) : r * (q + 1) + (xcd - r) * q) + off; }
        const int nig = WGM * nN, gid = wgid / nig, fm = gid * WGM, gsz = (nM - fm) < WGM ? (nM - fm) : WGM;
        u.pm = fm + ((wgid % nig) % gsz); const int pn = (wgid % nig) / gsz;
        if (MODE == 1) { u.pz = pn >> 1; u.pn = pn & 1; } else if (MODE == 2) { u.pz = i - ii * 3; u.pn = pn; } else { u.pz = 0; u.pn = pn; }
        return true;
    }
};

struct EpiBf16 {
    static constexpr bool PERM = true;
    bf16* O; int ldc; int zcols;
    DI void operator()(const f32x4 (&acc)[2][2][4][2], const Unit& u, int wr, int wc, int fr, int fq) const {
        const int row0 = u.pm * BM + wr * 64 + fr; const int col0 = u.pz * zcols + u.pn * BM + wc * 32 + 8 * fq;
#pragma unroll
        for (int ai = 0; ai < 2; ++ai)
#pragma unroll
            for (int m = 0; m < 4; ++m) { bf16* rowp = O + (size_t)(row0 + ai * HALF + m * 16) * ldc + col0;
#pragma unroll
                for (int bj = 0; bj < 2; ++bj) { const f32x4 v0 = acc[ai][bj][m][0], v1 = acc[ai][bj][m][1];
                    v4u w; w.x = pk2(v0[0], v0[1]); w.y = pk2(v0[2], v0[3]); w.z = pk2(v1[0], v1[1]); w.w = pk2(v1[2], v1[3]);
                    *(v4u*)(rowp + bj * HALF) = w; } }
    }
};
struct EpiZ {
    static constexpr bool PERM = true;
    bf16* O; int ldc; const float* lbl;
    DI void operator()(const f32x4 (&acc)[2][2][4][2], const Unit& u, int wr, int wc, int fr, int fq) const {
        const int row0 = u.pm * BM + wr * 64 + fr; const int col0 = u.pn * BM + wc * 32 + 8 * fq;
        const int kind = (u.pn >= ZC_HGQ / 256 && u.pn < ZC_HGF / 256) ? 1 : ((u.pn >= ZC_HGF / 256 && u.pn < ZC_HGI / 256) ? 2 : 0);
        float lb[2][8];
#pragma unroll
        for (int bj = 0; bj < 2; ++bj)
#pragma unroll
            for (int j = 0; j < 8; ++j) lb[bj][j] = 0.f;
        if (kind == 2 && lbl) {
#pragma unroll
            for (int bj = 0; bj < 2; ++bj) { const float* p0 = lbl + (col0 + bj * HALF - ZC_HGF);
#pragma unroll
                for (int j = 0; j < 8; ++j) lb[bj][j] = sigmoidf_(p0[D + j] - p0[j]); } }
#pragma unroll
        for (int ai = 0; ai < 2; ++ai)
#pragma unroll
            for (int m = 0; m < 4; ++m) { bf16* rowp = O + (size_t)(row0 + ai * HALF + m * 16) * ldc + col0;
#pragma unroll
                for (int bj = 0; bj < 2; ++bj) { float o[8];
#pragma unroll
                    for (int j = 0; j < 8; ++j) { const float x = acc[ai][bj][m][j >> 2][j & 3];
                        o[j] = kind == 0 ? x : (kind == 1 ? siluf_(x) : __logf(fmaxf(lb[bj][j] + (1.0f - lb[bj][j]) * sigmoidf_(x), 1e-30f))); }
                    *(v4u*)(rowp + bj * HALF) = pack8(o); } }
    }
};
struct EpiSwiGLU {
    static constexpr bool PERM = true;
    bf16* O; int ldc;
    DI void operator()(const f32x4 (&acc)[2][2][4][2], const Unit& u, int wr, int wc, int fr, int fq) const {
        const int row0 = u.pm * BM + wr * 64 + fr; const int col0 = u.pn * HALF + wc * 32 + 8 * fq;
#pragma unroll
        for (int ai = 0; ai < 2; ++ai)
#pragma unroll
            for (int m = 0; m < 4; ++m) { bf16* rowp = O + (size_t)(row0 + ai * HALF + m * 16) * ldc + col0;
                float o[8];
#pragma unroll
                for (int n = 0; n < 2; ++n)
#pragma unroll
                    for (int j = 0; j < 4; ++j) { const float a = acc[ai][0][m][n][j], b = acc[ai][1][m][n][j]; o[n * 4 + j] = a * b * __builtin_amdgcn_rcpf(1.0f + __expf(-a)); }
                *(v4u*)rowp = pack8(o); }
    }
};
struct EpiResid {
    static constexpr bool PERM = false;
    const float* xin; float* xout; const float* gate; float mul; int b0;
    DI void operator()(const f32x4 (&acc)[2][2][4][2], const Unit& u, int wr, int wc, int fr, int fq) const {
        const int row0 = u.pm * BM + wr * 64 + fr, col0 = u.pn * BM + wc * 32 + 4 * fq;
        const float* gp = gate + (size_t)(b0 + (u.pm * BM) / T) * NMOD + col0;
        f32x4 cf[2][2];
#pragma unroll
        for (int bj = 0; bj < 2; ++bj)
#pragma unroll
            for (int n = 0; n < 2; ++n) cf[bj][n] = (*(const f32x4*)(gp + bj * HALF + n * 16) + 1.0f) * mul;
#pragma unroll
        for (int ai = 0; ai < 2; ++ai)
#pragma unroll
            for (int m = 0; m < 4; ++m) { const size_t off = (size_t)(row0 + ai * HALF + m * 16) * D + col0;
#pragma unroll
                for (int bj = 0; bj < 2; ++bj)
#pragma unroll
                    for (int n = 0; n < 2; ++n) { const f32x4 xi = *(const f32x4*)(xin + off + bj * HALF + n * 16);
                        *(f32x4*)(xout + off + bj * HALF + n * 16) = xi + cf[bj][n] * acc[ai][bj][m][n]; }
                asm volatile("" ::: "memory"); }
    }
};
struct EpiBranch {
    static constexpr bool PERM = false;
    const bf16* gates; int ldg; float* mixf; bf16* mixb;
    DI void operator()(const f32x4 (&acc)[2][2][4][2], const Unit& u, int wr, int wc, int fr, int fq) const {
        const int row0 = u.pm * BM + wr * 64 + fr, col0 = u.pn * BM + wc * 32 + 4 * fq;
#pragma unroll
        for (int ai = 0; ai < 2; ++ai)
#pragma unroll
            for (int m = 0; m < 4; ++m) { const int row = row0 + ai * HALF + m * 16; const size_t off = (size_t)row * D + col0; const bf16* gp = gates + (size_t)row * ldg + u.pz * D + col0;
#pragma unroll
                for (int bj = 0; bj < 2; ++bj)
#pragma unroll
                    for (int n = 0; n < 2; ++n) { const v2u gw = *(const v2u*)(gp + bj * HALF + n * 16);
                        f32x4 g; g[0] = sigmoidf_(bflo(gw.x)); g[1] = sigmoidf_(bfhi(gw.x)); g[2] = sigmoidf_(bflo(gw.y)); g[3] = sigmoidf_(bfhi(gw.y));
                        f32x4 v = g * acc[ai][bj][m][n];
                        if (u.pz > 0) v += *(const f32x4*)(mixf + off + bj * HALF + n * 16);
                        if (u.pz < 2) *(f32x4*)(mixf + off + bj * HALF + n * 16) = v;
                        else { v2u w; w.x = pk2(v[0], v[1]); w.y = pk2(v[2], v[3]); *(v2u*)(mixb + off + bj * HALF + n * 16) = w; } }
                asm volatile("" ::: "memory"); }
    }
};

template <class Epi, class Sched>
DI void gemm_phase(LAS unsigned char* lds, const Gemm g, const Sched& S, const Epi& E, int tid_) {
    asm volatile("" : "+v"(tid_));
    const int tid = tid_, wid = __builtin_amdgcn_readfirstlane(tid >> 6), lane = tid & 63, wr = wid >> 2, wc = wid & 3, fr = lane & 15, fq = lane >> 4;
    int K_ = g.K; asm volatile("" : "+s"(K_));
    const int K = K_, nt = K / BK;
    unsigned voffA[2], voffB[2];
#pragma unroll
    for (int i = 0; i < 2; ++i) { int R, C; stage_rc(tid * 16 + i * 8192, R, C); const int Rb = Epi::PERM ? ((R & ~31) + perm32(R & 31)) : R;
        voffA[i] = (unsigned)(R * g.lda + C) * 2u; voffB[i] = (unsigned)(Rb * g.ldb + C) * 2u; }
    const size_t kstep = (size_t)(BK * 2);
    const size_t hstepA = (size_t)HALF * g.lda * 2, hstepB = (size_t)HALF * g.ldb * 2;
    const size_t tstepA = 2 * hstepA, tstepB = 2 * hstepB;
    const unsigned ldsw = (unsigned)wid * 1024u;
    const int aoff = lds_byte(wr * 64 + fr, fq * 8), boff = lds_byte(wc * 32 + fr, fq * 8);
#define PG8_SA(b, h) (((b) * 2 + (h)) * HTB)
#define PG8_SB(b, h) ((4 + (b) * 2 + (h)) * HTB)
#define PG8_STAGE(bufoff, gbase, voff) do { _Pragma("unroll") for (int _i = 0; _i < 2; ++_i) \
        __builtin_amdgcn_global_load_lds((const unsigned*)((const char*)(gbase) + (voff)[_i]), (LAS unsigned*)(lds + (bufoff) + ldsw + _i * 8192), 16, 0, 0); } while (0)
#define PG8_LDA(dst, b, h) do { _Pragma("unroll") for (int m = 0; m < 4; ++m) _Pragma("unroll") for (int k = 0; k < 2; ++k) dst[m][k] = *(const LAS bf16x8*)(lds + PG8_SA(b, h) + aoff + m * 2048 + k * 1024); } while (0)
#define PG8_LDB(dst, b, h) do { _Pragma("unroll") for (int n = 0; n < 2; ++n) _Pragma("unroll") for (int k = 0; k < 2; ++k) dst[n][k] = *(const LAS bf16x8*)(lds + PG8_SB(b, h) + boff + n * 2048 + k * 1024); } while (0)
#define PG8_MMA(ai, bj, At, Bt) do { __builtin_amdgcn_s_setprio(1); _Pragma("unroll") for (int m = 0; m < 4; ++m) _Pragma("unroll") for (int n = 0; n < 2; ++n) _Pragma("unroll") for (int k = 0; k < 2; ++k) \
        acc[ai][bj][m][n] = __builtin_amdgcn_mfma_f32_16x16x32_bf16(Bt[n][k], At[m][k], acc[ai][bj][m][n], 0, 0, 0); __builtin_amdgcn_s_setprio(0); } while (0)
#define PG8_WAIT_V(n) asm volatile("s_waitcnt vmcnt(" #n ")" ::: "memory")
#define PG8_WAIT_L(n) asm volatile("s_waitcnt lgkmcnt(" #n ")" ::: "memory")
#define PG8_BAR __builtin_amdgcn_s_barrier()
#define PG8_SCHED __builtin_amdgcn_sched_barrier(0)
    Unit cur, nxt; int ui = 0;
    if (!S.next(0, cur)) return;
    f32x4 acc[2][2][4][2];
#pragma unroll
    for (int a = 0; a < 2; ++a)
#pragma unroll
        for (int b = 0; b < 2; ++b)
#pragma unroll
            for (int m = 0; m < 4; ++m)
#pragma unroll
                for (int n = 0; n < 2; ++n) acc[a][b][m][n] = (f32x4){0.f, 0.f, 0.f, 0.f};
    bf16x8 At[4][2], B0[2][2], B1[2][2];
    const char* cA = (const char*)(g.A + (size_t)cur.pz * g.a_z) + (size_t)cur.pm * tstepA; const char* cB = (const char*)(g.Bt + (size_t)cur.pz * g.b_z) + (size_t)cur.pn * tstepB;
    PG8_STAGE(PG8_SB(0, 0), cB, voffB); PG8_STAGE(PG8_SB(0, 1), cB + hstepB, voffB); PG8_STAGE(PG8_SA(0, 0), cA, voffA); PG8_STAGE(PG8_SA(0, 1), cA + hstepA, voffA);
    if (wr == 1) PG8_BAR;
    PG8_WAIT_V(2); PG8_BAR;
    PG8_STAGE(PG8_SB(1, 0), cB + kstep, voffB); PG8_STAGE(PG8_SA(1, 0), cA + kstep, voffA); PG8_STAGE(PG8_SB(1, 1), cB + hstepB + kstep, voffB);
    PG8_WAIT_V(6); PG8_BAR;
    for (;;) {
        const bool has_next = S.next(ui + 1, nxt);
        const char* nA = has_next ? (const char*)(g.A + (size_t)nxt.pz * g.a_z) + (size_t)nxt.pm * tstepA : cA; const char* nB = has_next ? (const char*)(g.Bt + (size_t)nxt.pz * g.b_z) + (size_t)nxt.pn * tstepB : cB;
        for (int t = 0; t < nt; t += 2) {
            const bool last = (t == nt - 2);
            const char* a1 = cA + (size_t)(t + 1) * kstep;
            const char* a2 = last ? nA : cA + (size_t)(t + 2) * kstep; const char* b2 = last ? nB : cB + (size_t)(t + 2) * kstep;
            const char* a3 = a2 + kstep; const char* b3 = b2 + kstep;
            PG8_LDB(B0, 0, 0); PG8_LDB(B1, 0, 1); PG8_SCHED; PG8_LDA(At, 0, 0); PG8_STAGE(PG8_SA(1, 1), a1 + hstepA, voffA);
            PG8_WAIT_V(8); PG8_WAIT_L(0); PG8_BAR; PG8_MMA(0, 0, At, B0); PG8_MMA(0, 1, At, B1); PG8_BAR; PG8_SCHED;
            PG8_LDA(At, 0, 1); PG8_STAGE(PG8_SB(0, 0), b2, voffB); PG8_STAGE(PG8_SB(0, 1), b2 + hstepB, voffB); PG8_STAGE(PG8_SA(0, 0), a2, voffA);
            PG8_WAIT_V(8); PG8_WAIT_L(0); PG8_BAR; PG8_MMA(1, 0, At, B0); PG8_MMA(1, 1, At, B1); PG8_BAR; PG8_SCHED;
            PG8_LDB(B0, 1, 0); PG8_LDB(B1, 1, 1); PG8_SCHED; PG8_LDA(At, 1, 0); PG8_STAGE(PG8_SA(0, 1), a2 + hstepA, voffA);
            PG8_WAIT_V(8); PG8_WAIT_L(0); PG8_BAR; PG8_MMA(0, 0, At, B0); PG8_MMA(0, 1, At, B1); PG8_BAR; PG8_SCHED;
            PG8_LDA(At, 1, 1); PG8_STAGE(PG8_SB(1, 0), b3, voffB); PG8_STAGE(PG8_SB(1, 1), b3 + hstepB, voffB); PG8_STAGE(PG8_SA(1, 0), a3, voffA);
            PG8_WAIT_V(8); PG8_WAIT_L(0); PG8_BAR; PG8_MMA(1, 0, At, B0); PG8_MMA(1, 1, At, B1); PG8_BAR; PG8_SCHED;
        }
        if (wr == 0) PG8_BAR;
        E(acc, cur, wr, wc, fr, fq);
        if (!has_next) break;
#pragma unroll
        for (int a = 0; a < 2; ++a)
#pragma unroll
            for (int b = 0; b < 2; ++b)
#pragma unroll
                for (int m = 0; m < 4; ++m)
#pragma unroll
                    for (int n = 0; n < 2; ++n) acc[a][b][m][n] = (f32x4){0.f, 0.f, 0.f, 0.f};
        cur = nxt; cA = nA; cB = nB; ++ui;
        if (wr == 1) PG8_BAR;
    }
    PG8_WAIT_V(0);
    PG8_BAR;
#undef PG8_SA
#undef PG8_SB
#undef PG8_STAGE
#undef PG8_LDA
#undef PG8_LDB
#undef PG8_MMA
#undef PG8_WAIT_V
#undef PG8_WAIT_L
#undef PG8_BAR
#undef PG8_SCHED
}
}

struct Args {
    const float* in[36]; float* out; unsigned char* ws;
    int f_lo, f_hi, g_lo, g_hi, ph_lo, ph_hi, use_bar, pad;
};
struct Ctx {
    LAS unsigned char* lds;
    const float* const* in; float* out; unsigned char* ws;
    int tid, lane, wave, bid, G, z;
};
DI void refresh(Ctx& F) {
    { int z_ = 0; asm volatile("" : "+s"(z_)); F.z = z_; }
    asm volatile("" : "+v"(F.tid)); F.lane = F.tid & 63; F.wave = __builtin_amdgcn_readfirstlane(F.tid >> 6);
}
enum { I_X = 0, I_C, I_NORMW, I_FNORMW, I_ADAW, I_ADAB, I_FUP, I_FDN, I_WIN, I_WINV, I_CONVW, I_CONVB, I_WQ, I_WK, I_IB, I_FB, I_MLNW, I_MLSKIP,
       I_MU, I_MUV, I_W0, I_W2, I_A0, I_A2, I_V0, I_V2, I_G2, I_KK, I_KA, I_RK, I_LNW, I_LNB, I_LBL, I_HGNW, I_WBR, I_WOUT };

DI void transpose_item(const float* W, int ldw, int k0, int c0, bf16* WT, int ldt, int r0, float scale, LAS float* scr, int lane) {
#pragma unroll 8
    for (int i = 0; i < 32; ++i) { const int kk = 2 * i + (lane >> 5); scr[kk * 33 + (lane & 31)] = W[(size_t)(k0 + kk) * ldw + c0 + (lane & 31)]; }
    LDS_WAIT(); asm volatile("" ::: "memory");
    const int c = lane & 7;
#pragma unroll
    for (int j = 0; j < 4; ++j) { const int n = (lane >> 3) + 8 * j; const LAS float* s = scr + (8 * c) * 33 + n;
        v4u o; o.x = pk2(s[0 * 33] * scale, s[1 * 33] * scale); o.y = pk2(s[2 * 33] * scale, s[3 * 33] * scale); o.z = pk2(s[4 * 33] * scale, s[5 * 33] * scale); o.w = pk2(s[6 * 33] * scale, s[7 * 33] * scale);
        *(v4u*)(WT + (size_t)(r0 + n) * ldt + k0 + 8 * c) = o; }
    LDS_WAIT(); asm volatile("" ::: "memory");
}
DI void phase_weights(const Ctx& F, int l) {
    LAS float* scr = (LAS float*)(F.lds + F.wave * 16384);
    const int gw = F.bid * NWAVES + F.wave, NGW = F.G * NWAVES;
    constexpr int I_UP = 16 * 176, I_DN = 44 * 32, I_IN = 16 * 392, I_SQ = 16 * 32, I_QKI = 8 * 32;
    constexpr int NITEMS = 2 * I_UP + 2 * I_DN + I_IN + 4 * I_SQ + I_QKI;
    bf16* WUP = (bf16*)(F.ws + WS_WUP); bf16* WDN = (bf16*)(F.ws + WS_WDN); bf16* WIN = (bf16*)(F.ws + WS_WIN); bf16* WBR = (bf16*)(F.ws + WS_WBR);
    bf16* WOUT = (bf16*)(F.ws + WS_WOUT); bf16* WQK = (bf16*)(F.ws + WS_WQK);
    for (int it = gw; it < NITEMS; it += NGW) {
        int r = it;
        if (r < 2 * I_UP) { const int i = r / I_UP; r -= i * I_UP; const int kb = r / 176, nb = r % 176, c0 = 32 * nb; const int cc = c0 < DFF ? c0 : c0 - DFF;
            const int r0 = (cc / 128) * 256 + (c0 < DFF ? 0 : 128) + (cc % 128);
            transpose_item(F.in[F.z + I_FUP] + (size_t)(l * 2 + i) * D * NUP, NUP, 64 * kb, c0, WUP + (size_t)i * NUP * D, D, r0, 1.f, scr, F.lane); continue; }
        r -= 2 * I_UP;
        if (r < 2 * I_DN) { const int i = r / I_DN; r -= i * I_DN; const int kb = r / 32, nb = r % 32;
            transpose_item(F.in[F.z + I_FDN] + (size_t)(l * 2 + i) * DFF * D, D, 64 * kb, 32 * nb, WDN + (size_t)i * D * DFF, DFF, 32 * nb, 1.f, scr, F.lane); continue; }
        r -= 2 * I_DN;
        if (r < I_IN) { const int kb = r / 392, nb = r % 392, d0 = 32 * nb, c0 = d0 + (d0 >= 2048 ? 8 : 0);
            transpose_item(F.in[F.z + I_WIN] + (size_t)l * D * WIN_SRC, WIN_SRC, 64 * kb, c0, WIN, D, d0, 1.f, scr, F.lane); continue; }
        r -= I_IN;
        if (r < 3 * I_SQ) { const int n = r / I_SQ; r -= n * I_SQ; const int kb = r / 32, nb = r % 32;
            transpose_item(F.in[F.z + I_WBR] + (size_t)(l * 3 + n) * D * D, D, 64 * kb, 32 * nb, WBR + (size_t)n * D * D, D, 32 * nb, 1.f, scr, F.lane); continue; }
        r -= 3 * I_SQ;
        if (r < I_SQ) { const int kb = r / 32, nb = r % 32;
            transpose_item(F.in[F.z + I_WOUT] + (size_t)l * D * D, D, 64 * kb, 32 * nb, WOUT, D, 32 * nb, 1.f, scr, F.lane); continue; }
        r -= I_SQ;
        { const int mat = r / 32, rr = r % 32, h = mat >> 1, isk = mat & 1, kb = rr / 8, nb = rr % 8;
            transpose_item(F.in[F.z + isk ? I_WK : I_WQ] + (size_t)(l * 4 + h) * 256 * 256, 256, 64 * kb, 32 * nb, WQK + (size_t)(h * 512 + isk * 256) * 256, 256, 32 * nb, isk ? 0.0625f : 1.f, scr, F.lane); }
    }
    const int gt = F.bid * NTHREADS + F.tid, NT = F.G * NTHREADS;
    bf16* WL = (bf16*)(F.ws + WS_WLORA);
    for (int idx = gt; idx < NLORA * (KLORA / 8); idx += NT) {
        const int n = idx & (NLORA - 1), kc = idx >> 12, k0 = kc * 8, blk = n >> 10, nn = n & 1023;
        float o[8];
#pragma unroll
        for (int i = 0; i < 8; ++i) o[i] = 0.f;
        const float* src = nullptr; int kk = 0;
        if (blk == 0 && k0 < 64) { src = F.in[F.z + I_W2] + (size_t)l * 64 * D; kk = k0; }
        else if (blk == 1 && k0 >= 64 && k0 < 128) { src = F.in[F.z + I_A2] + (size_t)l * 64 * D; kk = k0 - 64; }
        else if (blk == 2 && k0 >= 128 && k0 < 256) { src = F.in[F.z + I_G2] + (size_t)l * 128 * D; kk = k0 - 128; }
        else if (blk == 3 && l == 1 && k0 >= 256 && k0 < 288) { src = F.in[F.z + I_V2]; kk = k0 - 256; }
        if (src) {
#pragma unroll
            for (int i = 0; i < 8; ++i) o[i] = src[(size_t)(kk + i) * D + nn]; }
        *(v4u*)(WL + (size_t)n * KLORA + k0) = pack8(o);
    }
    float* WS_ = (float*)(F.ws + WS_WSIDE);
    for (int idx = gt; idx < NSIDE * D; idx += NT) {
        const int j = idx >> 10, k = idx & 1023; float v = 0.f;
        if (j < 8) v = F.in[F.z + I_WIN][(size_t)l * D * WIN_SRC + (size_t)k * WIN_SRC + 2048 + j];
        else if (l == 1) v = F.in[F.z + I_WINV][(size_t)k * 32 + (j - 8)];
        WS_[idx] = v;
    }
}
DI void phase_mod(const Ctx& F) {
    LAS float* sc = (LAS float*)F.lds; LAS float* red = (LAS float*)(F.lds + 65536);
    float* mod = (float*)(F.ws + WS_MOD);
    bool loaded = false;
    for (int it = F.bid; it < 2 * 144; it += F.G) {
        if (!loaded) { for (int i = F.tid; i < NB * D; i += NTHREADS) sc[i] = siluf_(F.in[F.z + I_C][i]); loaded = true; __syncthreads(); }
        const int l = it / 144, n0 = (it % 144) * 64, n = F.tid & 63, ks = F.tid >> 6;
        float acc[16];
#pragma unroll
        for (int b = 0; b < 16; ++b) acc[b] = 0.f;
        const float* wp = F.in[F.z + I_ADAW] + (size_t)l * D * NMOD + n0 + n;
        for (int k = ks * 128; k < ks * 128 + 128; ++k) { const float w = wp[(size_t)k * NMOD];
#pragma unroll
            for (int b = 0; b < 16; ++b) acc[b] += sc[b * D + k] * w; }
#pragma unroll
        for (int b = 0; b < 16; ++b) red[(ks * 16 + b) * 64 + n] = acc[b];
        __syncthreads();
        for (int o = F.tid; o < 1024; o += NTHREADS) { const int b = o >> 6, nn = o & 63; float s = 0.f;
#pragma unroll
            for (int k8 = 0; k8 < 8; ++k8) s += red[(k8 * 16 + b) * 64 + nn];
            mod[(size_t)(l * 16 + b) * NMOD + n0 + nn] = s + F.in[F.z + I_ADAB][(size_t)l * NMOD + n0 + nn]; }
        __syncthreads();
    }
}

template <bool SIDE>
DI void phase_modulate(const Ctx& F, const float* x, bf16* hout, const float* nw, const float* modl, int sub, int r0, int nrows, float* side, int nside) {
    const int gw = F.bid * NWAVES + F.wave, NGW = F.G * NWAVES;
    const float* wside = (const float*)(F.ws + WS_WSIDE);
    constexpr int RB = SIDE ? 4 : 1;
    for (int rq = gw; rq < nrows / RB; rq += NGW) {
        const int b = (r0 + rq * RB) / T;
        const f32x4* nwp = (const f32x4*)nw + F.lane;
        const f32x4* shp = (const f32x4*)(modl + (size_t)b * NMOD + (sub * 3 + 0) * D) + F.lane;
        const f32x4* scp = (const f32x4*)(modl + (size_t)b * NMOD + (sub * 3 + 1) * D) + F.lane;
        f32x4 v[RB][4];
#pragma unroll
        for (int i = 0; i < RB; ++i) { const f32x4* xr = (const f32x4*)(x + (size_t)(r0 + rq * RB + i) * D) + F.lane;
#pragma unroll
            for (int j = 0; j < 4; ++j) v[i][j] = xr[64 * j]; }
#pragma unroll
        for (int i = 0; i < RB; ++i) { float ss = 0.f;
#pragma unroll
            for (int j = 0; j < 4; ++j) ss += (v[i][j].x * v[i][j].x + v[i][j].y * v[i][j].y) + (v[i][j].z * v[i][j].z + v[i][j].w * v[i][j].w);
            const float rstd = __builtin_amdgcn_rsqf(wave_sum(ss) * (1.f / D) + 1e-6f);
            unsigned long long* o8 = (unsigned long long*)(hout + (size_t)(rq * RB + i) * D) + F.lane;
#pragma unroll
            for (int j = 0; j < 4; ++j) { v[i][j] = v[i][j] * rstd * nwp[64 * j] * (scp[64 * j] + 1.0f) + shp[64 * j];
                o8[64 * j] = (unsigned long long)pk2(v[i][j].x, v[i][j].y) | ((unsigned long long)pk2(v[i][j].z, v[i][j].w) << 32); } }
        if (SIDE) {
            for (int jj = 0; jj < nside; ++jj) { const f32x4* wp = (const f32x4*)(wside + jj * D) + F.lane; f32x4 w[4];
#pragma unroll
                for (int j = 0; j < 4; ++j) w[j] = wp[64 * j];
                float s[RB];
#pragma unroll
                for (int i = 0; i < RB; ++i) { float a = 0.f;
#pragma unroll
                    for (int j = 0; j < 4; ++j) a += (v[i][j].x * w[j].x + v[i][j].y * w[j].y) + (v[i][j].z * w[j].z + v[i][j].w * w[j].w);
                    s[i] = wave_sum(a); }
#pragma unroll
                for (int i = 0; i < RB; ++i) if (F.lane == i) side[(size_t)(rq * RB + i) * NSIDE + jj] = s[i]; }
        }
    }
}
DI void phase_final_norm(const Ctx& F) {
    const int gw = F.bid * NWAVES + F.wave, NGW = F.G * NWAVES;
    for (int row = gw; row < M; row += NGW) {
        f32x4* xr = (f32x4*)(F.out + (size_t)row * D) + F.lane;
        f32x4 v[4]; float ss = 0.f;
#pragma unroll
        for (int j = 0; j < 4; ++j) { v[j] = xr[64 * j]; ss += (v[j].x * v[j].x + v[j].y * v[j].y) + (v[j].z * v[j].z + v[j].w * v[j].w); }
        const float rstd = 1.0f / sqrtf(wave_sum(ss) * (1.f / D) + 1e-6f);
        const f32x4* nwp = (const f32x4*)F.in[F.z + I_FNORMW] + F.lane;
#pragma unroll
        for (int j = 0; j < 4; ++j) xr[64 * j] = v[j] * rstd * nwp[64 * j];
    }
}

DI void phase_prep(const Ctx& F, int l) {
    const int gt = F.bid * NTHREADS + F.tid, NT = F.G * NTHREADS;
    const bf16* Z = (const bf16*)(F.ws + WS_Z); bf16* XC = (bf16*)(F.ws + WS_XC); bf16* LA = (bf16*)(F.ws + WS_LA); const float* SD = (const float*)(F.ws + WS_SIDE);
    const float* cw = F.in[F.z + I_CONVW] + (size_t)l * 4 * D; const float* cb = F.in[F.z + I_CONVB] + (size_t)l * D;
    const float* mu = F.in[F.z + I_MU] + (size_t)l * 3328;
    for (int idx = gt; idx < MG * 128; idx += NT) {
        const int row = idx >> 7, c8 = (idx & 127) * 8, t = row & (T - 1);
        float a[8], x[8];
#pragma unroll
        for (int i = 0; i < 8; ++i) a[i] = cb[c8 + i];
#pragma unroll
        for (int j = 0; j < 4; ++j) { if (t >= 3 - j) { unpack8(*(const v4u*)(Z + (size_t)(row - 3 + j) * NZ + ZC_MLX + c8), x);
#pragma unroll
                for (int i = 0; i < 8; ++i) a[i] += cw[j * D + c8 + i] * x[i]; } }
#pragma unroll
        for (int i = 0; i < 8; ++i) a[i] = siluf_(a[i]);
        *(v4u*)(XC + (size_t)row * D + c8) = pack8(a);
    }
    for (int idx = gt; idx < MG * 48; idx += NT) {
        const int row = idx / 48, k0 = (idx - row * 48) * 8, t = row & (T - 1);
        float o[8];
#pragma unroll
        for (int i = 0; i < 8; ++i) o[i] = 0.f;
        if (k0 < 256) { float cur[8], prv[8];
            unpack8(*(const v4u*)(Z + (size_t)row * NZ + ZC_RW + 3072 + k0), cur);
            if (t > 0) unpack8(*(const v4u*)(Z + (size_t)(row - 1) * NZ + ZC_RW + 3072 + k0), prv); else {
#pragma unroll
                for (int i = 0; i < 8; ++i) prv[i] = 0.f; }
#pragma unroll
            for (int i = 0; i < 8; ++i) { const float s = cur[i] + mu[3072 + k0 + i] * (prv[i] - cur[i]); o[i] = k0 < 64 ? tanhf(s) : (k0 < 128 ? s : sigmoidf_(s)); }
        } else if (l == 1 && k0 < 288) {
#pragma unroll
            for (int i = 0; i < 8; ++i) { const int j = k0 - 256 + i; const float cur = SD[(size_t)row * NSIDE + 8 + j], prv = t > 0 ? SD[(size_t)(row - 1) * NSIDE + 8 + j] : 0.f;
                o[i] = cur + F.in[F.z + I_MUV][j] * (prv - cur); }
        }
        *(v4u*)(LA + (size_t)row * KLORA + k0) = pack8(o);
    }
}

DI void scan_writeout(const Ctx& F, const LAS float* YT, bf16* dst  , int ld) {
    const int s = F.tid >> 4, r2 = (F.tid & 15) * 2;
    *(unsigned*)(dst + (size_t)s * ld + r2) = pk2(YT[s * 32 + r2], YT[s * 32 + r2 + 1]);
}
DI void scan_rwkv(const Ctx& F, int l, int g, int unit) {
    const int half = unit & 1, h = (unit >> 1) & 15, bl = unit >> 5;
    LAS float* TW = (LAS float*)F.lds; LAS float* TKP = TW + 2048; LAS float* TB = TW + 4096; LAS float* TKK = TW + 6144; LAS float* TR = TW + 8192; LAS float* TV = TW + 10240; LAS float* YT = TW + 12288;
    const bf16* Z = (const bf16*)(F.ws + WS_Z); const bf16* LO = (const bf16*)(F.ws + WS_LO); bf16* VF = (bf16*)(F.ws + WS_VF); bf16* BON = (bf16*)(F.ws + WS_BON);
    bf16* RAW = (bf16*)(F.ws + WS_RAW) + (size_t)1 * MG * D;
    const int gc = h * 64 + F.lane;
    const float mu_r = F.in[F.z + I_MU][l * 3328 + gc], mu_k = F.in[F.z + I_MU][l * 3328 + 1024 + gc], mu_v = F.in[F.z + I_MU][l * 3328 + 2048 + gc];
    const float w0 = F.in[F.z + I_W0][l * D + gc], a0 = F.in[F.z + I_A0][l * D + gc], kkc = F.in[F.z + I_KK][l * D + gc], kac = F.in[F.z + I_KA][l * D + gc], rk = F.in[F.z + I_RK][l * D + gc];
    const float v0 = l == 1 ? F.in[F.z + I_V0][gc] : 0.f;
    const int rowl = F.tid >> 4, ks = F.tid & 15;
    float s0 = 0.f, s1 = 0.f, s2 = 0.f, s3 = 0.f;
    for (int tt = 0; tt < T / 32; ++tt) {
        {
            const int sb = F.wave * 4, t0 = tt * 32 + sb; const size_t lrow0 = (size_t)bl * T + t0;
            float pr = 0.f, pk = 0.f, pv = 0.f;
            if (t0 > 0) { const bf16* zp = Z + (lrow0 - 1) * NZ + ZC_RW + gc; pr = bf1(zp[0]); pk = bf1(zp[1024]); pv = bf1(zp[2048]); }
#pragma unroll
            for (int j = 0; j < 4; ++j) {
                const size_t lrow = lrow0 + j; const bf16* zp = Z + lrow * NZ + ZC_RW + gc;
                const float zr = bf1(zp[0]), zk = bf1(zp[1024]), zv = bf1(zp[2048]);
                const float r = zr + mu_r * (pr - zr), k = zk + mu_k * (pk - zk); float v = zv + mu_v * (pv - zv);
                pr = zr; pk = zk; pv = zv;
                const bf16* lp = LO + lrow * NLORA + gc;
                const float xw = w0 + bf1(lp[0]); const float wraw = -softplusf_(-xw) - 0.5f; const float w = __expf(-__expf(wraw));
                const float a = sigmoidf_(a0 + bf1(lp[1024]));
                const size_t grow = (size_t)g * MG + lrow;
                if (l == 0) { if (half == 0) VF[grow * D + gc] = (bf16)f2bf(v); }
                else { const float vf = bf1(VF[grow * D + gc]); v = v + (vf - v) * sigmoidf_(v0 + bf1(lp[3072])); }
                const float kk = k * kkc; const float nrm = sqrtf(wave_sum(kk * kk)); const float kn = kk / fmaxf(nrm, 1e-12f);
                const float kp = k * (1.0f + (a - 1.0f) * kac);
                const float bsum = wave_sum(r * kp * rk);
                if (half == 0) BON[lrow * D + gc] = (bf16)f2bf(bsum * v);
                const int s = sb + j;
                TW[s * 64 + F.lane] = w; TKP[s * 64 + F.lane] = kp; TB[s * 64 + F.lane] = kn * a; TKK[s * 64 + F.lane] = kn; TR[s * 64 + F.lane] = r; TV[s * 64 + F.lane] = v;
            }
        }
        __syncthreads();
#pragma unroll 4
        for (int s = 0; s < 32; ++s) {
            const f32x4 kk = *(const LAS f32x4*)(TKK + s * 64 + ks * 4), w = *(const LAS f32x4*)(TW + s * 64 + ks * 4), b = *(const LAS f32x4*)(TB + s * 64 + ks * 4);
            const f32x4 kp = *(const LAS f32x4*)(TKP + s * 64 + ks * 4), r = *(const LAS f32x4*)(TR + s * 64 + ks * 4);
            const float vv = TV[s * 64 + half * 32 + rowl];
            const float u = sum16((s0 * kk.x + s1 * kk.y) + (s2 * kk.z + s3 * kk.w));
            s0 = s0 * w.x - u * b.x + vv * kp.x; s1 = s1 * w.y - u * b.y + vv * kp.y; s2 = s2 * w.z - u * b.z + vv * kp.z; s3 = s3 * w.w - u * b.w + vv * kp.w;
            const float y = sum16((s0 * r.x + s1 * r.y) + (s2 * r.z + s3 * r.w));
            if (ks == 0) YT[s * 32 + rowl] = y;
        }
        __syncthreads();
        scan_writeout(F, YT, RAW + ((size_t)bl * T + tt * 32) * D + h * 64 + half * 32, D);
    }
    __syncthreads();
}
DI void scan_hgrn(const Ctx& F, int l, int unit) {
    const int qt = unit & 3, h = (unit >> 2) & 7, bl = unit >> 5;
    LAS float* TQ = (LAS float*)F.lds; LAS float* TF = TQ + 4096; LAS float* TK = TQ + 8192; LAS float* TV = TQ + 12288; LAS float* YT = TQ + 13312;
    const bf16* Z = (const bf16*)(F.ws + WS_Z); bf16* RAW = (bf16*)(F.ws + WS_RAW) + (size_t)2 * MG * D;
    const int ps = F.tid >> 4, pc = (F.tid & 15) * 8;
    float lb[8];
#pragma unroll
    for (int i = 0; i < 8; ++i) lb[i] = l == 0 ? 0.f : sigmoidf_(F.in[F.z + I_LBL][D + h * 128 + pc + i] - F.in[F.z + I_LBL][h * 128 + pc + i]);
    const int el = F.tid >> 4, ds = F.tid & 15;
    float S[8];
#pragma unroll
    for (int i = 0; i < 8; ++i) S[i] = 0.f;
    for (int tt = 0; tt < T / 32; ++tt) {
        {
            const size_t lrow = (size_t)bl * T + tt * 32 + ps; float q[8], f[8], kk[8];
            unpack8(*(const v4u*)(Z + lrow * NZ + ZC_HGQ + h * 128 + pc), q); unpack8(*(const v4u*)(Z + lrow * NZ + ZC_HGF + h * 128 + pc), f);
#pragma unroll
            for (int i = 0; i < 8; ++i) { q[i] = siluf_(q[i]); const float sg = sigmoidf_(f[i]); kk[i] = (1.0f - lb[i]) * (1.0f - sg); f[i] = fmaxf(lb[i] + (1.0f - lb[i]) * sg, 1e-30f); }
            *(LAS f32x4*)(TQ + ps * 128 + pc) = (f32x4){q[0], q[1], q[2], q[3]}; *(LAS f32x4*)(TQ + ps * 128 + pc + 4) = (f32x4){q[4], q[5], q[6], q[7]};
            *(LAS f32x4*)(TF + ps * 128 + pc) = (f32x4){f[0], f[1], f[2], f[3]}; *(LAS f32x4*)(TF + ps * 128 + pc + 4) = (f32x4){f[4], f[5], f[6], f[7]};
            *(LAS f32x4*)(TK + ps * 128 + pc) = (f32x4){kk[0], kk[1], kk[2], kk[3]}; *(LAS f32x4*)(TK + ps * 128 + pc + 4) = (f32x4){kk[4], kk[5], kk[6], kk[7]};
            const unsigned vw = *(const unsigned*)(Z + lrow * NZ + ZC_HGI + h * 128 + qt * 32 + (F.tid & 15) * 2);
            TV[ps * 32 + (F.tid & 15) * 2] = bflo(vw); TV[ps * 32 + (F.tid & 15) * 2 + 1] = bfhi(vw);
        }
        __syncthreads();
#pragma unroll 4
        for (int s = 0; s < 32; ++s) {
            const float vv = TV[s * 32 + el]; float o = 0.f;
#pragma unroll
            for (int j = 0; j < 2; ++j) { const f32x4 q = *(const LAS f32x4*)(TQ + s * 128 + j * 64 + ds * 4), f = *(const LAS f32x4*)(TF + s * 128 + j * 64 + ds * 4), kk = *(const LAS f32x4*)(TK + s * 128 + j * 64 + ds * 4);
#pragma unroll
                for (int i = 0; i < 4; ++i) { S[j * 4 + i] = f[i] * S[j * 4 + i] + kk[i] * vv; o += S[j * 4 + i] * q[i]; } }
            o = sum16(o);
            if (ds == 0) YT[s * 32 + el] = o;
        }
        __syncthreads();
        scan_writeout(F, YT, RAW + ((size_t)bl * T + tt * 32) * D + h * 128 + qt * 32, D);
    }
    __syncthreads();
}
DI void scan_mlstm(const Ctx& F, int l, int unit) {
    const int e8 = unit & 7, h = (unit >> 3) & 3, bl = unit >> 5;
    LAS float* TQ = (LAS float*)F.lds; LAS float* TKI = TQ + 8192; LAS float* TV = TQ + 16384; LAS float* YT = TQ + 17408;
    LAS float* TLI = TQ + 18432; LAS float* TLF = TLI + 32; LAS float* TFG = TLI + 64; LAS float* TIG = TLI + 96; LAS float* TEM = TLI + 128; LAS float* MC = TLI + 160;
    const bf16* Z = (const bf16*)(F.ws + WS_Z); const bf16* QK = (const bf16*)(F.ws + WS_QK); const float* SD = (const float*)(F.ws + WS_SIDE);
    bf16* RAW = (bf16*)(F.ws + WS_RAW);
    const float ib = F.in[F.z + I_IB][l * 4 + h], fb = F.in[F.z + I_FB][l * 4 + h];
    const int ps = F.tid >> 4, pc = (F.tid & 15) * 16;
    const int el = F.tid >> 4, ds = F.tid & 15;
    float C[16], N[16];
#pragma unroll
    for (int i = 0; i < 16; ++i) { C[i] = 0.f; N[i] = 0.f; }
    if (F.tid == 0) MC[0] = 0.f;
    for (int tt = 0; tt < T / 32; ++tt) {
        if (F.wave == 0) {
            if (F.lane < 32) { const size_t lrow = (size_t)bl * T + tt * 32 + F.lane;
                TLI[F.lane] = SD[lrow * NSIDE + h] + ib; TLF[F.lane] = -softplusf_(-(SD[lrow * NSIDE + 4 + h] + fb)); }
            LDS_WAIT(); asm volatile("" ::: "memory");
            if (F.lane == 0) { float m = MC[0];
                for (int s = 0; s < 32; ++s) { const float lf = TLF[s], li = TLI[s], mp = m; m = fmaxf(mp + lf, li); TFG[s] = __expf(lf + mp - m); TIG[s] = __expf(li - m); TEM[s] = __expf(-m); }
                MC[0] = m; }
        }
        __syncthreads();
        {
            const size_t lrow = (size_t)bl * T + tt * 32 + ps; const float ig = TIG[ps]; float q[8], k[8];
#pragma unroll
            for (int hh = 0; hh < 2; ++hh) {
                unpack8(*(const v4u*)(QK + lrow * 2048 + h * 512 + pc + hh * 8), q); unpack8(*(const v4u*)(QK + lrow * 2048 + h * 512 + 256 + pc + hh * 8), k);
                *(LAS f32x4*)(TQ + ps * 256 + pc + hh * 8) = (f32x4){q[0], q[1], q[2], q[3]}; *(LAS f32x4*)(TQ + ps * 256 + pc + hh * 8 + 4) = (f32x4){q[4], q[5], q[6], q[7]};
                *(LAS f32x4*)(TKI + ps * 256 + pc + hh * 8) = (f32x4){k[0] * ig, k[1] * ig, k[2] * ig, k[3] * ig}; *(LAS f32x4*)(TKI + ps * 256 + pc + hh * 8 + 4) = (f32x4){k[4] * ig, k[5] * ig, k[6] * ig, k[7] * ig};
            }
            const unsigned vw = *(const unsigned*)(Z + lrow * NZ + ZC_MLX + h * 256 + e8 * 32 + (F.tid & 15) * 2);
            TV[ps * 32 + (F.tid & 15) * 2] = bflo(vw); TV[ps * 32 + (F.tid & 15) * 2 + 1] = bfhi(vw);
        }
        __syncthreads();
#pragma unroll 2
        for (int s = 0; s < 32; ++s) {
            const float vv = TV[s * 32 + el], fg = TFG[s], em = TEM[s]; float num = 0.f, den = 0.f;
#pragma unroll
            for (int j = 0; j < 4; ++j) { const f32x4 q = *(const LAS f32x4*)(TQ + s * 256 + j * 64 + ds * 4), ki = *(const LAS f32x4*)(TKI + s * 256 + j * 64 + ds * 4);
#pragma unroll
                for (int i = 0; i < 4; ++i) { C[j * 4 + i] = fg * C[j * 4 + i] + ki[i] * vv; N[j * 4 + i] = fg * N[j * 4 + i] + ki[i]; num += C[j * 4 + i] * q[i]; den += N[j * 4 + i] * q[i]; } }
            num = sum16(num); den = sum16(den);
            if (ds == 0) YT[s * 32 + el] = num / fmaxf(fabsf(den), em);
        }
        __syncthreads();
        scan_writeout(F, YT, RAW + ((size_t)bl * T + tt * 32) * D + h * 256 + e8 * 32, D);
    }
    __syncthreads();
}


typedef short s16x4 __attribute__((ext_vector_type(4)));
DI bf16x8 tr8(const LAS unsigned char* p0, const LAS unsigned char* p1) {
    const s16x4 lo = __builtin_amdgcn_ds_read_tr16_b64_v4i16((LAS s16x4*)p0), hi = __builtin_amdgcn_ds_read_tr16_b64_v4i16((LAS s16x4*)p1);
    return (bf16x8){lo[0], lo[1], lo[2], lo[3], hi[0], hi[1], hi[2], hi[3]};
}
DI float wave_incl_sum(float v, int lane) {
#pragma unroll
    for (int o = 1; o < 64; o <<= 1) { const float t = __shfl_up(v, o); if (lane >= o) v += t; }
    return v;
}
DI float wave_incl_max(float v, int lane) {
#pragma unroll
    for (int o = 1; o < 64; o <<= 1) { const float t = __shfl_up(v, o); if (lane >= o) v = fmaxf(v, t); }
    return v;
}
#define WG_SYNC() do { asm volatile("s_waitcnt lgkmcnt(0)" ::: "memory"); __builtin_amdgcn_s_barrier(); asm volatile("" ::: "memory"); } while (0)
DI void scan_mlstm_mfma(const Ctx& F, int l, int unit) {
    constexpr int QP = 528, PP = 144, VP = 96;
    constexpr int O_QS = 0, O_KS = 33792, O_CB = 67584, O_PS = 92928, O_VS = 102144, O_GT = 108288;
    const int e8 = unit & 7, h = (unit >> 3) & 3, bl = unit >> 5;
    LAS unsigned char* Qs = F.lds + O_QS; LAS unsigned char* Ks = F.lds + O_KS; LAS unsigned char* Cb = F.lds + O_CB; LAS unsigned char* Ps = F.lds + O_PS; LAS unsigned char* Vs = F.lds + O_VS;
    LAS float* RT = (LAS float*)(F.lds + O_GT); LAS float* CS = RT + 64; LAS float* WI = RT + 128; LAS float* EM = RT + 192; LAS float* WS = RT + 256; LAS float* SC = RT + 320;
    const bf16* QKp = (const bf16*)(F.ws + WS_QK) + (size_t)bl * T * 2048 + h * 512;
    const bf16* Vp = (const bf16*)(F.ws + WS_Z) + (size_t)bl * T * NZ + ZC_MLX + h * 256 + e8 * 32;
    const float* SD = (const float*)(F.ws + WS_SIDE) + (size_t)bl * T * NSIDE;
    bf16* OUT = (bf16*)(F.ws + WS_RAW) + (size_t)bl * T * D + h * 256 + e8 * 32;
    const float ib = F.in[F.z + I_IB][l * 4 + h], fb = F.in[F.z + I_FB][l * 4 + h];
    const int tid = F.tid, lane = F.lane, w = F.wave, g = lane >> 4, r = lane & 15, q = r >> 2, p = lane & 3;
    const int srow = tid >> 3, scj = tid & 7, vrow = tid >> 2, vc = tid & 3;
    v4u pq[4], pk[4], pv; float pli = 0.f, plf = 0.f; float m_prev = 0.f;
    f32x4 C[2][3];
#pragma unroll
    for (int a = 0; a < 2; ++a)
#pragma unroll
        for (int b = 0; b < 3; ++b) C[a][b] = (f32x4){0.f, 0.f, 0.f, 0.f};
    for (int i = tid; i < 25344 / 16; i += NTHREADS) *(LAS v4u*)(Cb + i * 16) = (v4u){0u, 0u, 0u, 0u};
    if (tid >= 256 && tid < 384) { const int rr = (tid - 256) >> 1, hh = tid & 1; unsigned one2 = 0x3F803F80u; asm volatile("" : "+v"(one2)); *(LAS v4u*)(Vs + rr * VP + 64 + hh * 16) = (v4u){one2, one2, one2, one2}; }
#define ML_LOAD(c) do { \
        _Pragma("unroll") for (int j = 0; j < 4; ++j) { pq[j] = *(const v4u*)(QKp + (size_t)((c) * 64 + srow) * 2048 + (scj + 8 * j) * 8); pk[j] = *(const v4u*)(QKp + (size_t)((c) * 64 + srow) * 2048 + 256 + (scj + 8 * j) * 8); } \
        if (tid < 256) pv = *(const v4u*)(Vp + (size_t)((c) * 64 + vrow) * NZ + vc * 8); \
        if (w == 0) { pli = SD[(size_t)((c) * 64 + lane) * NSIDE + h]; plf = SD[(size_t)((c) * 64 + lane) * NSIDE + 4 + h]; } } while (0)
#define ML_STORE() do { \
        _Pragma("unroll") for (int j = 0; j < 4; ++j) { *(LAS v4u*)(Qs + srow * QP + (scj + 8 * j) * 16) = pq[j]; *(LAS v4u*)(Ks + srow * QP + (scj + 8 * j) * 16) = pk[j]; } \
        if (tid < 256) *(LAS v4u*)(Vs + vrow * VP + vc * 16) = pv; \
        if (w == 0) { const float li = pli + ib, lf = -softplusf_(-(plf + fb)); const float bc = wave_incl_sum(lf, lane), cs = li - bc, pm = wave_incl_max(cs, lane), mx = fmaxf(m_prev, pm); \
            const float mx63 = __shfl(mx, 63), b63 = __shfl(bc, 63); \
            RT[lane] = -mx; CS[lane] = cs; WI[lane] = __expf(m_prev - mx); EM[lane] = __expf(-(bc + mx)); WS[lane] = __expf(cs - mx63); if (lane == 0) SC[0] = __expf(m_prev - mx63); m_prev = b63 + mx63; } } while (0)
    ML_LOAD(0); ML_STORE();
    WG_SYNC();
    const int tb = w >> 1, wh = w & 1;
    for (int c = 0; c < T / 64; ++c) {
        if (c + 1 < T / 64) ML_LOAD(c + 1);
#pragma unroll
        for (int si = 0; si < 2; ++si) {
            const int sb = wh * 2 + si; const int t = tb * 16 + r, s0 = sb * 16 + 4 * g;
            v2u pw = (v2u){0u, 0u};
            if (sb <= tb) {
                f32x4 acc = (f32x4){0.f, 0.f, 0.f, 0.f};
#pragma unroll
                for (int ks = 0; ks < 8; ++ks) { const bf16x8 a = *(const LAS bf16x8*)(Ks + (sb * 16 + r) * QP + (ks * 32 + 8 * g) * 2), b = *(const LAS bf16x8*)(Qs + (tb * 16 + r) * QP + (ks * 32 + 8 * g) * 2);
                    acc = __builtin_amdgcn_mfma_f32_16x16x32_bf16(a, b, acc, 0, 0, 0); }
                const float rt = RT[t]; const f32x4 cs4 = *(const LAS f32x4*)(CS + s0);
                float o[4];
#pragma unroll
                for (int i = 0; i < 4; ++i) o[i] = (s0 + i <= t) ? acc[i] * __expf(rt + cs4[i]) : 0.f;
                pw.x = pk2(o[0], o[1]); pw.y = pk2(o[2], o[3]);
            }
            *(LAS v2u*)(Ps + t * PP + s0 * 2) = pw;
        }
        { const float gm = SC[0];
#pragma unroll
            for (int a = 0; a < 2; ++a)
#pragma unroll
                for (int b = 0; b < 3; ++b) C[a][b] *= gm;
#pragma unroll
            for (int ks = 0; ks < 2; ++ks) {
                const f32x4 wsA = *(const LAS f32x4*)(WS + ks * 32 + 8 * g), wsB = *(const LAS f32x4*)(WS + ks * 32 + 8 * g + 4);
                bf16x8 bfr[3], afr[2];
#pragma unroll
                for (int et = 0; et < 3; ++et) { const LAS unsigned char* pa = Vs + (ks * 32 + 8 * g + q) * VP + (et * 16 + 4 * p) * 2; const bf16x8 raw = tr8(pa, pa + 4 * VP);
                    const v4u rw = __builtin_bit_cast(v4u, raw); v4u sw;
                    sw.x = pk2(bflo(rw.x) * wsA[0], bfhi(rw.x) * wsA[1]); sw.y = pk2(bflo(rw.y) * wsA[2], bfhi(rw.y) * wsA[3]);
                    sw.z = pk2(bflo(rw.z) * wsB[0], bfhi(rw.z) * wsB[1]); sw.w = pk2(bflo(rw.w) * wsB[2], bfhi(rw.w) * wsB[3]);
                    bfr[et] = __builtin_bit_cast(bf16x8, sw); }
#pragma unroll
                for (int a = 0; a < 2; ++a) { const LAS unsigned char* pa = Ks + (ks * 32 + 8 * g + q) * QP + ((2 * w + a) * 16 + 4 * p) * 2; afr[a] = tr8(pa, pa + 4 * QP); }
#pragma unroll
                for (int a = 0; a < 2; ++a)
#pragma unroll
                    for (int et = 0; et < 3; ++et) C[a][et] = __builtin_amdgcn_mfma_f32_16x16x32_bf16(afr[a], bfr[et], C[a][et], 0, 0, 0);
            } }
        WG_SYNC();
        {
            f32x4 oi[2], oc[2];
#pragma unroll
            for (int j = 0; j < 2; ++j) { oi[j] = (f32x4){0.f, 0.f, 0.f, 0.f}; oc[j] = (f32x4){0.f, 0.f, 0.f, 0.f}; }
#pragma unroll
            for (int ks = 0; ks < 2; ++ks) { const bf16x8 a = *(const LAS bf16x8*)(Ps + (tb * 16 + r) * PP + (ks * 32 + 8 * g) * 2);
#pragma unroll
                for (int j = 0; j < 2; ++j) { const int et = j == 0 ? wh : 2; const LAS unsigned char* pa = Vs + (ks * 32 + 8 * g + q) * VP + (et * 16 + 4 * p) * 2;
                    oi[j] = __builtin_amdgcn_mfma_f32_16x16x32_bf16(a, tr8(pa, pa + 4 * VP), oi[j], 0, 0, 0); } }
#pragma unroll
            for (int ks = 0; ks < 8; ++ks) { const bf16x8 a = *(const LAS bf16x8*)(Qs + (tb * 16 + r) * QP + (ks * 32 + 8 * g) * 2);
#pragma unroll
                for (int j = 0; j < 2; ++j) { const int et = j == 0 ? wh : 2; const bf16x8 b = *(const LAS bf16x8*)(Cb + (et * 16 + r) * QP + (ks * 32 + 8 * g) * 2);
                    oc[j] = __builtin_amdgcn_mfma_f32_16x16x32_bf16(a, b, oc[j], 0, 0, 0); } }
            const f32x4 wi4 = *(const LAS f32x4*)(WI + tb * 16 + 4 * g), em4 = *(const LAS f32x4*)(EM + tb * 16 + 4 * g);
#pragma unroll
            for (int i = 0; i < 4; ++i) { const float num = oi[0][i] + wi4[i] * oc[0][i], den = oi[1][i] + wi4[i] * oc[1][i];
                OUT[(size_t)(c * 64 + tb * 16 + 4 * g + i) * D + wh * 16 + r] = (bf16)f2bf(num / fmaxf(fabsf(den), em4[i])); }
        }
        WG_SYNC();
#pragma unroll
        for (int a = 0; a < 2; ++a)
#pragma unroll
            for (int et = 0; et < 3; ++et) { v2u cw; cw.x = pk2(C[a][et][0], C[a][et][1]); cw.y = pk2(C[a][et][2], C[a][et][3]);
                *(LAS v2u*)(Cb + (et * 16 + r) * QP + ((2 * w + a) * 16 + 4 * g) * 2) = cw; }
        if (c + 1 < T / 64) ML_STORE();
        WG_SYNC();
    }
#undef ML_LOAD
#undef ML_STORE
}


DI void scan_rwkv2(const Ctx& F, int l, int g, int unit) {
    const int half = unit & 1, h = (unit >> 1) & 15, bl = unit >> 5;
    LAS float* TW = (LAS float*)F.lds; LAS float* TKP = TW + 2048; LAS float* TB = TW + 4096; LAS float* TKK = TW + 6144; LAS float* TR = TW + 8192; LAS float* TV = TW + 10240; LAS float* YT = TW + 12288;
    const bf16* Z = (const bf16*)(F.ws + WS_Z); const bf16* LO = (const bf16*)(F.ws + WS_LO); bf16* VF = (bf16*)(F.ws + WS_VF); bf16* BON = (bf16*)(F.ws + WS_BON);
    bf16* RAW = (bf16*)(F.ws + WS_RAW) + (size_t)1 * MG * D;
    const int lane = F.lane, wave = F.wave;
    const int gc = h * 64 + lane;
    const float mu_r = F.in[F.z + I_MU][l * 3328 + gc], mu_k = F.in[F.z + I_MU][l * 3328 + 1024 + gc], mu_v = F.in[F.z + I_MU][l * 3328 + 2048 + gc];
    const float w0 = F.in[F.z + I_W0][l * D + gc], a0 = F.in[F.z + I_A0][l * D + gc], kkc = F.in[F.z + I_KK][l * D + gc], kac = F.in[F.z + I_KA][l * D + gc], rk = F.in[F.z + I_RK][l * D + gc];
    const float v0 = l == 1 ? F.in[F.z + I_V0][gc] : 0.f;
    const int rowl = F.tid >> 4, ks = F.tid & 15;
    f32x2 sa = (f32x2){0.f, 0.f}, sb = (f32x2){0.f, 0.f};
    bf16 rz[4][3], rl[4][2], rv[4][2], rp[3];
#define RW_LOAD(tt) do { const int t0_ = (tt) * 32 + wave * 4; const size_t lrow0_ = (size_t)bl * T + t0_; \
        _Pragma("unroll") for (int i = 0; i < 3; ++i) rp[i] = t0_ > 0 ? Z[(lrow0_ - 1) * NZ + ZC_RW + gc + 1024 * i] : (bf16)0; \
        _Pragma("unroll") for (int j = 0; j < 4; ++j) { const bf16* zp = Z + (lrow0_ + j) * NZ + ZC_RW + gc; const bf16* lp = LO + (lrow0_ + j) * NLORA + gc; \
            rz[j][0] = zp[0]; rz[j][1] = zp[1024]; rz[j][2] = zp[2048]; rl[j][0] = lp[0]; rl[j][1] = lp[1024]; \
            if (l == 1) { rv[j][0] = lp[3072]; rv[j][1] = VF[((size_t)g * MG + lrow0_ + j) * D + gc]; } } } while (0)
#define RW_PREP(tt) do { const int sb_ = wave * 4; const size_t lrow0_ = (size_t)bl * T + (tt) * 32 + sb_; \
        float pr = bf1(rp[0]), pk = bf1(rp[1]), pv = bf1(rp[2]); \
        _Pragma("unroll") for (int j = 0; j < 4; ++j) { const size_t lrow = lrow0_ + j; \
            const float zr = bf1(rz[j][0]), zk = bf1(rz[j][1]), zv = bf1(rz[j][2]); \
            const float r = zr + mu_r * (pr - zr), k = zk + mu_k * (pk - zk); float v = zv + mu_v * (pv - zv); \
            pr = zr; pk = zk; pv = zv; \
            const float xw = w0 + bf1(rl[j][0]); const float wraw = -softplusf_(-xw) - 0.5f; const float w = __expf(-__expf(wraw)); \
            const float a = sigmoidf_(a0 + bf1(rl[j][1])); \
            if (l == 0) { if (half == 0) VF[((size_t)g * MG + lrow) * D + gc] = (bf16)f2bf(v); } \
            else { const float vf = bf1(rv[j][1]); v = v + (vf - v) * sigmoidf_(v0 + bf1(rv[j][0])); } \
            const float kk = k * kkc; const float kn = kk * __builtin_amdgcn_rsqf(fmaxf(wave_sum(kk * kk), 1e-24f)); \
            const float kp = k * (1.0f + (a - 1.0f) * kac); \
            const float bsum = wave_sum(r * kp * rk); \
            if (half == 0) BON[lrow * D + gc] = (bf16)f2bf(bsum * v); \
            const int s = sb_ + j; \
            TW[s * 64 + lane] = w; TKP[s * 64 + lane] = kp; TB[s * 64 + lane] = kn * a; TKK[s * 64 + lane] = kn; TR[s * 64 + lane] = r; TV[s * 64 + lane] = v; } } while (0)
    RW_LOAD(0); RW_PREP(0);
    WG_SYNC();
    for (int tt = 0; tt < T / 32; ++tt) {
        if (tt + 1 < T / 32) RW_LOAD(tt + 1);
        {
            f32x4 nkk = *(const LAS f32x4*)(TKK + ks * 4), nw = *(const LAS f32x4*)(TW + ks * 4), nb = *(const LAS f32x4*)(TB + ks * 4), nkp = *(const LAS f32x4*)(TKP + ks * 4), nr = *(const LAS f32x4*)(TR + ks * 4);
            float nvv = TV[half * 32 + rowl];
#pragma unroll 1
            for (int hh = 0; hh < 2; ++hh) {
                float ysel = 0.f;
#pragma unroll
                for (int s16 = 0; s16 < 16; ++s16) {
                    const int s = hh * 16 + s16;
                    const f32x4 kk = nkk, w = nw, b = nb, kp = nkp, r = nr; const float vv = nvv;
                    const int sn = (s + 1) & 31;
                    nkk = *(const LAS f32x4*)(TKK + sn * 64 + ks * 4); nw = *(const LAS f32x4*)(TW + sn * 64 + ks * 4); nb = *(const LAS f32x4*)(TB + sn * 64 + ks * 4);
                    nkp = *(const LAS f32x4*)(TKP + sn * 64 + ks * 4); nr = *(const LAS f32x4*)(TR + sn * 64 + ks * 4); nvv = TV[sn * 64 + half * 32 + rowl];
                    const f32x2 d2 = sa * kk.xy + sb * kk.zw;
                    const f32x2 pa = sa * w.xy + kp.xy * vv, pb = sb * w.zw + kp.zw * vv;
                    const float nu = -sum16(d2.x + d2.y);
                    sa = b.xy * nu + pa; sb = b.zw * nu + pb;
                    const f32x2 y2 = sa * r.xy + sb * r.zw;
                    const float y = sum16(y2.x + y2.y);
                    ysel = (s16 == ks) ? y : ysel;
                }
                YT[(hh * 16 + ks) * 32 + rowl] = ysel;
            }
        }
        WG_SYNC();
        scan_writeout(F, YT, RAW + ((size_t)bl * T + tt * 32) * D + h * 64 + half * 32, D);
        if (tt + 1 < T / 32) RW_PREP(tt + 1);
        WG_SYNC();
    }
#undef RW_LOAD
#undef RW_PREP
}


DI void scan_hgrn_mfma(const Ctx& F, int l, int unit) {
    constexpr int QP = 272, VP = 80, PP = 80;
    constexpr int O_QA = 0, O_KA = 8704, O_SB = 17408, O_V = 26112, O_P = 28672, O_QT = 31232, O_E15 = 33280, O_GM = 33792, O_HH = 34304;
    const int qt = unit & 3, h = (unit >> 2) & 7, bl = unit >> 5;
    LAS unsigned char* Qa = F.lds + O_QA; LAS unsigned char* Ka = F.lds + O_KA; LAS unsigned char* Sb = F.lds + O_SB; LAS unsigned char* Vs = F.lds + O_V; LAS unsigned char* Ps = F.lds + O_P;
    LAS float* QT = (LAS float*)(F.lds + O_QT); LAS float* E15 = (LAS float*)(F.lds + O_E15); LAS float* GM = (LAS float*)(F.lds + O_GM); LAS float* HH = (LAS float*)(F.lds + O_HH);
    const bf16* Zq = (const bf16*)(F.ws + WS_Z) + (size_t)bl * T * NZ + ZC_HGQ + h * 128;
    const bf16* Zf = (const bf16*)(F.ws + WS_Z) + (size_t)bl * T * NZ + ZC_HGF + h * 128;
    const bf16* Zv = (const bf16*)(F.ws + WS_Z) + (size_t)bl * T * NZ + ZC_HGI + h * 128 + qt * 32;
    bf16* OUT = (bf16*)(F.ws + WS_RAW) + (size_t)2 * MG * D + (size_t)bl * T * D + h * 128 + qt * 32;
    const int tid = F.tid, lane = F.lane, w = F.wave, g = lane >> 4, r = lane & 15, q = r >> 2, p = lane & 3;
    const int pd = tid & 127, tq = tid >> 7;
    const int vrow = tid >> 2, vc = tid & 3;
    bf16 rq[8], rf[8]; v4u pv;
    f32x4 S[2];
    S[0] = (f32x4){0.f, 0.f, 0.f, 0.f}; S[1] = (f32x4){0.f, 0.f, 0.f, 0.f};
#define HG_LOAD(c) do { _Pragma("unroll") for (int i = 0; i < 8; ++i) { rq[i] = Zq[(size_t)((c) * 32 + tq * 8 + i) * NZ + pd]; rf[i] = Zf[(size_t)((c) * 32 + tq * 8 + i) * NZ + pd]; } \
        if (tid < 128) pv = *(const v4u*)(Zv + (size_t)((c) * 32 + vrow) * NZ + vc * 8); } while (0)
    HG_LOAD(0);
    for (int c = 0; c < T / 32; ++c) {
        float qv[8], kv[8], cb[8]; float run = 0.f;
#pragma unroll
        for (int i = 0; i < 8; ++i) { qv[i] = bf1(rq[i]); const float lf = bf1(rf[i]); kv[i] = 1.0f - __expf(lf); run += lf; cb[i] = run; }
        QT[tq * 128 + pd] = run;
        if (tid < 128) *(LAS v4u*)(Vs + vrow * VP + vc * 16) = pv;
        if (c + 1 < T / 32) HG_LOAD(c + 1);
        WG_SYNC();
        { const float q0 = QT[pd], q1 = QT[128 + pd], q2 = QT[256 + pd], q3 = QT[384 + pd];
            const float off = (tq > 0 ? q0 : 0.f) + (tq > 1 ? q1 : 0.f) + (tq > 2 ? q2 : 0.f); const float b15 = q0 + q1, b31 = (q0 + q1) + (q2 + q3);
#pragma unroll
            for (int i = 0; i < 8; ++i) { const float bt = off + cb[i]; const float ea = __expf(fminf(bt - b15, 80.f)), ek = __expf(fminf(b15 - bt, 80.f));
                *(LAS bf16*)(Qa + (tq * 8 + i) * QP + pd * 2) = (bf16)f2bf(qv[i] * ea); *(LAS bf16*)(Ka + (tq * 8 + i) * QP + pd * 2) = (bf16)f2bf(kv[i] * ek); }
            if (tq == 0) { E15[pd] = __expf(b15); GM[pd] = __expf(b31); HH[pd] = __expf(b31 - b15); } }
        WG_SYNC();
        { const f32x4 e4 = *(const LAS f32x4*)(E15 + w * 16 + 4 * g), g4 = *(const LAS f32x4*)(GM + w * 16 + 4 * g), h4 = *(const LAS f32x4*)(HH + w * 16 + 4 * g);
            const LAS unsigned char* pa = Ka + (8 * g + q) * QP + (w * 16 + 4 * p) * 2; const bf16x8 afr = tr8(pa, pa + 4 * QP);
#pragma unroll
            for (int et = 0; et < 2; ++et) { v2u sw; sw.x = pk2(S[et][0] * e4[0], S[et][1] * e4[1]); sw.y = pk2(S[et][2] * e4[2], S[et][3] * e4[3]);
                *(LAS v2u*)(Sb + (et * 16 + r) * QP + (w * 16 + 4 * g) * 2) = sw;
                const LAS unsigned char* pb = Vs + (8 * g + q) * VP + (et * 16 + 4 * p) * 2;
                const f32x4 kvp = __builtin_amdgcn_mfma_f32_16x16x32_bf16(afr, tr8(pb, pb + 4 * VP), (f32x4){0.f, 0.f, 0.f, 0.f}, 0, 0, 0);
                S[et] = g4 * S[et] + h4 * kvp; } }
        if (w < 4) { const int sb = w >> 1, tb = (w & 1) ^ sb;
            const int t = tb * 16 + r, s0 = sb * 16 + 4 * g; v2u pw = (v2u){0u, 0u};
            if (sb <= tb) { f32x4 acc = (f32x4){0.f, 0.f, 0.f, 0.f};
#pragma unroll
                for (int ks = 0; ks < 4; ++ks) { const bf16x8 a = *(const LAS bf16x8*)(Ka + (sb * 16 + r) * QP + (ks * 32 + 8 * g) * 2), b = *(const LAS bf16x8*)(Qa + (tb * 16 + r) * QP + (ks * 32 + 8 * g) * 2);
                    acc = __builtin_amdgcn_mfma_f32_16x16x32_bf16(a, b, acc, 0, 0, 0); }
                pw.x = pk2(s0 + 0 <= t ? acc[0] : 0.f, s0 + 1 <= t ? acc[1] : 0.f); pw.y = pk2(s0 + 2 <= t ? acc[2] : 0.f, s0 + 3 <= t ? acc[3] : 0.f); }
            *(LAS v2u*)(Ps + t * PP + s0 * 2) = pw; }
        WG_SYNC();
        if (w < 4) { const int tb = w >> 1, et = w & 1;
            const LAS unsigned char* pb = Vs + (8 * g + q) * VP + (et * 16 + 4 * p) * 2;
            f32x4 o = __builtin_amdgcn_mfma_f32_16x16x32_bf16(*(const LAS bf16x8*)(Ps + (tb * 16 + r) * PP + 8 * g * 2), tr8(pb, pb + 4 * VP), (f32x4){0.f, 0.f, 0.f, 0.f}, 0, 0, 0);
#pragma unroll
            for (int ks = 0; ks < 4; ++ks) { const bf16x8 a = *(const LAS bf16x8*)(Qa + (tb * 16 + r) * QP + (ks * 32 + 8 * g) * 2), b = *(const LAS bf16x8*)(Sb + (et * 16 + r) * QP + (ks * 32 + 8 * g) * 2);
                o = __builtin_amdgcn_mfma_f32_16x16x32_bf16(a, b, o, 0, 0, 0); }
#pragma unroll
            for (int i = 0; i < 4; ++i) OUT[(size_t)(c * 32 + tb * 16 + 4 * g + i) * D + et * 16 + r] = (bf16)f2bf(o[i]); }
        WG_SYNC();
    }
#undef HG_LOAD
}

DI void phase_post(const Ctx& F, int l) {
    const int gw = F.bid * NWAVES + F.wave, NGW = F.G * NWAVES;
    const bf16* Z = (const bf16*)(F.ws + WS_Z); const bf16* XC = (const bf16*)(F.ws + WS_XC); const bf16* LO = (const bf16*)(F.ws + WS_LO); const bf16* BON = (const bf16*)(F.ws + WS_BON);
    bf16* RAW = (bf16*)(F.ws + WS_RAW);
    const int c0 = F.lane * 16;
    for (int row = gw; row < MG; row += NGW) {
        float a[16], b[16], c[16];
        { bf16* rp = RAW + (size_t)row * D + c0;
            unpack16(rp, a);
            unpack16(Z + (size_t)row * NZ + ZC_MLO + c0, b);
            unpack16(XC + (size_t)row * D + c0, c);
            float s = 0.f;
#pragma unroll
            for (int i = 0; i < 16; ++i) { a[i] *= sigmoidf_(b[i]); s += a[i]; }
            const float mean = sum16(s) * (1.f / 256.f); float q = 0.f;
#pragma unroll
            for (int i = 0; i < 16; ++i) { a[i] -= mean; q += a[i] * a[i]; }
            const float rstd = 1.0f / sqrtf(sum16(q) * (1.f / 256.f) + 1e-6f);
#pragma unroll
            for (int i = 0; i < 16; ++i) a[i] = a[i] * rstd * F.in[F.z + I_MLNW][l * D + c0 + i] + F.in[F.z + I_MLSKIP][l * D + c0 + i] * c[i];
            pack16(rp, a); }
        { bf16* rp = RAW + (size_t)(MG + row) * D + c0;
            unpack16(rp, a);
            unpack16(BON + (size_t)row * D + c0, b);
            unpack16(LO + (size_t)row * NLORA + 2048 + c0, c);
            float s = 0.f;
#pragma unroll
            for (int i = 0; i < 16; ++i) s += a[i];
            const float mean = sum4(s) * (1.f / 64.f); float q = 0.f;
#pragma unroll
            for (int i = 0; i < 16; ++i) { a[i] -= mean; q += a[i] * a[i]; }
            const float rstd = 1.0f / sqrtf(sum4(q) * (1.f / 64.f) + 64e-5f);
#pragma unroll
            for (int i = 0; i < 16; ++i) a[i] = (a[i] * rstd * F.in[F.z + I_LNW][l * D + c0 + i] + F.in[F.z + I_LNB][l * D + c0 + i] + b[i]) * c[i];
            pack16(rp, a); }
        { bf16* rp = RAW + (size_t)(2 * MG + row) * D + c0;
            unpack16(rp, a);
            unpack16(Z + (size_t)row * NZ + ZC_HGG + c0, b);
            float q = 0.f;
#pragma unroll
            for (int i = 0; i < 16; ++i) q += a[i] * a[i];
            const float rstd = 1.0f / sqrtf(sum8(q) * (1.f / 128.f) + 1e-6f);
#pragma unroll
            for (int i = 0; i < 16; ++i) a[i] = a[i] * rstd * F.in[F.z + I_HGNW][l * D + c0 + i] * sigmoidf_(b[i]);
            pack16(rp, a); }
    }
}

enum { PH_W = 0, PH_A1, PH_A2, PH_A3, PH_B1, PH_B2, PH_B3, PH_B4, PH_B5, PH_B6, PH_B7, PH_B8, PH_FIN, PH_N };

__global__ void __launch_bounds__(NTHREADS, 2) fwd_kernel(Args args) {
    extern __shared__ __attribute__((aligned(16))) unsigned char lds_raw[];
    Ctx F;
    F.lds = (LAS unsigned char*)lds_raw; F.in = args.in; F.out = args.out; F.ws = args.ws;
    F.z = 0; F.tid = threadIdx.x; F.lane = F.tid & 63; F.wave = __builtin_amdgcn_readfirstlane(F.tid >> 6); F.bid = blockIdx.x; F.G = gridDim.x;
    volatile LAS unsigned* MISC = (volatile LAS unsigned*)(F.lds + MISC_OFF);
    if (F.tid < 32) MISC[F.tid] = 0u;
    __syncthreads();
    XcdBarrier bar; bar.bar = (unsigned*)(F.ws + WS_CTL) + CW_BAR; bar.x = 0; bar.st = nullptr;
    if (args.use_bar) bar = xcd_barrier_post((unsigned*)(F.ws + WS_CTL) + CW_BAR, MISC + 8);
#ifndef PHMASK
#define PHMASK 0xFFFF
#endif
#define IN(k) (((PHMASK >> (k)) & 1) && args.ph_lo <= (k) && (k) < args.ph_hi)
#ifndef REPEAT_PH
#define REPEAT_PH -1
#endif
#define PHASE(k) if (IN(k)) for (int rep_ = 0; rep_ < ((k) == REPEAT_PH ? 2 : 1); ++rep_) if (refresh(F), true)
#define SEAM() do { if (args.use_bar) xcd_barrier(bar); } while (0)
    const float* MOD = (const float*)(F.ws + WS_MOD);
    for (int f = args.f_lo; f < args.f_hi; ++f) {
        const int l = f >> 1, fi = f & 1;
        const float* modl = MOD + (size_t)l * NB * NMOD;
        if (fi == 0) PHASE(PH_W) { phase_weights(F, l); if (l == 0) { __syncthreads(); phase_mod(F); } SEAM(); }
        const int sub = fi ? 2 : 0;
        const float* xsrc = (f == 0) ? F.in[F.z + I_X] : F.out;
        PHASE(PH_A1) { phase_modulate<false>(F, xsrc, (bf16*)(F.ws + WS_H), F.in[F.z + I_NORMW] + (size_t)(l * 3 + sub) * D, modl, sub, 0, M, nullptr, 0); SEAM(); }
        PHASE(PH_A2) {
            pg8::Gemm gm{(const bf16*)(F.ws + WS_H), (const bf16*)(F.ws + WS_WUP) + (size_t)fi * NUP * D, D, D, D, 0, 0};
            pg8::Order<0> S; S.init(M / 256, NUP / 256, F.G, F.bid);
            pg8::EpiSwiGLU E{(bf16*)(F.ws + WS_HID), DFF};
            pg8::gemm_phase(F.lds, gm, S, E, F.tid); SEAM(); }
        PHASE(PH_A3) {
            pg8::Gemm gm{(const bf16*)(F.ws + WS_HID), (const bf16*)(F.ws + WS_WDN) + (size_t)fi * D * DFF, DFF, DFF, DFF, 0, 0};
            pg8::Order<0> S; S.init(M / 256, D / 256, F.G, F.bid);
            pg8::EpiResid E{xsrc, F.out, modl + (sub * 3 + 2) * D, 0.5f, 0};
            pg8::gemm_phase(F.lds, gm, S, E, F.tid); SEAM(); }
        if (fi == 0) {
            for (int g = args.g_lo; g < args.g_hi; ++g) {
                float* xg = F.out + (size_t)g * MG * D;
                PHASE(PH_B1) { phase_modulate<true>(F, F.out, (bf16*)(F.ws + WS_HG), F.in[F.z + I_NORMW] + (size_t)(l * 3 + 1) * D, modl, 1, g * MG, MG, (float*)(F.ws + WS_SIDE), l == 0 ? 8 : NSIDE); SEAM(); }
                PHASE(PH_B2) {
                    pg8::Gemm gm{(const bf16*)(F.ws + WS_HG), (const bf16*)(F.ws + WS_WIN), D, D, D, 0, 0};
                    pg8::Order<0> S; S.init(MG / 256, NZ / 256, F.G, F.bid);
                    pg8::EpiZ E{(bf16*)(F.ws + WS_Z), NZ, l == 0 ? nullptr : F.in[F.z + I_LBL]};
                    pg8::gemm_phase(F.lds, gm, S, E, F.tid); SEAM(); }
                PHASE(PH_B3) { phase_prep(F, l); SEAM(); }
                PHASE(PH_B4) {
                    { pg8::Gemm gm{(const bf16*)(F.ws + WS_XC), (const bf16*)(F.ws + WS_WQK), 256, D, 256, 256, (size_t)512 * 256};
                      pg8::Order<1> S; S.init(MG / 256, 8, F.G, F.bid);
                      pg8::EpiBf16 E{(bf16*)(F.ws + WS_QK), 2048, 512};
                      pg8::gemm_phase(F.lds, gm, S, E, F.tid); }
                    __syncthreads();
                    { pg8::Gemm gm{(const bf16*)(F.ws + WS_LA), (const bf16*)(F.ws + WS_WLORA), l == 0 ? 256 : 384, KLORA, KLORA, 0, 0};
                      pg8::Order<0> S; S.init(MG / 256, l == 0 ? 12 : 16, F.G, F.bid);
                      pg8::EpiBf16 E{(bf16*)(F.ws + WS_LO), NLORA, 0};
                      pg8::gemm_phase(F.lds, gm, S, E, F.tid); }
                    SEAM(); }
                PHASE(PH_B5) {
                    { unsigned* hgdone = (unsigned*)(F.ws + WS_CTL) + CW_HGDONE + 64 * (l * NGRP + g);
                      int lo0, lo1, lo2, st = 128, gq = 128, gc = F.bid;
                      if (F.G == 256) { const int a = F.bid < 128 ? F.bid : 128, b = F.bid >= 128 ? F.bid - 128 : 128; lo0 = a; lo1 = b; lo2 = a; }
                      else { lo0 = lo1 = lo2 = F.bid; st = F.G; gq = F.G; }
                      unsigned nhg = 0;
                      for (int i = lo2; i < 128; i += st) { scan_hgrn_mfma(F, l, i); ++nhg; }
                      if (nhg && F.tid == 0) __hip_atomic_fetch_add(hgdone, nhg, __ATOMIC_RELAXED, __HIP_MEMORY_SCOPE_AGENT);
                      for (int i = lo0; i < 128; i += st) scan_mlstm_mfma(F, l, i);
                      for (int i = lo1; i < 128; i += st) scan_rwkv2(F, l, g, i);
                      if (F.G != 256 || F.bid < 128) {
                          if (F.tid == 0) { unsigned sp = 0; while (__hip_atomic_load(hgdone, __ATOMIC_RELAXED, __HIP_MEMORY_SCOPE_AGENT) < 128u) { __builtin_amdgcn_s_sleep(4); if (++sp > (1u << 22)) break; } }
                          __syncthreads();
                          pg8::Gemm gm{(const bf16*)(F.ws + WS_HG), (const bf16*)(F.ws + WS_WIN) + (size_t)NZ * D, D, D, D, 0, 0};
                          pg8::Order<0> S; S.init(MG / 256, 12, gq, gc);
                          pg8::EpiBf16 E{(bf16*)(F.ws + WS_Z) + ZC_GATE, NZ, 0};
                          pg8::gemm_phase(F.lds, gm, S, E, F.tid); } }
                    SEAM(); }
                PHASE(PH_B6) { phase_post(F, l); SEAM(); }
                PHASE(PH_B7) {
                    pg8::Gemm gm{(const bf16*)(F.ws + WS_RAW), (const bf16*)(F.ws + WS_WBR), D, D, D, (size_t)MG * D, (size_t)D * D};
                    pg8::Order<2> S; S.init(MG / 256, 4, F.G, F.bid);
                    pg8::EpiBranch E{(const bf16*)(F.ws + WS_Z) + ZC_GATE, NZ, (float*)(F.ws + WS_QK), (bf16*)(F.ws + WS_XC)};
                    pg8::gemm_phase(F.lds, gm, S, E, F.tid); SEAM(); }
                PHASE(PH_B8) {
                    pg8::Gemm gm{(const bf16*)(F.ws + WS_XC), (const bf16*)(F.ws + WS_WOUT), D, D, D, 0, 0};
                    pg8::Order<0> S; S.init(MG / 256, 4, F.G, F.bid);
                    pg8::EpiResid E{xg, xg, modl + (1 * 3 + 2) * D, 1.0f, g * GB};
                    pg8::gemm_phase(F.lds, gm, S, E, F.tid); SEAM(); }
            }
        }
    }
    PHASE(PH_FIN) phase_final_norm(F);
#undef IN
#undef PHASE
#undef SEAM
}

extern "C" void kernel_launch(void* const* d_in, const int* in_sizes, int n_in, void* d_out, int out_size, void* d_ws, size_t ws_size, hipStream_t stream) {
    static int grid = 0;
    if (grid == 0) {
        if (n_in != 36 || out_size != M * D || ws_size < WS_END) { fprintf(stderr, "kernel_launch: unexpected problem (n_in %d out %d ws %zu, need %zu)\n", n_in, out_size, ws_size, (size_t)WS_END); grid = -1; return; }
        int dev = 0, cus = 0;
        if (hipGetDevice(&dev) != hipSuccess || hipDeviceGetAttribute(&cus, hipDeviceAttributeMultiprocessorCount, dev) != hipSuccess) { grid = -1; return; }
        if (hipFuncSetAttribute((const void*)fwd_kernel, hipFuncAttributeMaxDynamicSharedMemorySize, LDS_BYTES) != hipSuccess) { fprintf(stderr, "kernel_launch: hipFuncSetAttribute failed\n"); grid = -1; return; }
        int per_cu = 0;
        if (hipOccupancyMaxActiveBlocksPerMultiprocessor(&per_cu, (const void*)fwd_kernel, NTHREADS, LDS_BYTES) != hipSuccess || per_cu < 1) { fprintf(stderr, "kernel_launch: occupancy query says %d\n", per_cu); }
        (void)hipGetLastError();
        grid = cus;
    }
    if (grid < 0) return;
    (void)hipMemsetAsync((char*)d_ws + WS_CTL, 0, CTL_BYTES, stream);
    Args a{};
    for (int i = 0; i < 36; ++i) a.in[i] = (const float*)d_in[i];
    a.out = (float*)d_out; a.ws = (unsigned char*)d_ws; a.pad = 0;
#if ONE_LAUNCH
    a.f_lo = 0; a.f_hi = 4; a.g_lo = 0; a.g_hi = NGRP; a.ph_lo = 0; a.ph_hi = PH_N; a.use_bar = 1;
    hipLaunchKernelGGL(fwd_kernel, dim3(grid), dim3(NTHREADS), LDS_BYTES, stream, a);
#else
    a.use_bar = 0;
    for (int f = 0; f < 4; ++f) {
        a.f_lo = f; a.f_hi = f + 1;
        for (int ph = PH_W; ph <= PH_A3; ++ph) {
            if (ph == PH_W && (f & 1)) continue;
            a.ph_lo = ph; a.ph_hi = ph + 1; a.g_lo = 0; a.g_hi = 0;
            hipLaunchKernelGGL(fwd_kernel, dim3(grid), dim3(NTHREADS), LDS_BYTES, stream, a);
        }
        if ((f & 1) == 0)
            for (int g = 0; g < NGRP; ++g)
                for (int ph = PH_B1; ph <= PH_B8; ++ph) { a.ph_lo = ph; a.ph_hi = ph + 1; a.g_lo = g; a.g_hi = g + 1;
                    hipLaunchKernelGGL(fwd_kernel, dim3(grid), dim3(NTHREADS), LDS_BYTES, stream, a); }
    }
    a.f_lo = 0; a.f_hi = 0; a.g_lo = 0; a.g_hi = 0; a.ph_lo = PH_FIN; a.ph_hi = PH_FIN + 1;
    hipLaunchKernelGGL(fwd_kernel, dim3(grid), dim3(NTHREADS), LDS_BYTES, stream, a);
#endif
}
```

```cpp
#include <hip/hip_runtime.h>
#include <cstdio>
#include <cstdint>

#ifndef ONE_LAUNCH
#define ONE_LAUNCH 1
#endif

#define GAS __attribute__((address_space(1)))
#define LAS __attribute__((address_space(3)))
typedef unsigned short bf16;
typedef unsigned v4u __attribute__((ext_vector_type(4)));
typedef unsigned v2u __attribute__((ext_vector_type(2)));
typedef float f32x4 __attribute__((ext_vector_type(4)));
typedef float f32x2 __attribute__((ext_vector_type(2)));
typedef short bf16x8 __attribute__((ext_vector_type(8)));
#define DI __device__ __forceinline__

constexpr int D = 1024, NB = 16, T = 2048, M = NB * T, DFF = 2816, NUP = 2 * DFF;
constexpr int GB = 4, MG = GB * T, NGRP = NB / GB;
constexpr int NZ = 9472;
constexpr int ZC_MLX = 0, ZC_MLO = 1024, ZC_RW = 2048, ZC_HGQ = 5376, ZC_HGF = 6400, ZC_HGI = 7424, ZC_HGG = 8448;
constexpr int ZC_GATE = 5376;
constexpr int NWIN = 12544;
constexpr int WIN_SRC = 12552;
constexpr int NSIDE = 40, KLORA = 384, NLORA = 4096, NMOD = 9216;
constexpr int NTHREADS = 512, NWAVES = 8;

constexpr size_t MiB = 1u << 20;
constexpr size_t WS_CTL = 0, CTL_BYTES = 1 * MiB;
constexpr size_t WS_MOD = 1 * MiB;
constexpr size_t WS_WSIDE = 3 * MiB;
constexpr size_t WS_WUP = 4 * MiB;
constexpr size_t WS_WDN = 26 * MiB;
constexpr size_t WS_WIN = 37 * MiB;
constexpr size_t WS_WBR = 62 * MiB;
constexpr size_t WS_WOUT = 68 * MiB;
constexpr size_t WS_WQK = 70 * MiB;
constexpr size_t WS_WLORA = 71 * MiB;
constexpr size_t WS_VF = 74 * MiB;
constexpr size_t WS_ACT = 138 * MiB;
constexpr size_t WS_H = WS_ACT;
constexpr size_t WS_HID = WS_ACT + 64 * MiB;
constexpr size_t WS_HG = WS_ACT;
constexpr size_t WS_Z = WS_ACT + 16 * MiB;
constexpr size_t WS_XC = WS_ACT + 164 * MiB;
constexpr size_t WS_QK = WS_ACT + 180 * MiB;
constexpr size_t WS_LA = WS_ACT + 212 * MiB;
constexpr size_t WS_LO = WS_ACT + 218 * MiB;
constexpr size_t WS_SIDE = WS_ACT + 282 * MiB;
constexpr size_t WS_RAW = WS_ACT + 284 * MiB;
constexpr size_t WS_BON = WS_ACT + 332 * MiB;
constexpr size_t WS_END = WS_ACT + 348 * MiB;
static_assert(WS_HID + (size_t)M * DFF * 2 <= WS_END, "ffn view fits");
static_assert(WS_Z + (size_t)MG * NZ * 2 <= WS_XC, "z fits");

constexpr int CW_BAR = 4096, CW_HGDONE = 16384;

constexpr int LDS_BYTES = 147456;
constexpr int MISC_OFF = 131072 + 320;

DI unsigned f2bf(float f) { unsigned u = __builtin_bit_cast(unsigned, f); return (u + 0x7fffu + ((u >> 16) & 1u)) >> 16; }
DI unsigned pk2(float lo, float hi) { unsigned r; asm("v_cvt_pk_bf16_f32 %0, %1, %2" : "=v"(r) : "v"(lo), "v"(hi)); return r; }
DI float bflo(unsigned w) { return __builtin_bit_cast(float, w << 16); }
DI float bfhi(unsigned w) { return __builtin_bit_cast(float, w & 0xffff0000u); }
DI float bf1(bf16 h) { return __builtin_bit_cast(float, (unsigned)h << 16); }
DI float sigmoidf_(float x) { return __builtin_amdgcn_rcpf(1.0f + __expf(-x)); }
DI float siluf_(float x) { return x * __builtin_amdgcn_rcpf(1.0f + __expf(-x)); }
DI float softplusf_(float x) { return fmaxf(x, 0.f) + __logf(1.0f + __expf(-fabsf(x))); }
template <int CTRL> DI float dppf(float v) { return __builtin_bit_cast(float, __builtin_amdgcn_update_dpp(0, __builtin_bit_cast(int, v), CTRL, 0xF, 0xF, true)); }
DI float sum4(float v) { v += dppf<0xB1>(v); v += dppf<0x4E>(v); return v; }
DI float sum8(float v) { v = sum4(v); v += dppf<0x141>(v); return v; }
DI float sum16(float v) { v = sum8(v); v += dppf<0x140>(v); return v; }
DI float wave_sum(float v) {
    v = sum16(v);
    const float a = __builtin_bit_cast(float, __builtin_amdgcn_readlane(__builtin_bit_cast(int, v), 0)), b = __builtin_bit_cast(float, __builtin_amdgcn_readlane(__builtin_bit_cast(int, v), 16));
    const float c = __builtin_bit_cast(float, __builtin_amdgcn_readlane(__builtin_bit_cast(int, v), 32)), d = __builtin_bit_cast(float, __builtin_amdgcn_readlane(__builtin_bit_cast(int, v), 48));
    return (a + b) + (c + d);
}
#define LDS_WAIT() asm volatile("s_waitcnt lgkmcnt(0)" ::: "memory")
#define VM_WAIT() asm volatile("s_waitcnt vmcnt(0)" ::: "memory")
DI void unpack8(const v4u w, float (&o)[8]) { o[0] = bflo(w.x); o[1] = bfhi(w.x); o[2] = bflo(w.y); o[3] = bfhi(w.y); o[4] = bflo(w.z); o[5] = bfhi(w.z); o[6] = bflo(w.w); o[7] = bfhi(w.w); }
DI void unpack16(const bf16* p, float (&o)[16]) { const v4u a = *(const v4u*)p, b = *(const v4u*)(p + 8);
    o[0] = bflo(a.x); o[1] = bfhi(a.x); o[2] = bflo(a.y); o[3] = bfhi(a.y); o[4] = bflo(a.z); o[5] = bfhi(a.z); o[6] = bflo(a.w); o[7] = bfhi(a.w);
    o[8] = bflo(b.x); o[9] = bfhi(b.x); o[10] = bflo(b.y); o[11] = bfhi(b.y); o[12] = bflo(b.z); o[13] = bfhi(b.z); o[14] = bflo(b.w); o[15] = bfhi(b.w); }
DI void pack16(bf16* p, const float (&o)[16]) { v4u a, b; a.x = pk2(o[0], o[1]); a.y = pk2(o[2], o[3]); a.z = pk2(o[4], o[5]); a.w = pk2(o[6], o[7]);
    b.x = pk2(o[8], o[9]); b.y = pk2(o[10], o[11]); b.z = pk2(o[12], o[13]); b.w = pk2(o[14], o[15]); *(v4u*)p = a; *(v4u*)(p + 8) = b; }
DI v4u pack8(const float (&o)[8]) { v4u w; w.x = pk2(o[0], o[1]); w.y = pk2(o[2], o[3]); w.z = pk2(o[4], o[5]); w.w = pk2(o[6], o[7]); return w; }

#define XB_TMO      128
#define XB_XCNT(j)  (256  + 64 * (j))
#define XB_XSUB(j)  (1280 + 64 * (j))
#define XB_XGEN(j)  (2304 + 64 * (j))
#define XB_TOP      3328
#define XB_TOPGEN   3392
#define XCD_BAR_WORDS 3456
#define XB_SPIN_CAP (1u << 22)
__device__ __forceinline__ unsigned xb_ld(unsigned* p)              { return __hip_atomic_load(p, __ATOMIC_RELAXED, __HIP_MEMORY_SCOPE_AGENT); }
__device__ __forceinline__ unsigned xb_add(unsigned* p, unsigned v) { return __hip_atomic_fetch_add(p, v, __ATOMIC_RELAXED, __HIP_MEMORY_SCOPE_AGENT); }
__device__ __forceinline__ unsigned xb_xcc_id() { return (unsigned)__builtin_amdgcn_s_getreg((3 << 11) | 20) & 0xFu; }
#define XB_SPIN(cond, bar) do { unsigned _sp = 0; while (cond) { __builtin_amdgcn_s_sleep(1); \
    if ((++_sp & 255u) == 0u) { if (xb_ld(&(bar)[XB_TMO])) break; if (_sp > XB_SPIN_CAP) { atomicAdd(&(bar)[XB_TMO], 1u); break; } } } } while (0)
struct XcdBarrier { unsigned* bar; unsigned x; volatile LAS unsigned* st; };
__device__ __forceinline__ XcdBarrier xcd_barrier_post(unsigned* bar, volatile LAS unsigned* st) {
    XcdBarrier b; b.bar = bar; b.x = xb_xcc_id(); b.st = st;
    if (threadIdx.x == 0) (void)xb_add(&bar[XB_XCNT(b.x)], 1u);
    return b;
}
__device__ __forceinline__ void xcd_barrier_complete(unsigned* bar, unsigned x, unsigned& nloc, unsigned& nx) {
    const unsigned G = gridDim.x * gridDim.y * gridDim.z;
    unsigned sum, cnt, mine, sp = 0u;
    for (;;) {
        sum = 0u; cnt = 0u; mine = 0u;
#pragma unroll
        for (unsigned j = 0; j < 16; ++j) { const unsigned c = xb_ld(&bar[XB_XCNT(j)]); sum += c; cnt += (c > 0u) ? 1u : 0u; mine = (j == x) ? c : mine; }
        if (sum == G) break;
        __builtin_amdgcn_s_sleep(1);
        if ((++sp & 255u) == 0u) { if (xb_ld(&bar[XB_TMO])) break; if (sp > XB_SPIN_CAP) { atomicAdd(&bar[XB_TMO], 1u); break; } }
    }
    nloc = mine > 0u ? mine : 1u; nx = cnt > 0u ? cnt : 1u;
}
__device__ __forceinline__ void xcd_barrier(const XcdBarrier& b) {
    asm volatile("s_waitcnt vmcnt(0)" ::: "memory");
    __syncthreads();
    if (threadIdx.x == 0) {
        unsigned* bar = b.bar;
        __builtin_amdgcn_s_waitcnt(0);
        unsigned nloc = b.st[0], nx = b.st[1];
        if (nloc == 0u) { xcd_barrier_complete(bar, b.x, nloc, nx); b.st[0] = nloc; b.st[1] = nx; }
        const unsigned old = xb_add(&bar[XB_XSUB(b.x)], 1u);
        const unsigned gen = old / nloc;
        if (old + 1u == (gen + 1u) * nloc) {
            __builtin_amdgcn_fence(__ATOMIC_RELEASE, "agent");
            asm volatile("s_waitcnt vmcnt(0)" ::: "memory");
            const unsigned og = xb_add(&bar[XB_TOP], 1u);
            const unsigned tg = og / nx;
            if (og + 1u == (tg + 1u) * nx) xb_add(&bar[XB_TOPGEN], 1u);
            else XB_SPIN(xb_ld(&bar[XB_TOPGEN]) == tg, bar);
            __builtin_amdgcn_fence(__ATOMIC_ACQUIRE, "agent");
            xb_add(&bar[XB_XGEN(b.x)], 1u);
            asm volatile("s_waitcnt vmcnt(0)" ::: "memory");
        } else {
            XB_SPIN(xb_ld(&bar[XB_XGEN(b.x)]) == gen, bar);
            __builtin_amdgcn_fence(__ATOMIC_ACQUIRE, "agent");
            asm volatile("s_waitcnt vmcnt(0)" ::: "memory");
        }
    }
    __syncthreads();
}

namespace pg8 {
constexpr int BM = 256, BK = 64, HALF = 128, HTB = HALF * BK * 2, STAGE_BYTES = 8 * HTB, NXCD = 8, WGM = 8;
DI int lds_byte(int r, int c) { const int st = (r >> 4) * 2 + (c >> 5), rr = r & 15, cc = c & 31, ob = rr * 64 + cc * 2; return st * 1024 + (ob ^ (((ob >> 9) & 1) << 5)); }
DI void stage_rc(int b, int& R, int& C) { const int st = b / 1024, sb = b % 1024, swz = sb ^ (((sb >> 9) & 1) << 5); R = (st >> 1) * 16 + swz / 64; C = (st & 1) * 32 + (swz % 64) / 2; }
DI int perm32(int rho) { const int n = rho >> 4, i = rho & 15; return 8 * (i >> 2) + 4 * n + (i & 3); }

struct Unit { int pm, pn, pz; };
struct Gemm { const bf16* A; const bf16* Bt; int K, lda, ldb; size_t a_z, b_z; };

template <int MODE> struct Order {
    int nM, nN, nwg, G, c, L0 = 0, imax = 1 << 30;
    DI void init(int nM_, int nN_, int G_, int c_) { nM = nM_; nN = nN_; nwg = nM * nN; G = G_; c = c_; }
    DI bool next(int i, Unit& u) const {
        const int ii = (MODE == 2) ? i / 3 : i;
        const long L = (long)L0 + (long)ii * G + c; if (ii >= imax || L >= nwg) return false;
        int wgid = (int)L; { const int q = nwg / NXCD, r = nwg % NXCD, xcd = wgid % NXCD, off = wgid / NXCD; wgid = (xcd < r ? xcd * (q + 1) : r * (q + 1) + (xcd - r) * q) + off; }
        const int nig = WGM * nN, gid = wgid / nig, fm = gid * WGM, gsz = (nM - fm) < WGM ? (nM - fm) : WGM;
        u.pm = fm + ((wgid % nig) % gsz); const int pn = (wgid % nig) / gsz;
        if (MODE == 1) { u.pz = pn >> 1; u.pn = pn & 1; } else if (MODE == 2) { u.pz = i - ii * 3; u.pn = pn; } else { u.pz = 0; u.pn = pn; }
        return true;
    }
};

struct EpiBf16 {
    static constexpr bool PERM = true;
    bf16* O; int ldc; int zcols;
    DI void operator()(const f32x4 (&acc)[2][2][4][2], const Unit& u, int wr, int wc, int fr, int fq) const {
        const int row0 = u.pm * BM + wr * 64 + fr; const int col0 = u.pz * zcols + u.pn * BM + wc * 32 + 8 * fq;
#pragma unroll
        for (int ai = 0; ai < 2; ++ai)
#pragma unroll
            for (int m = 0; m < 4; ++m) { bf16* rowp = O + (size_t)(row0 + ai * HALF + m * 16) * ldc + col0;
#pragma unroll
                for (int bj = 0; bj < 2; ++bj) { const f32x4 v0 = acc[ai][bj][m][0], v1 = acc[ai][bj][m][1];
                    v4u w; w.x = pk2(v0[0], v0[1]); w.y = pk2(v0[2], v0[3]); w.z = pk2(v1[0], v1[1]); w.w = pk2(v1[2], v1[3]);
                    *(v4u*)(rowp + bj * HALF) = w; } }
    }
};
struct EpiZ {
    static constexpr bool PERM = true;
    bf16* O; int ldc; const float* lbl;
    DI void operator()(const f32x4 (&acc)[2][2][4][2], const Unit& u, int wr, int wc, int fr, int fq) const {
        const int row0 = u.pm * BM + wr * 64 + fr; const int col0 = u.pn * BM + wc * 32 + 8 * fq;
        const int kind = (u.pn >= ZC_HGQ / 256 && u.pn < ZC_HGF / 256) ? 1 : ((u.pn >= ZC_HGF / 256 && u.pn < ZC_HGI / 256) ? 2 : 0);
        float lb[2][8];
#pragma unroll
        for (int bj = 0; bj < 2; ++bj)
#pragma unroll
            for (int j = 0; j < 8; ++j) lb[bj][j] = 0.f;
        if (kind == 2 && lbl) {
#pragma unroll
            for (int bj = 0; bj < 2; ++bj) { const float* p0 = lbl + (col0 + bj * HALF - ZC_HGF);
#pragma unroll
                for (int j = 0; j < 8; ++j) lb[bj][j] = sigmoidf_(p0[D + j] - p0[j]); } }
#pragma unroll
        for (int ai = 0; ai < 2; ++ai)
#pragma unroll
            for (int m = 0; m < 4; ++m) { bf16* rowp = O + (size_t)(row0 + ai * HALF + m * 16) * ldc + col0;
#pragma unroll
                for (int bj = 0; bj < 2; ++bj) { float o[8];
#pragma unroll
                    for (int j = 0; j < 8; ++j) { const float x = acc[ai][bj][m][j >> 2][j & 3];
                        o[j] = kind == 0 ? x : (kind == 1 ? siluf_(x) : __logf(fmaxf(lb[bj][j] + (1.0f - lb[bj][j]) * sigmoidf_(x), 1e-30f))); }
                    *(v4u*)(rowp + bj * HALF) = pack8(o); } }
    }
};
struct EpiLora {
    static constexpr bool PERM = true;
    bf16* O; int ldc; const float* w0; const float* a0; const float* v0;
    DI void operator()(const f32x4 (&acc)[2][2][4][2], const Unit& u, int wr, int wc, int fr, int fq) const {
        const int row0 = u.pm * BM + wr * 64 + fr; const int col0 = u.pn * BM + wc * 32 + 8 * fq;
        const int kind = u.pn >> 2;
        const int cc = col0 & 1023;
#pragma unroll
        for (int bj = 0; bj < 2; ++bj) {
            f32x4 c0 = (f32x4){0.f, 0.f, 0.f, 0.f}, c1 = c0;
            if (kind == 0) { c0 = *(const f32x4*)(w0 + cc + bj * HALF); c1 = *(const f32x4*)(w0 + cc + bj * HALF + 4); }
            if (kind == 1) { c0 = *(const f32x4*)(a0 + cc + bj * HALF); c1 = *(const f32x4*)(a0 + cc + bj * HALF + 4); }
            if (kind == 3) { c0 = *(const f32x4*)(v0 + cc + bj * HALF); c1 = *(const f32x4*)(v0 + cc + bj * HALF + 4); }
#pragma unroll
            for (int ai = 0; ai < 2; ++ai)
#pragma unroll
                for (int m = 0; m < 4; ++m) { bf16* rowp = O + (size_t)(row0 + ai * HALF + m * 16) * ldc + col0 + bj * HALF; float o[8];
#pragma unroll
                    for (int j = 0; j < 8; ++j) { const float x = acc[ai][bj][m][j >> 2][j & 3] + (j < 4 ? c0[j & 3] : c1[j & 3]);
                        o[j] = kind == 2 ? x : (kind == 0 ? -__expf(-softplusf_(-x) - 0.5f) : sigmoidf_(x)); }
                    *(v4u*)rowp = pack8(o); }
        }
    }
};
struct EpiSwiGLU {
    static constexpr bool PERM = true;
    bf16* O; int ldc;
    DI void operator()(const f32x4 (&acc)[2][2][4][2], const Unit& u, int wr, int wc, int fr, int fq) const {
        const int row0 = u.pm * BM + wr * 64 + fr; const int col0 = u.pn * HALF + wc * 32 + 8 * fq;
#pragma unroll
        for (int ai = 0; ai < 2; ++ai)
#pragma unroll
            for (int m = 0; m < 4; ++m) { bf16* rowp = O + (size_t)(row0 + ai * HALF + m * 16) * ldc + col0;
                float o[8];
#pragma unroll
                for (int n = 0; n < 2; ++n)
#pragma unroll
                    for (int j = 0; j < 4; ++j) { const float a = acc[ai][0][m][n][j], b = acc[ai][1][m][n][j]; o[n * 4 + j] = a * b * __builtin_amdgcn_rcpf(1.0f + __expf(-a)); }
                *(v4u*)rowp = pack8(o); }
    }
};
struct EpiResid {
    static constexpr bool PERM = false;
    const float* xin; float* xout; const float* gate; float mul; int b0;
    DI void operator()(const f32x4 (&acc)[2][2][4][2], const Unit& u, int wr, int wc, int fr, int fq) const {
        const int row0 = u.pm * BM + wr * 64 + fr, col0 = u.pn * BM + wc * 32 + 4 * fq;
        const float* gp = gate + (size_t)(b0 + (u.pm * BM) / T) * NMOD + col0;
        f32x4 cf[2][2];
#pragma unroll
        for (int bj = 0; bj < 2; ++bj)
#pragma unroll
            for (int n = 0; n < 2; ++n) cf[bj][n] = (*(const f32x4*)(gp + bj * HALF + n * 16) + 1.0f) * mul;
#pragma unroll
        for (int ai = 0; ai < 2; ++ai)
#pragma unroll
            for (int m = 0; m < 4; ++m) { const size_t off = (size_t)(row0 + ai * HALF + m * 16) * D + col0;
#pragma unroll
                for (int bj = 0; bj < 2; ++bj)
#pragma unroll
                    for (int n = 0; n < 2; ++n) { const f32x4 xi = *(const f32x4*)(xin + off + bj * HALF + n * 16);
                        *(f32x4*)(xout + off + bj * HALF + n * 16) = xi + cf[bj][n] * acc[ai][bj][m][n]; }
                asm volatile("" ::: "memory"); }
    }
};
struct EpiBranch {
    static constexpr bool PERM = false;
    const bf16* gates; int ldg; float* mixf; bf16* mixb;
    DI void operator()(const f32x4 (&acc)[2][2][4][2], const Unit& u, int wr, int wc, int fr, int fq) const {
        const int row0 = u.pm * BM + wr * 64 + fr, col0 = u.pn * BM + wc * 32 + 4 * fq;
#pragma unroll
        for (int ai = 0; ai < 2; ++ai)
#pragma unroll
            for (int m = 0; m < 4; ++m) { const int row = row0 + ai * HALF + m * 16; const size_t off = (size_t)row * D + col0; const bf16* gp = gates + (size_t)row * ldg + u.pz * D + col0;
#pragma unroll
                for (int bj = 0; bj < 2; ++bj)
#pragma unroll
                    for (int n = 0; n < 2; ++n) { const v2u gw = *(const v2u*)(gp + bj * HALF + n * 16);
                        f32x4 g; g[0] = sigmoidf_(bflo(gw.x)); g[1] = sigmoidf_(bfhi(gw.x)); g[2] = sigmoidf_(bflo(gw.y)); g[3] = sigmoidf_(bfhi(gw.y));
                        f32x4 v = g * acc[ai][bj][m][n];
                        if (u.pz > 0) v += *(const f32x4*)(mixf + off + bj * HALF + n * 16);
                        if (u.pz < 2) *(f32x4*)(mixf + off + bj * HALF + n * 16) = v;
                        else { v2u w; w.x = pk2(v[0], v[1]); w.y = pk2(v[2], v[3]); *(v2u*)(mixb + off + bj * HALF + n * 16) = w; } }
                asm volatile("" ::: "memory"); }
    }
};

template <class Epi, class Sched>
DI void gemm_phase(LAS unsigned char* lds, const Gemm g, const Sched& S, const Epi& E, int tid_) {
    asm volatile("" : "+v"(tid_));
    const int tid = tid_, wid = __builtin_amdgcn_readfirstlane(tid >> 6), lane = tid & 63, wr = wid >> 2, wc = wid & 3, fr = lane & 15, fq = lane >> 4;
    int K_ = g.K; asm volatile("" : "+s"(K_));
    const int K = K_, nt = K / BK;
    unsigned voffA[2], voffB[2];
#pragma unroll
    for (int i = 0; i < 2; ++i) { int R, C; stage_rc(tid * 16 + i * 8192, R, C); const int Rb = Epi::PERM ? ((R & ~31) + perm32(R & 31)) : R;
        voffA[i] = (unsigned)(R * g.lda + C) * 2u; voffB[i] = (unsigned)(Rb * g.ldb + C) * 2u; }
    const size_t kstep = (size_t)(BK * 2);
    const size_t hstepA = (size_t)HALF * g.lda * 2, hstepB = (size_t)HALF * g.ldb * 2;
    const size_t tstepA = 2 * hstepA, tstepB = 2 * hstepB;
    const unsigned ldsw = (unsigned)wid * 1024u;
    const int aoff = lds_byte(wr * 64 + fr, fq * 8), boff = lds_byte(wc * 32 + fr, fq * 8);
#define PG8_SA(b, h) (((b) * 2 + (h)) * HTB)
#define PG8_SB(b, h) ((4 + (b) * 2 + (h)) * HTB)
#define PG8_STAGE(bufoff, gbase, voff) do { _Pragma("unroll") for (int _i = 0; _i < 2; ++_i) \
        __builtin_amdgcn_global_load_lds((const unsigned*)((const char*)(gbase) + (voff)[_i]), (LAS unsigned*)(lds + (bufoff) + ldsw + _i * 8192), 16, 0, 0); } while (0)
#define PG8_LDA(dst, b, h) do { _Pragma("unroll") for (int m = 0; m < 4; ++m) _Pragma("unroll") for (int k = 0; k < 2; ++k) dst[m][k] = *(const LAS bf16x8*)(lds + PG8_SA(b, h) + aoff + m * 2048 + k * 1024); } while (0)
#define PG8_LDB(dst, b, h) do { _Pragma("unroll") for (int n = 0; n < 2; ++n) _Pragma("unroll") for (int k = 0; k < 2; ++k) dst[n][k] = *(const LAS bf16x8*)(lds + PG8_SB(b, h) + boff + n * 2048 + k * 1024); } while (0)
#define PG8_MMA(ai, bj, At, Bt) do { __builtin_amdgcn_s_setprio(1); _Pragma("unroll") for (int m = 0; m < 4; ++m) _Pragma("unroll") for (int n = 0; n < 2; ++n) _Pragma("unroll") for (int k = 0; k < 2; ++k) \
        acc[ai][bj][m][n] = __builtin_amdgcn_mfma_f32_16x16x32_bf16(Bt[n][k], At[m][k], acc[ai][bj][m][n], 0, 0, 0); __builtin_amdgcn_s_setprio(0); } while (0)
#define PG8_WAIT_V(n) asm volatile("s_waitcnt vmcnt(" #n ")" ::: "memory")
#define PG8_WAIT_L(n) asm volatile("s_waitcnt lgkmcnt(" #n ")" ::: "memory")
#define PG8_BAR __builtin_amdgcn_s_barrier()
#define PG8_SCHED __builtin_amdgcn_sched_barrier(0)
    Unit cur, nxt; int ui = 0;
    if (!S.next(0, cur)) return;
    f32x4 acc[2][2][4][2];
#pragma unroll
    for (int a = 0; a < 2; ++a)
#pragma unroll
        for (int b = 0; b < 2; ++b)
#pragma unroll
            for (int m = 0; m < 4; ++m)
#pragma unroll
                for (int n = 0; n < 2; ++n) acc[a][b][m][n] = (f32x4){0.f, 0.f, 0.f, 0.f};
    bf16x8 At[4][2], B0[2][2], B1[2][2];
    const char* cA = (const char*)(g.A + (size_t)cur.pz * g.a_z) + (size_t)cur.pm * tstepA; const char* cB = (const char*)(g.Bt + (size_t)cur.pz * g.b_z) + (size_t)cur.pn * tstepB;
    PG8_STAGE(PG8_SB(0, 0), cB, voffB); PG8_STAGE(PG8_SB(0, 1), cB + hstepB, voffB); PG8_STAGE(PG8_SA(0, 0), cA, voffA); PG8_STAGE(PG8_SA(0, 1), cA + hstepA, voffA);
    if (wr == 1) PG8_BAR;
    PG8_WAIT_V(2); PG8_BAR;
    PG8_STAGE(PG8_SB(1, 0), cB + kstep, voffB); PG8_STAGE(PG8_SA(1, 0), cA + kstep, voffA); PG8_STAGE(PG8_SB(1, 1), cB + hstepB + kstep, voffB);
    PG8_WAIT_V(6); PG8_BAR;
    for (;;) {
        const bool has_next = S.next(ui + 1, nxt);
        const char* nA = has_next ? (const char*)(g.A + (size_t)nxt.pz * g.a_z) + (size_t)nxt.pm * tstepA : cA; const char* nB = has_next ? (const char*)(g.Bt + (size_t)nxt.pz * g.b_z) + (size_t)nxt.pn * tstepB : cB;
        for (int t = 0; t < nt; t += 2) {
            const bool last = (t == nt - 2);
            const char* a1 = cA + (size_t)(t + 1) * kstep;
            const char* a2 = last ? nA : cA + (size_t)(t + 2) * kstep; const char* b2 = last ? nB : cB + (size_t)(t + 2) * kstep;
            const char* a3 = a2 + kstep; const char* b3 = b2 + kstep;
            PG8_LDB(B0, 0, 0); PG8_LDB(B1, 0, 1); PG8_SCHED; PG8_LDA(At, 0, 0); PG8_STAGE(PG8_SA(1, 1), a1 + hstepA, voffA);
            PG8_WAIT_V(8); PG8_WAIT_L(0); PG8_BAR; PG8_MMA(0, 0, At, B0); PG8_MMA(0, 1, At, B1); PG8_BAR; PG8_SCHED;
            PG8_LDA(At, 0, 1); PG8_STAGE(PG8_SB(0, 0), b2, voffB); PG8_STAGE(PG8_SB(0, 1), b2 + hstepB, voffB); PG8_STAGE(PG8_SA(0, 0), a2, voffA);
            PG8_WAIT_V(8); PG8_WAIT_L(0); PG8_BAR; PG8_MMA(1, 0, At, B0); PG8_MMA(1, 1, At, B1); PG8_BAR; PG8_SCHED;
            PG8_LDB(B0, 1, 0); PG8_LDB(B1, 1, 1); PG8_SCHED; PG8_LDA(At, 1, 0); PG8_STAGE(PG8_SA(0, 1), a2 + hstepA, voffA);
            PG8_WAIT_V(8); PG8_WAIT_L(0); PG8_BAR; PG8_MMA(0, 0, At, B0); PG8_MMA(0, 1, At, B1); PG8_BAR; PG8_SCHED;
            PG8_LDA(At, 1, 1); PG8_STAGE(PG8_SB(1, 0), b3, voffB); PG8_STAGE(PG8_SB(1, 1), b3 + hstepB, voffB); PG8_STAGE(PG8_SA(1, 0), a3, voffA);
            PG8_WAIT_V(8); PG8_WAIT_L(0); PG8_BAR; PG8_MMA(1, 0, At, B0); PG8_MMA(1, 1, At, B1); PG8_BAR; PG8_SCHED;
        }
        if (wr == 0) PG8_BAR;
        E(acc, cur, wr, wc, fr, fq);
        if (!has_next) break;
#pragma unroll
        for (int a = 0; a < 2; ++a)
#pragma unroll
            for (int b = 0; b < 2; ++b)
#pragma unroll
                for (int m = 0; m < 4; ++m)
#pragma unroll
                    for (int n = 0; n < 2; ++n) acc[a][b][m][n] = (f32x4){0.f, 0.f, 0.f, 0.f};
        cur = nxt; cA = nA; cB = nB; ++ui;
        if (wr == 1) PG8_BAR;
    }
    PG8_WAIT_V(0);
    PG8_BAR;
#undef PG8_SA
#undef PG8_SB
#undef PG8_STAGE
#undef PG8_LDA
#undef PG8_LDB
#undef PG8_MMA
#undef PG8_WAIT_V
#undef PG8_WAIT_L
#undef PG8_BAR
#undef PG8_SCHED
}
}

struct Args {
    const float* in[36]; float* out; unsigned char* ws;
    int f_lo, f_hi, g_lo, g_hi, ph_lo, ph_hi, use_bar, pad;
};
struct Ctx {
    LAS unsigned char* lds;
    const float* const* in; float* out; unsigned char* ws;
    int tid, lane, wave, bid, G, z;
};
DI void refresh(Ctx& F) {
    { int z_ = 0; asm volatile("" : "+s"(z_)); F.z = z_; }
    asm volatile("" : "+v"(F.tid)); F.lane = F.tid & 63; F.wave = __builtin_amdgcn_readfirstlane(F.tid >> 6);
}
enum { I_X = 0, I_C, I_NORMW, I_FNORMW, I_ADAW, I_ADAB, I_FUP, I_FDN, I_WIN, I_WINV, I_CONVW, I_CONVB, I_WQ, I_WK, I_IB, I_FB, I_MLNW, I_MLSKIP,
       I_MU, I_MUV, I_W0, I_W2, I_A0, I_A2, I_V0, I_V2, I_G2, I_KK, I_KA, I_RK, I_LNW, I_LNB, I_LBL, I_HGNW, I_WBR, I_WOUT };

DI void transpose_item(const float* W, int ldw, int k0, int c0, bf16* WT, int ldt, int r0, float scale, LAS float* scr, int lane) {
#pragma unroll 8
    for (int i = 0; i < 32; ++i) { const int kk = 2 * i + (lane >> 5); scr[kk * 33 + (lane & 31)] = W[(size_t)(k0 + kk) * ldw + c0 + (lane & 31)]; }
    LDS_WAIT(); asm volatile("" ::: "memory");
    const int c = lane & 7;
#pragma unroll
    for (int j = 0; j < 4; ++j) { const int n = (lane >> 3) + 8 * j; const LAS float* s = scr + (8 * c) * 33 + n;
        v4u o; o.x = pk2(s[0 * 33] * scale, s[1 * 33] * scale); o.y = pk2(s[2 * 33] * scale, s[3 * 33] * scale); o.z = pk2(s[4 * 33] * scale, s[5 * 33] * scale); o.w = pk2(s[6 * 33] * scale, s[7 * 33] * scale);
        *(v4u*)(WT + (size_t)(r0 + n) * ldt + k0 + 8 * c) = o; }
    LDS_WAIT(); asm volatile("" ::: "memory");
}
DI void phase_weights(const Ctx& F, int l) {
    LAS float* scr = (LAS float*)(F.lds + F.wave * 16384);
    const int gw = F.bid * NWAVES + F.wave, NGW = F.G * NWAVES;
    constexpr int I_UP = 16 * 176, I_DN = 44 * 32, I_IN = 16 * 392, I_SQ = 16 * 32, I_QKI = 8 * 32;
    constexpr int NITEMS = 2 * I_UP + 2 * I_DN + I_IN + 4 * I_SQ + I_QKI;
    bf16* WUP = (bf16*)(F.ws + WS_WUP); bf16* WDN = (bf16*)(F.ws + WS_WDN); bf16* WIN = (bf16*)(F.ws + WS_WIN); bf16* WBR = (bf16*)(F.ws + WS_WBR);
    bf16* WOUT = (bf16*)(F.ws + WS_WOUT); bf16* WQK = (bf16*)(F.ws + WS_WQK);
    for (int it = gw; it < NITEMS; it += NGW) {
        int r = it;
        if (r < 2 * I_UP) { const int i = r / I_UP; r -= i * I_UP; const int kb = r / 176, nb = r % 176, c0 = 32 * nb; const int cc = c0 < DFF ? c0 : c0 - DFF;
            const int r0 = (cc / 128) * 256 + (c0 < DFF ? 0 : 128) + (cc % 128);
            transpose_item(F.in[F.z + I_FUP] + (size_t)(l * 2 + i) * D * NUP, NUP, 64 * kb, c0, WUP + (size_t)i * NUP * D, D, r0, 1.f, scr, F.lane); continue; }
        r -= 2 * I_UP;
        if (r < 2 * I_DN) { const int i = r / I_DN; r -= i * I_DN; const int kb = r / 32, nb = r % 32;
            transpose_item(F.in[F.z + I_FDN] + (size_t)(l * 2 + i) * DFF * D, D, 64 * kb, 32 * nb, WDN + (size_t)i * D * DFF, DFF, 32 * nb, 1.f, scr, F.lane); continue; }
        r -= 2 * I_DN;
        if (r < I_IN) { const int kb = r / 392, nb = r % 392, d0 = 32 * nb, c0 = d0 + (d0 >= 2048 ? 8 : 0);
            transpose_item(F.in[F.z + I_WIN] + (size_t)l * D * WIN_SRC, WIN_SRC, 64 * kb, c0, WIN, D, d0, 1.f, scr, F.lane); continue; }
        r -= I_IN;
        if (r < 3 * I_SQ) { const int n = r / I_SQ; r -= n * I_SQ; const int kb = r / 32, nb = r % 32;
            transpose_item(F.in[F.z + I_WBR] + (size_t)(l * 3 + n) * D * D, D, 64 * kb, 32 * nb, WBR + (size_t)n * D * D, D, 32 * nb, 1.f, scr, F.lane); continue; }
        r -= 3 * I_SQ;
        if (r < I_SQ) { const int kb = r / 32, nb = r % 32;
            transpose_item(F.in[F.z + I_WOUT] + (size_t)l * D * D, D, 64 * kb, 32 * nb, WOUT, D, 32 * nb, 1.f, scr, F.lane); continue; }
        r -= I_SQ;
        { const int mat = r / 32, rr = r % 32, h = mat >> 1, isk = mat & 1, kb = rr / 8, nb = rr % 8;
            transpose_item(F.in[F.z + isk ? I_WK : I_WQ] + (size_t)(l * 4 + h) * 256 * 256, 256, 64 * kb, 32 * nb, WQK + (size_t)(h * 512 + isk * 256) * 256, 256, 32 * nb, isk ? 0.0625f : 1.f, scr, F.lane); }
    }
    const int gt = F.bid * NTHREADS + F.tid, NT = F.G * NTHREADS;
    bf16* WL = (bf16*)(F.ws + WS_WLORA);
    for (int idx = gt; idx < NLORA * (KLORA / 8); idx += NT) {
        const int n = idx & (NLORA - 1), kc = idx >> 12, k0 = kc * 8, blk = n >> 10, nn = n & 1023;
        float o[8];
#pragma unroll
        for (int i = 0; i < 8; ++i) o[i] = 0.f;
        const float* src = nullptr; int kk = 0;
        if (blk == 0 && k0 < 64) { src = F.in[F.z + I_W2] + (size_t)l * 64 * D; kk = k0; }
        else if (blk == 1 && k0 >= 64 && k0 < 128) { src = F.in[F.z + I_A2] + (size_t)l * 64 * D; kk = k0 - 64; }
        else if (blk == 2 && k0 >= 128 && k0 < 256) { src = F.in[F.z + I_G2] + (size_t)l * 128 * D; kk = k0 - 128; }
        else if (blk == 3 && l == 1 && k0 >= 256 && k0 < 288) { src = F.in[F.z + I_V2]; kk = k0 - 256; }
        if (src) {
#pragma unroll
            for (int i = 0; i < 8; ++i) o[i] = src[(size_t)(kk + i) * D + nn]; }
        *(v4u*)(WL + (size_t)n * KLORA + k0) = pack8(o);
    }
    float* WS_ = (float*)(F.ws + WS_WSIDE);
    for (int idx = gt; idx < NSIDE * D; idx += NT) {
        const int j = idx >> 10, k = idx & 1023; float v = 0.f;
        if (j < 8) v = F.in[F.z + I_WIN][(size_t)l * D * WIN_SRC + (size_t)k * WIN_SRC + 2048 + j];
        else if (l == 1) v = F.in[F.z + I_WINV][(size_t)k * 32 + (j - 8)];
        WS_[idx] = v;
    }
}
DI void phase_mod(const Ctx& F) {
    LAS float* sc = (LAS float*)F.lds; LAS float* red = (LAS float*)(F.lds + 65536);
    float* mod = (float*)(F.ws + WS_MOD);
    bool loaded = false;
    for (int it = F.bid; it < 2 * 144; it += F.G) {
        if (!loaded) { for (int i = F.tid; i < NB * D; i += NTHREADS) sc[i] = siluf_(F.in[F.z + I_C][i]); loaded = true; __syncthreads(); }
        const int l = it / 144, n0 = (it % 144) * 64, n = F.tid & 63, ks = F.tid >> 6;
        float acc[16];
#pragma unroll
        for (int b = 0; b < 16; ++b) acc[b] = 0.f;
        const float* wp = F.in[F.z + I_ADAW] + (size_t)l * D * NMOD + n0 + n;
        for (int k = ks * 128; k < ks * 128 + 128; ++k) { const float w = wp[(size_t)k * NMOD];
#pragma unroll
            for (int b = 0; b < 16; ++b) acc[b] += sc[b * D + k] * w; }
#pragma unroll
        for (int b = 0; b < 16; ++b) red[(ks * 16 + b) * 64 + n] = acc[b];
        __syncthreads();
        for (int o = F.tid; o < 1024; o += NTHREADS) { const int b = o >> 6, nn = o & 63; float s = 0.f;
#pragma unroll
            for (int k8 = 0; k8 < 8; ++k8) s += red[(k8 * 16 + b) * 64 + nn];
            mod[(size_t)(l * 16 + b) * NMOD + n0 + nn] = s + F.in[F.z + I_ADAB][(size_t)l * NMOD + n0 + nn]; }
        __syncthreads();
    }
}

template <bool SIDE>
DI void phase_modulate(const Ctx& F, const float* x, bf16* hout, const float* nw, const float* modl, int sub, int r0, int nrows, float* side, int nside, int wg, int nwg) {
    const int gw = wg * NWAVES + F.wave, NGW = nwg * NWAVES;
    const float* wside = (const float*)(F.ws + WS_WSIDE);
    constexpr int RB = SIDE ? 4 : 1;
    for (int rq = gw; rq < nrows / RB; rq += NGW) {
        const int b = (r0 + rq * RB) / T;
        const f32x4* nwp = (const f32x4*)nw + F.lane;
        const f32x4* shp = (const f32x4*)(modl + (size_t)b * NMOD + (sub * 3 + 0) * D) + F.lane;
        const f32x4* scp = (const f32x4*)(modl + (size_t)b * NMOD + (sub * 3 + 1) * D) + F.lane;
        f32x4 v[RB][4];
#pragma unroll
        for (int i = 0; i < RB; ++i) { const f32x4* xr = (const f32x4*)(x + (size_t)(r0 + rq * RB + i) * D) + F.lane;
#pragma unroll
            for (int j = 0; j < 4; ++j) v[i][j] = xr[64 * j]; }
#pragma unroll
        for (int i = 0; i < RB; ++i) { float ss = 0.f;
#pragma unroll
            for (int j = 0; j < 4; ++j) ss += (v[i][j].x * v[i][j].x + v[i][j].y * v[i][j].y) + (v[i][j].z * v[i][j].z + v[i][j].w * v[i][j].w);
            const float rstd = __builtin_amdgcn_rsqf(wave_sum(ss) * (1.f / D) + 1e-6f);
            unsigned long long* o8 = (unsigned long long*)(hout + (size_t)(rq * RB + i) * D) + F.lane;
#pragma unroll
            for (int j = 0; j < 4; ++j) { v[i][j] = v[i][j] * rstd * nwp[64 * j] * (scp[64 * j] + 1.0f) + shp[64 * j];
                o8[64 * j] = (unsigned long long)pk2(v[i][j].x, v[i][j].y) | ((unsigned long long)pk2(v[i][j].z, v[i][j].w) << 32); } }
        if (SIDE) {
            for (int jj = 0; jj < nside; ++jj) { const f32x4* wp = (const f32x4*)(wside + jj * D) + F.lane; f32x4 w[4];
#pragma unroll
                for (int j = 0; j < 4; ++j) w[j] = wp[64 * j];
                float s[RB];
#pragma unroll
                for (int i = 0; i < RB; ++i) { float a = 0.f;
#pragma unroll
                    for (int j = 0; j < 4; ++j) a += (v[i][j].x * w[j].x + v[i][j].y * w[j].y) + (v[i][j].z * w[j].z + v[i][j].w * w[j].w);
                    s[i] = wave_sum(a); }
#pragma unroll
                for (int i = 0; i < RB; ++i) if (F.lane == i) side[(size_t)(rq * RB + i) * NSIDE + jj] = s[i]; }
        }
    }
}
DI void phase_final_norm(const Ctx& F) {
    const int gw = F.bid * NWAVES + F.wave, NGW = F.G * NWAVES;
    for (int row = gw; row < M; row += NGW) {
        f32x4* xr = (f32x4*)(F.out + (size_t)row * D) + F.lane;
        f32x4 v[4]; float ss = 0.f;
#pragma unroll
        for (int j = 0; j < 4; ++j) { v[j] = xr[64 * j]; ss += (v[j].x * v[j].x + v[j].y * v[j].y) + (v[j].z * v[j].z + v[j].w * v[j].w); }
        const float rstd = 1.0f / sqrtf(wave_sum(ss) * (1.f / D) + 1e-6f);
        const f32x4* nwp = (const f32x4*)F.in[F.z + I_FNORMW] + F.lane;
#pragma unroll
        for (int j = 0; j < 4; ++j) xr[64 * j] = v[j] * rstd * nwp[64 * j];
    }
}

DI void phase_prep(const Ctx& F, int l) {
    const int gt = F.bid * NTHREADS + F.tid, NT = F.G * NTHREADS;
    const bf16* Z = (const bf16*)(F.ws + WS_Z); bf16* XC = (bf16*)(F.ws + WS_XC); bf16* LA = (bf16*)(F.ws + WS_LA); const float* SD = (const float*)(F.ws + WS_SIDE);
    const float* cw = F.in[F.z + I_CONVW] + (size_t)l * 4 * D; const float* cb = F.in[F.z + I_CONVB] + (size_t)l * D;
    const float* mu = F.in[F.z + I_MU] + (size_t)l * 3328;
    for (int idx = gt; idx < MG * 128; idx += NT) {
        const int row = idx >> 7, c8 = (idx & 127) * 8, t = row & (T - 1);
        float a[8], x[8];
#pragma unroll
        for (int i = 0; i < 8; ++i) a[i] = cb[c8 + i];
#pragma unroll
        for (int j = 0; j < 4; ++j) { if (t >= 3 - j) { unpack8(*(const v4u*)(Z + (size_t)(row - 3 + j) * NZ + ZC_MLX + c8), x);
#pragma unroll
                for (int i = 0; i < 8; ++i) a[i] += cw[j * D + c8 + i] * x[i]; } }
#pragma unroll
        for (int i = 0; i < 8; ++i) a[i] = siluf_(a[i]);
        *(v4u*)(XC + (size_t)row * D + c8) = pack8(a);
    }
    for (int idx = gt; idx < MG * 48; idx += NT) {
        const int row = idx / 48, k0 = (idx - row * 48) * 8, t = row & (T - 1);
        float o[8];
#pragma unroll
        for (int i = 0; i < 8; ++i) o[i] = 0.f;
        if (k0 < 256) { float cur[8], prv[8];
            unpack8(*(const v4u*)(Z + (size_t)row * NZ + ZC_RW + 3072 + k0), cur);
            if (t > 0) unpack8(*(const v4u*)(Z + (size_t)(row - 1) * NZ + ZC_RW + 3072 + k0), prv); else {
#pragma unroll
                for (int i = 0; i < 8; ++i) prv[i] = 0.f; }
#pragma unroll
            for (int i = 0; i < 8; ++i) { const float s = cur[i] + mu[3072 + k0 + i] * (prv[i] - cur[i]); o[i] = k0 < 64 ? tanhf(s) : (k0 < 128 ? s : sigmoidf_(s)); }
        } else if (l == 1 && k0 < 288) {
#pragma unroll
            for (int i = 0; i < 8; ++i) { const int j = k0 - 256 + i; const float cur = SD[(size_t)row * NSIDE + 8 + j], prv = t > 0 ? SD[(size_t)(row - 1) * NSIDE + 8 + j] : 0.f;
                o[i] = cur + F.in[F.z + I_MUV][j] * (prv - cur); }
        }
        *(v4u*)(LA + (size_t)row * KLORA + k0) = pack8(o);
    }
}

DI void scan_writeout(const Ctx& F, const LAS float* YT, bf16* dst  , int ld) {
    const int s = F.tid >> 4, r2 = (F.tid & 15) * 2;
    *(unsigned*)(dst + (size_t)s * ld + r2) = pk2(YT[s * 32 + r2], YT[s * 32 + r2 + 1]);
}
DI void scan_rwkv(const Ctx& F, int l, int g, int unit) {
    const int half = unit & 1, h = (unit >> 1) & 15, bl = unit >> 5;
    LAS float* TW = (LAS float*)F.lds; LAS float* TKP = TW + 2048; LAS float* TB = TW + 4096; LAS float* TKK = TW + 6144; LAS float* TR = TW + 8192; LAS float* TV = TW + 10240; LAS float* YT = TW + 12288;
    const bf16* Z = (const bf16*)(F.ws + WS_Z); const bf16* LO = (const bf16*)(F.ws + WS_LO); bf16* VF = (bf16*)(F.ws + WS_VF); bf16* BON = (bf16*)(F.ws + WS_BON);
    bf16* RAW = (bf16*)(F.ws + WS_RAW) + (size_t)1 * MG * D;
    const int gc = h * 64 + F.lane;
    const float mu_r = F.in[F.z + I_MU][l * 3328 + gc], mu_k = F.in[F.z + I_MU][l * 3328 + 1024 + gc], mu_v = F.in[F.z + I_MU][l * 3328 + 2048 + gc];
    const float w0 = F.in[F.z + I_W0][l * D + gc], a0 = F.in[F.z + I_A0][l * D + gc], kkc = F.in[F.z + I_KK][l * D + gc], kac = F.in[F.z + I_KA][l * D + gc], rk = F.in[F.z + I_RK][l * D + gc];
    const float v0 = l == 1 ? F.in[F.z + I_V0][gc] : 0.f;
    const int rowl = F.tid >> 4, ks = F.tid & 15;
    float s0 = 0.f, s1 = 0.f, s2 = 0.f, s3 = 0.f;
    for (int tt = 0; tt < T / 32; ++tt) {
        {
            const int sb = F.wave * 4, t0 = tt * 32 + sb; const size_t lrow0 = (size_t)bl * T + t0;
            float pr = 0.f, pk = 0.f, pv = 0.f;
            if (t0 > 0) { const bf16* zp = Z + (lrow0 - 1) * NZ + ZC_RW + gc; pr = bf1(zp[0]); pk = bf1(zp[1024]); pv = bf1(zp[2048]); }
#pragma unroll
            for (int j = 0; j < 4; ++j) {
                const size_t lrow = lrow0 + j; const bf16* zp = Z + lrow * NZ + ZC_RW + gc;
                const float zr = bf1(zp[0]), zk = bf1(zp[1024]), zv = bf1(zp[2048]);
                const float r = zr + mu_r * (pr - zr), k = zk + mu_k * (pk - zk); float v = zv + mu_v * (pv - zv);
                pr = zr; pk = zk; pv = zv;
                const bf16* lp = LO + lrow * NLORA + gc;
                const float xw = w0 + bf1(lp[0]); const float wraw = -softplusf_(-xw) - 0.5f; const float w = __expf(-__expf(wraw));
                const float a = sigmoidf_(a0 + bf1(lp[1024]));
                const size_t grow = (size_t)g * MG + lrow;
                if (l == 0) { if (half == 0) VF[grow * D + gc] = (bf16)f2bf(v); }
                else { const float vf = bf1(VF[grow * D + gc]); v = v + (vf - v) * sigmoidf_(v0 + bf1(lp[3072])); }
                const float kk = k * kkc; const float nrm = sqrtf(wave_sum(kk * kk)); const float kn = kk / fmaxf(nrm, 1e-12f);
                const float kp = k * (1.0f + (a - 1.0f) * kac);
                const float bsum = wave_sum(r * kp * rk);
                if (half == 0) BON[lrow * D + gc] = (bf16)f2bf(bsum * v);
                const int s = sb + j;
                TW[s * 64 + F.lane] = w; TKP[s * 64 + F.lane] = kp; TB[s * 64 + F.lane] = kn * a; TKK[s * 64 + F.lane] = kn; TR[s * 64 + F.lane] = r; TV[s * 64 + F.lane] = v;
            }
        }
        __syncthreads();
#pragma unroll 4
        for (int s = 0; s < 32; ++s) {
            const f32x4 kk = *(const LAS f32x4*)(TKK + s * 64 + ks * 4), w = *(const LAS f32x4*)(TW + s * 64 + ks * 4), b = *(const LAS f32x4*)(TB + s * 64 + ks * 4);
            const f32x4 kp = *(const LAS f32x4*)(TKP + s * 64 + ks * 4), r = *(const LAS f32x4*)(TR + s * 64 + ks * 4);
            const float vv = TV[s * 64 + half * 32 + rowl];
            const float u = sum16((s0 * kk.x + s1 * kk.y) + (s2 * kk.z + s3 * kk.w));
            s0 = s0 * w.x - u * b.x + vv * kp.x; s1 = s1 * w.y - u * b.y + vv * kp.y; s2 = s2 * w.z - u * b.z + vv * kp.z; s3 = s3 * w.w - u * b.w + vv * kp.w;
            const float y = sum16((s0 * r.x + s1 * r.y) + (s2 * r.z + s3 * r.w));
            if (ks == 0) YT[s * 32 + rowl] = y;
        }
        __syncthreads();
        scan_writeout(F, YT, RAW + ((size_t)bl * T + tt * 32) * D + h * 64 + half * 32, D);
    }
    __syncthreads();
}
DI void scan_hgrn(const Ctx& F, int l, int unit) {
    const int qt = unit & 3, h = (unit >> 2) & 7, bl = unit >> 5;
    LAS float* TQ = (LAS float*)F.lds; LAS float* TF = TQ + 4096; LAS float* TK = TQ + 8192; LAS float* TV = TQ + 12288; LAS float* YT = TQ + 13312;
    const bf16* Z = (const bf16*)(F.ws + WS_Z); bf16* RAW = (bf16*)(F.ws + WS_RAW) + (size_t)2 * MG * D;
    const int ps = F.tid >> 4, pc = (F.tid & 15) * 8;
    float lb[8];
#pragma unroll
    for (int i = 0; i < 8; ++i) lb[i] = l == 0 ? 0.f : sigmoidf_(F.in[F.z + I_LBL][D + h * 128 + pc + i] - F.in[F.z + I_LBL][h * 128 + pc + i]);
    const int el = F.tid >> 4, ds = F.tid & 15;
    float S[8];
#pragma unroll
    for (int i = 0; i < 8; ++i) S[i] = 0.f;
    for (int tt = 0; tt < T / 32; ++tt) {
        {
            const size_t lrow = (size_t)bl * T + tt * 32 + ps; float q[8], f[8], kk[8];
            unpack8(*(const v4u*)(Z + lrow * NZ + ZC_HGQ + h * 128 + pc), q); unpack8(*(const v4u*)(Z + lrow * NZ + ZC_HGF + h * 128 + pc), f);
#pragma unroll
            for (int i = 0; i < 8; ++i) { q[i] = siluf_(q[i]); const float sg = sigmoidf_(f[i]); kk[i] = (1.0f - lb[i]) * (1.0f - sg); f[i] = fmaxf(lb[i] + (1.0f - lb[i]) * sg, 1e-30f); }
            *(LAS f32x4*)(TQ + ps * 128 + pc) = (f32x4){q[0], q[1], q[2], q[3]}; *(LAS f32x4*)(TQ + ps * 128 + pc + 4) = (f32x4){q[4], q[5], q[6], q[7]};
            *(LAS f32x4*)(TF + ps * 128 + pc) = (f32x4){f[0], f[1], f[2], f[3]}; *(LAS f32x4*)(TF + ps * 128 + pc + 4) = (f32x4){f[4], f[5], f[6], f[7]};
            *(LAS f32x4*)(TK + ps * 128 + pc) = (f32x4){kk[0], kk[1], kk[2], kk[3]}; *(LAS f32x4*)(TK + ps * 128 + pc + 4) = (f32x4){kk[4], kk[5], kk[6], kk[7]};
            const unsigned vw = *(const unsigned*)(Z + lrow * NZ + ZC_HGI + h * 128 + qt * 32 + (F.tid & 15) * 2);
            TV[ps * 32 + (F.tid & 15) * 2] = bflo(vw); TV[ps * 32 + (F.tid & 15) * 2 + 1] = bfhi(vw);
        }
        __syncthreads();
#pragma unroll 4
        for (int s = 0; s < 32; ++s) {
            const float vv = TV[s * 32 + el]; float o = 0.f;
#pragma unroll
            for (int j = 0; j < 2; ++j) { const f32x4 q = *(const LAS f32x4*)(TQ + s * 128 + j * 64 + ds * 4), f = *(const LAS f32x4*)(TF + s * 128 + j * 64 + ds * 4), kk = *(const LAS f32x4*)(TK + s * 128 + j * 64 + ds * 4);
#pragma unroll
                for (int i = 0; i < 4; ++i) { S[j * 4 + i] = f[i] * S[j * 4 + i] + kk[i] * vv; o += S[j * 4 + i] * q[i]; } }
            o = sum16(o);
            if (ds == 0) YT[s * 32 + el] = o;
        }
        __syncthreads();
        scan_writeout(F, YT, RAW + ((size_t)bl * T + tt * 32) * D + h * 128 + qt * 32, D);
    }
    __syncthreads();
}
DI void scan_mlstm(const Ctx& F, int l, int unit) {
    const int e8 = unit & 7, h = (unit >> 3) & 3, bl = unit >> 5;
    LAS float* TQ = (LAS float*)F.lds; LAS float* TKI = TQ + 8192; LAS float* TV = TQ + 16384; LAS float* YT = TQ + 17408;
    LAS float* TLI = TQ + 18432; LAS float* TLF = TLI + 32; LAS float* TFG = TLI + 64; LAS float* TIG = TLI + 96; LAS float* TEM = TLI + 128; LAS float* MC = TLI + 160;
    const bf16* Z = (const bf16*)(F.ws + WS_Z); const bf16* QK = (const bf16*)(F.ws + WS_QK); const float* SD = (const float*)(F.ws + WS_SIDE);
    bf16* RAW = (bf16*)(F.ws + WS_RAW);
    const float ib = F.in[F.z + I_IB][l * 4 + h], fb = F.in[F.z + I_FB][l * 4 + h];
    const int ps = F.tid >> 4, pc = (F.tid & 15) * 16;
    const int el = F.tid >> 4, ds = F.tid & 15;
    float C[16], N[16];
#pragma unroll
    for (int i = 0; i < 16; ++i) { C[i] = 0.f; N[i] = 0.f; }
    if (F.tid == 0) MC[0] = 0.f;
    for (int tt = 0; tt < T / 32; ++tt) {
        if (F.wave == 0) {
            if (F.lane < 32) { const size_t lrow = (size_t)bl * T + tt * 32 + F.lane;
                TLI[F.lane] = SD[lrow * NSIDE + h] + ib; TLF[F.lane] = -softplusf_(-(SD[lrow * NSIDE + 4 + h] + fb)); }
            LDS_WAIT(); asm volatile("" ::: "memory");
            if (F.lane == 0) { float m = MC[0];
                for (int s = 0; s < 32; ++s) { const float lf = TLF[s], li = TLI[s], mp = m; m = fmaxf(mp + lf, li); TFG[s] = __expf(lf + mp - m); TIG[s] = __expf(li - m); TEM[s] = __expf(-m); }
                MC[0] = m; }
        }
        __syncthreads();
        {
            const size_t lrow = (size_t)bl * T + tt * 32 + ps; const float ig = TIG[ps]; float q[8], k[8];
#pragma unroll
            for (int hh = 0; hh < 2; ++hh) {
                unpack8(*(const v4u*)(QK + lrow * 2048 + h * 512 + pc + hh * 8), q); unpack8(*(const v4u*)(QK + lrow * 2048 + h * 512 + 256 + pc + hh * 8), k);
                *(LAS f32x4*)(TQ + ps * 256 + pc + hh * 8) = (f32x4){q[0], q[1], q[2], q[3]}; *(LAS f32x4*)(TQ + ps * 256 + pc + hh * 8 + 4) = (f32x4){q[4], q[5], q[6], q[7]};
                *(LAS f32x4*)(TKI + ps * 256 + pc + hh * 8) = (f32x4){k[0] * ig, k[1] * ig, k[2] * ig, k[3] * ig}; *(LAS f32x4*)(TKI + ps * 256 + pc + hh * 8 + 4) = (f32x4){k[4] * ig, k[5] * ig, k[6] * ig, k[7] * ig};
            }
            const unsigned vw = *(const unsigned*)(Z + lrow * NZ + ZC_MLX + h * 256 + e8 * 32 + (F.tid & 15) * 2);
            TV[ps * 32 + (F.tid & 15) * 2] = bflo(vw); TV[ps * 32 + (F.tid & 15) * 2 + 1] = bfhi(vw);
        }
        __syncthreads();
#pragma unroll 2
        for (int s = 0; s < 32; ++s) {
            const float vv = TV[s * 32 + el], fg = TFG[s], em = TEM[s]; float num = 0.f, den = 0.f;
#pragma unroll
            for (int j = 0; j < 4; ++j) { const f32x4 q = *(const LAS f32x4*)(TQ + s * 256 + j * 64 + ds * 4), ki = *(const LAS f32x4*)(TKI + s * 256 + j * 64 + ds * 4);
#pragma unroll
                for (int i = 0; i < 4; ++i) { C[j * 4 + i] = fg * C[j * 4 + i] + ki[i] * vv; N[j * 4 + i] = fg * N[j * 4 + i] + ki[i]; num += C[j * 4 + i] * q[i]; den += N[j * 4 + i] * q[i]; } }
            num = sum16(num); den = sum16(den);
            if (ds == 0) YT[s * 32 + el] = num / fmaxf(fabsf(den), em);
        }
        __syncthreads();
        scan_writeout(F, YT, RAW + ((size_t)bl * T + tt * 32) * D + h * 256 + e8 * 32, D);
    }
    __syncthreads();
}


typedef short s16x4 __attribute__((ext_vector_type(4)));
DI bf16x8 tr8(const LAS unsigned char* p0, const LAS unsigned char* p1) {
    const s16x4 lo = __builtin_amdgcn_ds_read_tr16_b64_v4i16((LAS s16x4*)p0), hi = __builtin_amdgcn_ds_read_tr16_b64_v4i16((LAS s16x4*)p1);
    return (bf16x8){lo[0], lo[1], lo[2], lo[3], hi[0], hi[1], hi[2], hi[3]};
}
DI float wave_incl_sum(float v, int lane) {
#pragma unroll
    for (int o = 1; o < 64; o <<= 1) { const float t = __shfl_up(v, o); if (lane >= o) v += t; }
    return v;
}
DI float wave_incl_max(float v, int lane) {
#pragma unroll
    for (int o = 1; o < 64; o <<= 1) { const float t = __shfl_up(v, o); if (lane >= o) v = fmaxf(v, t); }
    return v;
}
#define WG_SYNC() do { asm volatile("s_waitcnt lgkmcnt(0)" ::: "memory"); __builtin_amdgcn_s_barrier(); asm volatile("" ::: "memory"); } while (0)
DI void scan_mlstm_mfma(const Ctx& F, int l, int unit) {
    constexpr int QP = 528, PP = 144, VP = 96;
    constexpr int O_QS = 0, O_KS = 33792, O_CB = 67584, O_PS = 92928, O_VS = 102144, O_GT = 108288;
    const int e8 = unit & 7, h = (unit >> 3) & 3, bl = unit >> 5;
    LAS unsigned char* Qs = F.lds + O_QS; LAS unsigned char* Ks = F.lds + O_KS; LAS unsigned char* Cb = F.lds + O_CB; LAS unsigned char* Ps = F.lds + O_PS; LAS unsigned char* Vs = F.lds + O_VS;
    LAS float* RT = (LAS float*)(F.lds + O_GT); LAS float* CS = RT + 64; LAS float* WI = RT + 128; LAS float* EM = RT + 192; LAS float* WS = RT + 256; LAS float* SC = RT + 320;
    const bf16* QKp = (const bf16*)(F.ws + WS_QK) + (size_t)bl * T * 2048 + h * 512;
    const bf16* Vp = (const bf16*)(F.ws + WS_Z) + (size_t)bl * T * NZ + ZC_MLX + h * 256 + e8 * 32;
    const float* SD = (const float*)(F.ws + WS_SIDE) + (size_t)bl * T * NSIDE;
    bf16* OUT = (bf16*)(F.ws + WS_RAW) + (size_t)bl * T * D + h * 256 + e8 * 32;
    const float ib = F.in[F.z + I_IB][l * 4 + h], fb = F.in[F.z + I_FB][l * 4 + h];
    const int tid = F.tid, lane = F.lane, w = F.wave, g = lane >> 4, r = lane & 15, q = r >> 2, p = lane & 3;
    const int srow = tid >> 3, scj = tid & 7, vrow = tid >> 2, vc = tid & 3;
    v4u pq[4], pk[4], pv; float pli = 0.f, plf = 0.f; float m_prev = 0.f;
    f32x4 C[2][3];
#pragma unroll
    for (int a = 0; a < 2; ++a)
#pragma unroll
        for (int b = 0; b < 3; ++b) C[a][b] = (f32x4){0.f, 0.f, 0.f, 0.f};
    for (int i = tid; i < 25344 / 16; i += NTHREADS) *(LAS v4u*)(Cb + i * 16) = (v4u){0u, 0u, 0u, 0u};
    if (tid >= 256 && tid < 384) { const int rr = (tid - 256) >> 1, hh = tid & 1; unsigned one2 = 0x3F803F80u; asm volatile("" : "+v"(one2)); *(LAS v4u*)(Vs + rr * VP + 64 + hh * 16) = (v4u){one2, one2, one2, one2}; }
#define ML_LOAD(c) do { \
        _Pragma("unroll") for (int j = 0; j < 4; ++j) { pq[j] = *(const v4u*)(QKp + (size_t)((c) * 64 + srow) * 2048 + (scj + 8 * j) * 8); pk[j] = *(const v4u*)(QKp + (size_t)((c) * 64 + srow) * 2048 + 256 + (scj + 8 * j) * 8); } \
        if (tid < 256) pv = *(const v4u*)(Vp + (size_t)((c) * 64 + vrow) * NZ + vc * 8); \
        if (w == 0) { pli = SD[(size_t)((c) * 64 + lane) * NSIDE + h]; plf = SD[(size_t)((c) * 64 + lane) * NSIDE + 4 + h]; } } while (0)
#define ML_STORE() do { \
        _Pragma("unroll") for (int j = 0; j < 4; ++j) { *(LAS v4u*)(Qs + srow * QP + (scj + 8 * j) * 16) = pq[j]; *(LAS v4u*)(Ks + srow * QP + (scj + 8 * j) * 16) = pk[j]; } \
        if (tid < 256) *(LAS v4u*)(Vs + vrow * VP + vc * 16) = pv; \
        if (w == 0) { const float li = pli + ib, lf = -softplusf_(-(plf + fb)); const float bc = wave_incl_sum(lf, lane), cs = li - bc, pm = wave_incl_max(cs, lane), mx = fmaxf(m_prev, pm); \
            const float mx63 = __shfl(mx, 63), b63 = __shfl(bc, 63); \
            RT[lane] = -mx; CS[lane] = cs; WI[lane] = __expf(m_prev - mx); EM[lane] = __expf(-(bc + mx)); WS[lane] = __expf(cs - mx63); if (lane == 0) SC[0] = __expf(m_prev - mx63); m_prev = b63 + mx63; } } while (0)
    ML_LOAD(0); ML_STORE();
    WG_SYNC();
    const int tb = w >> 1, wh = w & 1;
    for (int c = 0; c < T / 64; ++c) {
        if (c + 1 < T / 64) ML_LOAD(c + 1);
#pragma unroll
        for (int si = 0; si < 2; ++si) {
            const int sb = wh * 2 + si; const int t = tb * 16 + r, s0 = sb * 16 + 4 * g;
            v2u pw = (v2u){0u, 0u};
            if (sb <= tb) {
                f32x4 acc = (f32x4){0.f, 0.f, 0.f, 0.f};
#pragma unroll
                for (int ks = 0; ks < 8; ++ks) { const bf16x8 a = *(const LAS bf16x8*)(Ks + (sb * 16 + r) * QP + (ks * 32 + 8 * g) * 2), b = *(const LAS bf16x8*)(Qs + (tb * 16 + r) * QP + (ks * 32 + 8 * g) * 2);
                    acc = __builtin_amdgcn_mfma_f32_16x16x32_bf16(a, b, acc, 0, 0, 0); }
                const float rt = RT[t]; const f32x4 cs4 = *(const LAS f32x4*)(CS + s0);
                float o[4];
#pragma unroll
                for (int i = 0; i < 4; ++i) o[i] = (s0 + i <= t) ? acc[i] * __expf(rt + cs4[i]) : 0.f;
                pw.x = pk2(o[0], o[1]); pw.y = pk2(o[2], o[3]);
            }
            *(LAS v2u*)(Ps + t * PP + s0 * 2) = pw;
        }
        { const float gm = SC[0];
#pragma unroll
            for (int a = 0; a < 2; ++a)
#pragma unroll
                for (int b = 0; b < 3; ++b) C[a][b] *= gm;
#pragma unroll
            for (int ks = 0; ks < 2; ++ks) {
                const f32x4 wsA = *(const LAS f32x4*)(WS + ks * 32 + 8 * g), wsB = *(const LAS f32x4*)(WS + ks * 32 + 8 * g + 4);
                bf16x8 bfr[3], afr[2];
#pragma unroll
                for (int et = 0; et < 3; ++et) { const LAS unsigned char* pa = Vs + (ks * 32 + 8 * g + q) * VP + (et * 16 + 4 * p) * 2; const bf16x8 raw = tr8(pa, pa + 4 * VP);
                    const v4u rw = __builtin_bit_cast(v4u, raw); v4u sw;
                    sw.x = pk2(bflo(rw.x) * wsA[0], bfhi(rw.x) * wsA[1]); sw.y = pk2(bflo(rw.y) * wsA[2], bfhi(rw.y) * wsA[3]);
                    sw.z = pk2(bflo(rw.z) * wsB[0], bfhi(rw.z) * wsB[1]); sw.w = pk2(bflo(rw.w) * wsB[2], bfhi(rw.w) * wsB[3]);
                    bfr[et] = __builtin_bit_cast(bf16x8, sw); }
#pragma unroll
                for (int a = 0; a < 2; ++a) { const LAS unsigned char* pa = Ks + (ks * 32 + 8 * g + q) * QP + ((2 * w + a) * 16 + 4 * p) * 2; afr[a] = tr8(pa, pa + 4 * QP); }
#pragma unroll
                for (int a = 0; a < 2; ++a)
#pragma unroll
                    for (int et = 0; et < 3; ++et) C[a][et] = __builtin_amdgcn_mfma_f32_16x16x32_bf16(afr[a], bfr[et], C[a][et], 0, 0, 0);
            } }
        WG_SYNC();
        {
            f32x4 oi[2], oc[2];
#pragma unroll
            for (int j = 0; j < 2; ++j) { oi[j] = (f32x4){0.f, 0.f, 0.f, 0.f}; oc[j] = (f32x4){0.f, 0.f, 0.f, 0.f}; }
#pragma unroll
            for (int ks = 0; ks < 2; ++ks) { const bf16x8 a = *(const LAS bf16x8*)(Ps + (tb * 16 + r) * PP + (ks * 32 + 8 * g) * 2);
#pragma unroll
                for (int j = 0; j < 2; ++j) { const int et = j == 0 ? wh : 2; const LAS unsigned char* pa = Vs + (ks * 32 + 8 * g + q) * VP + (et * 16 + 4 * p) * 2;
                    oi[j] = __builtin_amdgcn_mfma_f32_16x16x32_bf16(a, tr8(pa, pa + 4 * VP), oi[j], 0, 0, 0); } }
#pragma unroll
            for (int ks = 0; ks < 8; ++ks) { const bf16x8 a = *(const LAS bf16x8*)(Qs + (tb * 16 + r) * QP + (ks * 32 + 8 * g) * 2);
#pragma unroll
                for (int j = 0; j < 2; ++j) { const int et = j == 0 ? wh : 2; const bf16x8 b = *(const LAS bf16x8*)(Cb + (et * 16 + r) * QP + (ks * 32 + 8 * g) * 2);
                    oc[j] = __builtin_amdgcn_mfma_f32_16x16x32_bf16(a, b, oc[j], 0, 0, 0); } }
            const f32x4 wi4 = *(const LAS f32x4*)(WI + tb * 16 + 4 * g), em4 = *(const LAS f32x4*)(EM + tb * 16 + 4 * g);
#pragma unroll
            for (int i = 0; i < 4; ++i) { const float num = oi[0][i] + wi4[i] * oc[0][i], den = oi[1][i] + wi4[i] * oc[1][i];
                OUT[(size_t)(c * 64 + tb * 16 + 4 * g + i) * D + wh * 16 + r] = (bf16)f2bf(num / fmaxf(fabsf(den), em4[i])); }
        }
        WG_SYNC();
#pragma unroll
        for (int a = 0; a < 2; ++a)
#pragma unroll
            for (int et = 0; et < 3; ++et) { v2u cw; cw.x = pk2(C[a][et][0], C[a][et][1]); cw.y = pk2(C[a][et][2], C[a][et][3]);
                *(LAS v2u*)(Cb + (et * 16 + r) * QP + ((2 * w + a) * 16 + 4 * g) * 2) = cw; }
        if (c + 1 < T / 64) ML_STORE();
        WG_SYNC();
    }
#undef ML_LOAD
#undef ML_STORE
}


DI void scan_rwkv2(const Ctx& F, int l, int g, int unit) {
    const int half = unit & 1, h = (unit >> 1) & 15, bl = unit >> 5;
    LAS float* TW = (LAS float*)F.lds; LAS float* TKP = TW + 2048; LAS float* TB = TW + 4096; LAS float* TKK = TW + 6144; LAS float* TR = TW + 8192; LAS float* TV = TW + 10240; LAS float* YT = TW + 12288;
    const bf16* Z = (const bf16*)(F.ws + WS_Z); const bf16* LO = (const bf16*)(F.ws + WS_LO); bf16* VF = (bf16*)(F.ws + WS_VF); bf16* BON = (bf16*)(F.ws + WS_BON);
    bf16* RAW = (bf16*)(F.ws + WS_RAW) + (size_t)1 * MG * D;
    const int lane = F.lane, wave = F.wave;
    const int gc = h * 64 + lane;
    const float mu_r = F.in[F.z + I_MU][l * 3328 + gc], mu_k = F.in[F.z + I_MU][l * 3328 + 1024 + gc], mu_v = F.in[F.z + I_MU][l * 3328 + 2048 + gc];
    const float w0 = F.in[F.z + I_W0][l * D + gc], a0 = F.in[F.z + I_A0][l * D + gc], kkc = F.in[F.z + I_KK][l * D + gc], kac = F.in[F.z + I_KA][l * D + gc], rk = F.in[F.z + I_RK][l * D + gc];
    const float v0 = l == 1 ? F.in[F.z + I_V0][gc] : 0.f;
    const int rowl = F.tid >> 4, ks = F.tid & 15;
    f32x2 sa = (f32x2){0.f, 0.f}, sb = (f32x2){0.f, 0.f};
    bf16 rz[4][3], rl[4][2], rv[4][2], rp[3];
#define RW_LOAD(tt) do { const int t0_ = (tt) * 32 + wave * 4; const size_t lrow0_ = (size_t)bl * T + t0_; \
        _Pragma("unroll") for (int i = 0; i < 3; ++i) rp[i] = t0_ > 0 ? Z[(lrow0_ - 1) * NZ + ZC_RW + gc + 1024 * i] : (bf16)0; \
        _Pragma("unroll") for (int j = 0; j < 4; ++j) { const bf16* zp = Z + (lrow0_ + j) * NZ + ZC_RW + gc; const bf16* lp = LO + (lrow0_ + j) * NLORA + gc; \
            rz[j][0] = zp[0]; rz[j][1] = zp[1024]; rz[j][2] = zp[2048]; rl[j][0] = lp[0]; rl[j][1] = lp[1024]; \
            if (l == 1) { rv[j][0] = lp[3072]; rv[j][1] = VF[((size_t)g * MG + lrow0_ + j) * D + gc]; } } } while (0)
#define RW_PREP(tt) do { const int sb_ = wave * 4; const size_t lrow0_ = (size_t)bl * T + (tt) * 32 + sb_; \
        float pr = bf1(rp[0]), pk = bf1(rp[1]), pv = bf1(rp[2]); \
        _Pragma("unroll") for (int j = 0; j < 4; ++j) { const size_t lrow = lrow0_ + j; \
            const float zr = bf1(rz[j][0]), zk = bf1(rz[j][1]), zv = bf1(rz[j][2]); \
            const float r = zr + mu_r * (pr - zr), k = zk + mu_k * (pk - zk); float v = zv + mu_v * (pv - zv); \
            pr = zr; pk = zk; pv = zv; \
            const float xw = w0 + bf1(rl[j][0]); const float wraw = -softplusf_(-xw) - 0.5f; const float w = __expf(-__expf(wraw)); \
            const float a = sigmoidf_(a0 + bf1(rl[j][1])); \
            if (l == 0) { if (half == 0) VF[((size_t)g * MG + lrow) * D + gc] = (bf16)f2bf(v); } \
            else { const float vf = bf1(rv[j][1]); v = v + (vf - v) * sigmoidf_(v0 + bf1(rv[j][0])); } \
            const float kk = k * kkc; const float kn = kk * __builtin_amdgcn_rsqf(fmaxf(wave_sum(kk * kk), 1e-24f)); \
            const float kp = k * (1.0f + (a - 1.0f) * kac); \
            const float bsum = wave_sum(r * kp * rk); \
            if (half == 0) BON[lrow * D + gc] = (bf16)f2bf(bsum * v); \
            const int s = sb_ + j; \
            TW[s * 64 + lane] = w; TKP[s * 64 + lane] = kp; TB[s * 64 + lane] = kn * a; TKK[s * 64 + lane] = kn; TR[s * 64 + lane] = r; TV[s * 64 + lane] = v; } } while (0)
    RW_LOAD(0); RW_PREP(0);
    WG_SYNC();
    for (int tt = 0; tt < T / 32; ++tt) {
        if (tt + 1 < T / 32) RW_LOAD(tt + 1);
        {
            f32x4 nkk = *(const LAS f32x4*)(TKK + ks * 4), nw = *(const LAS f32x4*)(TW + ks * 4), nb = *(const LAS f32x4*)(TB + ks * 4), nkp = *(const LAS f32x4*)(TKP + ks * 4), nr = *(const LAS f32x4*)(TR + ks * 4);
            float nvv = TV[half * 32 + rowl];
#pragma unroll 1
            for (int hh = 0; hh < 2; ++hh) {
                float ysel = 0.f;
#pragma unroll
                for (int s16 = 0; s16 < 16; ++s16) {
                    const int s = hh * 16 + s16;
                    const f32x4 kk = nkk, w = nw, b = nb, kp = nkp, r = nr; const float vv = nvv;
                    const int sn = (s + 1) & 31;
                    nkk = *(const LAS f32x4*)(TKK + sn * 64 + ks * 4); nw = *(const LAS f32x4*)(TW + sn * 64 + ks * 4); nb = *(const LAS f32x4*)(TB + sn * 64 + ks * 4);
                    nkp = *(const LAS f32x4*)(TKP + sn * 64 + ks * 4); nr = *(const LAS f32x4*)(TR + sn * 64 + ks * 4); nvv = TV[sn * 64 + half * 32 + rowl];
                    const f32x2 d2 = sa * kk.xy + sb * kk.zw;
                    const f32x2 pa = sa * w.xy + kp.xy * vv, pb = sb * w.zw + kp.zw * vv;
                    const float nu = -sum16(d2.x + d2.y);
                    sa = b.xy * nu + pa; sb = b.zw * nu + pb;
                    const f32x2 y2 = sa * r.xy + sb * r.zw;
                    const float y = sum16(y2.x + y2.y);
                    ysel = (s16 == ks) ? y : ysel;
                }
                YT[(hh * 16 + ks) * 32 + rowl] = ysel;
            }
        }
        WG_SYNC();
        scan_writeout(F, YT, RAW + ((size_t)bl * T + tt * 32) * D + h * 64 + half * 32, D);
        if (tt + 1 < T / 32) RW_PREP(tt + 1);
        WG_SYNC();
    }
#undef RW_LOAD
#undef RW_PREP
}


DI void scan_hgrn_mfma(const Ctx& F, int l, int unit) {
    constexpr int QP = 272, VP = 80, PP = 80;
    constexpr int O_QA = 0, O_KA = 8704, O_SB = 17408, O_V = 26112, O_P = 28672, O_QT = 31232, O_E15 = 33280, O_GM = 33792, O_HH = 34304;
    const int qt = unit & 3, h = (unit >> 2) & 7, bl = unit >> 5;
    LAS unsigned char* Qa = F.lds + O_QA; LAS unsigned char* Ka = F.lds + O_KA; LAS unsigned char* Sb = F.lds + O_SB; LAS unsigned char* Vs = F.lds + O_V; LAS unsigned char* Ps = F.lds + O_P;
    LAS float* QT = (LAS float*)(F.lds + O_QT); LAS float* E15 = (LAS float*)(F.lds + O_E15); LAS float* GM = (LAS float*)(F.lds + O_GM); LAS float* HH = (LAS float*)(F.lds + O_HH);
    const bf16* Zq = (const bf16*)(F.ws + WS_Z) + (size_t)bl * T * NZ + ZC_HGQ + h * 128;
    const bf16* Zf = (const bf16*)(F.ws + WS_Z) + (size_t)bl * T * NZ + ZC_HGF + h * 128;
    const bf16* Zv = (const bf16*)(F.ws + WS_Z) + (size_t)bl * T * NZ + ZC_HGI + h * 128 + qt * 32;
    bf16* OUT = (bf16*)(F.ws + WS_RAW) + (size_t)2 * MG * D + (size_t)bl * T * D + h * 128 + qt * 32;
    const int tid = F.tid, lane = F.lane, w = F.wave, g = lane >> 4, r = lane & 15, q = r >> 2, p = lane & 3;
    const int pd = tid & 127, tq = tid >> 7;
    const int vrow = tid >> 2, vc = tid & 3;
    bf16 rq[8], rf[8]; v4u pv;
    f32x4 S[2];
    S[0] = (f32x4){0.f, 0.f, 0.f, 0.f}; S[1] = (f32x4){0.f, 0.f, 0.f, 0.f};
#define HG_LOAD(c) do { _Pragma("unroll") for (int i = 0; i < 8; ++i) { rq[i] = Zq[(size_t)((c) * 32 + tq * 8 + i) * NZ + pd]; rf[i] = Zf[(size_t)((c) * 32 + tq * 8 + i) * NZ + pd]; } \
        if (tid < 128) pv = *(const v4u*)(Zv + (size_t)((c) * 32 + vrow) * NZ + vc * 8); } while (0)
    HG_LOAD(0);
    for (int c = 0; c < T / 32; ++c) {
        float qv[8], kv[8], cb[8]; float run = 0.f;
#pragma unroll
        for (int i = 0; i < 8; ++i) { qv[i] = bf1(rq[i]); const float lf = bf1(rf[i]); kv[i] = 1.0f - __expf(lf); run += lf; cb[i] = run; }
        QT[tq * 128 + pd] = run;
        if (tid < 128) *(LAS v4u*)(Vs + vrow * VP + vc * 16) = pv;
        if (c + 1 < T / 32) HG_LOAD(c + 1);
        WG_SYNC();
        { const float q0 = QT[pd], q1 = QT[128 + pd], q2 = QT[256 + pd], q3 = QT[384 + pd];
            const float off = (tq > 0 ? q0 : 0.f) + (tq > 1 ? q1 : 0.f) + (tq > 2 ? q2 : 0.f); const float b15 = q0 + q1, b31 = (q0 + q1) + (q2 + q3);
#pragma unroll
            for (int i = 0; i < 8; ++i) { const float bt = off + cb[i]; const float ea = __expf(fminf(bt - b15, 80.f)), ek = __expf(fminf(b15 - bt, 80.f));
                *(LAS bf16*)(Qa + (tq * 8 + i) * QP + pd * 2) = (bf16)f2bf(qv[i] * ea); *(LAS bf16*)(Ka + (tq * 8 + i) * QP + pd * 2) = (bf16)f2bf(kv[i] * ek); }
            if (tq == 0) { E15[pd] = __expf(b15); GM[pd] = __expf(b31); HH[pd] = __expf(b31 - b15); } }
        WG_SYNC();
        { const f32x4 e4 = *(const LAS f32x4*)(E15 + w * 16 + 4 * g), g4 = *(const LAS f32x4*)(GM + w * 16 + 4 * g), h4 = *(const LAS f32x4*)(HH + w * 16 + 4 * g);
            const LAS unsigned char* pa = Ka + (8 * g + q) * QP + (w * 16 + 4 * p) * 2; const bf16x8 afr = tr8(pa, pa + 4 * QP);
#pragma unroll
            for (int et = 0; et < 2; ++et) { v2u sw; sw.x = pk2(S[et][0] * e4[0], S[et][1] * e4[1]); sw.y = pk2(S[et][2] * e4[2], S[et][3] * e4[3]);
                *(LAS v2u*)(Sb + (et * 16 + r) * QP + (w * 16 + 4 * g) * 2) = sw;
                const LAS unsigned char* pb = Vs + (8 * g + q) * VP + (et * 16 + 4 * p) * 2;
                const f32x4 kvp = __builtin_amdgcn_mfma_f32_16x16x32_bf16(afr, tr8(pb, pb + 4 * VP), (f32x4){0.f, 0.f, 0.f, 0.f}, 0, 0, 0);
                S[et] = g4 * S[et] + h4 * kvp; } }
        if (w < 4) { const int sb = w >> 1, tb = (w & 1) ^ sb;
            const int t = tb * 16 + r, s0 = sb * 16 + 4 * g; v2u pw = (v2u){0u, 0u};
            if (sb <= tb) { f32x4 acc = (f32x4){0.f, 0.f, 0.f, 0.f};
#pragma unroll
                for (int ks = 0; ks < 4; ++ks) { const bf16x8 a = *(const LAS bf16x8*)(Ka + (sb * 16 + r) * QP + (ks * 32 + 8 * g) * 2), b = *(const LAS bf16x8*)(Qa + (tb * 16 + r) * QP + (ks * 32 + 8 * g) * 2);
                    acc = __builtin_amdgcn_mfma_f32_16x16x32_bf16(a, b, acc, 0, 0, 0); }
                pw.x = pk2(s0 + 0 <= t ? acc[0] : 0.f, s0 + 1 <= t ? acc[1] : 0.f); pw.y = pk2(s0 + 2 <= t ? acc[2] : 0.f, s0 + 3 <= t ? acc[3] : 0.f); }
            *(LAS v2u*)(Ps + t * PP + s0 * 2) = pw; }
        WG_SYNC();
        if (w < 4) { const int tb = w >> 1, et = w & 1;
            const LAS unsigned char* pb = Vs + (8 * g + q) * VP + (et * 16 + 4 * p) * 2;
            f32x4 o = __builtin_amdgcn_mfma_f32_16x16x32_bf16(*(const LAS bf16x8*)(Ps + (tb * 16 + r) * PP + 8 * g * 2), tr8(pb, pb + 4 * VP), (f32x4){0.f, 0.f, 0.f, 0.f}, 0, 0, 0);
#pragma unroll
            for (int ks = 0; ks < 4; ++ks) { const bf16x8 a = *(const LAS bf16x8*)(Qa + (tb * 16 + r) * QP + (ks * 32 + 8 * g) * 2), b = *(const LAS bf16x8*)(Sb + (et * 16 + r) * QP + (ks * 32 + 8 * g) * 2);
                o = __builtin_amdgcn_mfma_f32_16x16x32_bf16(a, b, o, 0, 0, 0); }
#pragma unroll
            for (int i = 0; i < 4; ++i) OUT[(size_t)(c * 32 + tb * 16 + 4 * g + i) * D + et * 16 + r] = (bf16)f2bf(o[i]); }
        WG_SYNC();
    }
#undef HG_LOAD
}


DI void scan_rwkv8(const Ctx& F, int l, int g, int unit) {
    const int half = unit & 1, h = (unit >> 1) & 15, bl = unit >> 5;
    constexpr int BUFB = 49152;
    LAS float* YT0 = (LAS float*)(F.lds + 2 * BUFB);
    const bf16* Z = (const bf16*)(F.ws + WS_Z); const bf16* LO = (const bf16*)(F.ws + WS_LO); bf16* VF = (bf16*)(F.ws + WS_VF); bf16* BON = (bf16*)(F.ws + WS_BON);
    bf16* RAW = (bf16*)(F.ws + WS_RAW) + (size_t)1 * MG * D;
    const int lane = F.lane, wave = F.wave;
    if (wave >= 4) {
        const int pw = wave - 4, gc = h * 64 + lane;
        const float mu_r = F.in[F.z + I_MU][l * 3328 + gc], mu_k = F.in[F.z + I_MU][l * 3328 + 1024 + gc], mu_v = F.in[F.z + I_MU][l * 3328 + 2048 + gc];
        const float kkc = F.in[F.z + I_KK][l * D + gc], kac = F.in[F.z + I_KA][l * D + gc], rk = F.in[F.z + I_RK][l * D + gc];
        bf16 rz[8][3], rl[8][2], rv[8][2], rp[3];
#define RW_LOAD(tt) do { const int t0_ = (tt) * 32 + pw * 8; const size_t lrow0_ = (size_t)bl * T + t0_; \
        _Pragma("unroll") for (int i = 0; i < 3; ++i) rp[i] = t0_ > 0 ? Z[(lrow0_ - 1) * NZ + ZC_RW + gc + 1024 * i] : (bf16)0; \
        _Pragma("unroll") for (int j = 0; j < 8; ++j) { const bf16* zp = Z + (lrow0_ + j) * NZ + ZC_RW + gc; const bf16* lp = LO + (lrow0_ + j) * NLORA + gc; \
            rz[j][0] = zp[0]; rz[j][1] = zp[1024]; rz[j][2] = zp[2048]; rl[j][0] = lp[0]; rl[j][1] = lp[1024]; \
            if (l == 1) { rv[j][0] = lp[3072]; rv[j][1] = VF[((size_t)g * MG + lrow0_ + j) * D + gc]; } } } while (0)
#define RW_PREP(tt) do { LAS float* TW = (LAS float*)(F.lds + ((tt) & 1) * BUFB); LAS float* TKP = TW + 2048; LAS float* TB = TW + 4096; LAS float* TKK = TW + 6144; LAS float* TR = TW + 8192; LAS float* TV = TW + 10240; \
        const int sb_ = pw * 8; const size_t lrow0_ = (size_t)bl * T + (tt) * 32 + sb_; \
        float pr = bf1(rp[0]), pk = bf1(rp[1]), pv = bf1(rp[2]); \
        _Pragma("unroll") for (int j = 0; j < 8; ++j) { const size_t lrow = lrow0_ + j; \
            const float zr = bf1(rz[j][0]), zk = bf1(rz[j][1]), zv = bf1(rz[j][2]); \
            const float r = zr + mu_r * (pr - zr), k = zk + mu_k * (pk - zk); float v = zv + mu_v * (pv - zv); \
            pr = zr; pk = zk; pv = zv; \
            const float w = __expf(bf1(rl[j][0])); const float a = bf1(rl[j][1]); \
            if (l == 0) { if (half == 0) VF[((size_t)g * MG + lrow) * D + gc] = (bf16)f2bf(v); } \
            else { const float vf = bf1(rv[j][1]); v = v + (vf - v) * bf1(rv[j][0]); } \
            const float kk = k * kkc; const float kn = kk * __builtin_amdgcn_rsqf(fmaxf(wave_sum(kk * kk), 1e-24f)); \
            const float kp = k * (1.0f + (a - 1.0f) * kac); \
            const float bsum = wave_sum(r * kp * rk); \
            if (half == 0) BON[lrow * D + gc] = (bf16)f2bf(bsum * v); \
            const int s = sb_ + j; \
            TW[s * 64 + lane] = w; TKP[s * 64 + lane] = kp; TB[s * 64 + lane] = kn * a; TKK[s * 64 + lane] = kn; TR[s * 64 + lane] = r; TV[s * 64 + lane] = v; } } while (0)
        RW_LOAD(0); RW_PREP(0); RW_LOAD(1);
        WG_SYNC();
        for (int tt = 0; tt < T / 32; ++tt) {
            if (tt + 1 < T / 32) { RW_PREP(tt + 1); if (tt + 2 < T / 32) RW_LOAD(tt + 2); }
            WG_SYNC();
        }
#undef RW_LOAD
#undef RW_PREP
    } else {
        const int rowl = F.tid >> 3, ks = F.tid & 7;
        f32x2 st[4];
#pragma unroll
        for (int i = 0; i < 4; ++i) st[i] = (f32x2){0.f, 0.f};
        WG_SYNC();
        for (int tt = 0; tt < T / 32; ++tt) {
            const LAS float* TW = (const LAS float*)(F.lds + (tt & 1) * BUFB); const LAS float* TKP = TW + 2048; const LAS float* TB = TW + 4096; const LAS float* TKK = TW + 6144; const LAS float* TR = TW + 8192; const LAS float* TV = TW + 10240;
            LAS float* YT = YT0 + (tt & 1) * 1024;
            f32x4 nkk[2], nw[2], nb[2], nkp[2], nr[2]; float nvv;
#pragma unroll
            for (int q = 0; q < 2; ++q) { nkk[q] = *(const LAS f32x4*)(TKK + ks * 8 + q * 4); nw[q] = *(const LAS f32x4*)(TW + ks * 8 + q * 4); nb[q] = *(const LAS f32x4*)(TB + ks * 8 + q * 4);
                nkp[q] = *(const LAS f32x4*)(TKP + ks * 8 + q * 4); nr[q] = *(const LAS f32x4*)(TR + ks * 8 + q * 4); }
            nvv = TV[half * 32 + rowl];
#pragma unroll 1
            for (int hh = 0; hh < 4; ++hh) {
                float ysel = 0.f;
#pragma unroll
                for (int s8 = 0; s8 < 8; ++s8) {
                    const int s = hh * 8 + s8;
                    f32x4 kk[2], w[2], b[2], kp[2], r[2];
#pragma unroll
                    for (int q = 0; q < 2; ++q) { kk[q] = nkk[q]; w[q] = nw[q]; b[q] = nb[q]; kp[q] = nkp[q]; r[q] = nr[q]; }
                    const float vv = nvv;
                    const int sn = (s + 1) & 31;
#pragma unroll
                    for (int q = 0; q < 2; ++q) { nkk[q] = *(const LAS f32x4*)(TKK + sn * 64 + ks * 8 + q * 4); nw[q] = *(const LAS f32x4*)(TW + sn * 64 + ks * 8 + q * 4); nb[q] = *(const LAS f32x4*)(TB + sn * 64 + ks * 8 + q * 4);
                        nkp[q] = *(const LAS f32x4*)(TKP + sn * 64 + ks * 8 + q * 4); nr[q] = *(const LAS f32x4*)(TR + sn * 64 + ks * 8 + q * 4); }
                    nvv = TV[sn * 64 + half * 32 + rowl];
                    const f32x2 d2 = (st[0] * kk[0].xy + st[1] * kk[0].zw) + (st[2] * kk[1].xy + st[3] * kk[1].zw);
                    f32x2 pp[4];
                    pp[0] = st[0] * w[0].xy + kp[0].xy * vv; pp[1] = st[1] * w[0].zw + kp[0].zw * vv; pp[2] = st[2] * w[1].xy + kp[1].xy * vv; pp[3] = st[3] * w[1].zw + kp[1].zw * vv;
                    const float nu = -sum8(d2.x + d2.y);
                    st[0] = b[0].xy * nu + pp[0]; st[1] = b[0].zw * nu + pp[1]; st[2] = b[1].xy * nu + pp[2]; st[3] = b[1].zw * nu + pp[3];
                    const f32x2 y2 = (st[0] * r[0].xy + st[1] * r[0].zw) + (st[2] * r[1].xy + st[3] * r[1].zw);
                    const float y = sum8(y2.x + y2.y);
                    ysel = (s8 == ks) ? y : ysel;
                }
                YT[(hh * 8 + ks) * 32 + rowl] = ysel;
            }
            WG_SYNC();
            { const int s = F.tid >> 3, r4 = (F.tid & 7) * 4;
                const f32x4 yv = *(const LAS f32x4*)(YT + s * 32 + r4); v2u o; o.x = pk2(yv.x, yv.y); o.y = pk2(yv.z, yv.w);
                *(v2u*)(RAW + ((size_t)bl * T + tt * 32 + s) * D + h * 64 + half * 32 + r4) = o; }
        }
    }
    WG_SYNC();
}

DI void phase_post(const Ctx& F, int l) {
    const int gw = F.bid * NWAVES + F.wave, NGW = F.G * NWAVES;
    const bf16* Z = (const bf16*)(F.ws + WS_Z); const bf16* XC = (const bf16*)(F.ws + WS_XC); const bf16* LO = (const bf16*)(F.ws + WS_LO); const bf16* BON = (const bf16*)(F.ws + WS_BON);
    bf16* RAW = (bf16*)(F.ws + WS_RAW);
    const int c0 = F.lane * 16;
    for (int row = gw; row < MG; row += NGW) {
        float a[16], b[16], c[16];
        { bf16* rp = RAW + (size_t)row * D + c0;
            unpack16(rp, a);
            unpack16(Z + (size_t)row * NZ + ZC_MLO + c0, b);
            unpack16(XC + (size_t)row * D + c0, c);
            float s = 0.f;
#pragma unroll
            for (int i = 0; i < 16; ++i) { a[i] *= sigmoidf_(b[i]); s += a[i]; }
            const float mean = sum16(s) * (1.f / 256.f); float q = 0.f;
#pragma unroll
            for (int i = 0; i < 16; ++i) { a[i] -= mean; q += a[i] * a[i]; }
            const float rstd = 1.0f / sqrtf(sum16(q) * (1.f / 256.f) + 1e-6f);
#pragma unroll
            for (int i = 0; i < 16; ++i) a[i] = a[i] * rstd * F.in[F.z + I_MLNW][l * D + c0 + i] + F.in[F.z + I_MLSKIP][l * D + c0 + i] * c[i];
            pack16(rp, a); }
        { bf16* rp = RAW + (size_t)(MG + row) * D + c0;
            unpack16(rp, a);
            unpack16(BON + (size_t)row * D + c0, b);
            unpack16(LO + (size_t)row * NLORA + 2048 + c0, c);
            float s = 0.f;
#pragma unroll
            for (int i = 0; i < 16; ++i) s += a[i];
            const float mean = sum4(s) * (1.f / 64.f); float q = 0.f;
#pragma unroll
            for (int i = 0; i < 16; ++i) { a[i] -= mean; q += a[i] * a[i]; }
            const float rstd = 1.0f / sqrtf(sum4(q) * (1.f / 64.f) + 64e-5f);
#pragma unroll
            for (int i = 0; i < 16; ++i) a[i] = (a[i] * rstd * F.in[F.z + I_LNW][l * D + c0 + i] + F.in[F.z + I_LNB][l * D + c0 + i] + b[i]) * c[i];
            pack16(rp, a); }
        { bf16* rp = RAW + (size_t)(2 * MG + row) * D + c0;
            unpack16(rp, a);
            unpack16(Z + (size_t)row * NZ + ZC_HGG + c0, b);
            float q = 0.f;
#pragma unroll
            for (int i = 0; i < 16; ++i) q += a[i] * a[i];
            const float rstd = 1.0f / sqrtf(sum8(q) * (1.f / 128.f) + 1e-6f);
#pragma unroll
            for (int i = 0; i < 16; ++i) a[i] = a[i] * rstd * F.in[F.z + I_HGNW][l * D + c0 + i] * sigmoidf_(b[i]);
            pack16(rp, a); }
    }
}

enum { PH_W = 0, PH_A1, PH_A2, PH_A3, PH_B1, PH_B2, PH_B3, PH_B4, PH_B5, PH_B6, PH_B7, PH_B8, PH_FIN, PH_N };

__global__ void __launch_bounds__(NTHREADS, 2) fwd_kernel(Args args) {
    extern __shared__ __attribute__((aligned(16))) unsigned char lds_raw[];
    Ctx F;
    F.lds = (LAS unsigned char*)lds_raw; F.in = args.in; F.out = args.out; F.ws = args.ws;
    F.z = 0; F.tid = threadIdx.x; F.lane = F.tid & 63; F.wave = __builtin_amdgcn_readfirstlane(F.tid >> 6); F.bid = blockIdx.x; F.G = gridDim.x;
    volatile LAS unsigned* MISC = (volatile LAS unsigned*)(F.lds + MISC_OFF);
    if (F.tid < 32) MISC[F.tid] = 0u;
    __syncthreads();
    XcdBarrier bar; bar.bar = (unsigned*)(F.ws + WS_CTL) + CW_BAR; bar.x = 0; bar.st = nullptr;
    if (args.use_bar) bar = xcd_barrier_post((unsigned*)(F.ws + WS_CTL) + CW_BAR, MISC + 8);
#ifndef PHMASK
#define PHMASK 0xFFFF
#endif
#define IN(k) (((PHMASK >> (k)) & 1) && args.ph_lo <= (k) && (k) < args.ph_hi)
#ifndef REPEAT_PH
#define REPEAT_PH -1
#endif
#ifndef TP_PH
#define TP_PH -1
#endif
#ifndef TP_WG
#define TP_WG 0
#endif
#define TPS(id) do { if ((id) == TP_PH && F.bid == TP_WG) tp0_ = __builtin_amdgcn_s_memrealtime(); } while (0)
#define TPE(id) do { if ((id) == TP_PH && F.bid == TP_WG && F.tid == 0) MISC[20] += (unsigned)(__builtin_amdgcn_s_memrealtime() - tp0_); } while (0)
#define PHASE(k) if (IN(k)) for (int rep_ = 0; rep_ < ((k) == REPEAT_PH ? 2 : 1); ++rep_) if (refresh(F), cur_ph_ = (k), (((k) == TP_PH && F.bid == TP_WG) ? (void)(tp0_ = __builtin_amdgcn_s_memrealtime()) : (void)0), true)
#define SEAM() do { TPE(cur_ph_); if (args.use_bar) xcd_barrier(bar); } while (0)
    const float* MOD = (const float*)(F.ws + WS_MOD);
    int cur_ph_ = -1; unsigned long long tp0_ = 0; (void)cur_ph_; (void)tp0_;
    for (int f = args.f_lo; f < args.f_hi; ++f) {
        const int l = f >> 1, fi = f & 1;
        const float* modl = MOD + (size_t)l * NB * NMOD;
        if (fi == 0) PHASE(PH_W) { phase_weights(F, l); if (l == 0) { __syncthreads(); phase_mod(F); } SEAM(); }
        const int sub = fi ? 2 : 0;
        const float* xsrc = (f == 0) ? F.in[F.z + I_X] : F.out;
        PHASE(PH_A1) { phase_modulate<false>(F, xsrc, (bf16*)(F.ws + WS_H), F.in[F.z + I_NORMW] + (size_t)(l * 3 + sub) * D, modl, sub, 0, M, nullptr, 0, F.bid, F.G); SEAM(); }
        PHASE(PH_A2) {
            pg8::Gemm gm{(const bf16*)(F.ws + WS_H), (const bf16*)(F.ws + WS_WUP) + (size_t)fi * NUP * D, D, D, D, 0, 0};
            pg8::Order<0> S; S.init(M / 256, NUP / 256, F.G, F.bid);
            pg8::EpiSwiGLU E{(bf16*)(F.ws + WS_HID), DFF};
            pg8::gemm_phase(F.lds, gm, S, E, F.tid); SEAM(); }
        PHASE(PH_A3) {
            pg8::Gemm gm{(const bf16*)(F.ws + WS_HID), (const bf16*)(F.ws + WS_WDN) + (size_t)fi * D * DFF, DFF, DFF, DFF, 0, 0};
            pg8::Order<0> S; S.init(M / 256, D / 256, F.G, F.bid);
            pg8::EpiResid E{xsrc, F.out, modl + (sub * 3 + 2) * D, 0.5f, 0};
            pg8::gemm_phase(F.lds, gm, S, E, F.tid); SEAM(); }
        if (fi == 0) {
            for (int g = args.g_lo; g < args.g_hi; ++g) {
                float* xg = F.out + (size_t)g * MG * D;
                const bool fuse_b1 = args.use_bar && F.G == 256 && args.ph_lo <= PH_B1 && args.ph_hi > PH_B7;
                if (!(fuse_b1 && g > args.g_lo)) PHASE(PH_B1) { phase_modulate<true>(F, F.out, (bf16*)(F.ws + WS_HG), F.in[F.z + I_NORMW] + (size_t)(l * 3 + 1) * D, modl, 1, g * MG, MG, (float*)(F.ws + WS_SIDE), l == 0 ? 8 : NSIDE, F.bid, F.G); SEAM(); }
                PHASE(PH_B2) {
                    pg8::Gemm gm{(const bf16*)(F.ws + WS_HG), (const bf16*)(F.ws + WS_WIN), D, D, D, 0, 0};
                    pg8::Order<0> S; S.init(MG / 256, NZ / 256, F.G, F.bid);
                    pg8::EpiZ E{(bf16*)(F.ws + WS_Z), NZ, l == 0 ? nullptr : F.in[F.z + I_LBL]};
                    pg8::gemm_phase(F.lds, gm, S, E, F.tid); SEAM(); }
                PHASE(PH_B3) { phase_prep(F, l); SEAM(); }
                PHASE(PH_B4) {
                    { pg8::Gemm gm{(const bf16*)(F.ws + WS_XC), (const bf16*)(F.ws + WS_WQK), 256, D, 256, 256, (size_t)512 * 256};
                      pg8::Order<1> S; S.init(MG / 256, 8, F.G, F.bid);
                      pg8::EpiBf16 E{(bf16*)(F.ws + WS_QK), 2048, 512};
                      pg8::gemm_phase(F.lds, gm, S, E, F.tid); }
                    __syncthreads();
                    { pg8::Gemm gm{(const bf16*)(F.ws + WS_LA), (const bf16*)(F.ws + WS_WLORA), l == 0 ? 256 : 384, KLORA, KLORA, 0, 0};
                      pg8::Order<0> S; S.init(MG / 256, l == 0 ? 12 : 16, F.G, F.bid);
                      pg8::EpiLora E{(bf16*)(F.ws + WS_LO), NLORA, F.in[F.z + I_W0] + (size_t)l * D, F.in[F.z + I_A0] + (size_t)l * D, F.in[F.z + I_V0]};
                      pg8::gemm_phase(F.lds, gm, S, E, F.tid); }
                    SEAM(); }
                PHASE(PH_B5) {
                    { unsigned* hgdone = (unsigned*)(F.ws + WS_CTL) + CW_HGDONE + 64 * (l * NGRP + g);
                      int lo0, lo1, lo2, st = 128, gq = 128, gc = F.bid;
                      if (F.G == 256) { const int a = F.bid < 128 ? F.bid : 128, b = F.bid >= 128 ? F.bid - 128 : 128; lo0 = a; lo1 = b; lo2 = a; }
                      else { lo0 = lo1 = lo2 = F.bid; st = F.G; gq = F.G; }
                      unsigned nhg = 0;
                      TPS(100); for (int i = lo2; i < 128; i += st) { scan_hgrn_mfma(F, l, i); ++nhg; } TPE(100);
                      if (nhg && F.tid == 0) __hip_atomic_fetch_add(hgdone, nhg, __ATOMIC_RELAXED, __HIP_MEMORY_SCOPE_AGENT);
                      TPS(101); for (int i = lo0; i < 128; i += st) scan_mlstm_mfma(F, l, i); TPE(101);
                      TPS(103); for (int i = lo1; i < 128; i += st) scan_rwkv8(F, l, g, i); TPE(103);
                      {
                          if (F.tid == 0) { unsigned sp = 0; while (__hip_atomic_load(hgdone, __ATOMIC_RELAXED, __HIP_MEMORY_SCOPE_AGENT) < 128u) { __builtin_amdgcn_s_sleep(4); if (++sp > (1u << 22)) break; } }
                          __syncthreads();
                          pg8::Gemm gm{(const bf16*)(F.ws + WS_HG), (const bf16*)(F.ws + WS_WIN) + (size_t)NZ * D, D, D, D, 0, 0};
                          pg8::Order<0> S; S.init(MG / 256, 12, gq, gc);
                          if (F.G == 256) { if (F.bid < 128) { S.imax = 2; } else { S.c = F.bid - 128; S.L0 = 256; S.imax = 1; } }
                          pg8::EpiBf16 E{(bf16*)(F.ws + WS_Z) + ZC_GATE, NZ, 0};
                          TPS(102); pg8::gemm_phase(F.lds, gm, S, E, F.tid); TPE(102); } }
                    SEAM(); }
                PHASE(PH_B6) { phase_post(F, l); SEAM(); }
                PHASE(PH_B7) {
                    pg8::Gemm gm{(const bf16*)(F.ws + WS_RAW), (const bf16*)(F.ws + WS_WBR), D, D, D, (size_t)MG * D, (size_t)D * D};
                    pg8::Order<2> S; S.init(MG / 256, 4, F.G, F.bid);
                    pg8::EpiBranch E{(const bf16*)(F.ws + WS_Z) + ZC_GATE, NZ, (float*)(F.ws + WS_QK), (bf16*)(F.ws + WS_XC)};
                    pg8::gemm_phase(F.lds, gm, S, E, F.tid);
                    if (fuse_b1 && g + 1 < args.g_hi && F.bid >= 128)
                        phase_modulate<true>(F, F.out, (bf16*)(F.ws + WS_HG), F.in[F.z + I_NORMW] + (size_t)(l * 3 + 1) * D, modl, 1, (g + 1) * MG, MG, (float*)(F.ws + WS_SIDE), l == 0 ? 8 : NSIDE, F.bid - 128, 128);
                    SEAM(); }
                PHASE(PH_B8) {
                    pg8::Gemm gm{(const bf16*)(F.ws + WS_XC), (const bf16*)(F.ws + WS_WOUT), D, D, D, 0, 0};
                    pg8::Order<0> S; S.init(MG / 256, 4, F.G, F.bid);
                    pg8::EpiResid E{xg, xg, modl + (1 * 3 + 2) * D, 1.0f, g * GB};
                    pg8::gemm_phase(F.lds, gm, S, E, F.tid);
                    SEAM(); }
            }
        }
    }
    PHASE(PH_FIN) phase_final_norm(F);
    if (TP_PH >= 0 && F.bid == TP_WG) { __syncthreads(); const unsigned long long t0 = __builtin_amdgcn_s_memrealtime(); const unsigned long long w = MISC[20]; while (__builtin_amdgcn_s_memrealtime() - t0 < w) __builtin_amdgcn_s_sleep(8); }
#undef IN
#undef PHASE
#undef SEAM
}

extern "C" void kernel_launch(void* const* d_in, const int* in_sizes, int n_in, void* d_out, int out_size, void* d_ws, size_t ws_size, hipStream_t stream) {
    static int grid = 0;
    if (grid == 0) {
        if (n_in != 36 || out_size != M * D || ws_size < WS_END) { fprintf(stderr, "kernel_launch: unexpected problem (n_in %d out %d ws %zu, need %zu)\n", n_in, out_size, ws_size, (size_t)WS_END); grid = -1; return; }
        int dev = 0, cus = 0;
        if (hipGetDevice(&dev) != hipSuccess || hipDeviceGetAttribute(&cus, hipDeviceAttributeMultiprocessorCount, dev) != hipSuccess) { grid = -1; return; }
        if (hipFuncSetAttribute((const void*)fwd_kernel, hipFuncAttributeMaxDynamicSharedMemorySize, LDS_BYTES) != hipSuccess) { fprintf(stderr, "kernel_launch: hipFuncSetAttribute failed\n"); grid = -1; return; }
        int per_cu = 0;
        if (hipOccupancyMaxActiveBlocksPerMultiprocessor(&per_cu, (const void*)fwd_kernel, NTHREADS, LDS_BYTES) != hipSuccess || per_cu < 1) { fprintf(stderr, "kernel_launch: occupancy query says %d\n", per_cu); }
        (void)hipGetLastError();
        grid = cus;
    }
    if (grid < 0) return;
    (void)hipMemsetAsync((char*)d_ws + WS_CTL, 0, CTL_BYTES, stream);
    Args a{};
    for (int i = 0; i < 36; ++i) a.in[i] = (const float*)d_in[i];
    a.out = (float*)d_out; a.ws = (unsigned char*)d_ws; a.pad = 0;
#if ONE_LAUNCH
    a.f_lo = 0; a.f_hi = 4; a.g_lo = 0; a.g_hi = NGRP; a.ph_lo = 0; a.ph_hi = PH_N; a.use_bar = 1;
    hipLaunchKernelGGL(fwd_kernel, dim3(grid), dim3(NTHREADS), LDS_BYTES, stream, a);
#else
    a.use_bar = 0;
    for (int f = 0; f < 4; ++f) {
        a.f_lo = f; a.f_hi = f + 1;
        for (int ph = PH_W; ph <= PH_A3; ++ph) {
            if (ph == PH_W && (f & 1)) continue;
            a.ph_lo = ph; a.ph_hi = ph + 1; a.g_lo = 0; a.g_hi = 0;
            hipLaunchKernelGGL(fwd_kernel, dim3(grid), dim3(NTHREADS), LDS_BYTES, stream, a);
        }
        if ((f & 1) == 0)
            for (int g = 0; g < NGRP; ++g)
                for (int ph = PH_B1; ph <= PH_B8; ++ph) { a.ph_lo = ph; a.ph_hi = ph + 1; a.g_lo = g; a.g_hi = g + 1;
                    hipLaunchKernelGGL(fwd_kernel, dim3(grid), dim3(NTHREADS), LDS_BYTES, stream, a); }
    }
    a.f_lo = 0; a.f_hi = 0; a.g_lo = 0; a.g_hi = 0; a.ph_lo = PH_FIN; a.ph_hi = PH_FIN + 1;
    hipLaunchKernelGGL(fwd_kernel, dim3(grid), dim3(NTHREADS), LDS_BYTES, stream, a);
#endif
}
```

```cpp
#include <hip/hip_runtime.h>
#include <cstdio>
#include <cstdint>

#ifndef RWKV_DEBUG
#define RWKV_DEBUG 0
#endif
#ifndef GATES_A
#define GATES_A 1
#endif
#ifndef ONE_LAUNCH
#define ONE_LAUNCH 1
#endif

#define GAS __attribute__((address_space(1)))
#define LAS __attribute__((address_space(3)))
typedef unsigned short bf16;
typedef unsigned v4u __attribute__((ext_vector_type(4)));
typedef unsigned v2u __attribute__((ext_vector_type(2)));
typedef float f32x4 __attribute__((ext_vector_type(4)));
typedef float f32x2 __attribute__((ext_vector_type(2)));
typedef short bf16x8 __attribute__((ext_vector_type(8)));
#define DI __device__ __forceinline__

constexpr int D = 1024, NB = 16, T = 2048, M = NB * T, DFF = 2816, NUP = 2 * DFF;
constexpr int GB = 4, MG = GB * T, NGRP = NB / GB;
constexpr int NZ = 9472;
constexpr int ZC_MLX = 0, ZC_MLO = 1024, ZC_RW = 2048, ZC_HGQ = 5376, ZC_HGF = 6400, ZC_HGI = 7424, ZC_HGG = 8448;
constexpr int ZC_GATE = 5376;
constexpr int NWIN = 12544;
constexpr int WIN_SRC = 12552;
constexpr int NSIDE = 40, KLORA = 384, NLORA = 4096, NMOD = 9216;
constexpr int NTHREADS = 512, NWAVES = 8;

constexpr size_t MiB = 1u << 20;
constexpr size_t WS_CTL = 0, CTL_BYTES = 1 * MiB;
constexpr size_t WS_MOD = 1 * MiB;
constexpr size_t WS_WSIDE = 3 * MiB;
constexpr size_t WS_WUP = 4 * MiB;
constexpr size_t WS_WDN = 26 * MiB;
constexpr size_t WS_WIN = 37 * MiB;
constexpr size_t WS_WBR = 62 * MiB;
constexpr size_t WS_WOUT = 68 * MiB;
constexpr size_t WS_WQK = 70 * MiB;
constexpr size_t WS_WLORA = 71 * MiB;
constexpr size_t WS_VF = 74 * MiB;
constexpr size_t WS_ACT = 138 * MiB;
constexpr size_t WS_H = WS_ACT;
constexpr size_t WS_HID = WS_ACT + 64 * MiB;
constexpr size_t WS_HG = WS_ACT;
constexpr size_t WS_Z = WS_ACT + 16 * MiB;
constexpr size_t WS_XC = WS_ACT + 164 * MiB;
constexpr size_t WS_QK = WS_ACT + 180 * MiB;
constexpr size_t WS_LA = WS_ACT + 212 * MiB;
constexpr size_t WS_LO = WS_ACT + 218 * MiB;
constexpr size_t WS_SIDE = WS_ACT + 282 * MiB;
constexpr size_t WS_RAW = WS_ACT + 284 * MiB;
constexpr size_t WS_BON = WS_ACT + 332 * MiB;
constexpr size_t WS_END = WS_ACT + 348 * MiB;
static_assert(WS_HID + (size_t)M * DFF * 2 <= WS_END, "ffn view fits");
static_assert(WS_Z + (size_t)MG * NZ * 2 <= WS_XC, "z fits");

constexpr int CW_BAR = 4096, CW_HGDONE = 16384;

constexpr int LDS_BYTES = 147456;
constexpr int MISC_OFF = LDS_BYTES - 256;

typedef __bf16 bf16x2_t __attribute__((ext_vector_type(2)));
DI unsigned f2bf(float f) { return (unsigned)__builtin_bit_cast(unsigned short, (__bf16)f); }
DI unsigned pk2(float lo, float hi) { const bf16x2_t v = __builtin_convertvector((f32x2){lo, hi}, bf16x2_t); return __builtin_bit_cast(unsigned, v); }
DI float bflo(unsigned w) { return __builtin_bit_cast(float, w << 16); }
DI float bfhi(unsigned w) { return __builtin_bit_cast(float, w & 0xffff0000u); }
DI float bf1(bf16 h) { return __builtin_bit_cast(float, (unsigned)h << 16); }
DI float sigmoidf_(float x) { return __builtin_amdgcn_rcpf(1.0f + __expf(-x)); }
DI float siluf_(float x) { return x * __builtin_amdgcn_rcpf(1.0f + __expf(-x)); }
DI float softplusf_(float x) { return fmaxf(x, 0.f) + __logf(1.0f + __expf(-fabsf(x))); }
template <int CTRL> DI float dppf(float v) { return __builtin_bit_cast(float, __builtin_amdgcn_update_dpp(0, __builtin_bit_cast(int, v), CTRL, 0xF, 0xF, true)); }
DI float sum4(float v) { v += dppf<0xB1>(v); v += dppf<0x4E>(v); return v; }
DI float sum8(float v) { v = sum4(v); v += dppf<0x141>(v); return v; }
DI float sum16(float v) { v = sum8(v); v += dppf<0x140>(v); return v; }
DI float wave_sum(float v) {
    v = sum16(v);
    const float a = __builtin_bit_cast(float, __builtin_amdgcn_readlane(__builtin_bit_cast(int, v), 0)), b = __builtin_bit_cast(float, __builtin_amdgcn_readlane(__builtin_bit_cast(int, v), 16));
    const float c = __builtin_bit_cast(float, __builtin_amdgcn_readlane(__builtin_bit_cast(int, v), 32)), d = __builtin_bit_cast(float, __builtin_amdgcn_readlane(__builtin_bit_cast(int, v), 48));
    return (a + b) + (c + d);
}
#define LDS_WAIT() asm volatile("s_waitcnt lgkmcnt(0)" ::: "memory")
#define VM_WAIT() asm volatile("s_waitcnt vmcnt(0)" ::: "memory")
DI void unpack8(const v4u w, float (&o)[8]) { o[0] = bflo(w.x); o[1] = bfhi(w.x); o[2] = bflo(w.y); o[3] = bfhi(w.y); o[4] = bflo(w.z); o[5] = bfhi(w.z); o[6] = bflo(w.w); o[7] = bfhi(w.w); }
DI void unpack16(const bf16* p, float (&o)[16]) { const v4u a = *(const v4u*)p, b = *(const v4u*)(p + 8);
    o[0] = bflo(a.x); o[1] = bfhi(a.x); o[2] = bflo(a.y); o[3] = bfhi(a.y); o[4] = bflo(a.z); o[5] = bfhi(a.z); o[6] = bflo(a.w); o[7] = bfhi(a.w);
    o[8] = bflo(b.x); o[9] = bfhi(b.x); o[10] = bflo(b.y); o[11] = bfhi(b.y); o[12] = bflo(b.z); o[13] = bfhi(b.z); o[14] = bflo(b.w); o[15] = bfhi(b.w); }
DI void pack16(bf16* p, const float (&o)[16]) { v4u a, b; a.x = pk2(o[0], o[1]); a.y = pk2(o[2], o[3]); a.z = pk2(o[4], o[5]); a.w = pk2(o[6], o[7]);
    b.x = pk2(o[8], o[9]); b.y = pk2(o[10], o[11]); b.z = pk2(o[12], o[13]); b.w = pk2(o[14], o[15]); *(v4u*)p = a; *(v4u*)(p + 8) = b; }
DI v4u pack8(const float (&o)[8]) { v4u w; w.x = pk2(o[0], o[1]); w.y = pk2(o[2], o[3]); w.z = pk2(o[4], o[5]); w.w = pk2(o[6], o[7]); return w; }

#define XB_TMO      128
#define XB_XCNT(j)  (256  + 64 * (j))
#define XB_XSUB(j)  (1280 + 64 * (j))
#define XB_XGEN(j)  (2304 + 64 * (j))
#define XB_TOP      3328
#define XB_TOPGEN   3392
#define XCD_BAR_WORDS 3456
#define XB_SPIN_CAP (1u << 22)
__device__ __forceinline__ unsigned xb_ld(unsigned* p)              { return __hip_atomic_load(p, __ATOMIC_RELAXED, __HIP_MEMORY_SCOPE_AGENT); }
__device__ __forceinline__ unsigned xb_add(unsigned* p, unsigned v) { return __hip_atomic_fetch_add(p, v, __ATOMIC_RELAXED, __HIP_MEMORY_SCOPE_AGENT); }
__device__ __forceinline__ unsigned xb_xcc_id() { return (unsigned)__builtin_amdgcn_s_getreg((3 << 11) | 20) & 0xFu; }
#define XB_SPIN(cond, bar) do { unsigned _sp = 0; while (cond) { __builtin_amdgcn_s_sleep(1); \
    if ((++_sp & 255u) == 0u) { if (xb_ld(&(bar)[XB_TMO])) break; if (_sp > XB_SPIN_CAP) { atomicAdd(&(bar)[XB_TMO], 1u); break; } } } } while (0)
struct XcdBarrier { unsigned* bar; unsigned x; volatile LAS unsigned* st; };
__device__ __forceinline__ XcdBarrier xcd_barrier_post(unsigned* bar, volatile LAS unsigned* st) {
    XcdBarrier b; b.bar = bar; b.x = xb_xcc_id(); b.st = st;
    if (threadIdx.x == 0) (void)xb_add(&bar[XB_XCNT(b.x)], 1u);
    return b;
}
__device__ __forceinline__ void xcd_barrier_complete(unsigned* bar, unsigned x, unsigned& nloc, unsigned& nx) {
    const unsigned G = gridDim.x * gridDim.y * gridDim.z;
    unsigned sum, cnt, mine, sp = 0u;
    for (;;) {
        sum = 0u; cnt = 0u; mine = 0u;
#pragma unroll
        for (unsigned j = 0; j < 16; ++j) { const unsigned c = xb_ld(&bar[XB_XCNT(j)]); sum += c; cnt += (c > 0u) ? 1u : 0u; mine = (j == x) ? c : mine; }
        if (sum == G) break;
        __builtin_amdgcn_s_sleep(1);
        if ((++sp & 255u) == 0u) { if (xb_ld(&bar[XB_TMO])) break; if (sp > XB_SPIN_CAP) { atomicAdd(&bar[XB_TMO], 1u); break; } }
    }
    nloc = mine > 0u ? mine : 1u; nx = cnt > 0u ? cnt : 1u;
}
__device__ __forceinline__ void xcd_barrier(const XcdBarrier& b) {
    asm volatile("s_waitcnt vmcnt(0)" ::: "memory");
    __syncthreads();
    if (threadIdx.x == 0) {
        unsigned* bar = b.bar;
        __builtin_amdgcn_s_waitcnt(0);
        unsigned nloc = b.st[0], nx = b.st[1];
        if (nloc == 0u) { xcd_barrier_complete(bar, b.x, nloc, nx); b.st[0] = nloc; b.st[1] = nx; }
        const unsigned old = xb_add(&bar[XB_XSUB(b.x)], 1u);
        const unsigned gen = old / nloc;
        if (old + 1u == (gen + 1u) * nloc) {
            __builtin_amdgcn_fence(__ATOMIC_RELEASE, "agent");
            asm volatile("s_waitcnt vmcnt(0)" ::: "memory");
            const unsigned og = xb_add(&bar[XB_TOP], 1u);
            const unsigned tg = og / nx;
            if (og + 1u == (tg + 1u) * nx) xb_add(&bar[XB_TOPGEN], 1u);
            else XB_SPIN(xb_ld(&bar[XB_TOPGEN]) == tg, bar);
            __builtin_amdgcn_fence(__ATOMIC_ACQUIRE, "agent");
            xb_add(&bar[XB_XGEN(b.x)], 1u);
            asm volatile("s_waitcnt vmcnt(0)" ::: "memory");
        } else {
            XB_SPIN(xb_ld(&bar[XB_XGEN(b.x)]) == gen, bar);
            __builtin_amdgcn_fence(__ATOMIC_ACQUIRE, "agent");
            asm volatile("s_waitcnt vmcnt(0)" ::: "memory");
        }
    }
    __syncthreads();
}

namespace pg8 {
constexpr int BM = 256, BK = 64, HALF = 128, HTB = HALF * BK * 2, STAGE_BYTES = 8 * HTB, NXCD = 8, WGM = 8;
DI int lds_byte(int r, int c) { const int st = (r >> 4) * 2 + (c >> 5), rr = r & 15, cc = c & 31, ob = rr * 64 + cc * 2; return st * 1024 + (ob ^ (((ob >> 9) & 1) << 5)); }
DI void stage_rc(int b, int& R, int& C) { const int st = b / 1024, sb = b % 1024, swz = sb ^ (((sb >> 9) & 1) << 5); R = (st >> 1) * 16 + swz / 64; C = (st & 1) * 32 + (swz % 64) / 2; }
DI int perm32(int rho) { const int n = rho >> 4, i = rho & 15; return 8 * (i >> 2) + 4 * n + (i & 3); }

struct Unit { int pm, pn, pz; };
struct Gemm { const bf16* A; const bf16* Bt; int K, lda, ldb; size_t a_z, b_z; };

template <int MODE> struct Order {
    int nM, nN, nwg, G, c, L0 = 0, imax = 1 << 30;
    DI void init(int nM_, int nN_, int G_, int c_) { nM = nM_; nN = nN_; nwg = nM * nN; G = G_; c = c_; }
    DI bool next(int i, Unit& u) const {
        const int ii = (MODE == 2) ? i / 3 : i;
        const long L = (long)L0 + (long)ii * G + c; if (ii >= imax || L >= nwg) return false;
        int wgid = (int)L; { const int q = nwg / NXCD, r = nwg % NXCD, xcd = wgid % NXCD, off = wgid / NXCD; wgid = (xcd < r ? xcd * (q + 1) : r * (q + 1) + (xcd - r) * q) + off; }
        const int nig = WGM * nN, gid = wgid / nig, fm = gid * WGM, gsz = (nM - fm) < WGM ? (nM - fm) : WGM;
        u.pm = fm + ((wgid % nig) % gsz); const int pn = (wgid % nig) / gsz;
        if (MODE == 1) { u.pz = pn >> 1; u.pn = pn & 1; } else if (MODE == 2) { u.pz = i - ii * 3; u.pn = pn; } else { u.pz = 0; u.pn = pn; }
        return true;
    }
};

struct EpiBf16 {
    static constexpr bool PERM = true;
    bf16* O; int ldc; int zcols;
    DI void operator()(const f32x4 (&acc)[2][2][4][2], const Unit& u, int wr, int wc, int fr, int fq) const {
        const int row0 = u.pm * BM + wr * 64 + fr; const int col0 = u.pz * zcols + u.pn * BM + wc * 32 + 8 * fq;
#pragma unroll
        for (int ai = 0; ai < 2; ++ai)
#pragma unroll
            for (int m = 0; m < 4; ++m) { bf16* rowp = O + (size_t)(row0 + ai * HALF + m * 16) * ldc + col0;
#pragma unroll
                for (int bj = 0; bj < 2; ++bj) { const f32x4 v0 = acc[ai][bj][m][0], v1 = acc[ai][bj][m][1];
                    v4u w; w.x = pk2(v0[0], v0[1]); w.y = pk2(v0[2], v0[3]); w.z = pk2(v1[0], v1[1]); w.w = pk2(v1[2], v1[3]);
                    *(v4u*)(rowp + bj * HALF) = w; } }
    }
};
struct EpiZ {
    static constexpr bool PERM = true;
    bf16* O; int ldc; const float* lbl;
    DI void operator()(const f32x4 (&acc)[2][2][4][2], const Unit& u, int wr, int wc, int fr, int fq) const {
        const int row0 = u.pm * BM + wr * 64 + fr; const int col0 = u.pn * BM + wc * 32 + 8 * fq;
        const int kind = (u.pn >= ZC_HGQ / 256 && u.pn < ZC_HGF / 256) ? 1 : ((u.pn >= ZC_HGF / 256 && u.pn < ZC_HGI / 256) ? 2 : 0);
        float lb[2][8];
#pragma unroll
        for (int bj = 0; bj < 2; ++bj)
#pragma unroll
            for (int j = 0; j < 8; ++j) lb[bj][j] = 0.f;
        if (kind == 2 && lbl) {
#pragma unroll
            for (int bj = 0; bj < 2; ++bj) { const float* p0 = lbl + (col0 + bj * HALF - ZC_HGF);
#pragma unroll
                for (int j = 0; j < 8; ++j) lb[bj][j] = sigmoidf_(p0[D + j] - p0[j]); } }
#pragma unroll
        for (int ai = 0; ai < 2; ++ai)
#pragma unroll
            for (int m = 0; m < 4; ++m) { bf16* rowp = O + (size_t)(row0 + ai * HALF + m * 16) * ldc + col0;
#pragma unroll
                for (int bj = 0; bj < 2; ++bj) { float o[8];
#pragma unroll
                    for (int j = 0; j < 8; ++j) { const float x = acc[ai][bj][m][j >> 2][j & 3];
                        o[j] = kind == 0 ? x : (kind == 1 ? siluf_(x) : __logf(fmaxf(lb[bj][j] + (1.0f - lb[bj][j]) * sigmoidf_(x), 1e-30f))); }
                    *(v4u*)(rowp + bj * HALF) = pack8(o); } }
    }
};
struct EpiLora {
    static constexpr bool PERM = true;
    bf16* O; int ldc; const float* w0; const float* a0; const float* v0;
    DI void operator()(const f32x4 (&acc)[2][2][4][2], const Unit& u, int wr, int wc, int fr, int fq) const {
        const int row0 = u.pm * BM + wr * 64 + fr; const int col0 = u.pn * BM + wc * 32 + 8 * fq;
        const int kind = u.pn >> 2;
        const int cc = col0 & 1023;
#pragma unroll
        for (int bj = 0; bj < 2; ++bj) {
            f32x4 c0 = (f32x4){0.f, 0.f, 0.f, 0.f}, c1 = c0;
            if (kind == 0) { c0 = *(const f32x4*)(w0 + cc + bj * HALF); c1 = *(const f32x4*)(w0 + cc + bj * HALF + 4); }
            if (kind == 1) { c0 = *(const f32x4*)(a0 + cc + bj * HALF); c1 = *(const f32x4*)(a0 + cc + bj * HALF + 4); }
            if (kind == 3) { c0 = *(const f32x4*)(v0 + cc + bj * HALF); c1 = *(const f32x4*)(v0 + cc + bj * HALF + 4); }
#pragma unroll
            for (int ai = 0; ai < 2; ++ai)
#pragma unroll
                for (int m = 0; m < 4; ++m) { bf16* rowp = O + (size_t)(row0 + ai * HALF + m * 16) * ldc + col0 + bj * HALF; float o[8];
#pragma unroll
                    for (int j = 0; j < 8; ++j) { const float x = acc[ai][bj][m][j >> 2][j & 3] + (j < 4 ? c0[j & 3] : c1[j & 3]);
                        o[j] = kind == 2 ? x : (kind == 0 ? -__expf(-softplusf_(-x) - 0.5f) : sigmoidf_(x)); }
                    *(v4u*)rowp = pack8(o); }
        }
    }
};
struct EpiSwiGLU {
    static constexpr bool PERM = true;
    bf16* O; int ldc;
    DI void operator()(const f32x4 (&acc)[2][2][4][2], const Unit& u, int wr, int wc, int fr, int fq) const {
        const int row0 = u.pm * BM + wr * 64 + fr; const int col0 = u.pn * HALF + wc * 32 + 8 * fq;
#pragma unroll
        for (int ai = 0; ai < 2; ++ai)
#pragma unroll
            for (int m = 0; m < 4; ++m) { bf16* rowp = O + (size_t)(row0 + ai * HALF + m * 16) * ldc + col0;
                float o[8];
#pragma unroll
                for (int n = 0; n < 2; ++n)
#pragma unroll
                    for (int j = 0; j < 4; ++j) { const float a = acc[ai][0][m][n][j], b = acc[ai][1][m][n][j]; o[n * 4 + j] = a * b * __builtin_amdgcn_rcpf(1.0f + __expf(-a)); }
                *(v4u*)rowp = pack8(o); }
    }
};
struct EpiResid {
    static constexpr bool PERM = false;
    const float* xin; float* xout; const float* gate; float mul; int b0;
    DI void operator()(const f32x4 (&acc)[2][2][4][2], const Unit& u, int wr, int wc, int fr, int fq) const {
        const int row0 = u.pm * BM + wr * 64 + fr, col0 = u.pn * BM + wc * 32 + 4 * fq;
        const float* gp = gate + (size_t)(b0 + (u.pm * BM) / T) * NMOD + col0;
        f32x4 cf[2][2];
#pragma unroll
        for (int bj = 0; bj < 2; ++bj)
#pragma unroll
            for (int n = 0; n < 2; ++n) cf[bj][n] = (*(const f32x4*)(gp + bj * HALF + n * 16) + 1.0f) * mul;
#pragma unroll
        for (int ai = 0; ai < 2; ++ai)
#pragma unroll
            for (int m = 0; m < 4; ++m) { const size_t off = (size_t)(row0 + ai * HALF + m * 16) * D + col0;
#pragma unroll
                for (int bj = 0; bj < 2; ++bj)
#pragma unroll
                    for (int n = 0; n < 2; ++n) { const f32x4 xi = *(const f32x4*)(xin + off + bj * HALF + n * 16);
                        *(f32x4*)(xout + off + bj * HALF + n * 16) = xi + cf[bj][n] * acc[ai][bj][m][n]; }
                asm volatile("" ::: "memory"); }
    }
};
struct EpiBranch {
    static constexpr bool PERM = false;
    const bf16* gates; int ldg; float* mixf; bf16* mixb;
    DI void operator()(const f32x4 (&acc)[2][2][4][2], const Unit& u, int wr, int wc, int fr, int fq) const {
        const int row0 = u.pm * BM + wr * 64 + fr, col0 = u.pn * BM + wc * 32 + 4 * fq;
#pragma unroll
        for (int ai = 0; ai < 2; ++ai)
#pragma unroll
            for (int m = 0; m < 4; ++m) { const int row = row0 + ai * HALF + m * 16; const size_t off = (size_t)row * D + col0; const bf16* gp = gates + (size_t)row * ldg + u.pz * D + col0;
#pragma unroll
                for (int bj = 0; bj < 2; ++bj)
#pragma unroll
                    for (int n = 0; n < 2; ++n) { const v2u gw = *(const v2u*)(gp + bj * HALF + n * 16);
                        f32x4 g; g[0] = sigmoidf_(bflo(gw.x)); g[1] = sigmoidf_(bfhi(gw.x)); g[2] = sigmoidf_(bflo(gw.y)); g[3] = sigmoidf_(bfhi(gw.y));
                        f32x4 v = g * acc[ai][bj][m][n];
                        if (u.pz > 0) v += *(const f32x4*)(mixf + off + bj * HALF + n * 16);
                        if (u.pz < 2) *(f32x4*)(mixf + off + bj * HALF + n * 16) = v;
                        else { v2u w; w.x = pk2(v[0], v[1]); w.y = pk2(v[2], v[3]); *(v2u*)(mixb + off + bj * HALF + n * 16) = w; } }
                asm volatile("" ::: "memory"); }
    }
};

template <class Epi, class Sched>
DI void gemm_phase(LAS unsigned char* lds, const Gemm g, const Sched& S, const Epi& E, int tid_) {
    asm volatile("" : "+v"(tid_));
    const int tid = tid_, wid = __builtin_amdgcn_readfirstlane(tid >> 6), lane = tid & 63, wr = wid >> 2, wc = wid & 3, fr = lane & 15, fq = lane >> 4;
    int K_ = g.K; asm volatile("" : "+s"(K_));
    const int K = K_, nt = K / BK;
    unsigned voffA[2], voffB[2];
#pragma unroll
    for (int i = 0; i < 2; ++i) { int R, C; stage_rc(tid * 16 + i * 8192, R, C); const int Rb = Epi::PERM ? ((R & ~31) + perm32(R & 31)) : R;
        voffA[i] = (unsigned)(R * g.lda + C) * 2u; voffB[i] = (unsigned)(Rb * g.ldb + C) * 2u; }
    const size_t kstep = (size_t)(BK * 2);
    const size_t hstepA = (size_t)HALF * g.lda * 2, hstepB = (size_t)HALF * g.ldb * 2;
    const size_t tstepA = 2 * hstepA, tstepB = 2 * hstepB;
    const unsigned ldsw = (unsigned)wid * 1024u;
    const int aoff = lds_byte(wr * 64 + fr, fq * 8), boff = lds_byte(wc * 32 + fr, fq * 8);
#define PG8_SA(b, h) (((b) * 2 + (h)) * HTB)
#define PG8_SB(b, h) ((4 + (b) * 2 + (h)) * HTB)
#define PG8_STAGE(bufoff, gbase, voff) do { _Pragma("unroll") for (int _i = 0; _i < 2; ++_i) \
        __builtin_amdgcn_global_load_lds((const unsigned*)((const char*)(gbase) + (voff)[_i]), (LAS unsigned*)(lds + (bufoff) + ldsw + _i * 8192), 16, 0, 0); } while (0)
#define PG8_LDA(dst, b, h) do { _Pragma("unroll") for (int m = 0; m < 4; ++m) _Pragma("unroll") for (int k = 0; k < 2; ++k) dst[m][k] = *(const LAS bf16x8*)(lds + PG8_SA(b, h) + aoff + m * 2048 + k * 1024); } while (0)
#define PG8_LDB(dst, b, h) do { _Pragma("unroll") for (int n = 0; n < 2; ++n) _Pragma("unroll") for (int k = 0; k < 2; ++k) dst[n][k] = *(const LAS bf16x8*)(lds + PG8_SB(b, h) + boff + n * 2048 + k * 1024); } while (0)
#define PG8_MMA(ai, bj, At, Bt) do { __builtin_amdgcn_s_setprio(1); _Pragma("unroll") for (int m = 0; m < 4; ++m) _Pragma("unroll") for (int n = 0; n < 2; ++n) _Pragma("unroll") for (int k = 0; k < 2; ++k) \
        acc[ai][bj][m][n] = __builtin_amdgcn_mfma_f32_16x16x32_bf16(Bt[n][k], At[m][k], acc[ai][bj][m][n], 0, 0, 0); __builtin_amdgcn_s_setprio(0); } while (0)
#define PG8_WAIT_V(n) asm volatile("s_waitcnt vmcnt(" #n ")" ::: "memory")
#define PG8_WAIT_L(n) asm volatile("s_waitcnt lgkmcnt(" #n ")" ::: "memory")
#define PG8_BAR __builtin_amdgcn_s_barrier()
#define PG8_SCHED __builtin_amdgcn_sched_barrier(0)
    Unit cur, nxt; int ui = 0;
    if (!S.next(0, cur)) return;
    f32x4 acc[2][2][4][2];
#pragma unroll
    for (int a = 0; a < 2; ++a)
#pragma unroll
        for (int b = 0; b < 2; ++b)
#pragma unroll
            for (int m = 0; m < 4; ++m)
#pragma unroll
                for (int n = 0; n < 2; ++n) acc[a][b][m][n] = (f32x4){0.f, 0.f, 0.f, 0.f};
    bf16x8 At[4][2], B0[2][2], B1[2][2];
    const char* cA = (const char*)(g.A + (size_t)cur.pz * g.a_z) + (size_t)cur.pm * tstepA; const char* cB = (const char*)(g.Bt + (size_t)cur.pz * g.b_z) + (size_t)cur.pn * tstepB;
    PG8_STAGE(PG8_SB(0, 0), cB, voffB); PG8_STAGE(PG8_SB(0, 1), cB + hstepB, voffB); PG8_STAGE(PG8_SA(0, 0), cA, voffA); PG8_STAGE(PG8_SA(0, 1), cA + hstepA, voffA);
    if (wr == 1) PG8_BAR;
    PG8_WAIT_V(2); PG8_BAR;
    PG8_STAGE(PG8_SB(1, 0), cB + kstep, voffB); PG8_STAGE(PG8_SA(1, 0), cA + kstep, voffA); PG8_STAGE(PG8_SB(1, 1), cB + hstepB + kstep, voffB);
    PG8_WAIT_V(6); PG8_BAR;
    for (;;) {
        const bool has_next = S.next(ui + 1, nxt);
        const char* nA = has_next ? (const char*)(g.A + (size_t)nxt.pz * g.a_z) + (size_t)nxt.pm * tstepA : cA; const char* nB = has_next ? (const char*)(g.Bt + (size_t)nxt.pz * g.b_z) + (size_t)nxt.pn * tstepB : cB;
        for (int t = 0; t < nt; t += 2) {
            const bool last = (t == nt - 2);
            const char* a1 = cA + (size_t)(t + 1) * kstep;
            const char* a2 = last ? nA : cA + (size_t)(t + 2) * kstep; const char* b2 = last ? nB : cB + (size_t)(t + 2) * kstep;
            const char* a3 = a2 + kstep; const char* b3 = b2 + kstep;
            PG8_LDB(B0, 0, 0); PG8_LDB(B1, 0, 1); PG8_SCHED; PG8_LDA(At, 0, 0); PG8_STAGE(PG8_SA(1, 1), a1 + hstepA, voffA);
            PG8_WAIT_V(8); PG8_WAIT_L(0); PG8_BAR; PG8_MMA(0, 0, At, B0); PG8_MMA(0, 1, At, B1); PG8_BAR; PG8_SCHED;
            PG8_LDA(At, 0, 1); PG8_STAGE(PG8_SB(0, 0), b2, voffB); PG8_STAGE(PG8_SB(0, 1), b2 + hstepB, voffB); PG8_STAGE(PG8_SA(0, 0), a2, voffA);
            PG8_WAIT_V(8); PG8_WAIT_L(0); PG8_BAR; PG8_MMA(1, 0, At, B0); PG8_MMA(1, 1, At, B1); PG8_BAR; PG8_SCHED;
            PG8_LDB(B0, 1, 0); PG8_LDB(B1, 1, 1); PG8_SCHED; PG8_LDA(At, 1, 0); PG8_STAGE(PG8_SA(0, 1), a2 + hstepA, voffA);
            PG8_WAIT_V(8); PG8_WAIT_L(0); PG8_BAR; PG8_MMA(0, 0, At, B0); PG8_MMA(0, 1, At, B1); PG8_BAR; PG8_SCHED;
            PG8_LDA(At, 1, 1); PG8_STAGE(PG8_SB(1, 0), b3, voffB); PG8_STAGE(PG8_SB(1, 1), b3 + hstepB, voffB); PG8_STAGE(PG8_SA(1, 0), a3, voffA);
            PG8_WAIT_V(8); PG8_WAIT_L(0); PG8_BAR; PG8_MMA(1, 0, At, B0); PG8_MMA(1, 1, At, B1); PG8_BAR; PG8_SCHED;
        }
        if (wr == 0) PG8_BAR;
        E(acc, cur, wr, wc, fr, fq);
        if (!has_next) break;
#pragma unroll
        for (int a = 0; a < 2; ++a)
#pragma unroll
            for (int b = 0; b < 2; ++b)
#pragma unroll
                for (int m = 0; m < 4; ++m)
#pragma unroll
                    for (int n = 0; n < 2; ++n) acc[a][b][m][n] = (f32x4){0.f, 0.f, 0.f, 0.f};
        cur = nxt; cA = nA; cB = nB; ++ui;
        if (wr == 1) PG8_BAR;
    }
    PG8_WAIT_V(0);
    PG8_BAR;
#undef PG8_SA
#undef PG8_SB
#undef PG8_STAGE
#undef PG8_LDA
#undef PG8_LDB
#undef PG8_MMA
#undef PG8_WAIT_V
#undef PG8_WAIT_L
#undef PG8_BAR
#undef PG8_SCHED
}
}

struct Args {
    const float* in[36]; float* out; unsigned char* ws;
    int f_lo, f_hi, g_lo, g_hi, ph_lo, ph_hi, use_bar, pad;
};
struct Ctx {
    LAS unsigned char* lds;
    const float* const* in; float* out; unsigned char* ws;
    int tid, lane, wave, bid, G, z;
};
DI void refresh(Ctx& F) {
    { int z_ = 0; asm volatile("" : "+s"(z_)); F.z = z_; }
    asm volatile("" : "+v"(F.tid)); F.lane = F.tid & 63; F.wave = __builtin_amdgcn_readfirstlane(F.tid >> 6);
}
enum { I_X = 0, I_C, I_NORMW, I_FNORMW, I_ADAW, I_ADAB, I_FUP, I_FDN, I_WIN, I_WINV, I_CONVW, I_CONVB, I_WQ, I_WK, I_IB, I_FB, I_MLNW, I_MLSKIP,
       I_MU, I_MUV, I_W0, I_W2, I_A0, I_A2, I_V0, I_V2, I_G2, I_KK, I_KA, I_RK, I_LNW, I_LNB, I_LBL, I_HGNW, I_WBR, I_WOUT };

DI void transpose_item(const float* W, int ldw, int k0, int c0, bf16* WT, int ldt, int r0, float scale, LAS float* scr, int lane) {
    float tv[32];
#pragma unroll
    for (int i = 0; i < 32; ++i) tv[i] = W[(size_t)(k0 + 2 * i + (lane >> 5)) * ldw + c0 + (lane & 31)];
#pragma unroll
    for (int i = 0; i < 32; ++i) scr[(2 * i + (lane >> 5)) * 33 + (lane & 31)] = tv[i];
    LDS_WAIT(); asm volatile("" ::: "memory");
    const int c = lane & 7;
#pragma unroll
    for (int j = 0; j < 4; ++j) { const int n = (lane >> 3) + 8 * j; const LAS float* s = scr + (8 * c) * 33 + n;
        v4u o; o.x = pk2(s[0 * 33] * scale, s[1 * 33] * scale); o.y = pk2(s[2 * 33] * scale, s[3 * 33] * scale); o.z = pk2(s[4 * 33] * scale, s[5 * 33] * scale); o.w = pk2(s[6 * 33] * scale, s[7 * 33] * scale);
        *(v4u*)(WT + (size_t)(r0 + n) * ldt + k0 + 8 * c) = o; }
    LDS_WAIT(); asm volatile("" ::: "memory");
}
DI void phase_weights(const Ctx& F, int l) {
    LAS float* scr = (LAS float*)(F.lds + F.wave * 16384);
    const int gw = F.bid * NWAVES + F.wave, NGW = F.G * NWAVES;
    constexpr int I_UP = 16 * 176, I_DN = 44 * 32, I_IN = 16 * 392, I_SQ = 16 * 32, I_QKI = 8 * 32;
    constexpr int NITEMS = 2 * I_UP + 2 * I_DN + I_IN + 4 * I_SQ + I_QKI;
    bf16* WUP = (bf16*)(F.ws + WS_WUP); bf16* WDN = (bf16*)(F.ws + WS_WDN); bf16* WIN = (bf16*)(F.ws + WS_WIN); bf16* WBR = (bf16*)(F.ws + WS_WBR);
    bf16* WOUT = (bf16*)(F.ws + WS_WOUT); bf16* WQK = (bf16*)(F.ws + WS_WQK);
    for (int it = gw; it < NITEMS; it += NGW) {
        int r = it;
        if (r < 2 * I_UP) { const int i = r / I_UP; r -= i * I_UP; const int kb = r / 176, nb = r % 176, c0 = 32 * nb; const int cc = c0 < DFF ? c0 : c0 - DFF;
            const int r0 = (cc / 128) * 256 + (c0 < DFF ? 0 : 128) + (cc % 128);
            transpose_item(F.in[F.z + I_FUP] + (size_t)(l * 2 + i) * D * NUP, NUP, 64 * kb, c0, WUP + (size_t)i * NUP * D, D, r0, 1.f, scr, F.lane); continue; }
        r -= 2 * I_UP;
        if (r < 2 * I_DN) { const int i = r / I_DN; r -= i * I_DN; const int kb = r / 32, nb = r % 32;
            transpose_item(F.in[F.z + I_FDN] + (size_t)(l * 2 + i) * DFF * D, D, 64 * kb, 32 * nb, WDN + (size_t)i * D * DFF, DFF, 32 * nb, 1.f, scr, F.lane); continue; }
        r -= 2 * I_DN;
        if (r < I_IN) { const int kb = r / 392, nb = r % 392, d0 = 32 * nb, c0 = d0 + (d0 >= 2048 ? 8 : 0);
            transpose_item(F.in[F.z + I_WIN] + (size_t)l * D * WIN_SRC, WIN_SRC, 64 * kb, c0, WIN, D, d0, 1.f, scr, F.lane); continue; }
        r -= I_IN;
        if (r < 3 * I_SQ) { const int n = r / I_SQ; r -= n * I_SQ; const int kb = r / 32, nb = r % 32;
            transpose_item(F.in[F.z + I_WBR] + (size_t)(l * 3 + n) * D * D, D, 64 * kb, 32 * nb, WBR + (size_t)n * D * D, D, 32 * nb, 1.f, scr, F.lane); continue; }
        r -= 3 * I_SQ;
        if (r < I_SQ) { const int kb = r / 32, nb = r % 32;
            transpose_item(F.in[F.z + I_WOUT] + (size_t)l * D * D, D, 64 * kb, 32 * nb, WOUT, D, 32 * nb, 1.f, scr, F.lane); continue; }
        r -= I_SQ;
        { const int mat = r / 32, rr = r % 32, h = mat >> 1, isk = mat & 1, kb = rr / 8, nb = rr % 8;
            transpose_item(F.in[F.z + isk ? I_WK : I_WQ] + (size_t)(l * 4 + h) * 256 * 256, 256, 64 * kb, 32 * nb, WQK + (size_t)(h * 512 + isk * 256) * 256, 256, 32 * nb, isk ? 0.0625f : 1.f, scr, F.lane); }
    }
    const int gt = F.bid * NTHREADS + F.tid, NT = F.G * NTHREADS;
    bf16* WL = (bf16*)(F.ws + WS_WLORA);
    for (int idx = gt; idx < NLORA * (KLORA / 8); idx += NT) {
        const int n = idx & (NLORA - 1), kc = idx >> 12, k0 = kc * 8, blk = n >> 10, nn = n & 1023;
        float o[8];
#pragma unroll
        for (int i = 0; i < 8; ++i) o[i] = 0.f;
        const float* src = nullptr; int kk = 0;
        if (blk == 0 && k0 < 64) { src = F.in[F.z + I_W2] + (size_t)l * 64 * D; kk = k0; }
        else if (blk == 1 && k0 >= 64 && k0 < 128) { src = F.in[F.z + I_A2] + (size_t)l * 64 * D; kk = k0 - 64; }
        else if (blk == 2 && k0 >= 128 && k0 < 256) { src = F.in[F.z + I_G2] + (size_t)l * 128 * D; kk = k0 - 128; }
        else if (blk == 3 && l == 1 && k0 >= 256 && k0 < 288) { src = F.in[F.z + I_V2]; kk = k0 - 256; }
        if (src) {
#pragma unroll
            for (int i = 0; i < 8; ++i) o[i] = src[(size_t)(kk + i) * D + nn]; }
        *(v4u*)(WL + (size_t)n * KLORA + k0) = pack8(o);
    }
    float* WS_ = (float*)(F.ws + WS_WSIDE);
    for (int idx = gt; idx < NSIDE * D; idx += NT) {
        const int j = idx >> 10, k = idx & 1023; float v = 0.f;
        if (j < 8) v = F.in[F.z + I_WIN][(size_t)l * D * WIN_SRC + (size_t)k * WIN_SRC + 2048 + j];
        else if (l == 1) v = F.in[F.z + I_WINV][(size_t)k * 32 + (j - 8)];
        WS_[idx] = v;
    }
}
DI void phase_mod(const Ctx& F) {
    LAS float* sc = (LAS float*)F.lds; LAS float* red = (LAS float*)(F.lds + 65536);
    float* mod = (float*)(F.ws + WS_MOD);
    bool loaded = false;
    for (int it = F.bid; it < 2 * 144; it += F.G) {
        if (!loaded) { for (int i = F.tid; i < NB * D; i += NTHREADS) sc[i] = siluf_(F.in[F.z + I_C][i]); loaded = true; __syncthreads(); }
        const int l = it / 144, n0 = (it % 144) * 64, n = F.tid & 63, ks = F.tid >> 6;
        float acc[16];
#pragma unroll
        for (int b = 0; b < 16; ++b) acc[b] = 0.f;
        const float* wp = F.in[F.z + I_ADAW] + (size_t)l * D * NMOD + n0 + n;
        for (int k = ks * 128; k < ks * 128 + 128; ++k) { const float w = wp[(size_t)k * NMOD];
#pragma unroll
            for (int b = 0; b < 16; ++b) acc[b] += sc[b * D + k] * w; }
#pragma unroll
        for (int b = 0; b < 16; ++b) red[(ks * 16 + b) * 64 + n] = acc[b];
        __syncthreads();
        for (int o = F.tid; o < 1024; o += NTHREADS) { const int b = o >> 6, nn = o & 63; float s = 0.f;
#pragma unroll
            for (int k8 = 0; k8 < 8; ++k8) s += red[(k8 * 16 + b) * 64 + nn];
            mod[(size_t)(l * 16 + b) * NMOD + n0 + nn] = s + F.in[F.z + I_ADAB][(size_t)l * NMOD + n0 + nn]; }
        __syncthreads();
    }
}

template <bool SIDE>
DI void phase_modulate(const Ctx& F, const float* x, bf16* hout, const float* nw, const float* modl, int sub, int r0, int nrows, float* side, int nside, int wg, int nwg) {
    const int gw = wg * NWAVES + F.wave, NGW = nwg * NWAVES;
    const float* wside = (const float*)(F.ws + WS_WSIDE);
    constexpr int RB = SIDE ? 4 : 1;
    for (int rq = gw; rq < nrows / RB; rq += NGW) {
        const int b = (r0 + rq * RB) / T;
        const f32x4* nwp = (const f32x4*)nw + F.lane;
        const f32x4* shp = (const f32x4*)(modl + (size_t)b * NMOD + (sub * 3 + 0) * D) + F.lane;
        const f32x4* scp = (const f32x4*)(modl + (size_t)b * NMOD + (sub * 3 + 1) * D) + F.lane;
        f32x4 v[RB][4];
#pragma unroll
        for (int i = 0; i < RB; ++i) { const f32x4* xr = (const f32x4*)(x + (size_t)(r0 + rq * RB + i) * D) + F.lane;
#pragma unroll
            for (int j = 0; j < 4; ++j) v[i][j] = xr[64 * j]; }
#pragma unroll
        for (int i = 0; i < RB; ++i) { float ss = 0.f;
#pragma unroll
            for (int j = 0; j < 4; ++j) ss += (v[i][j].x * v[i][j].x + v[i][j].y * v[i][j].y) + (v[i][j].z * v[i][j].z + v[i][j].w * v[i][j].w);
            const float rstd = __builtin_amdgcn_rsqf(wave_sum(ss) * (1.f / D) + 1e-6f);
            unsigned long long* o8 = (unsigned long long*)(hout + (size_t)(rq * RB + i) * D) + F.lane;
#pragma unroll
            for (int j = 0; j < 4; ++j) { v[i][j] = v[i][j] * rstd * nwp[64 * j] * (scp[64 * j] + 1.0f) + shp[64 * j];
                o8[64 * j] = (unsigned long long)pk2(v[i][j].x, v[i][j].y) | ((unsigned long long)pk2(v[i][j].z, v[i][j].w) << 32); } }
        if (SIDE) {
            for (int jj = 0; jj < nside; ++jj) { const f32x4* wp = (const f32x4*)(wside + jj * D) + F.lane; f32x4 w[4];
#pragma unroll
                for (int j = 0; j < 4; ++j) w[j] = wp[64 * j];
                float s[RB];
#pragma unroll
                for (int i = 0; i < RB; ++i) { float a = 0.f;
#pragma unroll
                    for (int j = 0; j < 4; ++j) a += (v[i][j].x * w[j].x + v[i][j].y * w[j].y) + (v[i][j].z * w[j].z + v[i][j].w * w[j].w);
                    s[i] = wave_sum(a); }
#pragma unroll
                for (int i = 0; i < RB; ++i) if (F.lane == i) side[(size_t)(rq * RB + i) * NSIDE + jj] = s[i]; }
        }
    }
}
DI void phase_final_norm(const Ctx& F) {
    const int gw = F.bid * NWAVES + F.wave, NGW = F.G * NWAVES;
    for (int row = gw; row < M; row += NGW) {
        f32x4* xr = (f32x4*)(F.out + (size_t)row * D) + F.lane;
        f32x4 v[4]; float ss = 0.f;
#pragma unroll
        for (int j = 0; j < 4; ++j) { v[j] = xr[64 * j]; ss += (v[j].x * v[j].x + v[j].y * v[j].y) + (v[j].z * v[j].z + v[j].w * v[j].w); }
        const float rstd = 1.0f / sqrtf(wave_sum(ss) * (1.f / D) + 1e-6f);
        const f32x4* nwp = (const f32x4*)F.in[F.z + I_FNORMW] + F.lane;
        float dbg = 1.0f; if (RWKV_DEBUG) { const float* cf = (const float*)(F.ws + WS_CTL) + 32768; dbg = 1.0f + sqrtf(__hip_atomic_load(cf, __ATOMIC_RELAXED, __HIP_MEMORY_SCOPE_AGENT) / fmaxf(__hip_atomic_load(cf + 1, __ATOMIC_RELAXED, __HIP_MEMORY_SCOPE_AGENT), 1e-30f)); }
#pragma unroll
        for (int j = 0; j < 4; ++j) xr[64 * j] = v[j] * rstd * nwp[64 * j] * dbg;
    }
}

DI void phase_prep(const Ctx& F, int l) {
    const int gt = F.bid * NTHREADS + F.tid, NT = F.G * NTHREADS;
    const bf16* Z = (const bf16*)(F.ws + WS_Z); bf16* XC = (bf16*)(F.ws + WS_XC); bf16* LA = (bf16*)(F.ws + WS_LA); const float* SD = (const float*)(F.ws + WS_SIDE);
    const float* cw = F.in[F.z + I_CONVW] + (size_t)l * 4 * D; const float* cb = F.in[F.z + I_CONVB] + (size_t)l * D;
    const float* mu = F.in[F.z + I_MU] + (size_t)l * 3328;
    for (int idx = gt; idx < (MG / 8) * 128; idx += NT) {
        const int rb = idx >> 7, c8 = (idx & 127) * 8, row0 = rb * 8, t0 = row0 & (T - 1);
        float wv[4][8], bv[8];
#pragma unroll
        for (int i = 0; i < 8; ++i) bv[i] = cb[c8 + i];
#pragma unroll
        for (int j = 0; j < 4; ++j)
#pragma unroll
            for (int i = 0; i < 8; ++i) wv[j][i] = cw[j * D + c8 + i];
        v4u zr[11];
#pragma unroll
        for (int r = 0; r < 11; ++r) zr[r] = (r >= 3 || t0 > 0) ? *(const v4u*)(Z + (size_t)(row0 - 3 + r) * NZ + ZC_MLX + c8) : (v4u){0u, 0u, 0u, 0u};
#pragma unroll
        for (int r = 0; r < 8; ++r) { float a[8], x[8];
#pragma unroll
            for (int i = 0; i < 8; ++i) a[i] = bv[i];
#pragma unroll
            for (int j = 0; j < 4; ++j) { unpack8(zr[r + j], x);
#pragma unroll
                for (int i = 0; i < 8; ++i) a[i] += wv[j][i] * x[i]; }
#pragma unroll
            for (int i = 0; i < 8; ++i) a[i] = siluf_(a[i]);
            *(v4u*)(XC + (size_t)(row0 + r) * D + c8) = pack8(a); }
    }
    for (int idx = gt; idx < MG * 48; idx += NT) {
        const int row = idx / 48, k0 = (idx - row * 48) * 8, t = row & (T - 1);
        float o[8];
#pragma unroll
        for (int i = 0; i < 8; ++i) o[i] = 0.f;
        if (k0 < 256) { float cur[8], prv[8];
            unpack8(*(const v4u*)(Z + (size_t)row * NZ + ZC_RW + 3072 + k0), cur);
            if (t > 0) unpack8(*(const v4u*)(Z + (size_t)(row - 1) * NZ + ZC_RW + 3072 + k0), prv); else {
#pragma unroll
                for (int i = 0; i < 8; ++i) prv[i] = 0.f; }
#pragma unroll
            for (int i = 0; i < 8; ++i) { const float s = cur[i] + mu[3072 + k0 + i] * (prv[i] - cur[i]); o[i] = k0 < 64 ? tanhf(s) : (k0 < 128 ? s : sigmoidf_(s)); }
        } else if (l == 1 && k0 < 288) {
#pragma unroll
            for (int i = 0; i < 8; ++i) { const int j = k0 - 256 + i; const float cur = SD[(size_t)row * NSIDE + 8 + j], prv = t > 0 ? SD[(size_t)(row - 1) * NSIDE + 8 + j] : 0.f;
                o[i] = cur + F.in[F.z + I_MUV][j] * (prv - cur); }
        }
        *(v4u*)(LA + (size_t)row * KLORA + k0) = pack8(o);
    }
}

DI void scan_writeout(const Ctx& F, const LAS float* YT, bf16* dst  , int ld) {
    const int s = F.tid >> 4, r2 = (F.tid & 15) * 2;
    *(unsigned*)(dst + (size_t)s * ld + r2) = pk2(YT[s * 32 + r2], YT[s * 32 + r2 + 1]);
}
typedef short s16x4 __attribute__((ext_vector_type(4)));
DI bf16x8 tr8(const LAS unsigned char* p0, const LAS unsigned char* p1) {
    const s16x4 lo = __builtin_amdgcn_ds_read_tr16_b64_v4i16((LAS s16x4*)p0), hi = __builtin_amdgcn_ds_read_tr16_b64_v4i16((LAS s16x4*)p1);
    return (bf16x8){lo[0], lo[1], lo[2], lo[3], hi[0], hi[1], hi[2], hi[3]};
}
DI float wave_incl_sum(float v, int lane) {
#pragma unroll
    for (int o = 1; o < 64; o <<= 1) { const float t = __shfl_up(v, o); if (lane >= o) v += t; }
    return v;
}
DI float wave_incl_max(float v, int lane) {
#pragma unroll
    for (int o = 1; o < 64; o <<= 1) { const float t = __shfl_up(v, o); if (lane >= o) v = fmaxf(v, t); }
    return v;
}
#define WG_SYNC() do { asm volatile("s_waitcnt lgkmcnt(0)" ::: "memory"); __builtin_amdgcn_s_barrier(); asm volatile("" ::: "memory"); } while (0)
DI void scan_mlstm_mfma(const Ctx& F, int l, int unit) {
    constexpr int QP = 528, PP = 144, VP = 96;
    constexpr int O_QS = 0, O_KS = 33792, O_CB = 67584, O_PS = 92928, O_VS = 102144, O_GT = 108288, O_GA = 110336;
    const int e8 = unit & 7, h = (unit >> 3) & 3, bl = unit >> 5;
    LAS unsigned char* Qs = F.lds + O_QS; LAS unsigned char* Ks = F.lds + O_KS; LAS unsigned char* Cb = F.lds + O_CB; LAS unsigned char* Ps = F.lds + O_PS; LAS unsigned char* Vs = F.lds + O_VS;
    LAS float* RT = (LAS float*)(F.lds + O_GT); LAS float* CS = RT + 64; LAS float* WI = RT + 128; LAS float* EM = RT + 192; LAS float* WS = RT + 256; LAS float* SC = RT + 320;
    LAS float* GBC = (LAS float*)(F.lds + O_GA); LAS float* GCS = GBC + 2048; LAS float* GPM = GBC + 4096; LAS float* GMP = GBC + 6144;
    const bf16* QKp = (const bf16*)(F.ws + WS_QK) + (size_t)bl * T * 2048 + h * 512;
    const bf16* Vp = (const bf16*)(F.ws + WS_Z) + (size_t)bl * T * NZ + ZC_MLX + h * 256 + e8 * 32;
    const float* SD = (const float*)(F.ws + WS_SIDE) + (size_t)bl * T * NSIDE;
    bf16* OUT = (bf16*)(F.ws + WS_RAW) + (size_t)bl * T * D + h * 256 + e8 * 32;
    const float ib = F.in[F.z + I_IB][l * 4 + h], fb = F.in[F.z + I_FB][l * 4 + h];
    const int tid = F.tid, lane = F.lane, w = F.wave, g = lane >> 4, r = lane & 15, q = r >> 2, p = lane & 3;
    const int srow = tid >> 3, scj = tid & 7, vrow = tid >> 2, vc = tid & 3;
    v4u pq[4], pk[4], pv;
    f32x4 C[2][3];
#pragma unroll
    for (int a = 0; a < 2; ++a)
#pragma unroll
        for (int b = 0; b < 3; ++b) C[a][b] = (f32x4){0.f, 0.f, 0.f, 0.f};
    for (int i = tid; i < 25344 / 16; i += NTHREADS) *(LAS v4u*)(Cb + i * 16) = (v4u){0u, 0u, 0u, 0u};
    if (tid >= 256 && tid < 384) { const int rr = (tid - 256) >> 1, hh = tid & 1; unsigned one2 = 0x3F803F80u; asm volatile("" : "+v"(one2)); *(LAS v4u*)(Vs + rr * VP + 64 + hh * 16) = (v4u){one2, one2, one2, one2}; }
#define ML_LOAD(c) do { \
        _Pragma("unroll") for (int j = 0; j < 4; ++j) { pq[j] = *(const v4u*)(QKp + (size_t)((c) * 64 + srow) * 2048 + (scj + 8 * j) * 8); pk[j] = *(const v4u*)(QKp + (size_t)((c) * 64 + srow) * 2048 + 256 + (scj + 8 * j) * 8); } \
        if (tid < 256) pv = *(const v4u*)(Vp + (size_t)((c) * 64 + vrow) * NZ + vc * 8); \
        } while (0)
#define ML_STORE(cst_) do { \
        _Pragma("unroll") for (int j = 0; j < 4; ++j) { *(LAS v4u*)(Qs + srow * QP + (scj + 8 * j) * 16) = pq[j]; *(LAS v4u*)(Ks + srow * QP + (scj + 8 * j) * 16) = pk[j]; } \
        if (tid < 256) *(LAS v4u*)(Vs + vrow * VP + vc * 16) = pv; \
        if (w == 0) { const float mp = GMP[(cst_)], pm = GPM[(cst_) * 64 + lane], bc = GBC[(cst_) * 64 + lane], cs = GCS[(cst_) * 64 + lane]; const float mx = fmaxf(mp, pm), mx63 = fmaxf(mp, GPM[(cst_) * 64 + 63]); \
            RT[lane] = -mx; CS[lane] = cs; WI[lane] = __expf(mp - mx); EM[lane] = __expf(-(bc + mx)); WS[lane] = __expf(cs - mx63); if (lane == 0) SC[0] = __expf(mp - mx63); } } while (0)
#pragma unroll 1
    for (int cc = w; cc < T / 64; cc += NWAVES) { const float li = SD[(size_t)(cc * 64 + lane) * NSIDE + h] + ib, lf = -softplusf_(-(SD[(size_t)(cc * 64 + lane) * NSIDE + 4 + h] + fb));
        const float bc = wave_incl_sum(lf, lane), cs = li - bc, pm = wave_incl_max(cs, lane);
        GBC[cc * 64 + lane] = bc; GCS[cc * 64 + lane] = cs; GPM[cc * 64 + lane] = pm; }
    WG_SYNC();
    if (tid == 0) { float m = 0.f; for (int cc = 0; cc < T / 64; ++cc) { GMP[cc] = m; m = GBC[cc * 64 + 63] + fmaxf(m, GPM[cc * 64 + 63]); } }
    WG_SYNC();
    ML_LOAD(0); ML_STORE(0);
    WG_SYNC();
    const int tb = w >> 1, wh = w & 1;
    for (int c = 0; c < T / 64; ++c) {
        if (c + 1 < T / 64) ML_LOAD(c + 1);
#pragma unroll
        for (int si = 0; si < 2; ++si) {
            const int sb = wh * 2 + si; const int t = tb * 16 + r, s0 = sb * 16 + 4 * g;
            v2u pw = (v2u){0u, 0u};
            if (sb <= tb) {
                f32x4 acc = (f32x4){0.f, 0.f, 0.f, 0.f};
#pragma unroll
                for (int ks = 0; ks < 8; ++ks) { const bf16x8 a = *(const LAS bf16x8*)(Ks + (sb * 16 + r) * QP + (ks * 32 + 8 * g) * 2), b = *(const LAS bf16x8*)(Qs + (tb * 16 + r) * QP + (ks * 32 + 8 * g) * 2);
                    acc = __builtin_amdgcn_mfma_f32_16x16x32_bf16(a, b, acc, 0, 0, 0); }
                const float rt = RT[t]; const f32x4 cs4 = *(const LAS f32x4*)(CS + s0);
                float o[4];
#pragma unroll
                for (int i = 0; i < 4; ++i) o[i] = (s0 + i <= t) ? acc[i] * __expf(rt + cs4[i]) : 0.f;
                pw.x = pk2(o[0], o[1]); pw.y = pk2(o[2], o[3]);
            }
            *(LAS v2u*)(Ps + t * PP + s0 * 2) = pw;
        }
        { const float gm = SC[0];
#pragma unroll
            for (int a = 0; a < 2; ++a)
#pragma unroll
                for (int b = 0; b < 3; ++b) C[a][b] *= gm;
#pragma unroll
            for (int ks = 0; ks < 2; ++ks) {
                const f32x4 wsA = *(const LAS f32x4*)(WS + ks * 32 + 8 * g), wsB = *(const LAS f32x4*)(WS + ks * 32 + 8 * g + 4);
                bf16x8 bfr[3], afr[2];
#pragma unroll
                for (int et = 0; et < 3; ++et) { const LAS unsigned char* pa = Vs + (ks * 32 + 8 * g + q) * VP + (et * 16 + 4 * p) * 2; const bf16x8 raw = tr8(pa, pa + 4 * VP);
                    const v4u rw = __builtin_bit_cast(v4u, raw); v4u sw;
                    sw.x = pk2(bflo(rw.x) * wsA[0], bfhi(rw.x) * wsA[1]); sw.y = pk2(bflo(rw.y) * wsA[2], bfhi(rw.y) * wsA[3]);
                    sw.z = pk2(bflo(rw.z) * wsB[0], bfhi(rw.z) * wsB[1]); sw.w = pk2(bflo(rw.w) * wsB[2], bfhi(rw.w) * wsB[3]);
                    bfr[et] = __builtin_bit_cast(bf16x8, sw); }
#pragma unroll
                for (int a = 0; a < 2; ++a) { const LAS unsigned char* pa = Ks + (ks * 32 + 8 * g + q) * QP + ((2 * w + a) * 16 + 4 * p) * 2; afr[a] = tr8(pa, pa + 4 * QP); }
#pragma unroll
                for (int a = 0; a < 2; ++a)
#pragma unroll
                    for (int et = 0; et < 3; ++et) C[a][et] = __builtin_amdgcn_mfma_f32_16x16x32_bf16(afr[a], bfr[et], C[a][et], 0, 0, 0);
            } }
        WG_SYNC();
        {
            f32x4 oi[2], oc[2];
#pragma unroll
            for (int j = 0; j < 2; ++j) { oi[j] = (f32x4){0.f, 0.f, 0.f, 0.f}; oc[j] = (f32x4){0.f, 0.f, 0.f, 0.f}; }
#pragma unroll
            for (int ks = 0; ks < 2; ++ks) { const bf16x8 a = *(const LAS bf16x8*)(Ps + (tb * 16 + r) * PP + (ks * 32 + 8 * g) * 2);
#pragma unroll
                for (int j = 0; j < 2; ++j) { const int et = j == 0 ? wh : 2; const LAS unsigned char* pa = Vs + (ks * 32 + 8 * g + q) * VP + (et * 16 + 4 * p) * 2;
                    oi[j] = __builtin_amdgcn_mfma_f32_16x16x32_bf16(a, tr8(pa, pa + 4 * VP), oi[j], 0, 0, 0); } }
#pragma unroll
            for (int ks = 0; ks < 8; ++ks) { const bf16x8 a = *(const LAS bf16x8*)(Qs + (tb * 16 + r) * QP + (ks * 32 + 8 * g) * 2);
#pragma unroll
                for (int j = 0; j < 2; ++j) { const int et = j == 0 ? wh : 2; const bf16x8 b = *(const LAS bf16x8*)(Cb + (et * 16 + r) * QP + (ks * 32 + 8 * g) * 2);
                    oc[j] = __builtin_amdgcn_mfma_f32_16x16x32_bf16(a, b, oc[j], 0, 0, 0); } }
            const f32x4 wi4 = *(const LAS f32x4*)(WI + tb * 16 + 4 * g), em4 = *(const LAS f32x4*)(EM + tb * 16 + 4 * g);
#pragma unroll
            for (int i = 0; i < 4; ++i) { const float num = oi[0][i] + wi4[i] * oc[0][i], den = oi[1][i] + wi4[i] * oc[1][i];
                OUT[(size_t)(c * 64 + tb * 16 + 4 * g + i) * D + wh * 16 + r] = (bf16)f2bf(num / fmaxf(fabsf(den), em4[i])); }
        }
        WG_SYNC();
#pragma unroll
        for (int a = 0; a < 2; ++a)
#pragma unroll
            for (int et = 0; et < 3; ++et) { v2u cw; cw.x = pk2(C[a][et][0], C[a][et][1]); cw.y = pk2(C[a][et][2], C[a][et][3]);
                *(LAS v2u*)(Cb + (et * 16 + r) * QP + ((2 * w + a) * 16 + 4 * g) * 2) = cw; }
        if (c + 1 < T / 64) ML_STORE(c + 1);
        WG_SYNC();
    }
#undef ML_LOAD
#undef ML_STORE
}


DI void scan_hgrn_mfma(const Ctx& F, int l, int unit) {
    constexpr int QP = 272, VP = 80, PP = 80;
    constexpr int O_QA = 0, O_KA = 8704, O_SB = 17408, O_V = 26112, O_P = 28672, O_QT = 31232, O_E15 = 33280, O_GM = 33792, O_HH = 34304;
    const int qt = unit & 3, h = (unit >> 2) & 7, bl = unit >> 5;
    LAS unsigned char* Qa = F.lds + O_QA; LAS unsigned char* Ka = F.lds + O_KA; LAS unsigned char* Sb = F.lds + O_SB; LAS unsigned char* Vs = F.lds + O_V; LAS unsigned char* Ps = F.lds + O_P;
    LAS float* QT = (LAS float*)(F.lds + O_QT); LAS float* E15 = (LAS float*)(F.lds + O_E15); LAS float* GM = (LAS float*)(F.lds + O_GM); LAS float* HH = (LAS float*)(F.lds + O_HH);
    const bf16* Zq = (const bf16*)(F.ws + WS_Z) + (size_t)bl * T * NZ + ZC_HGQ + h * 128;
    const bf16* Zf = (const bf16*)(F.ws + WS_Z) + (size_t)bl * T * NZ + ZC_HGF + h * 128;
    const bf16* Zv = (const bf16*)(F.ws + WS_Z) + (size_t)bl * T * NZ + ZC_HGI + h * 128 + qt * 32;
    bf16* OUT = (bf16*)(F.ws + WS_RAW) + (size_t)2 * MG * D + (size_t)bl * T * D + h * 128 + qt * 32;
    const int tid = F.tid, lane = F.lane, w = F.wave, g = lane >> 4, r = lane & 15, q = r >> 2, p = lane & 3;
    const int pd = tid & 127, tq = tid >> 7;
    const int vrow = tid >> 2, vc = tid & 3;
    bf16 rq[8], rf[8]; v4u pv;
    f32x4 S[2];
    S[0] = (f32x4){0.f, 0.f, 0.f, 0.f}; S[1] = (f32x4){0.f, 0.f, 0.f, 0.f};
#define HG_LOAD(c) do { _Pragma("unroll") for (int i = 0; i < 8; ++i) { rq[i] = Zq[(size_t)((c) * 32 + tq * 8 + i) * NZ + pd]; rf[i] = Zf[(size_t)((c) * 32 + tq * 8 + i) * NZ + pd]; } \
        if (tid < 128) pv = *(const v4u*)(Zv + (size_t)((c) * 32 + vrow) * NZ + vc * 8); } while (0)
    HG_LOAD(0);
    for (int c = 0; c < T / 32; ++c) {
        float qv[8], kv[8], cb[8]; float run = 0.f;
#pragma unroll
        for (int i = 0; i < 8; ++i) { qv[i] = bf1(rq[i]); const float lf = bf1(rf[i]); kv[i] = 1.0f - __expf(lf); run += lf; cb[i] = run; }
        QT[tq * 128 + pd] = run;
        if (tid < 128) *(LAS v4u*)(Vs + vrow * VP + vc * 16) = pv;
        if (c + 1 < T / 32) HG_LOAD(c + 1);
        WG_SYNC();
        { const float q0 = QT[pd], q1 = QT[128 + pd], q2 = QT[256 + pd], q3 = QT[384 + pd];
            const float off = (tq > 0 ? q0 : 0.f) + (tq > 1 ? q1 : 0.f) + (tq > 2 ? q2 : 0.f); const float b15 = q0 + q1, b31 = (q0 + q1) + (q2 + q3);
#pragma unroll
            for (int i = 0; i < 8; ++i) { const float bt = off + cb[i]; const float ea = __expf(fminf(bt - b15, 80.f)), ek = __expf(fminf(b15 - bt, 80.f));
                *(LAS bf16*)(Qa + (tq * 8 + i) * QP + pd * 2) = (bf16)f2bf(qv[i] * ea); *(LAS bf16*)(Ka + (tq * 8 + i) * QP + pd * 2) = (bf16)f2bf(kv[i] * ek); }
            if (tq == 0) { E15[pd] = __expf(b15); GM[pd] = __expf(b31); HH[pd] = __expf(b31 - b15); } }
        WG_SYNC();
        { const f32x4 e4 = *(const LAS f32x4*)(E15 + w * 16 + 4 * g), g4 = *(const LAS f32x4*)(GM + w * 16 + 4 * g), h4 = *(const LAS f32x4*)(HH + w * 16 + 4 * g);
            const LAS unsigned char* pa = Ka + (8 * g + q) * QP + (w * 16 + 4 * p) * 2; const bf16x8 afr = tr8(pa, pa + 4 * QP);
#pragma unroll
            for (int et = 0; et < 2; ++et) { v2u sw; sw.x = pk2(S[et][0] * e4[0], S[et][1] * e4[1]); sw.y = pk2(S[et][2] * e4[2], S[et][3] * e4[3]);
                *(LAS v2u*)(Sb + (et * 16 + r) * QP + (w * 16 + 4 * g) * 2) = sw;
                const LAS unsigned char* pb = Vs + (8 * g + q) * VP + (et * 16 + 4 * p) * 2;
                const f32x4 kvp = __builtin_amdgcn_mfma_f32_16x16x32_bf16(afr, tr8(pb, pb + 4 * VP), (f32x4){0.f, 0.f, 0.f, 0.f}, 0, 0, 0);
                S[et] = g4 * S[et] + h4 * kvp; } }
        if (w < 4) { const int sb = w >> 1, tb = (w & 1) ^ sb;
            const int t = tb * 16 + r, s0 = sb * 16 + 4 * g; v2u pw = (v2u){0u, 0u};
            if (sb <= tb) { f32x4 acc = (f32x4){0.f, 0.f, 0.f, 0.f};
#pragma unroll
                for (int ks = 0; ks < 4; ++ks) { const bf16x8 a = *(const LAS bf16x8*)(Ka + (sb * 16 + r) * QP + (ks * 32 + 8 * g) * 2), b = *(const LAS bf16x8*)(Qa + (tb * 16 + r) * QP + (ks * 32 + 8 * g) * 2);
                    acc = __builtin_amdgcn_mfma_f32_16x16x32_bf16(a, b, acc, 0, 0, 0); }
                pw.x = pk2(s0 + 0 <= t ? acc[0] : 0.f, s0 + 1 <= t ? acc[1] : 0.f); pw.y = pk2(s0 + 2 <= t ? acc[2] : 0.f, s0 + 3 <= t ? acc[3] : 0.f); }
            *(LAS v2u*)(Ps + t * PP + s0 * 2) = pw; }
        WG_SYNC();
        if (w < 4) { const int tb = w >> 1, et = w & 1;
            const LAS unsigned char* pb = Vs + (8 * g + q) * VP + (et * 16 + 4 * p) * 2;
            f32x4 o = __builtin_amdgcn_mfma_f32_16x16x32_bf16(*(const LAS bf16x8*)(Ps + (tb * 16 + r) * PP + 8 * g * 2), tr8(pb, pb + 4 * VP), (f32x4){0.f, 0.f, 0.f, 0.f}, 0, 0, 0);
#pragma unroll
            for (int ks = 0; ks < 4; ++ks) { const bf16x8 a = *(const LAS bf16x8*)(Qa + (tb * 16 + r) * QP + (ks * 32 + 8 * g) * 2), b = *(const LAS bf16x8*)(Sb + (et * 16 + r) * QP + (ks * 32 + 8 * g) * 2);
                o = __builtin_amdgcn_mfma_f32_16x16x32_bf16(a, b, o, 0, 0, 0); }
#pragma unroll
            for (int i = 0; i < 4; ++i) OUT[(size_t)(c * 32 + tb * 16 + 4 * g + i) * D + et * 16 + r] = (bf16)f2bf(o[i]); }
        WG_SYNC();
    }
#undef HG_LOAD
}


DI void scan_rwkv8(const Ctx& F, int l, int g, int unit) {
    const int half = unit & 1, h = (unit >> 1) & 15, bl = unit >> 5;
    constexpr int BUFB = 49152;
    LAS float* YT0 = (LAS float*)(F.lds + 2 * BUFB);
    const bf16* Z = (const bf16*)(F.ws + WS_Z); const bf16* LO = (const bf16*)(F.ws + WS_LO); bf16* VF = (bf16*)(F.ws + WS_VF); bf16* BON = (bf16*)(F.ws + WS_BON);
    bf16* RAW = (bf16*)(F.ws + WS_RAW) + (size_t)1 * MG * D;
    const int lane = F.lane, wave = F.wave;
    if (wave >= 4) {
        const int pw = wave - 4, gc = h * 64 + lane;
        const float mu_r = F.in[F.z + I_MU][l * 3328 + gc], mu_k = F.in[F.z + I_MU][l * 3328 + 1024 + gc], mu_v = F.in[F.z + I_MU][l * 3328 + 2048 + gc];
        const float kkc = F.in[F.z + I_KK][l * D + gc], kac = F.in[F.z + I_KA][l * D + gc], rk = F.in[F.z + I_RK][l * D + gc];
        bf16 rz[8][3], rl[8][2], rv[8][2], rp[3];
#define RW_LOAD(tt) do { const int t0_ = (tt) * 32 + pw * 8; const size_t lrow0_ = (size_t)bl * T + t0_; \
        _Pragma("unroll") for (int i = 0; i < 3; ++i) rp[i] = t0_ > 0 ? Z[(lrow0_ - 1) * NZ + ZC_RW + gc + 1024 * i] : (bf16)0; \
        _Pragma("unroll") for (int j = 0; j < 8; ++j) { const bf16* zp = Z + (lrow0_ + j) * NZ + ZC_RW + gc; const bf16* lp = LO + (lrow0_ + j) * NLORA + gc; \
            rz[j][0] = zp[0]; rz[j][1] = zp[1024]; rz[j][2] = zp[2048]; rl[j][0] = lp[0]; rl[j][1] = lp[1024]; \
            if (l == 1) { rv[j][0] = lp[3072]; rv[j][1] = VF[((size_t)g * MG + lrow0_ + j) * D + gc]; } } } while (0)
#define RW_PREP(tt) do { LAS float* TW = (LAS float*)(F.lds + ((tt) & 1) * BUFB); LAS float* TKP = TW + 2048; LAS float* TB = TW + 4096; LAS float* TKK = TW + 6144; LAS float* TR = TW + 8192; LAS float* TV = TW + 10240; \
        const int sb_ = pw * 8; const size_t lrow0_ = (size_t)bl * T + (tt) * 32 + sb_; \
        float pr = bf1(rp[0]), pk = bf1(rp[1]), pv = bf1(rp[2]); \
        _Pragma("unroll") for (int j = 0; j < 8; ++j) { const size_t lrow = lrow0_ + j; \
            const float zr = bf1(rz[j][0]), zk = bf1(rz[j][1]), zv = bf1(rz[j][2]); \
            const float r = zr + mu_r * (pr - zr), k = zk + mu_k * (pk - zk); float v = zv + mu_v * (pv - zv); \
            pr = zr; pk = zk; pv = zv; \
            const float w = __expf(bf1(rl[j][0])); const float a = bf1(rl[j][1]); \
            if (l == 0) { if (half == 0) VF[((size_t)g * MG + lrow) * D + gc] = (bf16)f2bf(v); } \
            else { const float vf = bf1(rv[j][1]); v = v + (vf - v) * bf1(rv[j][0]); } \
            const float kk = k * kkc; const float kn = kk * __builtin_amdgcn_rsqf(fmaxf(wave_sum(kk * kk), 1e-24f)); \
            const float kp = k * (1.0f + (a - 1.0f) * kac); \
            const float bsum = wave_sum(r * kp * rk); \
            if (half == 0) BON[lrow * D + gc] = (bf16)f2bf(bsum * v); \
            const int s = sb_ + j; \
            TW[s * 64 + lane] = w; TKP[s * 64 + lane] = kp; TB[s * 64 + lane] = kn * a; TKK[s * 64 + lane] = kn; TR[s * 64 + lane] = r; TV[s * 64 + lane] = v; } } while (0)
        RW_LOAD(0); RW_PREP(0); RW_LOAD(1);
        WG_SYNC();
        for (int tt = 0; tt < T / 32; ++tt) {
            if (tt + 1 < T / 32) { RW_PREP(tt + 1); if (tt + 2 < T / 32) RW_LOAD(tt + 2); }
            WG_SYNC();
        }
#undef RW_LOAD
#undef RW_PREP
    } else {
        const int rowl = F.tid >> 3, ks = F.tid & 7;
        f32x2 st[4];
#pragma unroll
        for (int i = 0; i < 4; ++i) st[i] = (f32x2){0.f, 0.f};
        WG_SYNC();
        for (int tt = 0; tt < T / 32; ++tt) {
            const LAS float* TW = (const LAS float*)(F.lds + (tt & 1) * BUFB); const LAS float* TKP = TW + 2048; const LAS float* TB = TW + 4096; const LAS float* TKK = TW + 6144; const LAS float* TR = TW + 8192; const LAS float* TV = TW + 10240;
            LAS float* YT = YT0 + (tt & 1) * 1024;
            f32x4 nkk[2], nw[2], nb[2], nkp[2], nr[2]; float nvv;
#pragma unroll
            for (int q = 0; q < 2; ++q) { nkk[q] = *(const LAS f32x4*)(TKK + ks * 8 + q * 4); nw[q] = *(const LAS f32x4*)(TW + ks * 8 + q * 4); nb[q] = *(const LAS f32x4*)(TB + ks * 8 + q * 4);
                nkp[q] = *(const LAS f32x4*)(TKP + ks * 8 + q * 4); nr[q] = *(const LAS f32x4*)(TR + ks * 8 + q * 4); }
            nvv = TV[half * 32 + rowl];
#pragma unroll 1
            for (int hh = 0; hh < 4; ++hh) {
                float ysel = 0.f;
#pragma unroll
                for (int s8 = 0; s8 < 8; ++s8) {
                    const int s = hh * 8 + s8;
                    f32x4 kk[2], w[2], b[2], kp[2], r[2];
#pragma unroll
                    for (int q = 0; q < 2; ++q) { kk[q] = nkk[q]; w[q] = nw[q]; b[q] = nb[q]; kp[q] = nkp[q]; r[q] = nr[q]; }
                    const float vv = nvv;
                    const int sn = (s + 1) & 31;
#pragma unroll
                    for (int q = 0; q < 2; ++q) { nkk[q] = *(const LAS f32x4*)(TKK + sn * 64 + ks * 8 + q * 4); nw[q] = *(const LAS f32x4*)(TW + sn * 64 + ks * 8 + q * 4); nb[q] = *(const LAS f32x4*)(TB + sn * 64 + ks * 8 + q * 4);
                        nkp[q] = *(const LAS f32x4*)(TKP + sn * 64 + ks * 8 + q * 4); nr[q] = *(const LAS f32x4*)(TR + sn * 64 + ks * 8 + q * 4); }
                    nvv = TV[sn * 64 + half * 32 + rowl];
                    const f32x2 d2 = (st[0] * kk[0].xy + st[1] * kk[0].zw) + (st[2] * kk[1].xy + st[3] * kk[1].zw);
                    f32x2 pp[4];
                    pp[0] = st[0] * w[0].xy + kp[0].xy * vv; pp[1] = st[1] * w[0].zw + kp[0].zw * vv; pp[2] = st[2] * w[1].xy + kp[1].xy * vv; pp[3] = st[3] * w[1].zw + kp[1].zw * vv;
                    const float nu = -sum8(d2.x + d2.y);
                    st[0] = b[0].xy * nu + pp[0]; st[1] = b[0].zw * nu + pp[1]; st[2] = b[1].xy * nu + pp[2]; st[3] = b[1].zw * nu + pp[3];
                    const f32x2 y2 = (st[0] * r[0].xy + st[1] * r[0].zw) + (st[2] * r[1].xy + st[3] * r[1].zw);
                    const float y = sum8(y2.x + y2.y);
                    ysel = (s8 == ks) ? y : ysel;
                }
                YT[(hh * 8 + ks) * 32 + rowl] = ysel;
            }
            WG_SYNC();
            { const int s = F.tid >> 3, r4 = (F.tid & 7) * 4;
                const f32x4 yv = *(const LAS f32x4*)(YT + s * 32 + r4); v2u o; o.x = pk2(yv.x, yv.y); o.y = pk2(yv.z, yv.w);
                *(v2u*)(RAW + ((size_t)bl * T + tt * 32 + s) * D + h * 64 + half * 32 + r4) = o; }
        }
    }
    WG_SYNC();
}


template <int N> DI float dpp_shr(float v) { return __builtin_bit_cast(float, __builtin_amdgcn_update_dpp(0, __builtin_bit_cast(int, v), 0x110 + N, 0xF, 0xF, true)); }
DI float row_incl_sum16(float x) { x += dpp_shr<1>(x); x += dpp_shr<2>(x); x += dpp_shr<4>(x); x += dpp_shr<8>(x); return x; }
DI void scan_rwkv_mfma(const Ctx& F, int l, int g, int unit, bf16* OUTB, bool side_writes) {
    const int h = unit & 15, bl = unit >> 4;
    constexpr int PI = 144, PA = 80;
    constexpr int SP = 66;
    constexpr int O_IMG = 50688, IMGB = 13824, O_AR = 78336, O_AY = 79616, O_AKB = 80896, O_RH = 81920, O_STI = 86272, O_WL = 95488;
    LAS float* SLW = (LAS float*)F.lds; LAS float* SKP = SLW + 32 * SP; LAS float* SB = SLW + 64 * SP; LAS float* SKK = SLW + 96 * SP; LAS float* SR = SLW + 128 * SP; LAS float* SV = SLW + 160 * SP;
    LAS unsigned char* AR = F.lds + O_AR; LAS unsigned char* AY = F.lds + O_AY; LAS float* AKB = (LAS float*)(F.lds + O_AKB); LAS float* RH = (LAS float*)(F.lds + O_RH);
    LAS unsigned char* STI = F.lds + O_STI; LAS float* WL = (LAS float*)(F.lds + O_WL);
    const bf16* Z = (const bf16*)(F.ws + WS_Z); const bf16* LO = (const bf16*)(F.ws + WS_LO); bf16* VF = (bf16*)(F.ws + WS_VF); bf16* BON = (bf16*)(F.ws + WS_BON);
    bf16* OUT = OUTB + (size_t)bl * T * D + h * 64;
    const int tid = F.tid, lane = F.lane, w = F.wave, gq = lane >> 4, r = lane & 15, q = r >> 2, p = lane & 3;
    const int gc = h * 64 + lane;
    const float mu_r = F.in[F.z + I_MU][l * 3328 + gc], mu_k = F.in[F.z + I_MU][l * 3328 + 1024 + gc], mu_v = F.in[F.z + I_MU][l * 3328 + 2048 + gc];
    const float kkc = F.in[F.z + I_KK][l * D + gc], kac = F.in[F.z + I_KA][l * D + gc], rk = F.in[F.z + I_RK][l * D + gc];
    bf16 rz[4][3], rl[4][2], rv[4][2], rp[3];
    f32x4 S[2]; S[0] = (f32x4){0.f, 0.f, 0.f, 0.f}; S[1] = S[0];
    for (int i = tid; i < 1280 / 4; i += NTHREADS) ((LAS unsigned*)AR)[i] = 0u;
    for (int i = tid; i < 2 * IMGB / 4; i += NTHREADS) ((LAS unsigned*)(F.lds + O_IMG))[i] = 0u;
    for (int i = tid; i < 9216 / 4; i += NTHREADS) ((LAS unsigned*)STI)[i] = 0u;
#define RW_LOAD(tt) do { const int t0_ = (tt) * 32 + w * 4; const size_t lrow0_ = (size_t)bl * T + t0_; \
        _Pragma("unroll") for (int i = 0; i < 3; ++i) rp[i] = t0_ > 0 ? Z[(lrow0_ - 1) * NZ + ZC_RW + gc + 1024 * i] : (bf16)0; \
        _Pragma("unroll") for (int j = 0; j < 4; ++j) { const bf16* zp = Z + (lrow0_ + j) * NZ + ZC_RW + gc; const bf16* lp = LO + (lrow0_ + j) * NLORA + gc; \
            rz[j][0] = zp[0]; rz[j][1] = zp[1024]; rz[j][2] = zp[2048]; rl[j][0] = lp[0]; rl[j][1] = lp[1024]; \
            if (l == 1) { rv[j][0] = lp[3072]; rv[j][1] = VF[((size_t)g * MG + lrow0_ + j) * D + gc]; } } } while (0)
#define RW_PREP(tt) do { const int sb_ = w * 4; const size_t lrow0_ = (size_t)bl * T + (tt) * 32 + sb_; \
        float pr = bf1(rp[0]), pk = bf1(rp[1]), pv = bf1(rp[2]); \
        _Pragma("unroll") for (int j = 0; j < 4; ++j) { const size_t lrow = lrow0_ + j; \
            const float zr = bf1(rz[j][0]), zk = bf1(rz[j][1]), zv = bf1(rz[j][2]); \
            const float rr = zr + mu_r * (pr - zr), k = zk + mu_k * (pk - zk); float v = zv + mu_v * (pv - zv); \
            pr = zr; pk = zk; pv = zv; \
            const float lw = bf1(rl[j][0]); const float a = bf1(rl[j][1]); \
            if (l == 0) { if (side_writes) VF[((size_t)g * MG + lrow) * D + gc] = (bf16)f2bf(v); } \
            else { const float vf = bf1(rv[j][1]); v = v + (vf - v) * bf1(rv[j][0]); } \
            const float kk = k * kkc; const float kn = kk * __builtin_amdgcn_rsqf(fmaxf(wave_sum(kk * kk), 1e-24f)); \
            const float kp = k * (1.0f + (a - 1.0f) * kac); \
            const float bsum = wave_sum(rr * kp * rk); \
            if (side_writes) BON[lrow * D + gc] = (bf16)f2bf(bsum * v); \
            const int s = sb_ + j; \
            SLW[s * SP + lane] = lw; SKP[s * SP + lane] = kp; SB[s * SP + lane] = kn * a; SKK[s * SP + lane] = kn; SR[s * SP + lane] = rr; SV[s * SP + lane] = v; } } while (0)
    RW_LOAD(0); RW_PREP(0);
    WG_SYNC();
    for (int tt = 0; tt < T / 32; ++tt) {
        if (tt + 1 < T / 32) RW_LOAD(tt + 1);
#pragma unroll 1
        for (int cc = 0; cc < 2; ++cc) {
            LAS unsigned char* RT = F.lds + O_IMG + cc * IMGB; LAS unsigned char* KT = RT + 2304; LAS unsigned char* KB = RT + 4608; LAS unsigned char* VU = RT + 9216;
            { const int t = tid & 15, c0 = (tid >> 4) * 2, s = cc * 16 + t;
                const f32x2 lw = *(const LAS f32x2*)(SLW + s * SP + c0), kp = *(const LAS f32x2*)(SKP + s * SP + c0), bb = *(const LAS f32x2*)(SB + s * SP + c0);
                const f32x2 kk = *(const LAS f32x2*)(SKK + s * SP + c0), rr = *(const LAS f32x2*)(SR + s * SP + c0), vv = *(const LAS f32x2*)(SV + s * SP + c0);
                const float cx = row_incl_sum16(lw.x), cy = row_incl_sum16(lw.y);
                const float wtx = __expf(cx), wty = __expf(cy), wpx = __expf(cx - lw.x), wpy = __expf(cy - lw.y), iwx = __expf(-cx), iwy = __expf(-cy);
                *(LAS unsigned*)(RT + t * PI + c0 * 2) = pk2(rr.x * wtx, rr.y * wty);
                *(LAS unsigned*)(KT + t * PI + c0 * 2) = pk2(kk.x * wpx, kk.y * wpy);
                *(LAS unsigned*)(KB + t * PI + c0 * 2) = pk2(kp.x * iwx, kp.y * iwy);
                *(LAS unsigned*)(KB + (16 + t) * PI + c0 * 2) = pk2(bb.x * iwx, bb.y * iwy);
                *(LAS unsigned*)(VU + t * PI + c0 * 2) = pk2(vv.x, vv.y);
                if (t == 15) { WL[c0] = wtx; WL[c0 + 1] = wty; } }
            WG_SYNC();
            f32x4 accG = (f32x4){0.f, 0.f, 0.f, 0.f}, accR = accG;
            if (w < 4) {
                f32x4 acc = (f32x4){0.f, 0.f, 0.f, 0.f};
                const LAS unsigned char* ia = KB + ((w & 1) * 16 + r) * PI; const LAS unsigned char* ib_ = (w < 2 ? KT : RT) + r * PI;
#pragma unroll
                for (int ks = 0; ks < 2; ++ks) acc = __builtin_amdgcn_mfma_f32_16x16x32_bf16(*(const LAS bf16x8*)(ia + (ks * 32 + 8 * gq) * 2), *(const LAS bf16x8*)(ib_ + (ks * 32 + 8 * gq) * 2), acc, 0, 0, 0);
                const int t = r, i0 = 4 * gq; float o[4];
#pragma unroll
                for (int j = 0; j < 4; ++j) o[j] = (w < 2 ? (i0 + j < t) : (i0 + j <= t)) ? acc[j] : 0.f;
                if (w == 1) *(LAS f32x4*)(AKB + t * 16 + i0) = (f32x4){o[0], o[1], o[2], o[3]};
                else { v2u pw; pw.x = pk2(o[0], o[1]); pw.y = pk2(o[2], o[3]);
                    *(LAS v2u*)((w == 0 ? AR : AY) + t * PA + ((w == 3 ? 16 : 0) + i0) * 2) = pw; }
            } else {
                const int vt = w - 4;
#pragma unroll
                for (int ks = 0; ks < 2; ++ks) { const LAS unsigned char* pb = STI + (ks * 32 + 8 * gq + q) * PI + (vt * 16 + 4 * p) * 2; const bf16x8 bfr = tr8(pb, pb + 4 * PI);
                    accG = __builtin_amdgcn_mfma_f32_16x16x32_bf16(*(const LAS bf16x8*)(KT + r * PI + (ks * 32 + 8 * gq) * 2), bfr, accG, 0, 0, 0);
                    accR = __builtin_amdgcn_mfma_f32_16x16x32_bf16(*(const LAS bf16x8*)(RT + r * PI + (ks * 32 + 8 * gq) * 2), bfr, accR, 0, 0, 0); }
            }
            WG_SYNC();
            if (w >= 4) { const int vt = w - 4; const LAS unsigned char* pb = VU + (8 * gq + q) * PI + (vt * 16 + 4 * p) * 2;
                accG = __builtin_amdgcn_mfma_f32_16x16x32_bf16(*(const LAS bf16x8*)(AR + r * PA + 8 * gq * 2), tr8(pb, pb + 4 * PI), accG, 0, 0, 0);
#pragma unroll
                for (int j = 0; j < 4; ++j) RH[(4 * gq + j) * 68 + vt * 16 + r] = accG[j]; }
            WG_SYNC();
            if (w == 0) { float u[16]; f32x4 am[16][4];
#pragma unroll
                for (int t = 0; t < 16; ++t) { u[t] = RH[t * 68 + lane];
#pragma unroll
                    for (int i4 = 0; i4 < 4; ++i4) if (i4 * 4 < t) am[t][i4] = *(const LAS f32x4*)(AKB + t * 16 + i4 * 4); }
#pragma unroll
                for (int i = 0; i < 15; ++i) {
#pragma unroll
                    for (int t = i + 1; t < 16; ++t) u[t] -= am[t][i >> 2][i & 3] * u[i]; }
#pragma unroll
                for (int t = 0; t < 16; ++t) *(LAS bf16*)(VU + (16 + t) * PI + lane * 2) = (bf16)f2bf(-u[t]); }
            WG_SYNC();
            if (w >= 4) { const int vt = w - 4; const LAS unsigned char* pb = VU + (8 * gq + q) * PI + (vt * 16 + 4 * p) * 2;
                accR = __builtin_amdgcn_mfma_f32_16x16x32_bf16(*(const LAS bf16x8*)(AY + r * PA + 8 * gq * 2), tr8(pb, pb + 4 * PI), accR, 0, 0, 0);
#pragma unroll
                for (int j = 0; j < 4; ++j) OUT[(size_t)(tt * 32 + cc * 16 + 4 * gq + j) * D + vt * 16 + r] = (bf16)f2bf(accR[j]); }
            { const int vt2 = w >> 1; const LAS unsigned char* pa = VU + (8 * gq + q) * PI + (vt2 * 16 + 4 * p) * 2; const bf16x8 afr = tr8(pa, pa + 4 * PI);
#pragma unroll
                for (int j2 = 0; j2 < 2; ++j2) { const int kt = 2 * (w & 1) + j2; const LAS unsigned char* pb = KB + (8 * gq + q) * PI + (kt * 16 + 4 * p) * 2;
                    S[j2] = __builtin_amdgcn_mfma_f32_16x16x32_bf16(afr, tr8(pb, pb + 4 * PI), S[j2], 0, 0, 0);
                    S[j2] *= WL[kt * 16 + r];
                    v2u sw; sw.x = pk2(S[j2][0], S[j2][1]); sw.y = pk2(S[j2][2], S[j2][3]);
                    *(LAS v2u*)(STI + (kt * 16 + r) * PI + (vt2 * 16 + 4 * gq) * 2) = sw; } }
            WG_SYNC();
        }
        if (tt + 1 < T / 32) RW_PREP(tt + 1);
        WG_SYNC();
    }
#undef RW_LOAD
#undef RW_PREP
}


DI void scan_rwkv_mfma2(const Ctx& F, int l, int g, int unit, bf16* OUTB, bool side_writes) {
    const int h = unit & 15, bl = unit >> 4;
    constexpr int PI = 144, PA = 80, IMGB = 13824, NBUF = 5;
    constexpr int O_IMG = 0, O_WL = NBUF * IMGB  , O_STI = O_WL + NBUF * 256  , O_PRIV = O_STI + 9216  , PRIVB = 1280 + 1280 + 1024 + 1088  ;
    LAS unsigned char* STI = F.lds + O_STI;
    const bf16* Z = (const bf16*)(F.ws + WS_Z); const bf16* LO = (const bf16*)(F.ws + WS_LO); bf16* VF = (bf16*)(F.ws + WS_VF); bf16* BON = (bf16*)(F.ws + WS_BON);
    bf16* OUT = OUTB + (size_t)bl * T * D + h * 64;
    const int tid = F.tid, lane = F.lane, w = F.wave, gq = lane >> 4, r = lane & 15, q = r >> 2, p = lane & 3;
    constexpr int NCH = T / 16;
    for (int i = tid; i < (O_PRIV + 4 * PRIVB) / 4; i += NTHREADS) ((LAS unsigned*)F.lds)[i] = 0u;
    WG_SYNC();
    if (w >= 4) {
        const int pw = w - 4, gc = h * 64 + lane;
        const float mu_r = F.in[F.z + I_MU][l * 3328 + gc], mu_k = F.in[F.z + I_MU][l * 3328 + 1024 + gc], mu_v = F.in[F.z + I_MU][l * 3328 + 2048 + gc];
        const float kkc = F.in[F.z + I_KK][l * D + gc], kac = F.in[F.z + I_KA][l * D + gc], rk = F.in[F.z + I_RK][l * D + gc];
        bf16 rz[4][3], rl[4][2], rv[4][2], rp[3]; float cum = 0.f;
#define RW_LOAD(t0_) do { const size_t lrow0_ = (size_t)bl * T + (t0_); \
        _Pragma("unroll") for (int i = 0; i < 3; ++i) rp[i] = (t0_) > 0 ? Z[(lrow0_ - 1) * NZ + ZC_RW + gc + 1024 * i] : (bf16)0; \
        _Pragma("unroll") for (int j = 0; j < 4; ++j) { const bf16* zp = Z + (lrow0_ + j) * NZ + ZC_RW + gc; const bf16* lp = LO + (lrow0_ + j) * NLORA + gc; \
            rz[j][0] = zp[0]; rz[j][1] = zp[1024]; rz[j][2] = zp[2048]; rl[j][0] = lp[0]; rl[j][1] = lp[1024]; \
            if (l == 1) { rv[j][0] = lp[3072]; rv[j][1] = VF[((size_t)g * MG + lrow0_ + j) * D + gc]; } } } while (0)
        { const int k0 = pw; if (k0 < NCH) RW_LOAD(k0 * 16); }
        for (int k = 0; k < NCH + 4; ++k) {
            const int qq = (k - pw) & 3, c = k - qq;
            if (k >= pw && c < NCH) {
                LAS unsigned char* RT = F.lds + O_IMG + (c % NBUF) * IMGB; LAS unsigned char* KT = RT + 2304; LAS unsigned char* KB = RT + 4608; LAS unsigned char* VU = RT + 9216;
                const size_t lrow0 = (size_t)bl * T + c * 16 + qq * 4;
                if (qq == 0) cum = 0.f;
                float pr = bf1(rp[0]), pk = bf1(rp[1]), pv = bf1(rp[2]);
#pragma unroll
                for (int j = 0; j < 4; ++j) { const size_t lrow = lrow0 + j; const int t = qq * 4 + j;
                    const float zr = bf1(rz[j][0]), zk = bf1(rz[j][1]), zv = bf1(rz[j][2]);
                    const float rr = zr + mu_r * (pr - zr), kx = zk + mu_k * (pk - zk); float v = zv + mu_v * (pv - zv);
                    pr = zr; pk = zk; pv = zv;
                    const float lw = bf1(rl[j][0]); const float a = bf1(rl[j][1]);
                    if (l == 0) { if (side_writes) VF[((size_t)g * MG + lrow) * D + gc] = (bf16)f2bf(v); }
                    else { const float vf = bf1(rv[j][1]); v = v + (vf - v) * bf1(rv[j][0]); }
                    const float kk = kx * kkc; const float kn = kk * __builtin_amdgcn_rsqf(fmaxf(wave_sum(kk * kk), 1e-24f));
                    const float kp = kx * (1.0f + (a - 1.0f) * kac);
                    const float bsum = wave_sum(rr * kp * rk);
                    if (side_writes) BON[lrow * D + gc] = (bf16)f2bf(bsum * v);
                    const float wp = __expf(cum); cum += lw; const float wt = __expf(cum), iw = __expf(-cum);
                    const unsigned c1 = pk2(rr * wt, kn * wp), c2 = pk2(kp * iw, kn * a * iw);
                    *(LAS bf16*)(RT + t * PI + lane * 2) = (bf16)c1; *(LAS bf16*)(KT + t * PI + lane * 2) = (bf16)(c1 >> 16);
                    *(LAS bf16*)(KB + t * PI + lane * 2) = (bf16)c2; *(LAS bf16*)(KB + (16 + t) * PI + lane * 2) = (bf16)(c2 >> 16);
                    *(LAS bf16*)(VU + t * PI + lane * 2) = (bf16)f2bf(v);
                    if (t == 15) ((LAS float*)(F.lds + O_WL))[(c % NBUF) * 64 + lane] = wt; }
                { const int tn = (qq < 3) ? c * 16 + (qq + 1) * 4 : (c + 4) * 16; if (tn < T) RW_LOAD(tn); }
            }
            WG_SYNC();
        }
#undef RW_LOAD
    } else {
        const int vt = w;
        LAS unsigned char* AR = F.lds + O_PRIV + w * PRIVB; LAS unsigned char* AY = AR + 1280; LAS float* AKB = (LAS float*)(AR + 2560); LAS float* RH = (LAS float*)(AR + 3584);
        f32x4 S[4];
#pragma unroll
        for (int i = 0; i < 4; ++i) S[i] = (f32x4){0.f, 0.f, 0.f, 0.f};
        for (int k = 0; k < NCH + 4; ++k) {
            const int c = k - 4;
            if (c >= 0) {
                const LAS unsigned char* RT = F.lds + O_IMG + (c % NBUF) * IMGB; const LAS unsigned char* KT = RT + 2304; const LAS unsigned char* KB = RT + 4608; LAS unsigned char* VU = F.lds + O_IMG + (c % NBUF) * IMGB + 9216;
                const LAS float* WL = (const LAS float*)(F.lds + O_WL) + (c % NBUF) * 64;
#pragma unroll
                for (int m = 0; m < 4; ++m) { f32x4 acc = (f32x4){0.f, 0.f, 0.f, 0.f};
                    const LAS unsigned char* ia = KB + ((m & 1) * 16 + r) * PI; const LAS unsigned char* ib_ = (m < 2 ? KT : RT) + r * PI;
#pragma unroll
                    for (int ks = 0; ks < 2; ++ks) acc = __builtin_amdgcn_mfma_f32_16x16x32_bf16(*(const LAS bf16x8*)(ia + (ks * 32 + 8 * gq) * 2), *(const LAS bf16x8*)(ib_ + (ks * 32 + 8 * gq) * 2), acc, 0, 0, 0);
                    const int t = r, i0 = 4 * gq; float o[4];
#pragma unroll
                    for (int j = 0; j < 4; ++j) o[j] = (m < 2 ? (i0 + j < t) : (i0 + j <= t)) ? acc[j] : 0.f;
                    if (m == 1) {
#pragma unroll
                        for (int j = 0; j < 4; ++j) AKB[(i0 + j) * 16 + t] = o[j]; }
                    else { v2u pw2; pw2.x = pk2(o[0], o[1]); pw2.y = pk2(o[2], o[3]); *(LAS v2u*)((m == 0 ? AR : AY) + t * PA + ((m == 3 ? 16 : 0) + i0) * 2) = pw2; } }
                asm volatile("" ::: "memory");
                f32x4 accG = (f32x4){0.f, 0.f, 0.f, 0.f}, accR = accG;
#pragma unroll
                for (int ks = 0; ks < 2; ++ks) { const LAS unsigned char* pb = STI + (ks * 32 + 8 * gq + q) * PI + (vt * 16 + 4 * p) * 2; const bf16x8 bfr = tr8(pb, pb + 4 * PI);
                    accG = __builtin_amdgcn_mfma_f32_16x16x32_bf16(*(const LAS bf16x8*)(KT + r * PI + (ks * 32 + 8 * gq) * 2), bfr, accG, 0, 0, 0);
                    accR = __builtin_amdgcn_mfma_f32_16x16x32_bf16(*(const LAS bf16x8*)(RT + r * PI + (ks * 32 + 8 * gq) * 2), bfr, accR, 0, 0, 0); }
                { const LAS unsigned char* pb = VU + (8 * gq + q) * PI + (vt * 16 + 4 * p) * 2;
                    accG = __builtin_amdgcn_mfma_f32_16x16x32_bf16(*(const LAS bf16x8*)(AR + r * PA + 8 * gq * 2), tr8(pb, pb + 4 * PI), accG, 0, 0, 0);
#pragma unroll
                    for (int j = 0; j < 4; ++j) RH[(4 * gq + j) * 17 + r] = accG[j]; }
                asm volatile("" ::: "memory");
                if (lane < 16) { float u[16];
#pragma unroll
                    for (int t = 0; t < 16; ++t) u[t] = RH[t * 17 + lane];
#pragma unroll
                    for (int i = 0; i < 15; ++i) {
                        f32x4 col[4];
#pragma unroll
                        for (int t4 = 0; t4 < 4; ++t4) if (t4 * 4 + 3 > i) col[t4] = *(const LAS f32x4*)(AKB + i * 16 + t4 * 4);
#pragma unroll
                        for (int t = i + 1; t < 16; ++t) u[t] -= col[t >> 2][t & 3] * u[i]; }
#pragma unroll
                    for (int t = 0; t < 16; ++t) *(LAS bf16*)(VU + (16 + t) * PI + (vt * 16 + lane) * 2) = (bf16)f2bf(-u[t]); }
                asm volatile("" ::: "memory");
                { const LAS unsigned char* pb = VU + (8 * gq + q) * PI + (vt * 16 + 4 * p) * 2; const bf16x8 vfr = tr8(pb, pb + 4 * PI);
                    accR = __builtin_amdgcn_mfma_f32_16x16x32_bf16(*(const LAS bf16x8*)(AY + r * PA + 8 * gq * 2), vfr, accR, 0, 0, 0);
#pragma unroll
                    for (int j = 0; j < 4; ++j) OUT[(size_t)(c * 16 + 4 * gq + j) * D + vt * 16 + r] = (bf16)f2bf(accR[j]);
#pragma unroll
                    for (int kt = 0; kt < 4; ++kt) { const LAS unsigned char* pk_ = KB + (8 * gq + q) * PI + (kt * 16 + 4 * p) * 2;
                        S[kt] = __builtin_amdgcn_mfma_f32_16x16x32_bf16(vfr, tr8(pk_, pk_ + 4 * PI), S[kt], 0, 0, 0);
                        S[kt] *= WL[kt * 16 + r];
                        v2u sw; sw.x = pk2(S[kt][0], S[kt][1]); sw.y = pk2(S[kt][2], S[kt][3]);
                        *(LAS v2u*)(STI + (kt * 16 + r) * PI + (vt * 16 + 4 * gq) * 2) = sw; } }
            }
            WG_SYNC();
        }
    }
    WG_SYNC();
}

DI void phase_post(const Ctx& F, int l) {
    const int gw = F.bid * NWAVES + F.wave, NGW = F.G * NWAVES;
    const bf16* Z = (const bf16*)(F.ws + WS_Z); const bf16* XC = (const bf16*)(F.ws + WS_XC); const bf16* LO = (const bf16*)(F.ws + WS_LO); const bf16* BON = (const bf16*)(F.ws + WS_BON);
    bf16* RAW = (bf16*)(F.ws + WS_RAW);
    const int c0 = F.lane * 16;
    for (int row = gw; row < MG; row += NGW) {
        float a[16], b[16], c[16];
        { bf16* rp = RAW + (size_t)row * D + c0;
            unpack16(rp, a);
            unpack16(Z + (size_t)row * NZ + ZC_MLO + c0, b);
            unpack16(XC + (size_t)row * D + c0, c);
            float s = 0.f;
#pragma unroll
            for (int i = 0; i < 16; ++i) { a[i] *= sigmoidf_(b[i]); s += a[i]; }
            const float mean = sum16(s) * (1.f / 256.f); float q = 0.f;
#pragma unroll
            for (int i = 0; i < 16; ++i) { a[i] -= mean; q += a[i] * a[i]; }
            const float rstd = 1.0f / sqrtf(sum16(q) * (1.f / 256.f) + 1e-6f);
#pragma unroll
            for (int i = 0; i < 16; ++i) a[i] = a[i] * rstd * F.in[F.z + I_MLNW][l * D + c0 + i] + F.in[F.z + I_MLSKIP][l * D + c0 + i] * c[i];
            pack16(rp, a); }
        { bf16* rp = RAW + (size_t)(MG + row) * D + c0;
            unpack16(rp, a);
            if (RWKV_DEBUG) { unpack16((const bf16*)(F.ws + WS_END) + (size_t)row * D + c0, b); float sd = 0.f, sr = 0.f;
#pragma unroll
                for (int i = 0; i < 16; ++i) { sd += (a[i] - b[i]) * (a[i] - b[i]); sr += a[i] * a[i]; }
                sd = wave_sum(sd); sr = wave_sum(sr);
                if (F.lane == 0) { atomicAdd((float*)(F.ws + WS_CTL) + 32768, sd); atomicAdd((float*)(F.ws + WS_CTL) + 32769, sr); } }
            unpack16(BON + (size_t)row * D + c0, b);
            unpack16(LO + (size_t)row * NLORA + 2048 + c0, c);
            float s = 0.f;
#pragma unroll
            for (int i = 0; i < 16; ++i) s += a[i];
            const float mean = sum4(s) * (1.f / 64.f); float q = 0.f;
#pragma unroll
            for (int i = 0; i < 16; ++i) { a[i] -= mean; q += a[i] * a[i]; }
            const float rstd = 1.0f / sqrtf(sum4(q) * (1.f / 64.f) + 64e-5f);
#pragma unroll
            for (int i = 0; i < 16; ++i) a[i] = (a[i] * rstd * F.in[F.z + I_LNW][l * D + c0 + i] + F.in[F.z + I_LNB][l * D + c0 + i] + b[i]) * c[i];
            pack16(rp, a); }
        { bf16* rp = RAW + (size_t)(2 * MG + row) * D + c0;
            unpack16(rp, a);
            unpack16(Z + (size_t)row * NZ + ZC_HGG + c0, b);
            float q = 0.f;
#pragma unroll
            for (int i = 0; i < 16; ++i) q += a[i] * a[i];
            const float rstd = 1.0f / sqrtf(sum8(q) * (1.f / 128.f) + 1e-6f);
#pragma unroll
            for (int i = 0; i < 16; ++i) a[i] = a[i] * rstd * F.in[F.z + I_HGNW][l * D + c0 + i] * sigmoidf_(b[i]);
            pack16(rp, a); }
    }
}

enum { PH_W = 0, PH_A1, PH_A2, PH_A3, PH_B1, PH_B2, PH_B3, PH_B4, PH_B5, PH_B6, PH_B7, PH_B8, PH_FIN, PH_N };

__global__ void __launch_bounds__(NTHREADS, 2) fwd_kernel(Args args) {
    extern __shared__ __attribute__((aligned(16))) unsigned char lds_raw[];
    Ctx F;
    F.lds = (LAS unsigned char*)lds_raw; F.in = args.in; F.out = args.out; F.ws = args.ws;
    F.z = 0; F.tid = threadIdx.x; F.lane = F.tid & 63; F.wave = __builtin_amdgcn_readfirstlane(F.tid >> 6); F.bid = blockIdx.x; F.G = gridDim.x;
    volatile LAS unsigned* MISC = (volatile LAS unsigned*)(F.lds + MISC_OFF);
    if (F.tid < 32) MISC[F.tid] = 0u;
    __syncthreads();
    XcdBarrier bar; bar.bar = (unsigned*)(F.ws + WS_CTL) + CW_BAR; bar.x = 0; bar.st = nullptr;
    if (args.use_bar) bar = xcd_barrier_post((unsigned*)(F.ws + WS_CTL) + CW_BAR, MISC + 8);
#ifndef PHMASK
#define PHMASK 0xFFFF
#endif
#define IN(k) (((PHMASK >> (k)) & 1) && args.ph_lo <= (k) && (k) < args.ph_hi)
#ifndef REPEAT_PH
#define REPEAT_PH -1
#endif
#ifndef TP_PH
#define TP_PH -1
#endif
#ifndef TP_WG
#define TP_WG 0
#endif
#define TPS(id) do { if ((id) == TP_PH && F.bid == TP_WG) tp0_ = __builtin_amdgcn_s_memrealtime(); } while (0)
#define TPE(id) do { if ((id) == TP_PH && F.bid == TP_WG && F.tid == 0) MISC[20] += (unsigned)(__builtin_amdgcn_s_memrealtime() - tp0_); } while (0)
#define PHASE(k) if (IN(k)) for (int rep_ = 0; rep_ < ((k) == REPEAT_PH ? 2 : 1); ++rep_) if (refresh(F), cur_ph_ = (k), (((k) == TP_PH && F.bid == TP_WG) ? (void)(tp0_ = __builtin_amdgcn_s_memrealtime()) : (void)0), true)
#define SEAM() do { TPE(cur_ph_); if (args.use_bar) xcd_barrier(bar); } while (0)
    const float* MOD = (const float*)(F.ws + WS_MOD);
    int cur_ph_ = -1; unsigned long long tp0_ = 0; (void)cur_ph_; (void)tp0_;
    for (int f = args.f_lo; f < args.f_hi; ++f) {
        const int l = f >> 1, fi = f & 1;
        const float* modl = MOD + (size_t)l * NB * NMOD;
        if (fi == 0) PHASE(PH_W) { phase_weights(F, l); if (l == 0) { __syncthreads(); phase_mod(F); } SEAM(); }
        const int sub = fi ? 2 : 0;
        const float* xsrc = (f == 0) ? F.in[F.z + I_X] : F.out;
        PHASE(PH_A1) { phase_modulate<false>(F, xsrc, (bf16*)(F.ws + WS_H), F.in[F.z + I_NORMW] + (size_t)(l * 3 + sub) * D, modl, sub, 0, M, nullptr, 0, F.bid, F.G); SEAM(); }
        PHASE(PH_A2) {
            pg8::Gemm gm{(const bf16*)(F.ws + WS_H), (const bf16*)(F.ws + WS_WUP) + (size_t)fi * NUP * D, D, D, D, 0, 0};
            pg8::Order<0> S; S.init(M / 256, NUP / 256, F.G, F.bid);
            pg8::EpiSwiGLU E{(bf16*)(F.ws + WS_HID), DFF};
            pg8::gemm_phase(F.lds, gm, S, E, F.tid); SEAM(); }
        PHASE(PH_A3) {
            pg8::Gemm gm{(const bf16*)(F.ws + WS_HID), (const bf16*)(F.ws + WS_WDN) + (size_t)fi * D * DFF, DFF, DFF, DFF, 0, 0};
            pg8::Order<0> S; S.init(M / 256, D / 256, F.G, F.bid);
            pg8::EpiResid E{xsrc, F.out, modl + (sub * 3 + 2) * D, 0.5f, 0};
            pg8::gemm_phase(F.lds, gm, S, E, F.tid); SEAM(); }
        if (fi == 0) {
            for (int g = args.g_lo; g < args.g_hi; ++g) {
                float* xg = F.out + (size_t)g * MG * D;
                const bool fuse_b1 = args.use_bar && F.G == 256 && args.ph_lo <= PH_B1 && args.ph_hi > PH_B7;
                if (!(fuse_b1 && g > args.g_lo)) PHASE(PH_B1) { phase_modulate<true>(F, F.out, (bf16*)(F.ws + WS_HG), F.in[F.z + I_NORMW] + (size_t)(l * 3 + 1) * D, modl, 1, g * MG, MG, (float*)(F.ws + WS_SIDE), l == 0 ? 8 : NSIDE, F.bid, F.G); SEAM(); }
                PHASE(PH_B2) {
                    pg8::Gemm gm{(const bf16*)(F.ws + WS_HG), (const bf16*)(F.ws + WS_WIN), D, D, D, 0, 0};
                    pg8::Order<0> S; S.init(MG / 256, NZ / 256, F.G, F.bid);
                    pg8::EpiZ E{(bf16*)(F.ws + WS_Z), NZ, l == 0 ? nullptr : F.in[F.z + I_LBL]};
                    pg8::gemm_phase(F.lds, gm, S, E, F.tid); SEAM(); }
                PHASE(PH_B3) { phase_prep(F, l); SEAM(); }
                PHASE(PH_B4) {
                    { pg8::Gemm gm{(const bf16*)(F.ws + WS_XC), (const bf16*)(F.ws + WS_WQK), 256, D, 256, 256, (size_t)512 * 256};
                      pg8::Order<1> S; S.init(MG / 256, 8, F.G, F.bid);
                      pg8::EpiBf16 E{(bf16*)(F.ws + WS_QK), 2048, 512};
                      pg8::gemm_phase(F.lds, gm, S, E, F.tid); }
                    __syncthreads();
                    { pg8::Gemm gm{(const bf16*)(F.ws + WS_LA), (const bf16*)(F.ws + WS_WLORA), l == 0 ? 256 : 384, KLORA, KLORA, 0, 0};
                      pg8::Order<0> S; S.init(MG / 256, l == 0 ? 12 : 16, F.G, F.bid);
                      pg8::EpiLora E{(bf16*)(F.ws + WS_LO), NLORA, F.in[F.z + I_W0] + (size_t)l * D, F.in[F.z + I_A0] + (size_t)l * D, F.in[F.z + I_V0]};
                      pg8::gemm_phase(F.lds, gm, S, E, F.tid); }
                    SEAM(); }
                PHASE(PH_B5) {
                    { unsigned* hgdone = (unsigned*)(F.ws + WS_CTL) + CW_HGDONE + 64 * (l * NGRP + g);
                      int lo0, lo1, lo2, st = 128, st1 = 64, gq = 128, gc = F.bid;
                      if (F.G == 256) { const int a = F.bid < 128 ? F.bid : 128; lo0 = a; lo2 = a; lo1 = F.bid >= 192 ? F.bid - 192 : 64; }
                      else { lo0 = lo1 = lo2 = F.bid; st = F.G; st1 = F.G; gq = F.G; }
                      unsigned nhg = 0;
                      TPS(100); for (int i = lo2; i < 128; i += st) { scan_hgrn_mfma(F, l, i); ++nhg; } TPE(100);
                      if (nhg && F.tid == 0) __hip_atomic_fetch_add(hgdone, nhg, __ATOMIC_RELAXED, __HIP_MEMORY_SCOPE_AGENT);
                      TPS(101); for (int i = lo0; i < 128; i += st) scan_mlstm_mfma(F, l, i); TPE(101);
                      TPS(103); for (int i = lo1; i < 64; i += st1) scan_rwkv_mfma2(F, l, g, i, (bf16*)(F.ws + WS_RAW) + (size_t)MG * D, true); TPE(103);
                      if (F.G != 256 || F.bid < 192) {
                          if (F.tid == 0) { unsigned sp = 0; while (__hip_atomic_load(hgdone, __ATOMIC_RELAXED, __HIP_MEMORY_SCOPE_AGENT) < 128u) { __builtin_amdgcn_s_sleep(4); if (++sp > (1u << 22)) break; } }
                          __syncthreads();
                          pg8::Gemm gm{(const bf16*)(F.ws + WS_HG), (const bf16*)(F.ws + WS_WIN) + (size_t)NZ * D, D, D, D, 0, 0};
                          pg8::Order<0> S; S.init(MG / 256, 12, gq, gc);
                          if (F.G == 256) { if (F.bid < 128) { S.imax = GATES_A; S.G = 128; } else { S.c = F.bid - 128; S.G = 64; S.L0 = 128 * GATES_A; } }
                          pg8::EpiBf16 E{(bf16*)(F.ws + WS_Z) + ZC_GATE, NZ, 0};
                          TPS(102); pg8::gemm_phase(F.lds, gm, S, E, F.tid); TPE(102); } }
                    SEAM(); }
                PHASE(PH_B6) { phase_post(F, l); SEAM(); }
                PHASE(PH_B7) {
                    pg8::Gemm gm{(const bf16*)(F.ws + WS_RAW), (const bf16*)(F.ws + WS_WBR), D, D, D, (size_t)MG * D, (size_t)D * D};
                    pg8::Order<2> S; S.init(MG / 256, 4, F.G, F.bid);
                    pg8::EpiBranch E{(const bf16*)(F.ws + WS_Z) + ZC_GATE, NZ, (float*)(F.ws + WS_QK), (bf16*)(F.ws + WS_XC)};
                    pg8::gemm_phase(F.lds, gm, S, E, F.tid);
                    if (fuse_b1 && g + 1 < args.g_hi && F.bid >= 128)
                        phase_modulate<true>(F, F.out, (bf16*)(F.ws + WS_HG), F.in[F.z + I_NORMW] + (size_t)(l * 3 + 1) * D, modl, 1, (g + 1) * MG, MG, (float*)(F.ws + WS_SIDE), l == 0 ? 8 : NSIDE, F.bid - 128, 128);
                    SEAM(); }
                PHASE(PH_B8) {
                    pg8::Gemm gm{(const bf16*)(F.ws + WS_XC), (const bf16*)(F.ws + WS_WOUT), D, D, D, 0, 0};
                    pg8::Order<0> S; S.init(MG / 256, 4, F.G, F.bid);
                    pg8::EpiResid E{xg, xg, modl + (1 * 3 + 2) * D, 1.0f, g * GB};
                    pg8::gemm_phase(F.lds, gm, S, E, F.tid);
                    SEAM(); }
            }
        }
    }
    PHASE(PH_FIN) phase_final_norm(F);
    if (TP_PH >= 0 && F.bid == TP_WG) { __syncthreads(); const unsigned long long t0 = __builtin_amdgcn_s_memrealtime(); const unsigned long long w = MISC[20]; while (__builtin_amdgcn_s_memrealtime() - t0 < w) __builtin_amdgcn_s_sleep(8); }
#undef IN
#undef PHASE
#undef SEAM
}

extern "C" void kernel_launch(void* const* d_in, const int* in_sizes, int n_in, void* d_out, int out_size, void* d_ws, size_t ws_size, hipStream_t stream) {
    static int grid = 0;
    if (grid == 0) {
        if (n_in != 36 || out_size != M * D || ws_size < WS_END + (RWKV_DEBUG ? 16 * MiB : 0)) { fprintf(stderr, "kernel_launch: unexpected problem (n_in %d out %d ws %zu, need %zu)\n", n_in, out_size, ws_size, (size_t)WS_END); grid = -1; return; }
        int dev = 0, cus = 0;
        if (hipGetDevice(&dev) != hipSuccess || hipDeviceGetAttribute(&cus, hipDeviceAttributeMultiprocessorCount, dev) != hipSuccess) { grid = -1; return; }
        if (hipFuncSetAttribute((const void*)fwd_kernel, hipFuncAttributeMaxDynamicSharedMemorySize, LDS_BYTES) != hipSuccess) { fprintf(stderr, "kernel_launch: hipFuncSetAttribute failed\n"); grid = -1; return; }
        int per_cu = 0;
        if (hipOccupancyMaxActiveBlocksPerMultiprocessor(&per_cu, (const void*)fwd_kernel, NTHREADS, LDS_BYTES) != hipSuccess || per_cu < 1) { fprintf(stderr, "kernel_launch: occupancy query says %d\n", per_cu); }
        (void)hipGetLastError();
        grid = cus;
    }
    if (grid < 0) return;
    (void)hipMemsetAsync((char*)d_ws + WS_CTL, 0, CTL_BYTES, stream);
    Args a{};
    for (int i = 0; i < 36; ++i) a.in[i] = (const float*)d_in[i];
    a.out = (float*)d_out; a.ws = (unsigned char*)d_ws; a.pad = 0;
#if ONE_LAUNCH
    a.f_lo = 0; a.f_hi = 4; a.g_lo = 0; a.g_hi = NGRP; a.ph_lo = 0; a.ph_hi = PH_N; a.use_bar = 1;
    hipLaunchKernelGGL(fwd_kernel, dim3(grid), dim3(NTHREADS), LDS_BYTES, stream, a);
#else
    a.use_bar = 0;
    for (int f = 0; f < 4; ++f) {
        a.f_lo = f; a.f_hi = f + 1;
        for (int ph = PH_W; ph <= PH_A3; ++ph) {
            if (ph == PH_W && (f & 1)) continue;
            a.ph_lo = ph; a.ph_hi = ph + 1; a.g_lo = 0; a.g_hi = 0;
            hipLaunchKernelGGL(fwd_kernel, dim3(grid), dim3(NTHREADS), LDS_BYTES, stream, a);
        }
        if ((f & 1) == 0)
            for (int g = 0; g < NGRP; ++g)
                for (int ph = PH_B1; ph <= PH_B8; ++ph) { a.ph_lo = ph; a.ph_hi = ph + 1; a.g_lo = g; a.g_hi = g + 1;
                    hipLaunchKernelGGL(fwd_kernel, dim3(grid), dim3(NTHREADS), LDS_BYTES, stream, a); }
    }
    a.f_lo = 0; a.f_hi = 0; a.g_lo = 0; a.g_hi = 0; a.ph_lo = PH_FIN; a.ph_hi = PH_FIN + 1;
    hipLaunchKernelGGL(fwd_kernel, dim3(grid), dim3(NTHREADS), LDS_BYTES, stream, a);
#endif
}
```

```cpp
#include <hip/hip_runtime.h>
#include <cstdio>
#include <cstdint>

#ifndef GATES_A
#define GATES_A 0
#endif
#ifndef ONE_LAUNCH
#define ONE_LAUNCH 1
#endif

#define GAS __attribute__((address_space(1)))
#define LAS __attribute__((address_space(3)))
typedef unsigned short bf16;
typedef unsigned v4u __attribute__((ext_vector_type(4)));
typedef unsigned v2u __attribute__((ext_vector_type(2)));
typedef float f32x4 __attribute__((ext_vector_type(4)));
typedef float f32x2 __attribute__((ext_vector_type(2)));
typedef short bf16x8 __attribute__((ext_vector_type(8)));
#define DI __device__ __forceinline__

constexpr int D = 1024, NB = 16, T = 2048, M = NB * T, DFF = 2816, NUP = 2 * DFF;
constexpr int GB = 4, MG = GB * T, NGRP = NB / GB;
constexpr int NZ = 9472;
constexpr int ZC_MLX = 0, ZC_RW = 1024, ZC_HGQ = 4352, ZC_HGF = 5376, ZC_HGI = 6400, ZC_MLO = 7424, ZC_HGG = 8448;
constexpr int NZE = 7424;
constexpr int ZC_GATE = 4352;
constexpr int NWIN = 12544;
constexpr int WIN_SRC = 12552;
constexpr int NSIDE = 40, KLORA = 384, NLORA = 4096, NMOD = 9216;
constexpr int NTHREADS = 512, NWAVES = 8;

constexpr size_t MiB = 1u << 20;
constexpr size_t WS_CTL = 0, CTL_BYTES = 1 * MiB;
constexpr size_t WS_MOD = 1 * MiB;
constexpr size_t WS_WSIDE = 3 * MiB;
constexpr size_t WS_WUP = 4 * MiB;
constexpr size_t WS_WDN = 26 * MiB;
constexpr size_t WS_WIN = 37 * MiB;
constexpr size_t WS_WBR = 62 * MiB;
constexpr size_t WS_WOUT = 68 * MiB;
constexpr size_t WS_WQK = 70 * MiB;
constexpr size_t WS_WLORA = 71 * MiB;
constexpr size_t WS_VF = 74 * MiB;
constexpr size_t WS_ACT = 138 * MiB;
constexpr size_t WS_H = WS_ACT;
constexpr size_t WS_HID = WS_ACT + 64 * MiB;
constexpr size_t WS_HG = WS_ACT;
constexpr size_t WS_Z = WS_ACT + 16 * MiB;
constexpr size_t WS_XC = WS_ACT + 164 * MiB;
constexpr size_t WS_QK = WS_ACT + 180 * MiB;
constexpr size_t WS_LA = WS_ACT + 212 * MiB;
constexpr size_t WS_LO = WS_ACT + 218 * MiB;
constexpr size_t WS_SIDE = WS_ACT + 282 * MiB;
constexpr size_t WS_RAW = WS_ACT + 284 * MiB;
constexpr size_t WS_BON = WS_ACT + 332 * MiB;
constexpr size_t WS_END = WS_ACT + 348 * MiB;
static_assert(WS_HID + (size_t)M * DFF * 2 <= WS_END, "ffn view fits");
static_assert(WS_Z + (size_t)MG * NZ * 2 <= WS_XC, "z fits");

constexpr int CW_BAR = 4096, CW_HGDONE = 16384;

constexpr int LDS_BYTES = 147456;
constexpr int MISC_OFF = LDS_BYTES - 256;

typedef __bf16 bf16x2_t __attribute__((ext_vector_type(2)));
DI unsigned f2bf(float f) { return (unsigned)__builtin_bit_cast(unsigned short, (__bf16)f); }
DI unsigned pk2(float lo, float hi) { const bf16x2_t v = __builtin_convertvector((f32x2){lo, hi}, bf16x2_t); return __builtin_bit_cast(unsigned, v); }
DI float bflo(unsigned w) { return __builtin_bit_cast(float, w << 16); }
DI float bfhi(unsigned w) { return __builtin_bit_cast(float, w & 0xffff0000u); }
DI float bf1(bf16 h) { return __builtin_bit_cast(float, (unsigned)h << 16); }
DI float sigmoidf_(float x) { return __builtin_amdgcn_rcpf(1.0f + __expf(-x)); }
DI float siluf_(float x) { return x * __builtin_amdgcn_rcpf(1.0f + __expf(-x)); }
DI float softplusf_(float x) { return fmaxf(x, 0.f) + __logf(1.0f + __expf(-fabsf(x))); }
template <int CTRL> DI float dppf(float v) { return __builtin_bit_cast(float, __builtin_amdgcn_update_dpp(0, __builtin_bit_cast(int, v), CTRL, 0xF, 0xF, true)); }
DI float sum4(float v) { v += dppf<0xB1>(v); v += dppf<0x4E>(v); return v; }
DI float sum8(float v) { v = sum4(v); v += dppf<0x141>(v); return v; }
DI float sum16(float v) { v = sum8(v); v += dppf<0x140>(v); return v; }
DI float wave_sum(float v) {
    v = sum16(v);
    const float a = __builtin_bit_cast(float, __builtin_amdgcn_readlane(__builtin_bit_cast(int, v), 0)), b = __builtin_bit_cast(float, __builtin_amdgcn_readlane(__builtin_bit_cast(int, v), 16));
    const float c = __builtin_bit_cast(float, __builtin_amdgcn_readlane(__builtin_bit_cast(int, v), 32)), d = __builtin_bit_cast(float, __builtin_amdgcn_readlane(__builtin_bit_cast(int, v), 48));
    return (a + b) + (c + d);
}
#define LDS_WAIT() asm volatile("s_waitcnt lgkmcnt(0)" ::: "memory")
#define VM_WAIT() asm volatile("s_waitcnt vmcnt(0)" ::: "memory")
DI void unpack8(const v4u w, float (&o)[8]) { o[0] = bflo(w.x); o[1] = bfhi(w.x); o[2] = bflo(w.y); o[3] = bfhi(w.y); o[4] = bflo(w.z); o[5] = bfhi(w.z); o[6] = bflo(w.w); o[7] = bfhi(w.w); }
DI void unpack16(const bf16* p, float (&o)[16]) { const v4u a = *(const v4u*)p, b = *(const v4u*)(p + 8);
    o[0] = bflo(a.x); o[1] = bfhi(a.x); o[2] = bflo(a.y); o[3] = bfhi(a.y); o[4] = bflo(a.z); o[5] = bfhi(a.z); o[6] = bflo(a.w); o[7] = bfhi(a.w);
    o[8] = bflo(b.x); o[9] = bfhi(b.x); o[10] = bflo(b.y); o[11] = bfhi(b.y); o[12] = bflo(b.z); o[13] = bfhi(b.z); o[14] = bflo(b.w); o[15] = bfhi(b.w); }
DI void pack16(bf16* p, const float (&o)[16]) { v4u a, b; a.x = pk2(o[0], o[1]); a.y = pk2(o[2], o[3]); a.z = pk2(o[4], o[5]); a.w = pk2(o[6], o[7]);
    b.x = pk2(o[8], o[9]); b.y = pk2(o[10], o[11]); b.z = pk2(o[12], o[13]); b.w = pk2(o[14], o[15]); *(v4u*)p = a; *(v4u*)(p + 8) = b; }
DI v4u pack8(const float (&o)[8]) { v4u w; w.x = pk2(o[0], o[1]); w.y = pk2(o[2], o[3]); w.z = pk2(o[4], o[5]); w.w = pk2(o[6], o[7]); return w; }

#define XB_TMO      128
#define XB_XCNT(j)  (256  + 64 * (j))
#define XB_XSUB(j)  (1280 + 64 * (j))
#define XB_XGEN(j)  (2304 + 64 * (j))
#define XB_TOP      3328
#define XB_TOPGEN   3392
#define XCD_BAR_WORDS 3456
#define XB_SPIN_CAP (1u << 22)
__device__ __forceinline__ unsigned xb_ld(unsigned* p)              { return __hip_atomic_load(p, __ATOMIC_RELAXED, __HIP_MEMORY_SCOPE_AGENT); }
__device__ __forceinline__ unsigned xb_add(unsigned* p, unsigned v) { return __hip_atomic_fetch_add(p, v, __ATOMIC_RELAXED, __HIP_MEMORY_SCOPE_AGENT); }
__device__ __forceinline__ unsigned xb_xcc_id() { return (unsigned)__builtin_amdgcn_s_getreg((3 << 11) | 20) & 0xFu; }
#define XB_SPIN(cond, bar) do { unsigned _sp = 0; while (cond) { __builtin_amdgcn_s_sleep(1); \
    if ((++_sp & 255u) == 0u) { if (xb_ld(&(bar)[XB_TMO])) break; if (_sp > XB_SPIN_CAP) { atomicAdd(&(bar)[XB_TMO], 1u); break; } } } } while (0)
struct XcdBarrier { unsigned* bar; unsigned x; volatile LAS unsigned* st; };
__device__ __forceinline__ XcdBarrier xcd_barrier_post(unsigned* bar, volatile LAS unsigned* st) {
    XcdBarrier b; b.bar = bar; b.x = xb_xcc_id(); b.st = st;
    if (threadIdx.x == 0) (void)xb_add(&bar[XB_XCNT(b.x)], 1u);
    return b;
}
__device__ __forceinline__ void xcd_barrier_complete(unsigned* bar, unsigned x, unsigned& nloc, unsigned& nx) {
    const unsigned G = gridDim.x * gridDim.y * gridDim.z;
    unsigned sum, cnt, mine, sp = 0u;
    for (;;) {
        sum = 0u; cnt = 0u; mine = 0u;
#pragma unroll
        for (unsigned j = 0; j < 16; ++j) { const unsigned c = xb_ld(&bar[XB_XCNT(j)]); sum += c; cnt += (c > 0u) ? 1u : 0u; mine = (j == x) ? c : mine; }
        if (sum == G) break;
        __builtin_amdgcn_s_sleep(1);
        if ((++sp & 255u) == 0u) { if (xb_ld(&bar[XB_TMO])) break; if (sp > XB_SPIN_CAP) { atomicAdd(&bar[XB_TMO], 1u); break; } }
    }
    nloc = mine > 0u ? mine : 1u; nx = cnt > 0u ? cnt : 1u;
}
__device__ __forceinline__ void xcd_barrier(const XcdBarrier& b) {
    asm volatile("s_waitcnt vmcnt(0)" ::: "memory");
    __syncthreads();
    if (threadIdx.x == 0) {
        unsigned* bar = b.bar;
        __builtin_amdgcn_s_waitcnt(0);
        unsigned nloc = b.st[0], nx = b.st[1];
        if (nloc == 0u) { xcd_barrier_complete(bar, b.x, nloc, nx); b.st[0] = nloc; b.st[1] = nx; }
        const unsigned old = xb_add(&bar[XB_XSUB(b.x)], 1u);
        const unsigned gen = old / nloc;
        if (old + 1u == (gen + 1u) * nloc) {
            __builtin_amdgcn_fence(__ATOMIC_RELEASE, "agent");
            asm volatile("s_waitcnt vmcnt(0)" ::: "memory");
            const unsigned og = xb_add(&bar[XB_TOP], 1u);
            const unsigned tg = og / nx;
            if (og + 1u == (tg + 1u) * nx) xb_add(&bar[XB_TOPGEN], 1u);
            else XB_SPIN(xb_ld(&bar[XB_TOPGEN]) == tg, bar);
            __builtin_amdgcn_fence(__ATOMIC_ACQUIRE, "agent");
            xb_add(&bar[XB_XGEN(b.x)], 1u);
            asm volatile("s_waitcnt vmcnt(0)" ::: "memory");
        } else {
            XB_SPIN(xb_ld(&bar[XB_XGEN(b.x)]) == gen, bar);
            __builtin_amdgcn_fence(__ATOMIC_ACQUIRE, "agent");
            asm volatile("s_waitcnt vmcnt(0)" ::: "memory");
        }
    }
    __syncthreads();
}

namespace pg8 {
constexpr int BM = 256, BK = 64, HALF = 128, HTB = HALF * BK * 2, STAGE_BYTES = 8 * HTB, NXCD = 8, WGM = 8;
DI int lds_byte(int r, int c) { const int st = (r >> 4) * 2 + (c >> 5), rr = r & 15, cc = c & 31, ob = rr * 64 + cc * 2; return st * 1024 + (ob ^ (((ob >> 9) & 1) << 5)); }
DI void stage_rc(int b, int& R, int& C) { const int st = b / 1024, sb = b % 1024, swz = sb ^ (((sb >> 9) & 1) << 5); R = (st >> 1) * 16 + swz / 64; C = (st & 1) * 32 + (swz % 64) / 2; }
DI int perm32(int rho) { const int n = rho >> 4, i = rho & 15; return 8 * (i >> 2) + 4 * n + (i & 3); }

struct Unit { int pm, pn, pz; };
struct Gemm { const bf16* A; const bf16* Bt; int K, lda, ldb; size_t a_z, b_z; };

template <int MODE> struct Order {
    int nM, nN, nwg, G, c, L0 = 0, imax = 1 << 30;
    DI void init(int nM_, int nN_, int G_, int c_) { nM = nM_; nN = nN_; nwg = nM * nN; G = G_; c = c_; }
    DI bool next(int i, Unit& u) const {
        const int ii = (MODE == 2) ? i / 3 : i;
        const long L = (long)L0 + (long)ii * G + c; if (ii >= imax || L >= nwg) return false;
        int wgid = (int)L; { const int q = nwg / NXCD, r = nwg % NXCD, xcd = wgid % NXCD, off = wgid / NXCD; wgid = (xcd < r ? xcd * (q + 1) : r * (q + 1) + (xcd - r) * q) + off; }
        const int nig = WGM * nN, gid = wgid / nig, fm = gid * WGM, gsz = (nM - fm) < WGM ? (nM - fm) : WGM;
        u.pm = fm + ((wgid % nig) % gsz); const int pn = (wgid % nig) / gsz;
        if (MODE == 1) { u.pz = pn >> 1; u.pn = pn & 1; } else if (MODE == 2) { u.pz = i - ii * 3; u.pn = pn; } else { u.pz = 0; u.pn = pn; }
        return true;
    }
};

struct EpiBf16 {
    static constexpr bool PERM = true;
    bf16* O; int ldc; int zcols;
    DI void operator()(const f32x4 (&acc)[2][2][4][2], const Unit& u, int wr, int wc, int fr, int fq) const {
        const int row0 = u.pm * BM + wr * 64 + fr; const int col0 = u.pz * zcols + u.pn * BM + wc * 32 + 8 * fq;
#pragma unroll
        for (int ai = 0; ai < 2; ++ai)
#pragma unroll
            for (int m = 0; m < 4; ++m) { bf16* rowp = O + (size_t)(row0 + ai * HALF + m * 16) * ldc + col0;
#pragma unroll
                for (int bj = 0; bj < 2; ++bj) { const f32x4 v0 = acc[ai][bj][m][0], v1 = acc[ai][bj][m][1];
                    v4u w; w.x = pk2(v0[0], v0[1]); w.y = pk2(v0[2], v0[3]); w.z = pk2(v1[0], v1[1]); w.w = pk2(v1[2], v1[3]);
                    *(v4u*)(rowp + bj * HALF) = w; } }
    }
};
struct EpiZ {
    static constexpr bool PERM = true;
    bf16* O; int ldc; const float* lbl;
    DI void operator()(const f32x4 (&acc)[2][2][4][2], const Unit& u, int wr, int wc, int fr, int fq) const {
        const int row0 = u.pm * BM + wr * 64 + fr; const int col0 = u.pn * BM + wc * 32 + 8 * fq;
        const int kind = (u.pn >= ZC_HGQ / 256 && u.pn < ZC_HGF / 256) ? 1 : ((u.pn >= ZC_HGF / 256 && u.pn < ZC_HGI / 256) ? 2 : 0);
        float lb[2][8];
#pragma unroll
        for (int bj = 0; bj < 2; ++bj)
#pragma unroll
            for (int j = 0; j < 8; ++j) lb[bj][j] = 0.f;
        if (kind == 2 && lbl) {
#pragma unroll
            for (int bj = 0; bj < 2; ++bj) { const float* p0 = lbl + (col0 + bj * HALF - ZC_HGF);
#pragma unroll
                for (int j = 0; j < 8; ++j) lb[bj][j] = sigmoidf_(p0[D + j] - p0[j]); } }
#pragma unroll
        for (int ai = 0; ai < 2; ++ai)
#pragma unroll
            for (int m = 0; m < 4; ++m) { bf16* rowp = O + (size_t)(row0 + ai * HALF + m * 16) * ldc + col0;
#pragma unroll
                for (int bj = 0; bj < 2; ++bj) { float o[8];
#pragma unroll
                    for (int j = 0; j < 8; ++j) { const float x = acc[ai][bj][m][j >> 2][j & 3];
                        o[j] = kind == 0 ? x : (kind == 1 ? siluf_(x) : __logf(fmaxf(lb[bj][j] + (1.0f - lb[bj][j]) * sigmoidf_(x), 1e-30f))); }
                    *(v4u*)(rowp + bj * HALF) = pack8(o); } }
    }
};
struct EpiLora {
    static constexpr bool PERM = true;
    bf16* O; int ldc; const float* w0; const float* a0; const float* v0;
    DI void operator()(const f32x4 (&acc)[2][2][4][2], const Unit& u, int wr, int wc, int fr, int fq) const {
        const int row0 = u.pm * BM + wr * 64 + fr; const int col0 = u.pn * BM + wc * 32 + 8 * fq;
        const int kind = u.pn >> 2;
        const int cc = col0 & 1023;
#pragma unroll
        for (int bj = 0; bj < 2; ++bj) {
            f32x4 c0 = (f32x4){0.f, 0.f, 0.f, 0.f}, c1 = c0;
            if (kind == 0) { c0 = *(const f32x4*)(w0 + cc + bj * HALF); c1 = *(const f32x4*)(w0 + cc + bj * HALF + 4); }
            if (kind == 1) { c0 = *(const f32x4*)(a0 + cc + bj * HALF); c1 = *(const f32x4*)(a0 + cc + bj * HALF + 4); }
            if (kind == 3) { c0 = *(const f32x4*)(v0 + cc + bj * HALF); c1 = *(const f32x4*)(v0 + cc + bj * HALF + 4); }
#pragma unroll
            for (int ai = 0; ai < 2; ++ai)
#pragma unroll
                for (int m = 0; m < 4; ++m) { bf16* rowp = O + (size_t)(row0 + ai * HALF + m * 16) * ldc + col0 + bj * HALF; float o[8];
#pragma unroll
                    for (int j = 0; j < 8; ++j) { const float x = acc[ai][bj][m][j >> 2][j & 3] + (j < 4 ? c0[j & 3] : c1[j & 3]);
                        o[j] = kind == 2 ? x : (kind == 0 ? -__expf(-softplusf_(-x) - 0.5f) : sigmoidf_(x)); }
                    *(v4u*)rowp = pack8(o); }
        }
    }
};
struct EpiSwiGLU {
    static constexpr bool PERM = true;
    bf16* O; int ldc;
    DI void operator()(const f32x4 (&acc)[2][2][4][2], const Unit& u, int wr, int wc, int fr, int fq) const {
        const int row0 = u.pm * BM + wr * 64 + fr; const int col0 = u.pn * HALF + wc * 32 + 8 * fq;
#pragma unroll
        for (int ai = 0; ai < 2; ++ai)
#pragma unroll
            for (int m = 0; m < 4; ++m) { bf16* rowp = O + (size_t)(row0 + ai * HALF + m * 16) * ldc + col0;
                float o[8];
#pragma unroll
                for (int n = 0; n < 2; ++n)
#pragma unroll
                    for (int j = 0; j < 4; ++j) { const float a = acc[ai][0][m][n][j], b = acc[ai][1][m][n][j]; o[n * 4 + j] = a * b * __builtin_amdgcn_rcpf(1.0f + __expf(-a)); }
                *(v4u*)rowp = pack8(o); }
    }
};
struct EpiResid {
    static constexpr bool PERM = false;
    const float* xin; float* xout; const float* gate; float mul; int b0;
    DI void operator()(const f32x4 (&acc)[2][2][4][2], const Unit& u, int wr, int wc, int fr, int fq) const {
        const int row0 = u.pm * BM + wr * 64 + fr, col0 = u.pn * BM + wc * 32 + 4 * fq;
        const float* gp = gate + (size_t)(b0 + (u.pm * BM) / T) * NMOD + col0;
        f32x4 cf[2][2];
#pragma unroll
        for (int bj = 0; bj < 2; ++bj)
#pragma unroll
            for (int n = 0; n < 2; ++n) cf[bj][n] = (*(const f32x4*)(gp + bj * HALF + n * 16) + 1.0f) * mul;
#pragma unroll
        for (int ai = 0; ai < 2; ++ai)
#pragma unroll
            for (int m = 0; m < 4; ++m) { const size_t off = (size_t)(row0 + ai * HALF + m * 16) * D + col0;
#pragma unroll
                for (int bj = 0; bj < 2; ++bj)
#pragma unroll
                    for (int n = 0; n < 2; ++n) { const f32x4 xi = *(const f32x4*)(xin + off + bj * HALF + n * 16);
                        *(f32x4*)(xout + off + bj * HALF + n * 16) = xi + cf[bj][n] * acc[ai][bj][m][n]; }
                asm volatile("" ::: "memory"); }
    }
};
struct EpiBranch {
    static constexpr bool PERM = false;
    const bf16* gates; int ldg; float* mixf; bf16* mixb;
    DI void operator()(const f32x4 (&acc)[2][2][4][2], const Unit& u, int wr, int wc, int fr, int fq) const {
        const int row0 = u.pm * BM + wr * 64 + fr, col0 = u.pn * BM + wc * 32 + 4 * fq;
#pragma unroll
        for (int ai = 0; ai < 2; ++ai)
#pragma unroll
            for (int m = 0; m < 4; ++m) { const int row = row0 + ai * HALF + m * 16; const size_t off = (size_t)row * D + col0; const bf16* gp = gates + (size_t)row * ldg + u.pz * D + col0;
#pragma unroll
                for (int bj = 0; bj < 2; ++bj)
#pragma unroll
                    for (int n = 0; n < 2; ++n) { const v2u gw = *(const v2u*)(gp + bj * HALF + n * 16);
                        f32x4 g; g[0] = sigmoidf_(bflo(gw.x)); g[1] = sigmoidf_(bfhi(gw.x)); g[2] = sigmoidf_(bflo(gw.y)); g[3] = sigmoidf_(bfhi(gw.y));
                        f32x4 v = g * acc[ai][bj][m][n];
                        if (u.pz > 0) v += *(const f32x4*)(mixf + off + bj * HALF + n * 16);
                        if (u.pz < 2) *(f32x4*)(mixf + off + bj * HALF + n * 16) = v;
                        else { v2u w; w.x = pk2(v[0], v[1]); w.y = pk2(v[2], v[3]); *(v2u*)(mixb + off + bj * HALF + n * 16) = w; } }
                asm volatile("" ::: "memory"); }
    }
};

template <class Epi, class Sched>
DI void gemm_phase(LAS unsigned char* lds, const Gemm g, const Sched& S, const Epi& E, int tid_) {
    asm volatile("" : "+v"(tid_));
    const int tid = tid_, wid = __builtin_amdgcn_readfirstlane(tid >> 6), lane = tid & 63, wr = wid >> 2, wc = wid & 3, fr = lane & 15, fq = lane >> 4;
    int K_ = g.K; asm volatile("" : "+s"(K_));
    const int K = K_, nt = K / BK;
    unsigned voffA[2], voffB[2];
#pragma unroll
    for (int i = 0; i < 2; ++i) { int R, C; stage_rc(tid * 16 + i * 8192, R, C); const int Rb = Epi::PERM ? ((R & ~31) + perm32(R & 31)) : R;
        voffA[i] = (unsigned)(R * g.lda + C) * 2u; voffB[i] = (unsigned)(Rb * g.ldb + C) * 2u; }
    const size_t kstep = (size_t)(BK * 2);
    const size_t hstepA = (size_t)HALF * g.lda * 2, hstepB = (size_t)HALF * g.ldb * 2;
    const size_t tstepA = 2 * hstepA, tstepB = 2 * hstepB;
    const unsigned ldsw = (unsigned)wid * 1024u;
    const int aoff = lds_byte(wr * 64 + fr, fq * 8), boff = lds_byte(wc * 32 + fr, fq * 8);
#define PG8_SA(b, h) (((b) * 2 + (h)) * HTB)
#define PG8_SB(b, h) ((4 + (b) * 2 + (h)) * HTB)
#define PG8_STAGE(bufoff, gbase, voff) do { _Pragma("unroll") for (int _i = 0; _i < 2; ++_i) \
        __builtin_amdgcn_global_load_lds((const unsigned*)((const char*)(gbase) + (voff)[_i]), (LAS unsigned*)(lds + (bufoff) + ldsw + _i * 8192), 16, 0, 0); } while (0)
#define PG8_LDA(dst, b, h) do { _Pragma("unroll") for (int m = 0; m < 4; ++m) _Pragma("unroll") for (int k = 0; k < 2; ++k) dst[m][k] = *(const LAS bf16x8*)(lds + PG8_SA(b, h) + aoff + m * 2048 + k * 1024); } while (0)
#define PG8_LDB(dst, b, h) do { _Pragma("unroll") for (int n = 0; n < 2; ++n) _Pragma("unroll") for (int k = 0; k < 2; ++k) dst[n][k] = *(const LAS bf16x8*)(lds + PG8_SB(b, h) + boff + n * 2048 + k * 1024); } while (0)
#define PG8_MMA(ai, bj, At, Bt) do { __builtin_amdgcn_s_setprio(1); _Pragma("unroll") for (int m = 0; m < 4; ++m) _Pragma("unroll") for (int n = 0; n < 2; ++n) _Pragma("unroll") for (int k = 0; k < 2; ++k) \
        acc[ai][bj][m][n] = __builtin_amdgcn_mfma_f32_16x16x32_bf16(Bt[n][k], At[m][k], acc[ai][bj][m][n], 0, 0, 0); __builtin_amdgcn_s_setprio(0); } while (0)
#define PG8_WAIT_V(n) asm volatile("s_waitcnt vmcnt(" #n ")" ::: "memory")
#define PG8_WAIT_L(n) asm volatile("s_waitcnt lgkmcnt(" #n ")" ::: "memory")
#define PG8_BAR __builtin_amdgcn_s_barrier()
#define PG8_SCHED __builtin_amdgcn_sched_barrier(0)
    Unit cur, nxt; int ui = 0;
    if (!S.next(0, cur)) return;
    f32x4 acc[2][2][4][2];
#pragma unroll
    for (int a = 0; a < 2; ++a)
#pragma unroll
        for (int b = 0; b < 2; ++b)
#pragma unroll
            for (int m = 0; m < 4; ++m)
#pragma unroll
                for (int n = 0; n < 2; ++n) acc[a][b][m][n] = (f32x4){0.f, 0.f, 0.f, 0.f};
    bf16x8 At[4][2], B0[2][2], B1[2][2];
    const char* cA = (const char*)(g.A + (size_t)cur.pz * g.a_z) + (size_t)cur.pm * tstepA; const char* cB = (const char*)(g.Bt + (size_t)cur.pz * g.b_z) + (size_t)cur.pn * tstepB;
    PG8_STAGE(PG8_SB(0, 0), cB, voffB); PG8_STAGE(PG8_SB(0, 1), cB + hstepB, voffB); PG8_STAGE(PG8_SA(0, 0), cA, voffA); PG8_STAGE(PG8_SA(0, 1), cA + hstepA, voffA);
    if (wr == 1) PG8_BAR;
    PG8_WAIT_V(2); PG8_BAR;
    PG8_STAGE(PG8_SB(1, 0), cB + kstep, voffB); PG8_STAGE(PG8_SA(1, 0), cA + kstep, voffA); PG8_STAGE(PG8_SB(1, 1), cB + hstepB + kstep, voffB);
    PG8_WAIT_V(6); PG8_BAR;
    for (;;) {
        const bool has_next = S.next(ui + 1, nxt);
        const char* nA = has_next ? (const char*)(g.A + (size_t)nxt.pz * g.a_z) + (size_t)nxt.pm * tstepA : cA; const char* nB = has_next ? (const char*)(g.Bt + (size_t)nxt.pz * g.b_z) + (size_t)nxt.pn * tstepB : cB;
        for (int t = 0; t < nt; t += 2) {
            const bool last = (t == nt - 2);
            const char* a1 = cA + (size_t)(t + 1) * kstep;
            const char* a2 = last ? nA : cA + (size_t)(t + 2) * kstep; const char* b2 = last ? nB : cB + (size_t)(t + 2) * kstep;
            const char* a3 = a2 + kstep; const char* b3 = b2 + kstep;
            PG8_LDB(B0, 0, 0); PG8_LDB(B1, 0, 1); PG8_SCHED; PG8_LDA(At, 0, 0); PG8_STAGE(PG8_SA(1, 1), a1 + hstepA, voffA);
            PG8_WAIT_V(8); PG8_WAIT_L(0); PG8_BAR; PG8_MMA(0, 0, At, B0); PG8_MMA(0, 1, At, B1); PG8_BAR; PG8_SCHED;
            PG8_LDA(At, 0, 1); PG8_STAGE(PG8_SB(0, 0), b2, voffB); PG8_STAGE(PG8_SB(0, 1), b2 + hstepB, voffB); PG8_STAGE(PG8_SA(0, 0), a2, voffA);
            PG8_WAIT_V(8); PG8_WAIT_L(0); PG8_BAR; PG8_MMA(1, 0, At, B0); PG8_MMA(1, 1, At, B1); PG8_BAR; PG8_SCHED;
            PG8_LDB(B0, 1, 0); PG8_LDB(B1, 1, 1); PG8_SCHED; PG8_LDA(At, 1, 0); PG8_STAGE(PG8_SA(0, 1), a2 + hstepA, voffA);
            PG8_WAIT_V(8); PG8_WAIT_L(0); PG8_BAR; PG8_MMA(0, 0, At, B0); PG8_MMA(0, 1, At, B1); PG8_BAR; PG8_SCHED;
            PG8_LDA(At, 1, 1); PG8_STAGE(PG8_SB(1, 0), b3, voffB); PG8_STAGE(PG8_SB(1, 1), b3 + hstepB, voffB); PG8_STAGE(PG8_SA(1, 0), a3, voffA);
            PG8_WAIT_V(8); PG8_WAIT_L(0); PG8_BAR; PG8_MMA(1, 0, At, B0); PG8_MMA(1, 1, At, B1); PG8_BAR; PG8_SCHED;
        }
        if (wr == 0) PG8_BAR;
        E(acc, cur, wr, wc, fr, fq);
        if (!has_next) break;
#pragma unroll
        for (int a = 0; a < 2; ++a)
#pragma unroll
            for (int b = 0; b < 2; ++b)
#pragma unroll
                for (int m = 0; m < 4; ++m)
#pragma unroll
                    for (int n = 0; n < 2; ++n) acc[a][b][m][n] = (f32x4){0.f, 0.f, 0.f, 0.f};
        cur = nxt; cA = nA; cB = nB; ++ui;
        if (wr == 1) PG8_BAR;
    }
    PG8_WAIT_V(0);
    PG8_BAR;
#undef PG8_SA
#undef PG8_SB
#undef PG8_STAGE
#undef PG8_LDA
#undef PG8_LDB
#undef PG8_MMA
#undef PG8_WAIT_V
#undef PG8_WAIT_L
#undef PG8_BAR
#undef PG8_SCHED
}
}

struct Args {
    const float* in[36]; float* out; unsigned char* ws;
    int f_lo, f_hi, g_lo, g_hi, ph_lo, ph_hi, use_bar, pad;
};
struct Ctx {
    LAS unsigned char* lds;
    const float* const* in; float* out; unsigned char* ws;
    int tid, lane, wave, bid, G, z;
};
DI void refresh(Ctx& F) {
    { int z_ = 0; asm volatile("" : "+s"(z_)); F.z = z_; }
    asm volatile("" : "+v"(F.tid)); F.lane = F.tid & 63; F.wave = __builtin_amdgcn_readfirstlane(F.tid >> 6);
}
enum { I_X = 0, I_C, I_NORMW, I_FNORMW, I_ADAW, I_ADAB, I_FUP, I_FDN, I_WIN, I_WINV, I_CONVW, I_CONVB, I_WQ, I_WK, I_IB, I_FB, I_MLNW, I_MLSKIP,
       I_MU, I_MUV, I_W0, I_W2, I_A0, I_A2, I_V0, I_V2, I_G2, I_KK, I_KA, I_RK, I_LNW, I_LNB, I_LBL, I_HGNW, I_WBR, I_WOUT };

DI void transpose_item(const float* W, int ldw, int k0, int c0, bf16* WT, int ldt, int r0, float scale, LAS float* scr, int lane) {
    float tv[32];
#pragma unroll
    for (int i = 0; i < 32; ++i) tv[i] = W[(size_t)(k0 + 2 * i + (lane >> 5)) * ldw + c0 + (lane & 31)];
#pragma unroll
    for (int i = 0; i < 32; ++i) scr[(2 * i + (lane >> 5)) * 33 + (lane & 31)] = tv[i];
    LDS_WAIT(); asm volatile("" ::: "memory");
    const int c = lane & 7;
#pragma unroll
    for (int j = 0; j < 4; ++j) { const int n = (lane >> 3) + 8 * j; const LAS float* s = scr + (8 * c) * 33 + n;
        v4u o; o.x = pk2(s[0 * 33] * scale, s[1 * 33] * scale); o.y = pk2(s[2 * 33] * scale, s[3 * 33] * scale); o.z = pk2(s[4 * 33] * scale, s[5 * 33] * scale); o.w = pk2(s[6 * 33] * scale, s[7 * 33] * scale);
        *(v4u*)(WT + (size_t)(r0 + n) * ldt + k0 + 8 * c) = o; }
    LDS_WAIT(); asm volatile("" ::: "memory");
}
DI void phase_weights(const Ctx& F, int l) {
    LAS float* scr = (LAS float*)(F.lds + F.wave * 16384);
    const int gw = F.bid * NWAVES + F.wave, NGW = F.G * NWAVES;
    constexpr int I_UP = 16 * 176, I_DN = 44 * 32, I_IN = 16 * 392, I_SQ = 16 * 32, I_QKI = 8 * 32;
    constexpr int NITEMS = 2 * I_UP + 2 * I_DN + I_IN + 4 * I_SQ + I_QKI;
    bf16* WUP = (bf16*)(F.ws + WS_WUP); bf16* WDN = (bf16*)(F.ws + WS_WDN); bf16* WIN = (bf16*)(F.ws + WS_WIN); bf16* WBR = (bf16*)(F.ws + WS_WBR);
    bf16* WOUT = (bf16*)(F.ws + WS_WOUT); bf16* WQK = (bf16*)(F.ws + WS_WQK);
    for (int it = gw; it < NITEMS; it += NGW) {
        int r = it;
        if (r < 2 * I_UP) { const int i = r / I_UP; r -= i * I_UP; const int kb = r / 176, nb = r % 176, c0 = 32 * nb; const int cc = c0 < DFF ? c0 : c0 - DFF;
            const int r0 = (cc / 128) * 256 + (c0 < DFF ? 0 : 128) + (cc % 128);
            transpose_item(F.in[F.z + I_FUP] + (size_t)(l * 2 + i) * D * NUP, NUP, 64 * kb, c0, WUP + (size_t)i * NUP * D, D, r0, 1.f, scr, F.lane); continue; }
        r -= 2 * I_UP;
        if (r < 2 * I_DN) { const int i = r / I_DN; r -= i * I_DN; const int kb = r / 32, nb = r % 32;
            transpose_item(F.in[F.z + I_FDN] + (size_t)(l * 2 + i) * DFF * D, D, 64 * kb, 32 * nb, WDN + (size_t)i * D * DFF, DFF, 32 * nb, 1.f, scr, F.lane); continue; }
        r -= 2 * I_DN;
        if (r < I_IN) { const int kb = r / 392, nb = r % 392, d0 = 32 * nb, c0 = d0 < 1024 ? d0 : (d0 < NZE ? d0 + 1032 : (d0 < 8448 ? d0 - 6400 : d0 + 8));
            transpose_item(F.in[F.z + I_WIN] + (size_t)l * D * WIN_SRC, WIN_SRC, 64 * kb, c0, WIN, D, d0, 1.f, scr, F.lane); continue; }
        r -= I_IN;
        if (r < 3 * I_SQ) { const int n = r / I_SQ; r -= n * I_SQ; const int kb = r / 32, nb = r % 32;
            transpose_item(F.in[F.z + I_WBR] + (size_t)(l * 3 + n) * D * D, D, 64 * kb, 32 * nb, WBR + (size_t)n * D * D, D, 32 * nb, 1.f, scr, F.lane); continue; }
        r -= 3 * I_SQ;
        if (r < I_SQ) { const int kb = r / 32, nb = r % 32;
            transpose_item(F.in[F.z + I_WOUT] + (size_t)l * D * D, D, 64 * kb, 32 * nb, WOUT, D, 32 * nb, 1.f, scr, F.lane); continue; }
        r -= I_SQ;
        { const int mat = r / 32, rr = r % 32, h = mat >> 1, isk = mat & 1, kb = rr / 8, nb = rr % 8;
            transpose_item(F.in[F.z + isk ? I_WK : I_WQ] + (size_t)(l * 4 + h) * 256 * 256, 256, 64 * kb, 32 * nb, WQK + (size_t)(h * 512 + isk * 256) * 256, 256, 32 * nb, isk ? 0.0625f : 1.f, scr, F.lane); }
    }
    const int gt = F.bid * NTHREADS + F.tid, NT = F.G * NTHREADS;
    bf16* WL = (bf16*)(F.ws + WS_WLORA);
    for (int idx = gt; idx < NLORA * (KLORA / 8); idx += NT) {
        const int n = idx & (NLORA - 1), kc = idx >> 12, k0 = kc * 8, blk = n >> 10, nn = n & 1023;
        float o[8];
#pragma unroll
        for (int i = 0; i < 8; ++i) o[i] = 0.f;
        const float* src = nullptr; int kk = 0;
        if (blk == 0 && k0 < 64) { src = F.in[F.z + I_W2] + (size_t)l * 64 * D; kk = k0; }
        else if (blk == 1 && k0 >= 64 && k0 < 128) { src = F.in[F.z + I_A2] + (size_t)l * 64 * D; kk = k0 - 64; }
        else if (blk == 2 && k0 >= 128 && k0 < 256) { src = F.in[F.z + I_G2] + (size_t)l * 128 * D; kk = k0 - 128; }
        else if (blk == 3 && l == 1 && k0 >= 256 && k0 < 288) { src = F.in[F.z + I_V2]; kk = k0 - 256; }
        if (src) {
#pragma unroll
            for (int i = 0; i < 8; ++i) o[i] = src[(size_t)(kk + i) * D + nn]; }
        *(v4u*)(WL + (size_t)n * KLORA + k0) = pack8(o);
    }
    float* WS_ = (float*)(F.ws + WS_WSIDE);
    for (int idx = gt; idx < NSIDE * D; idx += NT) {
        const int j = idx >> 10, k = idx & 1023; float v = 0.f;
        if (j < 8) v = F.in[F.z + I_WIN][(size_t)l * D * WIN_SRC + (size_t)k * WIN_SRC + 2048 + j];
        else if (l == 1) v = F.in[F.z + I_WINV][(size_t)k * 32 + (j - 8)];
        WS_[idx] = v;
    }
}
DI void phase_mod(const Ctx& F) {
    LAS float* sc = (LAS float*)F.lds; LAS float* red = (LAS float*)(F.lds + 65536);
    float* mod = (float*)(F.ws + WS_MOD);
    bool loaded = false;
    for (int it = F.bid; it < 2 * 144; it += F.G) {
        if (!loaded) { for (int i = F.tid; i < NB * D; i += NTHREADS) sc[i] = siluf_(F.in[F.z + I_C][i]); loaded = true; __syncthreads(); }
        const int l = it / 144, n0 = (it % 144) * 64, n = F.tid & 63, ks = F.tid >> 6;
        float acc[16];
#pragma unroll
        for (int b = 0; b < 16; ++b) acc[b] = 0.f;
        const float* wp = F.in[F.z + I_ADAW] + (size_t)l * D * NMOD + n0 + n;
        for (int k = ks * 128; k < ks * 128 + 128; ++k) { const float w = wp[(size_t)k * NMOD];
#pragma unroll
            for (int b = 0; b < 16; ++b) acc[b] += sc[b * D + k] * w; }
#pragma unroll
        for (int b = 0; b < 16; ++b) red[(ks * 16 + b) * 64 + n] = acc[b];
        __syncthreads();
        for (int o = F.tid; o < 1024; o += NTHREADS) { const int b = o >> 6, nn = o & 63; float s = 0.f;
#pragma unroll
            for (int k8 = 0; k8 < 8; ++k8) s += red[(k8 * 16 + b) * 64 + nn];
            mod[(size_t)(l * 16 + b) * NMOD + n0 + nn] = s + F.in[F.z + I_ADAB][(size_t)l * NMOD + n0 + nn]; }
        __syncthreads();
    }
}

template <bool SIDE>
DI void phase_modulate(const Ctx& F, const float* x, bf16* hout, const float* nw, const float* modl, int sub, int r0, int nrows, float* side, int nside, int wg, int nwg) {
    const int gw = wg * NWAVES + F.wave, NGW = nwg * NWAVES;
    const float* wside = (const float*)(F.ws + WS_WSIDE);
    constexpr int RB = SIDE ? 4 : 1;
    for (int rq = gw; rq < nrows / RB; rq += NGW) {
        const int b = (r0 + rq * RB) / T;
        const f32x4* nwp = (const f32x4*)nw + F.lane;
        const f32x4* shp = (const f32x4*)(modl + (size_t)b * NMOD + (sub * 3 + 0) * D) + F.lane;
        const f32x4* scp = (const f32x4*)(modl + (size_t)b * NMOD + (sub * 3 + 1) * D) + F.lane;
        f32x4 v[RB][4];
#pragma unroll
        for (int i = 0; i < RB; ++i) { const f32x4* xr = (const f32x4*)(x + (size_t)(r0 + rq * RB + i) * D) + F.lane;
#pragma unroll
            for (int j = 0; j < 4; ++j) v[i][j] = xr[64 * j]; }
#pragma unroll
        for (int i = 0; i < RB; ++i) { float ss = 0.f;
#pragma unroll
            for (int j = 0; j < 4; ++j) ss += (v[i][j].x * v[i][j].x + v[i][j].y * v[i][j].y) + (v[i][j].z * v[i][j].z + v[i][j].w * v[i][j].w);
            const float rstd = __builtin_amdgcn_rsqf(wave_sum(ss) * (1.f / D) + 1e-6f);
            unsigned long long* o8 = (unsigned long long*)(hout + (size_t)(rq * RB + i) * D) + F.lane;
#pragma unroll
            for (int j = 0; j < 4; ++j) { v[i][j] = v[i][j] * rstd * nwp[64 * j] * (scp[64 * j] + 1.0f) + shp[64 * j];
                o8[64 * j] = (unsigned long long)pk2(v[i][j].x, v[i][j].y) | ((unsigned long long)pk2(v[i][j].z, v[i][j].w) << 32); } }
        if (SIDE) {
            for (int jj = 0; jj < nside; ++jj) { const f32x4* wp = (const f32x4*)(wside + jj * D) + F.lane; f32x4 w[4];
#pragma unroll
                for (int j = 0; j < 4; ++j) w[j] = wp[64 * j];
                float s[RB];
#pragma unroll
                for (int i = 0; i < RB; ++i) { float a = 0.f;
#pragma unroll
                    for (int j = 0; j < 4; ++j) a += (v[i][j].x * w[j].x + v[i][j].y * w[j].y) + (v[i][j].z * w[j].z + v[i][j].w * w[j].w);
                    s[i] = wave_sum(a); }
#pragma unroll
                for (int i = 0; i < RB; ++i) if (F.lane == i) side[(size_t)(rq * RB + i) * NSIDE + jj] = s[i]; }
        }
    }
}
DI void phase_final_norm(const Ctx& F) {
    const int gw = F.bid * NWAVES + F.wave, NGW = F.G * NWAVES;
    for (int row = gw; row < M; row += NGW) {
        f32x4* xr = (f32x4*)(F.out + (size_t)row * D) + F.lane;
        f32x4 v[4]; float ss = 0.f;
#pragma unroll
        for (int j = 0; j < 4; ++j) { v[j] = xr[64 * j]; ss += (v[j].x * v[j].x + v[j].y * v[j].y) + (v[j].z * v[j].z + v[j].w * v[j].w); }
        const float rstd = 1.0f / sqrtf(wave_sum(ss) * (1.f / D) + 1e-6f);
        const f32x4* nwp = (const f32x4*)F.in[F.z + I_FNORMW] + F.lane;
#pragma unroll
        for (int j = 0; j < 4; ++j) xr[64 * j] = v[j] * rstd * nwp[64 * j];
    }
}

DI void phase_prep(const Ctx& F, int l) {
    const int gt = F.bid * NTHREADS + F.tid, NT = F.G * NTHREADS;
    const bf16* Z = (const bf16*)(F.ws + WS_Z); bf16* XC = (bf16*)(F.ws + WS_XC); bf16* LA = (bf16*)(F.ws + WS_LA); const float* SD = (const float*)(F.ws + WS_SIDE);
    const float* cw = F.in[F.z + I_CONVW] + (size_t)l * 4 * D; const float* cb = F.in[F.z + I_CONVB] + (size_t)l * D;
    const float* mu = F.in[F.z + I_MU] + (size_t)l * 3328;
    for (int idx = gt; idx < (MG / 8) * 128; idx += NT) {
        const int rb = idx >> 7, c8 = (idx & 127) * 8, row0 = rb * 8, t0 = row0 & (T - 1);
        float wv[4][8], bv[8];
#pragma unroll
        for (int i = 0; i < 8; ++i) bv[i] = cb[c8 + i];
#pragma unroll
        for (int j = 0; j < 4; ++j)
#pragma unroll
            for (int i = 0; i < 8; ++i) wv[j][i] = cw[j * D + c8 + i];
        v4u zr[11];
#pragma unroll
        for (int r = 0; r < 11; ++r) zr[r] = (r >= 3 || t0 > 0) ? *(const v4u*)(Z + (size_t)(row0 - 3 + r) * NZ + ZC_MLX + c8) : (v4u){0u, 0u, 0u, 0u};
#pragma unroll
        for (int r = 0; r < 8; ++r) { float a[8], x[8];
#pragma unroll
            for (int i = 0; i < 8; ++i) a[i] = bv[i];
#pragma unroll
            for (int j = 0; j < 4; ++j) { unpack8(zr[r + j], x);
#pragma unroll
                for (int i = 0; i < 8; ++i) a[i] += wv[j][i] * x[i]; }
#pragma unroll
            for (int i = 0; i < 8; ++i) a[i] = siluf_(a[i]);
            *(v4u*)(XC + (size_t)(row0 + r) * D + c8) = pack8(a); }
    }
    for (int idx = gt; idx < MG * 48; idx += NT) {
        const int row = idx / 48, k0 = (idx - row * 48) * 8, t = row & (T - 1);
        float o[8];
#pragma unroll
        for (int i = 0; i < 8; ++i) o[i] = 0.f;
        if (k0 < 256) { float cur[8], prv[8];
            unpack8(*(const v4u*)(Z + (size_t)row * NZ + ZC_RW + 3072 + k0), cur);
            if (t > 0) unpack8(*(const v4u*)(Z + (size_t)(row - 1) * NZ + ZC_RW + 3072 + k0), prv); else {
#pragma unroll
                for (int i = 0; i < 8; ++i) prv[i] = 0.f; }
#pragma unroll
            for (int i = 0; i < 8; ++i) { const float s = cur[i] + mu[3072 + k0 + i] * (prv[i] - cur[i]); o[i] = k0 < 64 ? tanhf(s) : (k0 < 128 ? s : sigmoidf_(s)); }
        } else if (l == 1 && k0 < 288) {
#pragma unroll
            for (int i = 0; i < 8; ++i) { const int j = k0 - 256 + i; const float cur = SD[(size_t)row * NSIDE + 8 + j], prv = t > 0 ? SD[(size_t)(row - 1) * NSIDE + 8 + j] : 0.f;
                o[i] = cur + F.in[F.z + I_MUV][j] * (prv - cur); }
        }
        *(v4u*)(LA + (size_t)row * KLORA + k0) = pack8(o);
    }
}

typedef short s16x4 __attribute__((ext_vector_type(4)));
DI bf16x8 tr8(const LAS unsigned char* p0, const LAS unsigned char* p1) {
    const s16x4 lo = __builtin_amdgcn_ds_read_tr16_b64_v4i16((LAS s16x4*)p0), hi = __builtin_amdgcn_ds_read_tr16_b64_v4i16((LAS s16x4*)p1);
    return (bf16x8){lo[0], lo[1], lo[2], lo[3], hi[0], hi[1], hi[2], hi[3]};
}
DI float wave_incl_sum(float v, int lane) {
#pragma unroll
    for (int o = 1; o < 64; o <<= 1) { const float t = __shfl_up(v, o); if (lane >= o) v += t; }
    return v;
}
DI float wave_incl_max(float v, int lane) {
#pragma unroll
    for (int o = 1; o < 64; o <<= 1) { const float t = __shfl_up(v, o); if (lane >= o) v = fmaxf(v, t); }
    return v;
}
#define WG_SYNC() do { asm volatile("s_waitcnt lgkmcnt(0)" ::: "memory"); __builtin_amdgcn_s_barrier(); asm volatile("" ::: "memory"); } while (0)
DI void scan_mlstm_mfma(const Ctx& F, int l, int unit) {
    constexpr int QP = 528, PP = 144, VP = 96;
    constexpr int O_QS = 0, O_KS = 33792, O_CB = 67584, O_PS = 92928, O_VS = 102144, O_GT = 108288, O_GA = 110336;
    const int e8 = unit & 7, h = (unit >> 3) & 3, bl = unit >> 5;
    LAS unsigned char* Qs = F.lds + O_QS; LAS unsigned char* Ks = F.lds + O_KS; LAS unsigned char* Cb = F.lds + O_CB; LAS unsigned char* Ps = F.lds + O_PS; LAS unsigned char* Vs = F.lds + O_VS;
    LAS float* RT = (LAS float*)(F.lds + O_GT); LAS float* CS = RT + 64; LAS float* WI = RT + 128; LAS float* EM = RT + 192; LAS float* WS = RT + 256; LAS float* SC = RT + 320;
    LAS float* GBC = (LAS float*)(F.lds + O_GA); LAS float* GCS = GBC + 2048; LAS float* GPM = GBC + 4096; LAS float* GMP = GBC + 6144;
    const bf16* QKp = (const bf16*)(F.ws + WS_QK) + (size_t)bl * T * 2048 + h * 512;
    const bf16* Vp = (const bf16*)(F.ws + WS_Z) + (size_t)bl * T * NZ + ZC_MLX + h * 256 + e8 * 32;
    const float* SD = (const float*)(F.ws + WS_SIDE) + (size_t)bl * T * NSIDE;
    bf16* OUT = (bf16*)(F.ws + WS_RAW) + (size_t)bl * T * D + h * 256 + e8 * 32;
    const float ib = F.in[F.z + I_IB][l * 4 + h], fb = F.in[F.z + I_FB][l * 4 + h];
    const int tid = F.tid, lane = F.lane, w = F.wave, g = lane >> 4, r = lane & 15, q = r >> 2, p = lane & 3;
    const int srow = tid >> 3, scj = tid & 7, vrow = tid >> 2, vc = tid & 3;
    v4u pq[4], pk[4], pv;
    f32x4 C[2][3];
#pragma unroll
    for (int a = 0; a < 2; ++a)
#pragma unroll
        for (int b = 0; b < 3; ++b) C[a][b] = (f32x4){0.f, 0.f, 0.f, 0.f};
    for (int i = tid; i < 25344 / 16; i += NTHREADS) *(LAS v4u*)(Cb + i * 16) = (v4u){0u, 0u, 0u, 0u};
    if (tid >= 256 && tid < 384) { const int rr = (tid - 256) >> 1, hh = tid & 1; unsigned one2 = 0x3F803F80u; asm volatile("" : "+v"(one2)); *(LAS v4u*)(Vs + rr * VP + 64 + hh * 16) = (v4u){one2, one2, one2, one2}; }
#define ML_LOAD(c) do { \
        _Pragma("unroll") for (int j = 0; j < 4; ++j) { pq[j] = *(const v4u*)(QKp + (size_t)((c) * 64 + srow) * 2048 + (scj + 8 * j) * 8); pk[j] = *(const v4u*)(QKp + (size_t)((c) * 64 + srow) * 2048 + 256 + (scj + 8 * j) * 8); } \
        if (tid < 256) pv = *(const v4u*)(Vp + (size_t)((c) * 64 + vrow) * NZ + vc * 8); \
        } while (0)
#define ML_STORE(cst_) do { \
        _Pragma("unroll") for (int j = 0; j < 4; ++j) { *(LAS v4u*)(Qs + srow * QP + (scj + 8 * j) * 16) = pq[j]; *(LAS v4u*)(Ks + srow * QP + (scj + 8 * j) * 16) = pk[j]; } \
        if (tid < 256) *(LAS v4u*)(Vs + vrow * VP + vc * 16) = pv; \
        if (w == 0) { const float mp = GMP[(cst_)], pm = GPM[(cst_) * 64 + lane], bc = GBC[(cst_) * 64 + lane], cs = GCS[(cst_) * 64 + lane]; const float mx = fmaxf(mp, pm), mx63 = fmaxf(mp, GPM[(cst_) * 64 + 63]); \
            RT[lane] = -mx; CS[lane] = cs; WI[lane] = __expf(mp - mx); EM[lane] = __expf(-(bc + mx)); WS[lane] = __expf(cs - mx63); if (lane == 0) SC[0] = __expf(mp - mx63); } } while (0)
#pragma unroll 1
    for (int cc = w; cc < T / 64; cc += NWAVES) { const float li = SD[(size_t)(cc * 64 + lane) * NSIDE + h] + ib, lf = -softplusf_(-(SD[(size_t)(cc * 64 + lane) * NSIDE + 4 + h] + fb));
        const float bc = wave_incl_sum(lf, lane), cs = li - bc, pm = wave_incl_max(cs, lane);
        GBC[cc * 64 + lane] = bc; GCS[cc * 64 + lane] = cs; GPM[cc * 64 + lane] = pm; }
    WG_SYNC();
    if (tid == 0) { float m = 0.f; for (int cc = 0; cc < T / 64; ++cc) { GMP[cc] = m; m = GBC[cc * 64 + 63] + fmaxf(m, GPM[cc * 64 + 63]); } }
    WG_SYNC();
    ML_LOAD(0); ML_STORE(0);
    WG_SYNC();
    const int tb = w >> 1, wh = w & 1;
    for (int c = 0; c < T / 64; ++c) {
        if (c + 1 < T / 64) ML_LOAD(c + 1);
#pragma unroll
        for (int si = 0; si < 2; ++si) {
            const int sb = wh * 2 + si; const int t = tb * 16 + r, s0 = sb * 16 + 4 * g;
            v2u pw = (v2u){0u, 0u};
            if (sb <= tb) {
                f32x4 acc = (f32x4){0.f, 0.f, 0.f, 0.f};
#pragma unroll
                for (int ks = 0; ks < 8; ++ks) { const bf16x8 a = *(const LAS bf16x8*)(Ks + (sb * 16 + r) * QP + (ks * 32 + 8 * g) * 2), b = *(const LAS bf16x8*)(Qs + (tb * 16 + r) * QP + (ks * 32 + 8 * g) * 2);
                    acc = __builtin_amdgcn_mfma_f32_16x16x32_bf16(a, b, acc, 0, 0, 0); }
                const float rt = RT[t]; const f32x4 cs4 = *(const LAS f32x4*)(CS + s0);
                float o[4];
#pragma unroll
                for (int i = 0; i < 4; ++i) o[i] = (s0 + i <= t) ? acc[i] * __expf(rt + cs4[i]) : 0.f;
                pw.x = pk2(o[0], o[1]); pw.y = pk2(o[2], o[3]);
            }
            *(LAS v2u*)(Ps + t * PP + s0 * 2) = pw;
        }
        { const float gm = SC[0];
#pragma unroll
            for (int a = 0; a < 2; ++a)
#pragma unroll
                for (int b = 0; b < 3; ++b) C[a][b] *= gm;
#pragma unroll
            for (int ks = 0; ks < 2; ++ks) {
                const f32x4 wsA = *(const LAS f32x4*)(WS + ks * 32 + 8 * g), wsB = *(const LAS f32x4*)(WS + ks * 32 + 8 * g + 4);
                bf16x8 bfr[3], afr[2];
#pragma unroll
                for (int et = 0; et < 3; ++et) { const LAS unsigned char* pa = Vs + (ks * 32 + 8 * g + q) * VP + (et * 16 + 4 * p) * 2; const bf16x8 raw = tr8(pa, pa + 4 * VP);
                    const v4u rw = __builtin_bit_cast(v4u, raw); v4u sw;
                    sw.x = pk2(bflo(rw.x) * wsA[0], bfhi(rw.x) * wsA[1]); sw.y = pk2(bflo(rw.y) * wsA[2], bfhi(rw.y) * wsA[3]);
                    sw.z = pk2(bflo(rw.z) * wsB[0], bfhi(rw.z) * wsB[1]); sw.w = pk2(bflo(rw.w) * wsB[2], bfhi(rw.w) * wsB[3]);
                    bfr[et] = __builtin_bit_cast(bf16x8, sw); }
#pragma unroll
                for (int a = 0; a < 2; ++a) { const LAS unsigned char* pa = Ks + (ks * 32 + 8 * g + q) * QP + ((2 * w + a) * 16 + 4 * p) * 2; afr[a] = tr8(pa, pa + 4 * QP); }
#pragma unroll
                for (int a = 0; a < 2; ++a)
#pragma unroll
                    for (int et = 0; et < 3; ++et) C[a][et] = __builtin_amdgcn_mfma_f32_16x16x32_bf16(afr[a], bfr[et], C[a][et], 0, 0, 0);
            } }
        WG_SYNC();
        {
            f32x4 oi[2], oc[2];
#pragma unroll
            for (int j = 0; j < 2; ++j) { oi[j] = (f32x4){0.f, 0.f, 0.f, 0.f}; oc[j] = (f32x4){0.f, 0.f, 0.f, 0.f}; }
#pragma unroll
            for (int ks = 0; ks < 2; ++ks) { const bf16x8 a = *(const LAS bf16x8*)(Ps + (tb * 16 + r) * PP + (ks * 32 + 8 * g) * 2);
#pragma unroll
                for (int j = 0; j < 2; ++j) { const int et = j == 0 ? wh : 2; const LAS unsigned char* pa = Vs + (ks * 32 + 8 * g + q) * VP + (et * 16 + 4 * p) * 2;
                    oi[j] = __builtin_amdgcn_mfma_f32_16x16x32_bf16(a, tr8(pa, pa + 4 * VP), oi[j], 0, 0, 0); } }
#pragma unroll
            for (int ks = 0; ks < 8; ++ks) { const bf16x8 a = *(const LAS bf16x8*)(Qs + (tb * 16 + r) * QP + (ks * 32 + 8 * g) * 2);
#pragma unroll
                for (int j = 0; j < 2; ++j) { const int et = j == 0 ? wh : 2; const bf16x8 b = *(const LAS bf16x8*)(Cb + (et * 16 + r) * QP + (ks * 32 + 8 * g) * 2);
                    oc[j] = __builtin_amdgcn_mfma_f32_16x16x32_bf16(a, b, oc[j], 0, 0, 0); } }
            const f32x4 wi4 = *(const LAS f32x4*)(WI + tb * 16 + 4 * g), em4 = *(const LAS f32x4*)(EM + tb * 16 + 4 * g);
#pragma unroll
            for (int i = 0; i < 4; ++i) { const float num = oi[0][i] + wi4[i] * oc[0][i], den = oi[1][i] + wi4[i] * oc[1][i];
                OUT[(size_t)(c * 64 + tb * 16 + 4 * g + i) * D + wh * 16 + r] = (bf16)f2bf(num / fmaxf(fabsf(den), em4[i])); }
        }
        WG_SYNC();
#pragma unroll
        for (int a = 0; a < 2; ++a)
#pragma unroll
            for (int et = 0; et < 3; ++et) { v2u cw; cw.x = pk2(C[a][et][0], C[a][et][1]); cw.y = pk2(C[a][et][2], C[a][et][3]);
                *(LAS v2u*)(Cb + (et * 16 + r) * QP + ((2 * w + a) * 16 + 4 * g) * 2) = cw; }
        if (c + 1 < T / 64) ML_STORE(c + 1);
        WG_SYNC();
    }
#undef ML_LOAD
#undef ML_STORE
}


DI void scan_hgrn_mfma(const Ctx& F, int l, int unit) {
    constexpr int QP = 272, VP = 80, PP = 80;
    constexpr int O_QA = 0, O_KA = 8704, O_SB = 17408, O_V = 26112, O_P = 28672, O_QT = 31232, O_E15 = 33280, O_GM = 33792, O_HH = 34304;
    const int qt = unit & 3, h = (unit >> 2) & 7, bl = unit >> 5;
    LAS unsigned char* Qa = F.lds + O_QA; LAS unsigned char* Ka = F.lds + O_KA; LAS unsigned char* Sb = F.lds + O_SB; LAS unsigned char* Vs = F.lds + O_V; LAS unsigned char* Ps = F.lds + O_P;
    LAS float* QT = (LAS float*)(F.lds + O_QT); LAS float* E15 = (LAS float*)(F.lds + O_E15); LAS float* GM = (LAS float*)(F.lds + O_GM); LAS float* HH = (LAS float*)(F.lds + O_HH);
    const bf16* Zq = (const bf16*)(F.ws + WS_Z) + (size_t)bl * T * NZ + ZC_HGQ + h * 128;
    const bf16* Zf = (const bf16*)(F.ws + WS_Z) + (size_t)bl * T * NZ + ZC_HGF + h * 128;
    const bf16* Zv = (const bf16*)(F.ws + WS_Z) + (size_t)bl * T * NZ + ZC_HGI + h * 128 + qt * 32;
    bf16* OUT = (bf16*)(F.ws + WS_RAW) + (size_t)2 * MG * D + (size_t)bl * T * D + h * 128 + qt * 32;
    const int tid = F.tid, lane = F.lane, w = F.wave, g = lane >> 4, r = lane & 15, q = r >> 2, p = lane & 3;
    const int pd = tid & 127, tq = tid >> 7;
    const int vrow = tid >> 2, vc = tid & 3;
    bf16 rq[8], rf[8]; v4u pv;
    f32x4 S[2];
    S[0] = (f32x4){0.f, 0.f, 0.f, 0.f}; S[1] = (f32x4){0.f, 0.f, 0.f, 0.f};
#define HG_LOAD(c) do { _Pragma("unroll") for (int i = 0; i < 8; ++i) { rq[i] = Zq[(size_t)((c) * 32 + tq * 8 + i) * NZ + pd]; rf[i] = Zf[(size_t)((c) * 32 + tq * 8 + i) * NZ + pd]; } \
        if (tid < 128) pv = *(const v4u*)(Zv + (size_t)((c) * 32 + vrow) * NZ + vc * 8); } while (0)
    HG_LOAD(0);
    for (int c = 0; c < T / 32; ++c) {
        float qv[8], kv[8], cb[8]; float run = 0.f;
#pragma unroll
        for (int i = 0; i < 8; ++i) { qv[i] = bf1(rq[i]); const float lf = bf1(rf[i]); kv[i] = 1.0f - __expf(lf); run += lf; cb[i] = run; }
        QT[tq * 128 + pd] = run;
        if (tid < 128) *(LAS v4u*)(Vs + vrow * VP + vc * 16) = pv;
        if (c + 1 < T / 32) HG_LOAD(c + 1);
        WG_SYNC();
        { const float q0 = QT[pd], q1 = QT[128 + pd], q2 = QT[256 + pd], q3 = QT[384 + pd];
            const float off = (tq > 0 ? q0 : 0.f) + (tq > 1 ? q1 : 0.f) + (tq > 2 ? q2 : 0.f); const float b15 = q0 + q1, b31 = (q0 + q1) + (q2 + q3);
#pragma unroll
            for (int i = 0; i < 8; ++i) { const float bt = off + cb[i]; const float ea = __expf(fminf(bt - b15, 80.f)), ek = __expf(fminf(b15 - bt, 80.f));
                *(LAS bf16*)(Qa + (tq * 8 + i) * QP + pd * 2) = (bf16)f2bf(qv[i] * ea); *(LAS bf16*)(Ka + (tq * 8 + i) * QP + pd * 2) = (bf16)f2bf(kv[i] * ek); }
            if (tq == 0) { E15[pd] = __expf(b15); GM[pd] = __expf(b31); HH[pd] = __expf(b31 - b15); } }
        WG_SYNC();
        { const f32x4 e4 = *(const LAS f32x4*)(E15 + w * 16 + 4 * g), g4 = *(const LAS f32x4*)(GM + w * 16 + 4 * g), h4 = *(const LAS f32x4*)(HH + w * 16 + 4 * g);
            const LAS unsigned char* pa = Ka + (8 * g + q) * QP + (w * 16 + 4 * p) * 2; const bf16x8 afr = tr8(pa, pa + 4 * QP);
#pragma unroll
            for (int et = 0; et < 2; ++et) { v2u sw; sw.x = pk2(S[et][0] * e4[0], S[et][1] * e4[1]); sw.y = pk2(S[et][2] * e4[2], S[et][3] * e4[3]);
                *(LAS v2u*)(Sb + (et * 16 + r) * QP + (w * 16 + 4 * g) * 2) = sw;
                const LAS unsigned char* pb = Vs + (8 * g + q) * VP + (et * 16 + 4 * p) * 2;
                const f32x4 kvp = __builtin_amdgcn_mfma_f32_16x16x32_bf16(afr, tr8(pb, pb + 4 * VP), (f32x4){0.f, 0.f, 0.f, 0.f}, 0, 0, 0);
                S[et] = g4 * S[et] + h4 * kvp; } }
        if (w < 4) { const int sb = w >> 1, tb = (w & 1) ^ sb;
            const int t = tb * 16 + r, s0 = sb * 16 + 4 * g; v2u pw = (v2u){0u, 0u};
            if (sb <= tb) { f32x4 acc = (f32x4){0.f, 0.f, 0.f, 0.f};
#pragma unroll
                for (int ks = 0; ks < 4; ++ks) { const bf16x8 a = *(const LAS bf16x8*)(Ka + (sb * 16 + r) * QP + (ks * 32 + 8 * g) * 2), b = *(const LAS bf16x8*)(Qa + (tb * 16 + r) * QP + (ks * 32 + 8 * g) * 2);
                    acc = __builtin_amdgcn_mfma_f32_16x16x32_bf16(a, b, acc, 0, 0, 0); }
                pw.x = pk2(s0 + 0 <= t ? acc[0] : 0.f, s0 + 1 <= t ? acc[1] : 0.f); pw.y = pk2(s0 + 2 <= t ? acc[2] : 0.f, s0 + 3 <= t ? acc[3] : 0.f); }
            *(LAS v2u*)(Ps + t * PP + s0 * 2) = pw; }
        WG_SYNC();
        if (w < 4) { const int tb = w >> 1, et = w & 1;
            const LAS unsigned char* pb = Vs + (8 * g + q) * VP + (et * 16 + 4 * p) * 2;
            f32x4 o = __builtin_amdgcn_mfma_f32_16x16x32_bf16(*(const LAS bf16x8*)(Ps + (tb * 16 + r) * PP + 8 * g * 2), tr8(pb, pb + 4 * VP), (f32x4){0.f, 0.f, 0.f, 0.f}, 0, 0, 0);
#pragma unroll
            for (int ks = 0; ks < 4; ++ks) { const bf16x8 a = *(const LAS bf16x8*)(Qa + (tb * 16 + r) * QP + (ks * 32 + 8 * g) * 2), b = *(const LAS bf16x8*)(Sb + (et * 16 + r) * QP + (ks * 32 + 8 * g) * 2);
                o = __builtin_amdgcn_mfma_f32_16x16x32_bf16(a, b, o, 0, 0, 0); }
#pragma unroll
            for (int i = 0; i < 4; ++i) OUT[(size_t)(c * 32 + tb * 16 + 4 * g + i) * D + et * 16 + r] = (bf16)f2bf(o[i]); }
        WG_SYNC();
    }
#undef HG_LOAD
}


template <int N> DI float dpp_shr(float v) { return __builtin_bit_cast(float, __builtin_amdgcn_update_dpp(0, __builtin_bit_cast(int, v), 0x110 + N, 0xF, 0xF, true)); }
DI float row_incl_sum16(float x) { x += dpp_shr<1>(x); x += dpp_shr<2>(x); x += dpp_shr<4>(x); x += dpp_shr<8>(x); return x; }
DI void scan_rwkv_mfma2(const Ctx& F, int l, int g, int unit, bf16* OUTB, bool side_writes) {
    const int h = unit & 15, bl = unit >> 4;
    constexpr int PI = 144, PA = 80, IMGB = 13824, NBUF = 5;
    constexpr int O_IMG = 0, O_WL = NBUF * IMGB  , O_STI = O_WL + NBUF * 256  , O_PRIV = O_STI + 9216  , PRIVB = 1280 + 1280 + 1024 + 1088  ;
    LAS unsigned char* STI = F.lds + O_STI;
    const bf16* Z = (const bf16*)(F.ws + WS_Z); const bf16* LO = (const bf16*)(F.ws + WS_LO); bf16* VF = (bf16*)(F.ws + WS_VF); bf16* BON = (bf16*)(F.ws + WS_BON);
    bf16* OUT = OUTB + (size_t)bl * T * D + h * 64;
    const int tid = F.tid, lane = F.lane, w = F.wave, gq = lane >> 4, r = lane & 15, q = r >> 2, p = lane & 3;
    constexpr int NCH = T / 16;
    for (int i = tid; i < (O_PRIV + 4 * PRIVB) / 4; i += NTHREADS) ((LAS unsigned*)F.lds)[i] = 0u;
    WG_SYNC();
    if (w >= 4) {
        const int pw = w - 4, gc = h * 64 + lane;
        const float mu_r = F.in[F.z + I_MU][l * 3328 + gc], mu_k = F.in[F.z + I_MU][l * 3328 + 1024 + gc], mu_v = F.in[F.z + I_MU][l * 3328 + 2048 + gc];
        const float kkc = F.in[F.z + I_KK][l * D + gc], kac = F.in[F.z + I_KA][l * D + gc], rk = F.in[F.z + I_RK][l * D + gc];
        bf16 rz[4][3], rl[4][2], rv[4][2], rp[3]; float cum = 0.f;
#define RW_LOAD(t0_) do { const size_t lrow0_ = (size_t)bl * T + (t0_); \
        _Pragma("unroll") for (int i = 0; i < 3; ++i) rp[i] = (t0_) > 0 ? Z[(lrow0_ - 1) * NZ + ZC_RW + gc + 1024 * i] : (bf16)0; \
        _Pragma("unroll") for (int j = 0; j < 4; ++j) { const bf16* zp = Z + (lrow0_ + j) * NZ + ZC_RW + gc; const bf16* lp = LO + (lrow0_ + j) * NLORA + gc; \
            rz[j][0] = zp[0]; rz[j][1] = zp[1024]; rz[j][2] = zp[2048]; rl[j][0] = lp[0]; rl[j][1] = lp[1024]; \
            if (l == 1) { rv[j][0] = lp[3072]; rv[j][1] = VF[((size_t)g * MG + lrow0_ + j) * D + gc]; } } } while (0)
        { const int k0 = pw; if (k0 < NCH) RW_LOAD(k0 * 16); }
        for (int k = 0; k < NCH + 4; ++k) {
            const int qq = (k - pw) & 3, c = k - qq;
            if (k >= pw && c < NCH) {
                LAS unsigned char* RT = F.lds + O_IMG + (c % NBUF) * IMGB; LAS unsigned char* KT = RT + 2304; LAS unsigned char* KB = RT + 4608; LAS unsigned char* VU = RT + 9216;
                const size_t lrow0 = (size_t)bl * T + c * 16 + qq * 4;
                if (qq == 0) cum = 0.f;
                float pr = bf1(rp[0]), pk = bf1(rp[1]), pv = bf1(rp[2]);
#pragma unroll
                for (int j = 0; j < 4; ++j) { const size_t lrow = lrow0 + j; const int t = qq * 4 + j;
                    const float zr = bf1(rz[j][0]), zk = bf1(rz[j][1]), zv = bf1(rz[j][2]);
                    const float rr = zr + mu_r * (pr - zr), kx = zk + mu_k * (pk - zk); float v = zv + mu_v * (pv - zv);
                    pr = zr; pk = zk; pv = zv;
                    const float lw = bf1(rl[j][0]); const float a = bf1(rl[j][1]);
                    if (l == 0) { if (side_writes) VF[((size_t)g * MG + lrow) * D + gc] = (bf16)f2bf(v); }
                    else { const float vf = bf1(rv[j][1]); v = v + (vf - v) * bf1(rv[j][0]); }
                    const float kk = kx * kkc; const float kn = kk * __builtin_amdgcn_rsqf(fmaxf(wave_sum(kk * kk), 1e-24f));
                    const float kp = kx * (1.0f + (a - 1.0f) * kac);
                    const float bsum = wave_sum(rr * kp * rk);
                    if (side_writes) BON[lrow * D + gc] = (bf16)f2bf(bsum * v);
                    const float wp = __expf(cum); cum += lw; const float wt = __expf(cum), iw = __expf(-cum);
                    const unsigned c1 = pk2(rr * wt, kn * wp), c2 = pk2(kp * iw, kn * a * iw);
                    *(LAS bf16*)(RT + t * PI + lane * 2) = (bf16)c1; *(LAS bf16*)(KT + t * PI + lane * 2) = (bf16)(c1 >> 16);
                    *(LAS bf16*)(KB + t * PI + lane * 2) = (bf16)c2; *(LAS bf16*)(KB + (16 + t) * PI + lane * 2) = (bf16)(c2 >> 16);
                    *(LAS bf16*)(VU + t * PI + lane * 2) = (bf16)f2bf(v);
                    if (t == 15) ((LAS float*)(F.lds + O_WL))[(c % NBUF) * 64 + lane] = wt; }
                { const int tn = (qq < 3) ? c * 16 + (qq + 1) * 4 : (c + 4) * 16; if (tn < T) RW_LOAD(tn); }
            }
            WG_SYNC();
        }
#undef RW_LOAD
    } else {
        const int vt = w;
        LAS unsigned char* AR = F.lds + O_PRIV + w * PRIVB; LAS unsigned char* AY = AR + 1280; LAS float* AKB = (LAS float*)(AR + 2560); LAS float* RH = (LAS float*)(AR + 3584);
        f32x4 S[4];
#pragma unroll
        for (int i = 0; i < 4; ++i) S[i] = (f32x4){0.f, 0.f, 0.f, 0.f};
        for (int k = 0; k < NCH + 4; ++k) {
            const int c = k - 4;
            if (c >= 0) {
                const LAS unsigned char* RT = F.lds + O_IMG + (c % NBUF) * IMGB; const LAS unsigned char* KT = RT + 2304; const LAS unsigned char* KB = RT + 4608; LAS unsigned char* VU = F.lds + O_IMG + (c % NBUF) * IMGB + 9216;
                const LAS float* WL = (const LAS float*)(F.lds + O_WL) + (c % NBUF) * 64;
#pragma unroll
                for (int m = 0; m < 4; ++m) { f32x4 acc = (f32x4){0.f, 0.f, 0.f, 0.f};
                    const LAS unsigned char* ia = KB + ((m & 1) * 16 + r) * PI; const LAS unsigned char* ib_ = (m < 2 ? KT : RT) + r * PI;
#pragma unroll
                    for (int ks = 0; ks < 2; ++ks) acc = __builtin_amdgcn_mfma_f32_16x16x32_bf16(*(const LAS bf16x8*)(ia + (ks * 32 + 8 * gq) * 2), *(const LAS bf16x8*)(ib_ + (ks * 32 + 8 * gq) * 2), acc, 0, 0, 0);
                    const int t = r, i0 = 4 * gq; float o[4];
#pragma unroll
                    for (int j = 0; j < 4; ++j) o[j] = (m < 2 ? (i0 + j < t) : (i0 + j <= t)) ? acc[j] : 0.f;
                    if (m == 1) {
#pragma unroll
                        for (int j = 0; j < 4; ++j) AKB[(i0 + j) * 16 + t] = o[j]; }
                    else { v2u pw2; pw2.x = pk2(o[0], o[1]); pw2.y = pk2(o[2], o[3]); *(LAS v2u*)((m == 0 ? AR : AY) + t * PA + ((m == 3 ? 16 : 0) + i0) * 2) = pw2; } }
                asm volatile("" ::: "memory");
                f32x4 accG = (f32x4){0.f, 0.f, 0.f, 0.f}, accR = accG;
#pragma unroll
                for (int ks = 0; ks < 2; ++ks) { const LAS unsigned char* pb = STI + (ks * 32 + 8 * gq + q) * PI + (vt * 16 + 4 * p) * 2; const bf16x8 bfr = tr8(pb, pb + 4 * PI);
                    accG = __builtin_amdgcn_mfma_f32_16x16x32_bf16(*(const LAS bf16x8*)(KT + r * PI + (ks * 32 + 8 * gq) * 2), bfr, accG, 0, 0, 0);
                    accR = __builtin_amdgcn_mfma_f32_16x16x32_bf16(*(const LAS bf16x8*)(RT + r * PI + (ks * 32 + 8 * gq) * 2), bfr, accR, 0, 0, 0); }
                { const LAS unsigned char* pb = VU + (8 * gq + q) * PI + (vt * 16 + 4 * p) * 2;
                    accG = __builtin_amdgcn_mfma_f32_16x16x32_bf16(*(const LAS bf16x8*)(AR + r * PA + 8 * gq * 2), tr8(pb, pb + 4 * PI), accG, 0, 0, 0);
#pragma unroll
                    for (int j = 0; j < 4; ++j) RH[(4 * gq + j) * 17 + r] = accG[j]; }
                asm volatile("" ::: "memory");
                if (lane < 16) { float u[16];
#pragma unroll
                    for (int t = 0; t < 16; ++t) u[t] = RH[t * 17 + lane];
#pragma unroll
                    for (int i = 0; i < 15; ++i) {
                        f32x4 col[4];
#pragma unroll
                        for (int t4 = 0; t4 < 4; ++t4) if (t4 * 4 + 3 > i) col[t4] = *(const LAS f32x4*)(AKB + i * 16 + t4 * 4);
#pragma unroll
                        for (int t = i + 1; t < 16; ++t) u[t] -= col[t >> 2][t & 3] * u[i]; }
#pragma unroll
                    for (int t = 0; t < 16; ++t) *(LAS bf16*)(VU + (16 + t) * PI + (vt * 16 + lane) * 2) = (bf16)f2bf(-u[t]); }
                asm volatile("" ::: "memory");
                { const LAS unsigned char* pb = VU + (8 * gq + q) * PI + (vt * 16 + 4 * p) * 2; const bf16x8 vfr = tr8(pb, pb + 4 * PI);
                    accR = __builtin_amdgcn_mfma_f32_16x16x32_bf16(*(const LAS bf16x8*)(AY + r * PA + 8 * gq * 2), vfr, accR, 0, 0, 0);
#pragma unroll
                    for (int j = 0; j < 4; ++j) OUT[(size_t)(c * 16 + 4 * gq + j) * D + vt * 16 + r] = (bf16)f2bf(accR[j]);
#pragma unroll
                    for (int kt = 0; kt < 4; ++kt) { const LAS unsigned char* pk_ = KB + (8 * gq + q) * PI + (kt * 16 + 4 * p) * 2;
                        S[kt] = __builtin_amdgcn_mfma_f32_16x16x32_bf16(vfr, tr8(pk_, pk_ + 4 * PI), S[kt], 0, 0, 0);
                        S[kt] *= WL[kt * 16 + r];
                        v2u sw; sw.x = pk2(S[kt][0], S[kt][1]); sw.y = pk2(S[kt][2], S[kt][3]);
                        *(LAS v2u*)(STI + (kt * 16 + r) * PI + (vt * 16 + 4 * gq) * 2) = sw; } }
            }
            WG_SYNC();
        }
    }
    WG_SYNC();
}

DI void phase_post(const Ctx& F, int l) {
    const int gw = F.bid * NWAVES + F.wave, NGW = F.G * NWAVES;
    const bf16* Z = (const bf16*)(F.ws + WS_Z); const bf16* XC = (const bf16*)(F.ws + WS_XC); const bf16* LO = (const bf16*)(F.ws + WS_LO); const bf16* BON = (const bf16*)(F.ws + WS_BON);
    bf16* RAW = (bf16*)(F.ws + WS_RAW);
    const int c0 = F.lane * 16;
    for (int row = gw; row < MG; row += NGW) {
        float a[16], b[16], c[16];
        { bf16* rp = RAW + (size_t)row * D + c0;
            unpack16(rp, a);
            unpack16(Z + (size_t)row * NZ + ZC_MLO + c0, b);
            unpack16(XC + (size_t)row * D + c0, c);
            float s = 0.f;
#pragma unroll
            for (int i = 0; i < 16; ++i) { a[i] *= sigmoidf_(b[i]); s += a[i]; }
            const float mean = sum16(s) * (1.f / 256.f); float q = 0.f;
#pragma unroll
            for (int i = 0; i < 16; ++i) { a[i] -= mean; q += a[i] * a[i]; }
            const float rstd = 1.0f / sqrtf(sum16(q) * (1.f / 256.f) + 1e-6f);
#pragma unroll
            for (int i = 0; i < 16; ++i) a[i] = a[i] * rstd * F.in[F.z + I_MLNW][l * D + c0 + i] + F.in[F.z + I_MLSKIP][l * D + c0 + i] * c[i];
            pack16(rp, a); }
        { bf16* rp = RAW + (size_t)(MG + row) * D + c0;
            unpack16(rp, a);

            unpack16(BON + (size_t)row * D + c0, b);
            unpack16(LO + (size_t)row * NLORA + 2048 + c0, c);
            float s = 0.f;
#pragma unroll
            for (int i = 0; i < 16; ++i) s += a[i];
            const float mean = sum4(s) * (1.f / 64.f); float q = 0.f;
#pragma unroll
            for (int i = 0; i < 16; ++i) { a[i] -= mean; q += a[i] * a[i]; }
            const float rstd = 1.0f / sqrtf(sum4(q) * (1.f / 64.f) + 64e-5f);
#pragma unroll
            for (int i = 0; i < 16; ++i) a[i] = (a[i] * rstd * F.in[F.z + I_LNW][l * D + c0 + i] + F.in[F.z + I_LNB][l * D + c0 + i] + b[i]) * c[i];
            pack16(rp, a); }
        { bf16* rp = RAW + (size_t)(2 * MG + row) * D + c0;
            unpack16(rp, a);
            unpack16(Z + (size_t)row * NZ + ZC_HGG + c0, b);
            float q = 0.f;
#pragma unroll
            for (int i = 0; i < 16; ++i) q += a[i] * a[i];
            const float rstd = 1.0f / sqrtf(sum8(q) * (1.f / 128.f) + 1e-6f);
#pragma unroll
            for (int i = 0; i < 16; ++i) a[i] = a[i] * rstd * F.in[F.z + I_HGNW][l * D + c0 + i] * sigmoidf_(b[i]);
            pack16(rp, a); }
    }
}

enum { PH_W = 0, PH_A1, PH_A2, PH_A3, PH_B1, PH_B2, PH_B3, PH_B4, PH_B5, PH_B6, PH_B7, PH_B8, PH_FIN, PH_N };

__global__ void __launch_bounds__(NTHREADS, 2) fwd_kernel(Args args) {
    extern __shared__ __attribute__((aligned(16))) unsigned char lds_raw[];
    Ctx F;
    F.lds = (LAS unsigned char*)lds_raw; F.in = args.in; F.out = args.out; F.ws = args.ws;
    F.z = 0; F.tid = threadIdx.x; F.lane = F.tid & 63; F.wave = __builtin_amdgcn_readfirstlane(F.tid >> 6); F.bid = blockIdx.x; F.G = gridDim.x;
    volatile LAS unsigned* MISC = (volatile LAS unsigned*)(F.lds + MISC_OFF);
    if (F.tid < 32) MISC[F.tid] = 0u;
    __syncthreads();
    XcdBarrier bar; bar.bar = (unsigned*)(F.ws + WS_CTL) + CW_BAR; bar.x = 0; bar.st = nullptr;
    if (args.use_bar) bar = xcd_barrier_post((unsigned*)(F.ws + WS_CTL) + CW_BAR, MISC + 8);
#ifndef PHMASK
#define PHMASK 0xFFFF
#endif
#define IN(k) (((PHMASK >> (k)) & 1) && args.ph_lo <= (k) && (k) < args.ph_hi)
#ifndef REPEAT_PH
#define REPEAT_PH -1
#endif
#define PHASE(k) if (IN(k)) for (int rep_ = 0; rep_ < ((k) == REPEAT_PH ? 2 : 1); ++rep_) if (refresh(F), true)
#define SEAM() do { if (args.use_bar) xcd_barrier(bar); } while (0)
    const float* MOD = (const float*)(F.ws + WS_MOD);
    for (int f = args.f_lo; f < args.f_hi; ++f) {
        const int l = f >> 1, fi = f & 1;
        const float* modl = MOD + (size_t)l * NB * NMOD;
        if (fi == 0) PHASE(PH_W) { phase_weights(F, l); if (l == 0) { __syncthreads(); phase_mod(F); } SEAM(); }
        const int sub = fi ? 2 : 0;
        const float* xsrc = (f == 0) ? F.in[F.z + I_X] : F.out;
        PHASE(PH_A1) { phase_modulate<false>(F, xsrc, (bf16*)(F.ws + WS_H), F.in[F.z + I_NORMW] + (size_t)(l * 3 + sub) * D, modl, sub, 0, M, nullptr, 0, F.bid, F.G); SEAM(); }
        PHASE(PH_A2) {
            pg8::Gemm gm{(const bf16*)(F.ws + WS_H), (const bf16*)(F.ws + WS_WUP) + (size_t)fi * NUP * D, D, D, D, 0, 0};
            pg8::Order<0> S; S.init(M / 256, NUP / 256, F.G, F.bid);
            pg8::EpiSwiGLU E{(bf16*)(F.ws + WS_HID), DFF};
            pg8::gemm_phase(F.lds, gm, S, E, F.tid); SEAM(); }
        PHASE(PH_A3) {
            pg8::Gemm gm{(const bf16*)(F.ws + WS_HID), (const bf16*)(F.ws + WS_WDN) + (size_t)fi * D * DFF, DFF, DFF, DFF, 0, 0};
            pg8::Order<0> S; S.init(M / 256, D / 256, F.G, F.bid);
            pg8::EpiResid E{xsrc, F.out, modl + (sub * 3 + 2) * D, 0.5f, 0};
            pg8::gemm_phase(F.lds, gm, S, E, F.tid); SEAM(); }
        if (fi == 0) {
            for (int g = args.g_lo; g < args.g_hi; ++g) {
                float* xg = F.out + (size_t)g * MG * D;
                const bool fuse_b1 = args.use_bar && F.G == 256 && args.ph_lo <= PH_B1 && args.ph_hi > PH_B7;
                if (!(fuse_b1 && g > args.g_lo)) PHASE(PH_B1) { phase_modulate<true>(F, F.out, (bf16*)(F.ws + WS_HG), F.in[F.z + I_NORMW] + (size_t)(l * 3 + 1) * D, modl, 1, g * MG, MG, (float*)(F.ws + WS_SIDE), l == 0 ? 8 : NSIDE, F.bid, F.G); SEAM(); }
                PHASE(PH_B2) {
                    pg8::Gemm gm{(const bf16*)(F.ws + WS_HG), (const bf16*)(F.ws + WS_WIN), D, D, D, 0, 0};
                    pg8::Order<0> S; S.init(MG / 256, NZE / 256, F.G, F.bid);
                    pg8::EpiZ E{(bf16*)(F.ws + WS_Z), NZ, l == 0 ? nullptr : F.in[F.z + I_LBL]};
                    pg8::gemm_phase(F.lds, gm, S, E, F.tid); SEAM(); }
                PHASE(PH_B3) { phase_prep(F, l); SEAM(); }
                PHASE(PH_B4) {
                    { pg8::Gemm gm{(const bf16*)(F.ws + WS_XC), (const bf16*)(F.ws + WS_WQK), 256, D, 256, 256, (size_t)512 * 256};
                      pg8::Order<1> S; S.init(MG / 256, 8, F.G, F.bid);
                      pg8::EpiBf16 E{(bf16*)(F.ws + WS_QK), 2048, 512};
                      pg8::gemm_phase(F.lds, gm, S, E, F.tid); }
                    __syncthreads();
                    { pg8::Gemm gm{(const bf16*)(F.ws + WS_LA), (const bf16*)(F.ws + WS_WLORA), l == 0 ? 256 : 384, KLORA, KLORA, 0, 0};
                      pg8::Order<0> S; S.init(MG / 256, l == 0 ? 12 : 16, F.G, F.bid);
                      pg8::EpiLora E{(bf16*)(F.ws + WS_LO), NLORA, F.in[F.z + I_W0] + (size_t)l * D, F.in[F.z + I_A0] + (size_t)l * D, F.in[F.z + I_V0]};
                      pg8::gemm_phase(F.lds, gm, S, E, F.tid); }
                    SEAM(); }
                PHASE(PH_B5) {
                    { unsigned* hgdone = (unsigned*)(F.ws + WS_CTL) + CW_HGDONE + 64 * (l * NGRP + g);
                      int lo0, lo1, lo2, st = 128, st1 = 64, gq = 128, gc = F.bid;
                      if (F.G == 256) { const int a = F.bid < 128 ? F.bid : 128; lo0 = a; lo2 = a; lo1 = F.bid >= 192 ? F.bid - 192 : 64; }
                      else { lo0 = lo1 = lo2 = F.bid; st = F.G; st1 = F.G; gq = F.G; }
                      unsigned nhg = 0;
                      for (int i = lo2; i < 128; i += st) { scan_hgrn_mfma(F, l, i); ++nhg; }
                      if (nhg && F.tid == 0) __hip_atomic_fetch_add(hgdone, nhg, __ATOMIC_RELAXED, __HIP_MEMORY_SCOPE_AGENT);
                      for (int i = lo0; i < 128; i += st) scan_mlstm_mfma(F, l, i);
                      for (int i = lo1; i < 64; i += st1) scan_rwkv_mfma2(F, l, g, i, (bf16*)(F.ws + WS_RAW) + (size_t)MG * D, true);
                      if (F.G != 256 || (F.bid >= 128 && F.bid < 192)) {
                          pg8::Gemm gm{(const bf16*)(F.ws + WS_HG), (const bf16*)(F.ws + WS_WIN) + (size_t)NZE * D, D, D, D, 0, 0};
                          pg8::Order<0> S; S.init(MG / 256, 8, F.G == 256 ? 64 : F.G, F.G == 256 ? F.bid - 128 : F.bid);
                          pg8::EpiBf16 E{(bf16*)(F.ws + WS_Z) + ZC_MLO, NZ, 0};
                          pg8::gemm_phase(F.lds, gm, S, E, F.tid); __syncthreads(); }
                      if (F.G != 256 || F.bid < 192) {
                          if (F.tid == 0) { unsigned sp = 0; while (__hip_atomic_load(hgdone, __ATOMIC_RELAXED, __HIP_MEMORY_SCOPE_AGENT) < 128u) { __builtin_amdgcn_s_sleep(4); if (++sp > (1u << 22)) break; } }
                          __syncthreads();
                          pg8::Gemm gm{(const bf16*)(F.ws + WS_HG), (const bf16*)(F.ws + WS_WIN) + (size_t)NZ * D, D, D, D, 0, 0};
                          pg8::Order<0> S; S.init(MG / 256, 12, gq, gc);
                          if (F.G == 256) { if (F.bid < 128) { S.imax = GATES_A; S.G = 128; } else { S.c = F.bid - 128; S.G = 64; S.L0 = 128 * GATES_A; } }
                          pg8::EpiBf16 E{(bf16*)(F.ws + WS_Z) + ZC_GATE, NZ, 0};
                          pg8::gemm_phase(F.lds, gm, S, E, F.tid); } }
                    SEAM(); }
                PHASE(PH_B6) { phase_post(F, l); SEAM(); }
                PHASE(PH_B7) {
                    pg8::Gemm gm{(const bf16*)(F.ws + WS_RAW), (const bf16*)(F.ws + WS_WBR), D, D, D, (size_t)MG * D, (size_t)D * D};
                    pg8::Order<2> S; S.init(MG / 256, 4, F.G, F.bid);
                    pg8::EpiBranch E{(const bf16*)(F.ws + WS_Z) + ZC_GATE, NZ, (float*)(F.ws + WS_QK), (bf16*)(F.ws + WS_XC)};
                    pg8::gemm_phase(F.lds, gm, S, E, F.tid);
                    if (fuse_b1 && g + 1 < args.g_hi && F.bid >= 128)
                        phase_modulate<true>(F, F.out, (bf16*)(F.ws + WS_HG), F.in[F.z + I_NORMW] + (size_t)(l * 3 + 1) * D, modl, 1, (g + 1) * MG, MG, (float*)(F.ws + WS_SIDE), l == 0 ? 8 : NSIDE, F.bid - 128, 128);
                    SEAM(); }
                PHASE(PH_B8) {
                    pg8::Gemm gm{(const bf16*)(F.ws + WS_XC), (const bf16*)(F.ws + WS_WOUT), D, D, D, 0, 0};
                    pg8::Order<0> S; S.init(MG / 256, 4, F.G, F.bid);
                    pg8::EpiResid E{xg, xg, modl + (1 * 3 + 2) * D, 1.0f, g * GB};
                    pg8::gemm_phase(F.lds, gm, S, E, F.tid);
                    SEAM(); }
            }
        }
    }
    PHASE(PH_FIN) phase_final_norm(F);
#undef IN
#undef PHASE
#undef SEAM
}

extern "C" void kernel_launch(void* const* d_in, const int* in_sizes, int n_in, void* d_out, int out_size, void* d_ws, size_t ws_size, hipStream_t stream) {
    static int grid = 0;
    if (grid == 0) {
        if (n_in != 36 || out_size != M * D || ws_size < WS_END) { fprintf(stderr, "kernel_launch: unexpected problem (n_in %d out %d ws %zu, need %zu)\n", n_in, out_size, ws_size, (size_t)WS_END); grid = -1; return; }
        int dev = 0, cus = 0;
        if (hipGetDevice(&dev) != hipSuccess || hipDeviceGetAttribute(&cus, hipDeviceAttributeMultiprocessorCount, dev) != hipSuccess) { grid = -1; return; }
        if (hipFuncSetAttribute((const void*)fwd_kernel, hipFuncAttributeMaxDynamicSharedMemorySize, LDS_BYTES) != hipSuccess) { fprintf(stderr, "kernel_launch: hipFuncSetAttribute failed\n"); grid = -1; return; }
        int per_cu = 0;
        if (hipOccupancyMaxActiveBlocksPerMultiprocessor(&per_cu, (const void*)fwd_kernel, NTHREADS, LDS_BYTES) != hipSuccess || per_cu < 1) { fprintf(stderr, "kernel_launch: occupancy query says %d\n", per_cu); }
        (void)hipGetLastError();
        grid = cus;
    }
    if (grid < 0) return;
    (void)hipMemsetAsync((char*)d_ws + WS_CTL, 0, CTL_BYTES, stream);
    Args a{};
    for (int i = 0; i < 36; ++i) a.in[i] = (const float*)d_in[i];
    a.out = (float*)d_out; a.ws = (unsigned char*)d_ws; a.pad = 0;
#if ONE_LAUNCH
    a.f_lo = 0; a.f_hi = 4; a.g_lo = 0; a.g_hi = NGRP; a.ph_lo = 0; a.ph_hi = PH_N; a.use_bar = 1;
    hipLaunchKernelGGL(fwd_kernel, dim3(grid), dim3(NTHREADS), LDS_BYTES, stream, a);
#else
    a.use_bar = 0;
    for (int f = 0; f < 4; ++f) {
        a.f_lo = f; a.f_hi = f + 1;
        for (int ph = PH_W; ph <= PH_A3; ++ph) {
            if (ph == PH_W && (f & 1)) continue;
            a.ph_lo = ph; a.ph_hi = ph + 1; a.g_lo = 0; a.g_hi = 0;
            hipLaunchKernelGGL(fwd_kernel, dim3(grid), dim3(NTHREADS), LDS_BYTES, stream, a);
        }
        if ((f & 1) == 0)
            for (int g = 0; g < NGRP; ++g)
                for (int ph = PH_B1; ph <= PH_B8; ++ph) { a.ph_lo = ph; a.ph_hi = ph + 1; a.g_lo = g; a.g_hi = g + 1;
                    hipLaunchKernelGGL(fwd_kernel, dim3(grid), dim3(NTHREADS), LDS_BYTES, stream, a); }
    }
    a.f_lo = 0; a.f_hi = 0; a.g_lo = 0; a.g_hi = 0; a.ph_lo = PH_FIN; a.ph_hi = PH_FIN + 1;
    hipLaunchKernelGGL(fwd_kernel, dim3(grid), dim3(NTHREADS), LDS_BYTES, stream, a);
#endif
}
```

```cpp
#include <hip/hip_runtime.h>
#include <cstdio>
#include <cstdint>

#ifndef GATES_A
#define GATES_A 0
#endif
#ifndef ONE_LAUNCH
#define ONE_LAUNCH 1
#endif

#define GAS __attribute__((address_space(1)))
#define LAS __attribute__((address_space(3)))
typedef unsigned short bf16;
typedef unsigned v4u __attribute__((ext_vector_type(4)));
typedef unsigned v2u __attribute__((ext_vector_type(2)));
typedef float f32x4 __attribute__((ext_vector_type(4)));
typedef float f32x2 __attribute__((ext_vector_type(2)));
typedef short bf16x8 __attribute__((ext_vector_type(8)));
#define DI __device__ __forceinline__

constexpr int D = 1024, NB = 16, T = 2048, M = NB * T, DFF = 2816, NUP = 2 * DFF;
constexpr int GB = 4, MG = GB * T, NGRP = NB / GB;
constexpr int NZ = 9472;
constexpr int ZC_MLX = 0, ZC_RW = 1024, ZC_HGQ = 4352, ZC_HGF = 5376, ZC_HGI = 6400, ZC_MLO = 7424, ZC_HGG = 8448;
constexpr int NZE = 7424;
constexpr int ZC_GATE = 4352;
constexpr int NWIN = 12544;
constexpr int WIN_SRC = 12552;
constexpr int NSIDE = 40, KLORA = 384, NLORA = 4096, NMOD = 9216;
constexpr int NTHREADS = 512, NWAVES = 8;

constexpr size_t MiB = 1u << 20;
constexpr size_t WS_CTL = 0, CTL_BYTES = 1 * MiB;
constexpr size_t WS_MOD = 1 * MiB;
constexpr size_t WS_WSIDE = 3 * MiB;
constexpr size_t WS_WUP = 4 * MiB;
constexpr size_t WS_WDN = 26 * MiB;
constexpr size_t WS_WIN = 37 * MiB;
constexpr size_t WS_WBR = 62 * MiB;
constexpr size_t WS_WOUT = 68 * MiB;
constexpr size_t WS_WQK = 70 * MiB;
constexpr size_t WS_WLORA = 71 * MiB;
constexpr size_t WS_VF = 74 * MiB;
constexpr size_t WS_ACT = 138 * MiB;
constexpr size_t WS_H = WS_ACT;
constexpr size_t WS_HID = WS_ACT + 64 * MiB;
constexpr size_t WS_HG = WS_ACT;
constexpr size_t WS_Z = WS_ACT + 16 * MiB;
constexpr size_t WS_XC = WS_ACT + 164 * MiB;
constexpr size_t WS_QK = WS_ACT + 180 * MiB;
constexpr size_t WS_LA = WS_ACT + 212 * MiB;
constexpr size_t WS_LO = WS_ACT + 218 * MiB;
constexpr size_t WS_SIDE = WS_ACT + 282 * MiB;
constexpr size_t WS_RAW = WS_ACT + 284 * MiB;
constexpr size_t WS_BON = WS_ACT + 332 * MiB;
constexpr size_t WS_GB0 = WS_ACT + 348 * MiB;
constexpr size_t WS_END = WS_ACT + 364 * MiB;
static_assert(WS_HID + (size_t)M * DFF * 2 <= WS_END, "ffn view fits");
static_assert(WS_Z + (size_t)MG * NZ * 2 <= WS_XC, "z fits");

constexpr int CW_BAR = 4096, CW_HGDONE = 16384;

constexpr int LDS_BYTES = 163840;
constexpr int MISC_OFF = LDS_BYTES - 256;

typedef __bf16 bf16x2_t __attribute__((ext_vector_type(2)));
DI unsigned f2bf(float f) { return (unsigned)__builtin_bit_cast(unsigned short, (__bf16)f); }
DI unsigned pk2(float lo, float hi) { const bf16x2_t v = __builtin_convertvector((f32x2){lo, hi}, bf16x2_t); return __builtin_bit_cast(unsigned, v); }
DI float bflo(unsigned w) { return __builtin_bit_cast(float, w << 16); }
DI float bfhi(unsigned w) { return __builtin_bit_cast(float, w & 0xffff0000u); }
DI float bf1(bf16 h) { return __builtin_bit_cast(float, (unsigned)h << 16); }
DI float sigmoidf_(float x) { return __builtin_amdgcn_rcpf(1.0f + __expf(-x)); }
DI float siluf_(float x) { return x * __builtin_amdgcn_rcpf(1.0f + __expf(-x)); }
DI float softplusf_(float x) { return fmaxf(x, 0.f) + __logf(1.0f + __expf(-fabsf(x))); }
template <int CTRL> DI float dppf(float v) { return __builtin_bit_cast(float, __builtin_amdgcn_update_dpp(0, __builtin_bit_cast(int, v), CTRL, 0xF, 0xF, true)); }
DI float sum4(float v) { v += dppf<0xB1>(v); v += dppf<0x4E>(v); return v; }
DI float sum8(float v) { v = sum4(v); v += dppf<0x141>(v); return v; }
DI float sum16(float v) { v = sum8(v); v += dppf<0x140>(v); return v; }
DI float wave_sum(float v) {
    v = sum16(v);
    const float a = __builtin_bit_cast(float, __builtin_amdgcn_readlane(__builtin_bit_cast(int, v), 0)), b = __builtin_bit_cast(float, __builtin_amdgcn_readlane(__builtin_bit_cast(int, v), 16));
    const float c = __builtin_bit_cast(float, __builtin_amdgcn_readlane(__builtin_bit_cast(int, v), 32)), d = __builtin_bit_cast(float, __builtin_amdgcn_readlane(__builtin_bit_cast(int, v), 48));
    return (a + b) + (c + d);
}
#define LDS_WAIT() asm volatile("s_waitcnt lgkmcnt(0)" ::: "memory")
#define VM_WAIT() asm volatile("s_waitcnt vmcnt(0)" ::: "memory")
DI void unpack8(const v4u w, float (&o)[8]) { o[0] = bflo(w.x); o[1] = bfhi(w.x); o[2] = bflo(w.y); o[3] = bfhi(w.y); o[4] = bflo(w.z); o[5] = bfhi(w.z); o[6] = bflo(w.w); o[7] = bfhi(w.w); }
DI void unpack16(const bf16* p, float (&o)[16]) { const v4u a = *(const v4u*)p, b = *(const v4u*)(p + 8);
    o[0] = bflo(a.x); o[1] = bfhi(a.x); o[2] = bflo(a.y); o[3] = bfhi(a.y); o[4] = bflo(a.z); o[5] = bfhi(a.z); o[6] = bflo(a.w); o[7] = bfhi(a.w);
    o[8] = bflo(b.x); o[9] = bfhi(b.x); o[10] = bflo(b.y); o[11] = bfhi(b.y); o[12] = bflo(b.z); o[13] = bfhi(b.z); o[14] = bflo(b.w); o[15] = bfhi(b.w); }
DI void pack16(bf16* p, const float (&o)[16]) { v4u a, b; a.x = pk2(o[0], o[1]); a.y = pk2(o[2], o[3]); a.z = pk2(o[4], o[5]); a.w = pk2(o[6], o[7]);
    b.x = pk2(o[8], o[9]); b.y = pk2(o[10], o[11]); b.z = pk2(o[12], o[13]); b.w = pk2(o[14], o[15]); *(v4u*)p = a; *(v4u*)(p + 8) = b; }
DI v4u pack8(const float (&o)[8]) { v4u w; w.x = pk2(o[0], o[1]); w.y = pk2(o[2], o[3]); w.z = pk2(o[4], o[5]); w.w = pk2(o[6], o[7]); return w; }

#define XB_TMO      128
#define XB_XCNT(j)  (256  + 64 * (j))
#define XB_XSUB(j)  (1280 + 64 * (j))
#define XB_XGEN(j)  (2304 + 64 * (j))
#define XB_TOP      3328
#define XB_TOPGEN   3392
#define XCD_BAR_WORDS 3456
#define XB_SPIN_CAP (1u << 22)
__device__ __forceinline__ unsigned xb_ld(unsigned* p)              { return __hip_atomic_load(p, __ATOMIC_RELAXED, __HIP_MEMORY_SCOPE_AGENT); }
__device__ __forceinline__ unsigned xb_add(unsigned* p, unsigned v) { return __hip_atomic_fetch_add(p, v, __ATOMIC_RELAXED, __HIP_MEMORY_SCOPE_AGENT); }
__device__ __forceinline__ unsigned xb_xcc_id() { return (unsigned)__builtin_amdgcn_s_getreg((3 << 11) | 20) & 0xFu; }
#define XB_SPIN(cond, bar) do { unsigned _sp = 0; while (cond) { __builtin_amdgcn_s_sleep(1); \
    if ((++_sp & 255u) == 0u) { if (xb_ld(&(bar)[XB_TMO])) break; if (_sp > XB_SPIN_CAP) { atomicAdd(&(bar)[XB_TMO], 1u); break; } } } } while (0)
struct XcdBarrier { unsigned* bar; unsigned x; volatile LAS unsigned* st; };
__device__ __forceinline__ XcdBarrier xcd_barrier_post(unsigned* bar, volatile LAS unsigned* st) {
    XcdBarrier b; b.bar = bar; b.x = xb_xcc_id(); b.st = st;
    if (threadIdx.x == 0) (void)xb_add(&bar[XB_XCNT(b.x)], 1u);
    return b;
}
__device__ __forceinline__ void xcd_barrier_complete(unsigned* bar, unsigned x, unsigned& nloc, unsigned& nx) {
    const unsigned G = gridDim.x * gridDim.y * gridDim.z;
    unsigned sum, cnt, mine, sp = 0u;
    for (;;) {
        sum = 0u; cnt = 0u; mine = 0u;
#pragma unroll
        for (unsigned j = 0; j < 16; ++j) { const unsigned c = xb_ld(&bar[XB_XCNT(j)]); sum += c; cnt += (c > 0u) ? 1u : 0u; mine = (j == x) ? c : mine; }
        if (sum == G) break;
        __builtin_amdgcn_s_sleep(1);
        if ((++sp & 255u) == 0u) { if (xb_ld(&bar[XB_TMO])) break; if (sp > XB_SPIN_CAP) { atomicAdd(&bar[XB_TMO], 1u); break; } }
    }
    nloc = mine > 0u ? mine : 1u; nx = cnt > 0u ? cnt : 1u;
}
__device__ __forceinline__ void xcd_barrier(const XcdBarrier& b) {
    asm volatile("s_waitcnt vmcnt(0)" ::: "memory");
    __syncthreads();
    if (threadIdx.x == 0) {
        unsigned* bar = b.bar;
        __builtin_amdgcn_s_waitcnt(0);
        unsigned nloc = b.st[0], nx = b.st[1];
        if (nloc == 0u) { xcd_barrier_complete(bar, b.x, nloc, nx); b.st[0] = nloc; b.st[1] = nx; }
        const unsigned old = xb_add(&bar[XB_XSUB(b.x)], 1u);
        const unsigned gen = old / nloc;
        if (old + 1u == (gen + 1u) * nloc) {
            __builtin_amdgcn_fence(__ATOMIC_RELEASE, "agent");
            asm volatile("s_waitcnt vmcnt(0)" ::: "memory");
            const unsigned og = xb_add(&bar[XB_TOP], 1u);
            const unsigned tg = og / nx;
            if (og + 1u == (tg + 1u) * nx) xb_add(&bar[XB_TOPGEN], 1u);
            else XB_SPIN(xb_ld(&bar[XB_TOPGEN]) == tg, bar);
            __builtin_amdgcn_fence(__ATOMIC_ACQUIRE, "agent");
            xb_add(&bar[XB_XGEN(b.x)], 1u);
            asm volatile("s_waitcnt vmcnt(0)" ::: "memory");
        } else {
            XB_SPIN(xb_ld(&bar[XB_XGEN(b.x)]) == gen, bar);
            __builtin_amdgcn_fence(__ATOMIC_ACQUIRE, "agent");
            asm volatile("s_waitcnt vmcnt(0)" ::: "memory");
        }
    }
    __syncthreads();
}

namespace pg8 {
constexpr int BM = 256, BK = 64, HALF = 128, HTB = HALF * BK * 2, STAGE_BYTES = 8 * HTB, NXCD = 8, WGM = 4;
DI int lds_byte(int r, int c) { const int st = (r >> 4) * 2 + (c >> 5), rr = r & 15, cc = c & 31, ob = rr * 64 + cc * 2; return st * 1024 + (ob ^ (((ob >> 9) & 1) << 5)); }
DI void stage_rc(int b, int& R, int& C) { const int st = b / 1024, sb = b % 1024, swz = sb ^ (((sb >> 9) & 1) << 5); R = (st >> 1) * 16 + swz / 64; C = (st & 1) * 32 + (swz % 64) / 2; }
DI int perm32(int rho) { const int n = rho >> 4, i = rho & 15; return 8 * (i >> 2) + 4 * n + (i & 3); }

struct Unit { int pm, pn, pz; };
struct Gemm { const bf16* A; const bf16* Bt; int K, lda, ldb; size_t a_z, b_z; };

template <int MODE> struct Order {
    int nM, nN, nwg, G, c, L0 = 0, imax = 1 << 30;
    DI void init(int nM_, int nN_, int G_, int c_) { nM = nM_; nN = nN_; nwg = nM * nN; G = G_; c = c_; }
    DI bool next(int i, Unit& u) const {
        const int ii = (MODE == 2) ? i / 3 : i;
        const long L = (long)L0 + (long)ii * G + c; if (ii >= imax || L >= nwg) return false;
        int wgid = (int)L; { const int q = nwg / NXCD, r = nwg % NXCD, xcd = wgid % NXCD, off = wgid / NXCD; wgid = (xcd < r ? xcd * (q + 1) : r * (q + 1) + (xcd - r) * q) + off; }
        const int nig = WGM * nN, gid = wgid / nig, fm = gid * WGM, gsz = (nM - fm) < WGM ? (nM - fm) : WGM;
        u.pm = fm + ((wgid % nig) % gsz); int pn = (wgid % nig) / gsz; if (gid & 1) pn = nN - 1 - pn;
        if (MODE == 1) { u.pz = pn >> 1; u.pn = pn & 1; } else if (MODE == 2) { u.pz = i - ii * 3; u.pn = pn; } else { u.pz = 0; u.pn = pn; }
        return true;
    }
};

struct OrderEq4 {
    int bid;
    DI bool next(int i, Unit& u) const { if (i >= 4) return false; const int xcd = bid & 7, off = bid >> 3; u.pm = xcd * 4 + (off & 3); u.pn = (off >> 2) + 8 * i; u.pz = 0; return true; }
};

struct EpiBf16 {
    static constexpr bool PERM = true;
    bf16* O; int ldc; int zcols;
    DI void operator()(const f32x4 (&acc)[2][2][4][2], const Unit& u, int wr, int wc, int fr, int fq) const {
        const int row0 = u.pm * BM + wr * 64 + fr; const int col0 = u.pz * zcols + u.pn * BM + wc * 32 + 8 * fq;
#pragma unroll
        for (int ai = 0; ai < 2; ++ai)
#pragma unroll
            for (int m = 0; m < 4; ++m) { bf16* rowp = O + (size_t)(row0 + ai * HALF + m * 16) * ldc + col0;
#pragma unroll
                for (int bj = 0; bj < 2; ++bj) { const f32x4 v0 = acc[ai][bj][m][0], v1 = acc[ai][bj][m][1];
                    v4u w; w.x = pk2(v0[0], v0[1]); w.y = pk2(v0[2], v0[3]); w.z = pk2(v1[0], v1[1]); w.w = pk2(v1[2], v1[3]);
                    *(v4u*)(rowp + bj * HALF) = w; } }
    }
};
struct EpiBf16Split {
    static constexpr bool PERM = true;
    bf16* O0; int ld0; bf16* O1; int ld1; int ns;
    DI void operator()(const f32x4 (&acc)[2][2][4][2], const Unit& u, int wr, int wc, int fr, int fq) const {
        const bool lo = u.pn < ns; bf16* O = lo ? O0 : O1; const int ldc = lo ? ld0 : ld1;
        const int row0 = u.pm * BM + wr * 64 + fr; const int col0 = (lo ? u.pn : u.pn - ns) * BM + wc * 32 + 8 * fq;
#pragma unroll
        for (int ai = 0; ai < 2; ++ai)
#pragma unroll
            for (int m = 0; m < 4; ++m) { bf16* rowp = O + (size_t)(row0 + ai * HALF + m * 16) * ldc + col0;
#pragma unroll
                for (int bj = 0; bj < 2; ++bj) { const f32x4 v0 = acc[ai][bj][m][0], v1 = acc[ai][bj][m][1];
                    v4u w; w.x = pk2(v0[0], v0[1]); w.y = pk2(v0[2], v0[3]); w.z = pk2(v1[0], v1[1]); w.w = pk2(v1[2], v1[3]);
                    *(v4u*)(rowp + bj * HALF) = w; } }
    }
};
struct EpiZ {
    static constexpr bool PERM = true;
    bf16* O; int ldc; const float* lbl;
    DI void operator()(const f32x4 (&acc)[2][2][4][2], const Unit& u, int wr, int wc, int fr, int fq) const {
        const int row0 = u.pm * BM + wr * 64 + fr; const int col0 = u.pn * BM + wc * 32 + 8 * fq;
        const int kind = (u.pn >= ZC_HGQ / 256 && u.pn < ZC_HGF / 256) ? 1 : ((u.pn >= ZC_HGF / 256 && u.pn < ZC_HGI / 256) ? 2 : 0);
        float lb[2][8];
#pragma unroll
        for (int bj = 0; bj < 2; ++bj)
#pragma unroll
            for (int j = 0; j < 8; ++j) lb[bj][j] = 0.f;
        if (kind == 2 && lbl) {
#pragma unroll
            for (int bj = 0; bj < 2; ++bj) { const float* p0 = lbl + (col0 + bj * HALF - ZC_HGF);
#pragma unroll
                for (int j = 0; j < 8; ++j) lb[bj][j] = sigmoidf_(p0[D + j] - p0[j]); } }
#pragma unroll
        for (int ai = 0; ai < 2; ++ai)
#pragma unroll
            for (int m = 0; m < 4; ++m) { bf16* rowp = O + (size_t)(row0 + ai * HALF + m * 16) * ldc + col0;
#pragma unroll
                for (int bj = 0; bj < 2; ++bj) { float o[8];
#pragma unroll
                    for (int j = 0; j < 8; ++j) { const float x = acc[ai][bj][m][j >> 2][j & 3];
                        o[j] = kind == 0 ? x : (kind == 1 ? siluf_(x) : __logf(fmaxf(lb[bj][j] + (1.0f - lb[bj][j]) * sigmoidf_(x), 1e-30f))); }
                    *(v4u*)(rowp + bj * HALF) = pack8(o); } }
    }
};
struct EpiLora {
    static constexpr bool PERM = true;
    bf16* O; int ldc; const float* w0; const float* a0; const float* v0;
    DI void operator()(const f32x4 (&acc)[2][2][4][2], const Unit& u, int wr, int wc, int fr, int fq) const {
        const int row0 = u.pm * BM + wr * 64 + fr; const int col0 = u.pn * BM + wc * 32 + 8 * fq;
        const int kind = u.pn >> 2;
        const int cc = col0 & 1023;
#pragma unroll
        for (int bj = 0; bj < 2; ++bj) {
            f32x4 c0 = (f32x4){0.f, 0.f, 0.f, 0.f}, c1 = c0;
            if (kind == 0) { c0 = *(const f32x4*)(w0 + cc + bj * HALF); c1 = *(const f32x4*)(w0 + cc + bj * HALF + 4); }
            if (kind == 1) { c0 = *(const f32x4*)(a0 + cc + bj * HALF); c1 = *(const f32x4*)(a0 + cc + bj * HALF + 4); }
            if (kind == 3) { c0 = *(const f32x4*)(v0 + cc + bj * HALF); c1 = *(const f32x4*)(v0 + cc + bj * HALF + 4); }
#pragma unroll
            for (int ai = 0; ai < 2; ++ai)
#pragma unroll
                for (int m = 0; m < 4; ++m) { bf16* rowp = O + (size_t)(row0 + ai * HALF + m * 16) * ldc + col0 + bj * HALF; float o[8];
#pragma unroll
                    for (int j = 0; j < 8; ++j) { const float x = acc[ai][bj][m][j >> 2][j & 3] + (j < 4 ? c0[j & 3] : c1[j & 3]);
                        o[j] = kind == 2 ? x : (kind == 0 ? -__expf(-softplusf_(-x) - 0.5f) : sigmoidf_(x)); }
                    *(v4u*)rowp = pack8(o); }
        }
    }
};
struct EpiSwiGLU {
    static constexpr bool PERM = true;
    bf16* O; int ldc;
    DI void operator()(const f32x4 (&acc)[2][2][4][2], const Unit& u, int wr, int wc, int fr, int fq) const {
        const int row0 = u.pm * BM + wr * 64 + fr; const int col0 = u.pn * HALF + wc * 32 + 8 * fq;
#pragma unroll
        for (int ai = 0; ai < 2; ++ai)
#pragma unroll
            for (int m = 0; m < 4; ++m) { bf16* rowp = O + (size_t)(row0 + ai * HALF + m * 16) * ldc + col0;
                float o[8];
#pragma unroll
                for (int n = 0; n < 2; ++n)
#pragma unroll
                    for (int j = 0; j < 4; ++j) { const float a = acc[ai][0][m][n][j], b = acc[ai][1][m][n][j]; o[n * 4 + j] = a * b * __builtin_amdgcn_rcpf(1.0f + __expf(-a)); }
                *(v4u*)rowp = pack8(o); }
    }
};
struct EpiResid {
    static constexpr bool PERM = false;
    const float* xin; float* xout; const float* gate; float mul; int b0;
    template <int NA> DI void operator()(const f32x4 (&acc)[NA][2][4][2], const Unit& u, int wr, int wc, int fr, int fq) const {
        const int row0 = u.pm * (NA * HALF) + wr * 64 + fr, col0 = u.pn * BM + wc * 32 + 4 * fq;
        const float* gp = gate + (size_t)(b0 + (u.pm * (NA * HALF)) / T) * NMOD + col0;
        f32x4 cf[2][2];
#pragma unroll
        for (int bj = 0; bj < 2; ++bj)
#pragma unroll
            for (int n = 0; n < 2; ++n) cf[bj][n] = (*(const f32x4*)(gp + bj * HALF + n * 16) + 1.0f) * mul;
        f32x4 xi[3][4];
#define ER_LD(c) do { const size_t off_ = (size_t)(row0 + ((c) >> 2) * HALF + ((c) & 3) * 16) * D + col0; _Pragma("unroll") for (int q_ = 0; q_ < 4; ++q_) xi[(c) % 3][q_] = *(const f32x4*)(xin + off_ + (q_ >> 1) * HALF + (q_ & 1) * 16); } while (0)
        ER_LD(0); ER_LD(1);
#pragma unroll
        for (int c = 0; c < 4 * NA; ++c) { const int ai = c >> 2, m = c & 3; const size_t off = (size_t)(row0 + ai * HALF + m * 16) * D + col0;
            if (c + 2 < 4 * NA) ER_LD(c + 2);
            asm volatile("" ::: "memory");
#pragma unroll
            for (int q = 0; q < 4; ++q) *(f32x4*)(xout + off + (q >> 1) * HALF + (q & 1) * 16) = xi[c % 3][q] + cf[q >> 1][q & 1] * acc[ai][q >> 1][m][q & 1];
            asm volatile("" ::: "memory"); }
#undef ER_LD
    }
};
struct EpiBranch {
    static constexpr bool PERM = false;
    const bf16* gates; int ldg; bf16* mix; const bf16* gates0;
    template <int NA> DI void operator()(const f32x4 (&acc)[NA][2][4][2], const Unit& u, int wr, int wc, int fr, int fq) const {
        const int row0 = u.pm * (NA * HALF) + wr * 64 + fr, col0 = u.pn * BM + wc * 32 + 4 * fq;
        v2u gw[3][4], mw[3][4];
#define EB_LD(c) do { const int row_ = row0 + ((c) >> 2) * HALF + ((c) & 3) * 16; const bf16* gp_ = (u.pz == 0 ? gates0 + (size_t)row_ * D : gates + (size_t)row_ * ldg + (u.pz - 1) * D) + col0; const bf16* mp_ = mix + (size_t)row_ * D + col0; \
            _Pragma("unroll") for (int q_ = 0; q_ < 4; ++q_) { gw[(c) % 3][q_] = *(const v2u*)(gp_ + (q_ >> 1) * HALF + (q_ & 1) * 16); if (u.pz > 0) mw[(c) % 3][q_] = *(const v2u*)(mp_ + (q_ >> 1) * HALF + (q_ & 1) * 16); } } while (0)
        EB_LD(0); EB_LD(1);
#pragma unroll
        for (int c = 0; c < 4 * NA; ++c) { const int ai = c >> 2, m = c & 3; const size_t off = (size_t)(row0 + ai * HALF + m * 16) * D + col0;
            if (c + 2 < 4 * NA) EB_LD(c + 2);
            asm volatile("" ::: "memory");
#pragma unroll
            for (int q = 0; q < 4; ++q) { const v2u g2 = gw[c % 3][q];
                f32x4 g; g[0] = sigmoidf_(bflo(g2.x)); g[1] = sigmoidf_(bfhi(g2.x)); g[2] = sigmoidf_(bflo(g2.y)); g[3] = sigmoidf_(bfhi(g2.y));
                f32x4 v = g * acc[ai][q >> 1][m][q & 1];
                if (u.pz > 0) { const v2u m2 = mw[c % 3][q]; v[0] += bflo(m2.x); v[1] += bfhi(m2.x); v[2] += bflo(m2.y); v[3] += bfhi(m2.y); }
                v2u w; w.x = pk2(v[0], v[1]); w.y = pk2(v[2], v[3]); *(v2u*)(mix + off + (q >> 1) * HALF + (q & 1) * 16) = w; }
            asm volatile("" ::: "memory"); }
#undef EB_LD
    }
};

template <class Epi, class Sched>
DI void gemm_phase(LAS unsigned char* lds, const Gemm g, const Sched& S, const Epi& E, int tid_) {
    asm volatile("" : "+v"(tid_));
    const int tid = tid_, wid = __builtin_amdgcn_readfirstlane(tid >> 6), lane = tid & 63, wr = wid >> 2, wc = wid & 3, fr = lane & 15, fq = lane >> 4;
    int K_ = g.K; asm volatile("" : "+s"(K_));
    const int K = K_, nt = K / BK;
    unsigned voffA[2], voffB[2];
#pragma unroll
    for (int i = 0; i < 2; ++i) { int R, C; stage_rc(tid * 16 + i * 8192, R, C); const int Rb = Epi::PERM ? ((R & ~31) + perm32(R & 31)) : R;
        voffA[i] = (unsigned)(R * g.lda + C) * 2u; voffB[i] = (unsigned)(Rb * g.ldb + C) * 2u; }
    const size_t kstep = (size_t)(BK * 2);
    const size_t hstepA = (size_t)HALF * g.lda * 2, hstepB = (size_t)HALF * g.ldb * 2;
    const size_t tstepA = 2 * hstepA, tstepB = 2 * hstepB;
    const unsigned ldsw = (unsigned)wid * 1024u;
    const int aoff = lds_byte(wr * 64 + fr, fq * 8), boff = lds_byte(wc * 32 + fr, fq * 8);
#define PG8_SA(b, h) (((b) * 2 + (h)) * HTB)
#define PG8_SB(b, h) ((4 + (b) * 2 + (h)) * HTB)
#define PG8_STAGE(bufoff, gbase, voff) do { _Pragma("unroll") for (int _i = 0; _i < 2; ++_i) \
        __builtin_amdgcn_global_load_lds((const unsigned*)((const char*)(gbase) + (voff)[_i]), (LAS unsigned*)(lds + (bufoff) + ldsw + _i * 8192), 16, 0, 0); } while (0)
#define PG8_LDA(dst, b, h) do { _Pragma("unroll") for (int m = 0; m < 4; ++m) _Pragma("unroll") for (int k = 0; k < 2; ++k) dst[m][k] = *(const LAS bf16x8*)(lds + PG8_SA(b, h) + aoff + m * 2048 + k * 1024); } while (0)
#define PG8_LDB(dst, b, h) do { _Pragma("unroll") for (int n = 0; n < 2; ++n) _Pragma("unroll") for (int k = 0; k < 2; ++k) dst[n][k] = *(const LAS bf16x8*)(lds + PG8_SB(b, h) + boff + n * 2048 + k * 1024); } while (0)
#define PG8_MMA(ai, bj, At, Bt) do { __builtin_amdgcn_s_setprio(1); _Pragma("unroll") for (int m = 0; m < 4; ++m) _Pragma("unroll") for (int n = 0; n < 2; ++n) _Pragma("unroll") for (int k = 0; k < 2; ++k) \
        acc[ai][bj][m][n] = __builtin_amdgcn_mfma_f32_16x16x32_bf16(Bt[n][k], At[m][k], acc[ai][bj][m][n], 0, 0, 0); __builtin_amdgcn_s_setprio(0); } while (0)
#define PG8_WAIT_V(n) asm volatile("s_waitcnt vmcnt(" #n ")" ::: "memory")
#define PG8_WAIT_L(n) asm volatile("s_waitcnt lgkmcnt(" #n ")" ::: "memory")
#define PG8_BAR __builtin_amdgcn_s_barrier()
#define PG8_SCHED __builtin_amdgcn_sched_barrier(0)
    Unit cur, nxt; int ui = 0;
    if (!S.next(0, cur)) return;
    f32x4 acc[2][2][4][2];
#pragma unroll
    for (int a = 0; a < 2; ++a)
#pragma unroll
        for (int b = 0; b < 2; ++b)
#pragma unroll
            for (int m = 0; m < 4; ++m)
#pragma unroll
                for (int n = 0; n < 2; ++n) acc[a][b][m][n] = (f32x4){0.f, 0.f, 0.f, 0.f};
    bf16x8 At[4][2], B0[2][2], B1[2][2];
    const char* cA = (const char*)(g.A + (size_t)cur.pz * g.a_z) + (size_t)cur.pm * tstepA; const char* cB = (const char*)(g.Bt + (size_t)cur.pz * g.b_z) + (size_t)cur.pn * tstepB;
    PG8_STAGE(PG8_SB(0, 0), cB, voffB); PG8_STAGE(PG8_SB(0, 1), cB + hstepB, voffB); PG8_STAGE(PG8_SA(0, 0), cA, voffA); PG8_STAGE(PG8_SA(0, 1), cA + hstepA, voffA);
    if (wr == 1) PG8_BAR;
    PG8_WAIT_V(2); PG8_BAR;
    PG8_STAGE(PG8_SB(1, 0), cB + kstep, voffB); PG8_STAGE(PG8_SA(1, 0), cA + kstep, voffA); PG8_STAGE(PG8_SB(1, 1), cB + hstepB + kstep, voffB);
    PG8_WAIT_V(6); PG8_BAR;
    for (;;) {
        const bool has_next = S.next(ui + 1, nxt);
        const char* nA = has_next ? (const char*)(g.A + (size_t)nxt.pz * g.a_z) + (size_t)nxt.pm * tstepA : cA; const char* nB = has_next ? (const char*)(g.Bt + (size_t)nxt.pz * g.b_z) + (size_t)nxt.pn * tstepB : cB;
        for (int t = 0; t < nt; t += 2) {
            const bool last = (t == nt - 2);
            const char* a1 = cA + (size_t)(t + 1) * kstep;
            const char* a2 = last ? nA : cA + (size_t)(t + 2) * kstep; const char* b2 = last ? nB : cB + (size_t)(t + 2) * kstep;
            const char* a3 = a2 + kstep; const char* b3 = b2 + kstep;
            PG8_LDB(B0, 0, 0); PG8_LDB(B1, 0, 1); PG8_SCHED; PG8_LDA(At, 0, 0); PG8_STAGE(PG8_SA(1, 1), a1 + hstepA, voffA);
            PG8_WAIT_V(8); PG8_WAIT_L(0); PG8_BAR; PG8_MMA(0, 0, At, B0); PG8_MMA(0, 1, At, B1); PG8_BAR; PG8_SCHED;
            PG8_LDA(At, 0, 1); PG8_STAGE(PG8_SB(0, 0), b2, voffB); PG8_STAGE(PG8_SB(0, 1), b2 + hstepB, voffB); PG8_STAGE(PG8_SA(0, 0), a2, voffA);
            PG8_WAIT_V(8); PG8_WAIT_L(0); PG8_BAR; PG8_MMA(1, 0, At, B0); PG8_MMA(1, 1, At, B1); PG8_BAR; PG8_SCHED;
            PG8_LDB(B0, 1, 0); PG8_LDB(B1, 1, 1); PG8_SCHED; PG8_LDA(At, 1, 0); PG8_STAGE(PG8_SA(0, 1), a2 + hstepA, voffA);
            PG8_WAIT_V(8); PG8_WAIT_L(0); PG8_BAR; PG8_MMA(0, 0, At, B0); PG8_MMA(0, 1, At, B1); PG8_BAR; PG8_SCHED;
            PG8_LDA(At, 1, 1); PG8_STAGE(PG8_SB(1, 0), b3, voffB); PG8_STAGE(PG8_SB(1, 1), b3 + hstepB, voffB); PG8_STAGE(PG8_SA(1, 0), a3, voffA);
            PG8_WAIT_V(8); PG8_WAIT_L(0); PG8_BAR; PG8_MMA(1, 0, At, B0); PG8_MMA(1, 1, At, B1); PG8_BAR; PG8_SCHED;
        }
        if (wr == 0) PG8_BAR;
        E(acc, cur, wr, wc, fr, fq);
        if (!has_next) break;
#pragma unroll
        for (int a = 0; a < 2; ++a)
#pragma unroll
            for (int b = 0; b < 2; ++b)
#pragma unroll
                for (int m = 0; m < 4; ++m)
#pragma unroll
                    for (int n = 0; n < 2; ++n) acc[a][b][m][n] = (f32x4){0.f, 0.f, 0.f, 0.f};
        cur = nxt; cA = nA; cB = nB; ++ui;
        if (wr == 1) PG8_BAR;
    }
    PG8_WAIT_V(0);
    PG8_BAR;
#undef PG8_SA
#undef PG8_SB
#undef PG8_STAGE
#undef PG8_LDA
#undef PG8_LDB
#undef PG8_MMA
#undef PG8_WAIT_V
#undef PG8_WAIT_L
#undef PG8_BAR
#undef PG8_SCHED
}
template <class Epi, class Sched>
DI void gemm_phase_hm(LAS unsigned char* lds, const Gemm g, const Sched& S, const Epi& E, int tid_) {
    asm volatile("" : "+v"(tid_));
    const int tid = tid_, wid = __builtin_amdgcn_readfirstlane(tid >> 6), lane = tid & 63, wr = wid >> 2, wc = wid & 3, fr = lane & 15, fq = lane >> 4;
    int K_ = g.K; asm volatile("" : "+s"(K_));
    const int nt = K_ / BK;
    unsigned voffA[2], voffB[2], voffAp[2], voffBp[2];
#pragma unroll
    for (int i = 0; i < 2; ++i) { int R, C; stage_rc(tid * 16 + i * 8192, R, C); int Rb = Epi::PERM ? ((R & ~31) + perm32(R & 31)) : R;
        voffA[i] = (unsigned)(R * g.lda + C) * 2u; voffB[i] = (unsigned)(Rb * g.ldb + C) * 2u;
        stage_rc((tid & 255) * 16 + i * 8192, R, C); Rb = Epi::PERM ? ((R & ~31) + perm32(R & 31)) : R;
        voffAp[i] = (unsigned)(R * g.lda + C) * 2u; voffBp[i] = (unsigned)(Rb * g.ldb + C) * 2u; }
    const size_t kstep = (size_t)(BK * 2);
    const size_t hstepB = (size_t)HALF * g.ldb * 2, tstepA = (size_t)HALF * g.lda * 2, tstepB = 2 * hstepB;
    const unsigned ldsw = (unsigned)wid * 1024u, ldswp = (unsigned)(wid & 3) * 1024u;
    const int aoff = lds_byte(wr * 64 + fr, fq * 8), boff = lds_byte(wc * 32 + fr, fq * 8);
    constexpr int STG = 3 * HTB;
#define HM_STAGE1(bufoff, gbase, voff, lw) do { _Pragma("unroll") for (int _i = 0; _i < 2; ++_i) \
        __builtin_amdgcn_global_load_lds((const unsigned*)((const char*)(gbase) + (voff)[_i]), (LAS unsigned*)(lds + (bufoff) + (lw) + _i * 8192), 16, 0, 0); } while (0)
#define HM_STAGE_ADV(s, BOTH) do { const char* pa_ = sA + (size_t)sk * kstep; const char* pb_ = sB + (size_t)sk * kstep; \
        HM_STAGE1((s) * STG + HTB, pb_, voffB, ldsw); HM_STAGE1((s) * STG + 2 * HTB, pb_ + hstepB, voffB, ldsw); HM_STAGE1((s) * STG, pa_, voffA, ldsw); \
        if (BOTH) { HM_STAGE1((s) * STG + HTB, pb_, voffBp, ldswp); HM_STAGE1((s) * STG + 2 * HTB, pb_ + hstepB, voffBp, ldswp); HM_STAGE1((s) * STG, pa_, voffAp, ldswp); } \
        if (++sk == nt) { sk = 0; Unit nu_; if (S.next(sui + 1, nu_)) { ++sui; sA = (const char*)(g.A + (size_t)nu_.pz * g.a_z) + (size_t)nu_.pm * tstepA; sB = (const char*)(g.Bt + (size_t)nu_.pz * g.b_z) + (size_t)nu_.pn * tstepB; } } } while (0)
#define HM_LDA(dst, s) do { _Pragma("unroll") for (int m = 0; m < 4; ++m) _Pragma("unroll") for (int k = 0; k < 2; ++k) dst[m][k] = *(const LAS bf16x8*)(lds + (s) * STG + aoff + m * 2048 + k * 1024); } while (0)
#define HM_LDB(dst, s, h) do { _Pragma("unroll") for (int n = 0; n < 2; ++n) _Pragma("unroll") for (int k = 0; k < 2; ++k) dst[n][k] = *(const LAS bf16x8*)(lds + (s) * STG + (1 + (h)) * HTB + boff + n * 2048 + k * 1024); } while (0)
#define HM_MMA(bj, At, Bt) do { __builtin_amdgcn_s_setprio(1); _Pragma("unroll") for (int m = 0; m < 4; ++m) _Pragma("unroll") for (int n = 0; n < 2; ++n) _Pragma("unroll") for (int k = 0; k < 2; ++k) \
        acc[0][bj][m][n] = __builtin_amdgcn_mfma_f32_16x16x32_bf16(Bt[n][k], At[m][k], acc[0][bj][m][n], 0, 0, 0); __builtin_amdgcn_s_setprio(0); } while (0)
#define HM_WAIT_V(n) asm volatile("s_waitcnt vmcnt(" #n ")" ::: "memory")
#define HM_WAIT_L(n) asm volatile("s_waitcnt lgkmcnt(" #n ")" ::: "memory")
#define HM_BAR __builtin_amdgcn_s_barrier()
#define HM_SCHED __builtin_amdgcn_sched_barrier(0)
    Unit cur, nxt; int ui = 0;
    if (!S.next(0, cur)) return;
    f32x4 acc[1][2][4][2];
#pragma unroll
    for (int b = 0; b < 2; ++b)
#pragma unroll
        for (int m = 0; m < 4; ++m)
#pragma unroll
            for (int n = 0; n < 2; ++n) acc[0][b][m][n] = (f32x4){0.f, 0.f, 0.f, 0.f};
    bf16x8 At[4][2], B0[2][2], B1[2][2];
    int sui = 0, sk = 0;
    const char* sA = (const char*)(g.A + (size_t)cur.pz * g.a_z) + (size_t)cur.pm * tstepA; const char* sB = (const char*)(g.Bt + (size_t)cur.pz * g.b_z) + (size_t)cur.pn * tstepB;
    HM_STAGE_ADV(0, false); HM_STAGE_ADV(1, false); HM_STAGE_ADV(2, false);
    HM_WAIT_V(0);
    if (wr == 1) HM_BAR;
    HM_BAR;
    int cs = 0;
    for (;;) {
        for (int t = 0; t < nt; ++t) {
            HM_LDB(B0, cs, 0); HM_LDB(B1, cs, 1); HM_LDA(At, cs);
            HM_WAIT_L(0); if (wr == 1) HM_WAIT_V(12); HM_BAR; HM_SCHED;
            if (wr == 1) HM_STAGE_ADV(cs, true);
            HM_MMA(0, At, B0); HM_MMA(1, At, B1);
            HM_BAR; HM_SCHED;
            cs = cs == 2 ? 0 : cs + 1;
        }
        if (wr == 0) HM_BAR;
        const bool has_next = S.next(ui + 1, nxt);
        E(acc, cur, wr, wc, fr, fq);
        if (!has_next) break;
#pragma unroll
        for (int b = 0; b < 2; ++b)
#pragma unroll
            for (int m = 0; m < 4; ++m)
#pragma unroll
                for (int n = 0; n < 2; ++n) acc[0][b][m][n] = (f32x4){0.f, 0.f, 0.f, 0.f};
        cur = nxt; ++ui;
        if (wr == 1) HM_BAR;
    }
    HM_WAIT_V(0);
    HM_BAR;
#undef HM_STAGE1
#undef HM_STAGE_ADV
#undef HM_LDA
#undef HM_LDB
#undef HM_MMA
#undef HM_WAIT_V
#undef HM_WAIT_L
#undef HM_BAR
#undef HM_SCHED
}
}

struct Args {
    const float* in[36]; float* out; unsigned char* ws;
    int f_lo, f_hi, g_lo, g_hi, ph_lo, ph_hi, use_bar, pad;
};
struct Ctx {
    LAS unsigned char* lds;
    const float* const* in; float* out; unsigned char* ws;
    int tid, lane, wave, bid, G, z;
};
DI void refresh(Ctx& F) {
    { int z_ = 0; asm volatile("" : "+s"(z_)); F.z = z_; }
    asm volatile("" : "+v"(F.tid)); F.lane = F.tid & 63; F.wave = __builtin_amdgcn_readfirstlane(F.tid >> 6);
}
enum { I_X = 0, I_C, I_NORMW, I_FNORMW, I_ADAW, I_ADAB, I_FUP, I_FDN, I_WIN, I_WINV, I_CONVW, I_CONVB, I_WQ, I_WK, I_IB, I_FB, I_MLNW, I_MLSKIP,
       I_MU, I_MUV, I_W0, I_W2, I_A0, I_A2, I_V0, I_V2, I_G2, I_KK, I_KA, I_RK, I_LNW, I_LNB, I_LBL, I_HGNW, I_WBR, I_WOUT };

DI void transpose_item(const float* W, int ldw, int k0, int c0, bf16* WT, int ldt, int r0, float scale, LAS float* scr, int lane) {
    float tv[32];
#pragma unroll
    for (int i = 0; i < 32; ++i) tv[i] = W[(size_t)(k0 + 2 * i + (lane >> 5)) * ldw + c0 + (lane & 31)];
#pragma unroll
    for (int i = 0; i < 32; ++i) scr[(2 * i + (lane >> 5)) * 33 + (lane & 31)] = tv[i];
    LDS_WAIT(); asm volatile("" ::: "memory");
    const int c = lane & 7;
#pragma unroll
    for (int j = 0; j < 4; ++j) { const int n = (lane >> 3) + 8 * j; const LAS float* s = scr + (8 * c) * 33 + n;
        v4u o; o.x = pk2(s[0 * 33] * scale, s[1 * 33] * scale); o.y = pk2(s[2 * 33] * scale, s[3 * 33] * scale); o.z = pk2(s[4 * 33] * scale, s[5 * 33] * scale); o.w = pk2(s[6 * 33] * scale, s[7 * 33] * scale);
        *(v4u*)(WT + (size_t)(r0 + n) * ldt + k0 + 8 * c) = o; }
    LDS_WAIT(); asm volatile("" ::: "memory");
}
DI void phase_weights(const Ctx& F, int l) {
    LAS float* scr = (LAS float*)(F.lds + F.wave * 16384);
    const int gw = F.bid * NWAVES + F.wave, NGW = F.G * NWAVES;
    constexpr int I_UP = 16 * 176, I_DN = 44 * 32, I_IN = 16 * 392, I_SQ = 16 * 32, I_QKI = 8 * 32;
    constexpr int NITEMS = 2 * I_UP + 2 * I_DN + I_IN + 4 * I_SQ + I_QKI;
    bf16* WUP = (bf16*)(F.ws + WS_WUP); bf16* WDN = (bf16*)(F.ws + WS_WDN); bf16* WIN = (bf16*)(F.ws + WS_WIN); bf16* WBR = (bf16*)(F.ws + WS_WBR);
    bf16* WOUT = (bf16*)(F.ws + WS_WOUT); bf16* WQK = (bf16*)(F.ws + WS_WQK);
    for (int it = gw; it < NITEMS; it += NGW) {
        int r = it;
        if (r < 2 * I_UP) { const int i = r / I_UP; r -= i * I_UP; const int kb = r / 176, nb = r % 176, c0 = 32 * nb; const int cc = c0 < DFF ? c0 : c0 - DFF;
            const int r0 = (cc / 128) * 256 + (c0 < DFF ? 0 : 128) + (cc % 128);
            transpose_item(F.in[F.z + I_FUP] + (size_t)(l * 2 + i) * D * NUP, NUP, 64 * kb, c0, WUP + (size_t)i * NUP * D, D, r0, 1.f, scr, F.lane); continue; }
        r -= 2 * I_UP;
        if (r < 2 * I_DN) { const int i = r / I_DN; r -= i * I_DN; const int kb = r / 32, nb = r % 32;
            transpose_item(F.in[F.z + I_FDN] + (size_t)(l * 2 + i) * DFF * D, D, 64 * kb, 32 * nb, WDN + (size_t)i * D * DFF, DFF, 32 * nb, 1.f, scr, F.lane); continue; }
        r -= 2 * I_DN;
        if (r < I_IN) { const int kb = r / 392, nb = r % 392, d0 = 32 * nb, c0 = d0 < 1024 ? d0 : (d0 < NZE ? d0 + 1032 : (d0 < 8448 ? d0 - 6400 : d0 + 8));
            transpose_item(F.in[F.z + I_WIN] + (size_t)l * D * WIN_SRC, WIN_SRC, 64 * kb, c0, WIN, D, d0, 1.f, scr, F.lane); continue; }
        r -= I_IN;
        if (r < 3 * I_SQ) { const int n = r / I_SQ; r -= n * I_SQ; const int kb = r / 32, nb = r % 32;
            transpose_item(F.in[F.z + I_WBR] + (size_t)(l * 3 + n) * D * D, D, 64 * kb, 32 * nb, WBR + (size_t)n * D * D, D, 32 * nb, 1.f, scr, F.lane); continue; }
        r -= 3 * I_SQ;
        if (r < I_SQ) { const int kb = r / 32, nb = r % 32;
            transpose_item(F.in[F.z + I_WOUT] + (size_t)l * D * D, D, 64 * kb, 32 * nb, WOUT, D, 32 * nb, 1.f, scr, F.lane); continue; }
        r -= I_SQ;
        { const int mat = r / 32, rr = r % 32, h = mat >> 1, isk = mat & 1, kb = rr / 8, nb = rr % 8;
            transpose_item(F.in[F.z + isk ? I_WK : I_WQ] + (size_t)(l * 4 + h) * 256 * 256, 256, 64 * kb, 32 * nb, WQK + (size_t)(h * 512 + isk * 256) * 256, 256, 32 * nb, isk ? 0.0625f : 1.f, scr, F.lane); }
    }
    const int gt = F.bid * NTHREADS + F.tid, NT = F.G * NTHREADS;
    bf16* WL = (bf16*)(F.ws + WS_WLORA);
    for (int idx = gt; idx < NLORA * (KLORA / 8); idx += NT) {
        const int n = idx & (NLORA - 1), kc = idx >> 12, k0 = kc * 8, blk = n >> 10, nn = n & 1023;
        float o[8];
#pragma unroll
        for (int i = 0; i < 8; ++i) o[i] = 0.f;
        const float* src = nullptr; int kk = 0;
        if (blk == 0 && k0 < 64) { src = F.in[F.z + I_W2] + (size_t)l * 64 * D; kk = k0; }
        else if (blk == 1 && k0 >= 64 && k0 < 128) { src = F.in[F.z + I_A2] + (size_t)l * 64 * D; kk = k0 - 64; }
        else if (blk == 2 && k0 >= 128 && k0 < 256) { src = F.in[F.z + I_G2] + (size_t)l * 128 * D; kk = k0 - 128; }
        else if (blk == 3 && l == 1 && k0 >= 256 && k0 < 288) { src = F.in[F.z + I_V2]; kk = k0 - 256; }
        if (src) {
#pragma unroll
            for (int i = 0; i < 8; ++i) o[i] = src[(size_t)(kk + i) * D + nn]; }
        *(v4u*)(WL + (size_t)n * KLORA + k0) = pack8(o);
    }
    float* WS_ = (float*)(F.ws + WS_WSIDE);
    for (int idx = gt; idx < NSIDE * D; idx += NT) {
        const int j = idx >> 10, k = idx & 1023; float v = 0.f;
        if (j < 8) v = F.in[F.z + I_WIN][(size_t)l * D * WIN_SRC + (size_t)k * WIN_SRC + 2048 + j];
        else if (l == 1) v = F.in[F.z + I_WINV][(size_t)k * 32 + (j - 8)];
        WS_[idx] = v;
    }
}
DI void phase_mod(const Ctx& F) {
    LAS float* sc = (LAS float*)F.lds; LAS float* red = (LAS float*)(F.lds + 65536);
    float* mod = (float*)(F.ws + WS_MOD);
    bool loaded = false;
    for (int it = F.bid; it < 2 * 144; it += F.G) {
        if (!loaded) { for (int i = F.tid; i < NB * D; i += NTHREADS) sc[i] = siluf_(F.in[F.z + I_C][i]); loaded = true; __syncthreads(); }
        const int l = it / 144, n0 = (it % 144) * 64, n = F.tid & 63, ks = F.tid >> 6;
        float acc[16];
#pragma unroll
        for (int b = 0; b < 16; ++b) acc[b] = 0.f;
        const float* wp = F.in[F.z + I_ADAW] + (size_t)l * D * NMOD + n0 + n;
        for (int k = ks * 128; k < ks * 128 + 128; ++k) { const float w = wp[(size_t)k * NMOD];
#pragma unroll
            for (int b = 0; b < 16; ++b) acc[b] += sc[b * D + k] * w; }
#pragma unroll
        for (int b = 0; b < 16; ++b) red[(ks * 16 + b) * 64 + n] = acc[b];
        __syncthreads();
        for (int o = F.tid; o < 1024; o += NTHREADS) { const int b = o >> 6, nn = o & 63; float s = 0.f;
#pragma unroll
            for (int k8 = 0; k8 < 8; ++k8) s += red[(k8 * 16 + b) * 64 + nn];
            mod[(size_t)(l * 16 + b) * NMOD + n0 + nn] = s + F.in[F.z + I_ADAB][(size_t)l * NMOD + n0 + nn]; }
        __syncthreads();
    }
}

template <bool SIDE>
DI void phase_modulate(const Ctx& F, const float* x, bf16* hout, const float* nw, const float* modl, int sub, int r0, int nrows, float* side, int nside, int wg, int nwg) {
    const int gw = wg * NWAVES + F.wave, NGW = nwg * NWAVES;
    const float* wside = (const float*)(F.ws + WS_WSIDE);
    constexpr int RB = SIDE ? 4 : 1;
    for (int rq = gw; rq < nrows / RB; rq += NGW) {
        const int b = (r0 + rq * RB) / T;
        const f32x4* nwp = (const f32x4*)nw + F.lane;
        const f32x4* shp = (const f32x4*)(modl + (size_t)b * NMOD + (sub * 3 + 0) * D) + F.lane;
        const f32x4* scp = (const f32x4*)(modl + (size_t)b * NMOD + (sub * 3 + 1) * D) + F.lane;
        f32x4 v[RB][4];
#pragma unroll
        for (int i = 0; i < RB; ++i) { const f32x4* xr = (const f32x4*)(x + (size_t)(r0 + rq * RB + i) * D) + F.lane;
#pragma unroll
            for (int j = 0; j < 4; ++j) v[i][j] = xr[64 * j]; }
#pragma unroll
        for (int i = 0; i < RB; ++i) { float ss = 0.f;
#pragma unroll
            for (int j = 0; j < 4; ++j) ss += (v[i][j].x * v[i][j].x + v[i][j].y * v[i][j].y) + (v[i][j].z * v[i][j].z + v[i][j].w * v[i][j].w);
            const float rstd = __builtin_amdgcn_rsqf(wave_sum(ss) * (1.f / D) + 1e-6f);
            unsigned long long* o8 = (unsigned long long*)(hout + (size_t)(rq * RB + i) * D) + F.lane;
#pragma unroll
            for (int j = 0; j < 4; ++j) { v[i][j] = v[i][j] * rstd * nwp[64 * j] * (scp[64 * j] + 1.0f) + shp[64 * j];
                o8[64 * j] = (unsigned long long)pk2(v[i][j].x, v[i][j].y) | ((unsigned long long)pk2(v[i][j].z, v[i][j].w) << 32); } }
        if (SIDE) {
            const f32x4* wp0 = (const f32x4*)wside + F.lane; f32x4 wa[4], wb[4];
#pragma unroll
            for (int j = 0; j < 4; ++j) wa[j] = wp0[64 * j];
#define PM_SIDE(W, JJ) do { float s[RB]; _Pragma("unroll") for (int i = 0; i < RB; ++i) { float a = 0.f; \
                _Pragma("unroll") for (int j = 0; j < 4; ++j) a += (v[i][j].x * W[j].x + v[i][j].y * W[j].y) + (v[i][j].z * W[j].z + v[i][j].w * W[j].w); \
                s[i] = wave_sum(a); } \
            _Pragma("unroll") for (int i = 0; i < RB; ++i) if (F.lane == i) side[(size_t)(rq * RB + i) * NSIDE + (JJ)] = s[i]; } while (0)
            for (int jj = 0; jj < nside; jj += 2) {
#pragma unroll
                for (int j = 0; j < 4; ++j) wb[j] = wp0[(size_t)(jj + 1) * (D / 4) + 64 * j];
                PM_SIDE(wa, jj);
                if (jj + 2 < nside) {
#pragma unroll
                    for (int j = 0; j < 4; ++j) wa[j] = wp0[(size_t)(jj + 2) * (D / 4) + 64 * j]; }
                PM_SIDE(wb, jj + 1); }
#undef PM_SIDE
        }
    }
}
DI void phase_final_norm(const Ctx& F) {
    const int gw = F.bid * NWAVES + F.wave, NGW = F.G * NWAVES;
    for (int row = gw; row < M; row += NGW) {
        f32x4* xr = (f32x4*)(F.out + (size_t)row * D) + F.lane;
        f32x4 v[4]; float ss = 0.f;
#pragma unroll
        for (int j = 0; j < 4; ++j) { v[j] = xr[64 * j]; ss += (v[j].x * v[j].x + v[j].y * v[j].y) + (v[j].z * v[j].z + v[j].w * v[j].w); }
        const float rstd = 1.0f / sqrtf(wave_sum(ss) * (1.f / D) + 1e-6f);
        const f32x4* nwp = (const f32x4*)F.in[F.z + I_FNORMW] + F.lane;
#pragma unroll
        for (int j = 0; j < 4; ++j) xr[64 * j] = v[j] * rstd * nwp[64 * j];
    }
}

DI void phase_prep(const Ctx& F, int l) {
    const int gt = F.bid * NTHREADS + F.tid, NT = F.G * NTHREADS;
    const bf16* Z = (const bf16*)(F.ws + WS_Z); bf16* XC = (bf16*)(F.ws + WS_XC); bf16* LA = (bf16*)(F.ws + WS_LA); const float* SD = (const float*)(F.ws + WS_SIDE);
    const float* cw = F.in[F.z + I_CONVW] + (size_t)l * 4 * D; const float* cb = F.in[F.z + I_CONVB] + (size_t)l * D;
    const float* mu = F.in[F.z + I_MU] + (size_t)l * 3328;
    for (int idx = gt; idx < (MG / 8) * 128; idx += NT) {
        const int rb = idx >> 7, c8 = (idx & 127) * 8, row0 = rb * 8, t0 = row0 & (T - 1);
        float wv[4][8], bv[8];
#pragma unroll
        for (int i = 0; i < 8; ++i) bv[i] = cb[c8 + i];
#pragma unroll
        for (int j = 0; j < 4; ++j)
#pragma unroll
            for (int i = 0; i < 8; ++i) wv[j][i] = cw[j * D + c8 + i];
        v4u zr[11];
#pragma unroll
        for (int r = 0; r < 11; ++r) zr[r] = (r >= 3 || t0 > 0) ? *(const v4u*)(Z + (size_t)(row0 - 3 + r) * NZ + ZC_MLX + c8) : (v4u){0u, 0u, 0u, 0u};
#pragma unroll
        for (int r = 0; r < 8; ++r) { float a[8], x[8];
#pragma unroll
            for (int i = 0; i < 8; ++i) a[i] = bv[i];
#pragma unroll
            for (int j = 0; j < 4; ++j) { unpack8(zr[r + j], x);
#pragma unroll
                for (int i = 0; i < 8; ++i) a[i] += wv[j][i] * x[i]; }
#pragma unroll
            for (int i = 0; i < 8; ++i) a[i] = siluf_(a[i]);
            *(v4u*)(XC + (size_t)(row0 + r) * D + c8) = pack8(a); }
    }
    for (int idx = gt; idx < MG * 48; idx += NT) {
        const int row = idx / 48, k0 = (idx - row * 48) * 8, t = row & (T - 1);
        float o[8];
#pragma unroll
        for (int i = 0; i < 8; ++i) o[i] = 0.f;
        if (k0 < 256) { float cur[8], prv[8];
            unpack8(*(const v4u*)(Z + (size_t)row * NZ + ZC_RW + 3072 + k0), cur);
            if (t > 0) unpack8(*(const v4u*)(Z + (size_t)(row - 1) * NZ + ZC_RW + 3072 + k0), prv); else {
#pragma unroll
                for (int i = 0; i < 8; ++i) prv[i] = 0.f; }
#pragma unroll
            for (int i = 0; i < 8; ++i) { const float s = cur[i] + mu[3072 + k0 + i] * (prv[i] - cur[i]); o[i] = k0 < 64 ? tanhf(s) : (k0 < 128 ? s : sigmoidf_(s)); }
        } else if (l == 1 && k0 < 288) {
#pragma unroll
            for (int i = 0; i < 8; ++i) { const int j = k0 - 256 + i; const float cur = SD[(size_t)row * NSIDE + 8 + j], prv = t > 0 ? SD[(size_t)(row - 1) * NSIDE + 8 + j] : 0.f;
                o[i] = cur + F.in[F.z + I_MUV][j] * (prv - cur); }
        }
        *(v4u*)(LA + (size_t)row * KLORA + k0) = pack8(o);
    }
}

typedef short s16x4 __attribute__((ext_vector_type(4)));
DI bf16x8 tr8(const LAS unsigned char* p0, const LAS unsigned char* p1) {
    const s16x4 lo = __builtin_amdgcn_ds_read_tr16_b64_v4i16((LAS s16x4*)p0), hi = __builtin_amdgcn_ds_read_tr16_b64_v4i16((LAS s16x4*)p1);
    return (bf16x8){lo[0], lo[1], lo[2], lo[3], hi[0], hi[1], hi[2], hi[3]};
}
DI float wave_incl_sum(float v, int lane) {
#pragma unroll
    for (int o = 1; o < 64; o <<= 1) { const float t = __shfl_up(v, o); if (lane >= o) v += t; }
    return v;
}
DI float wave_incl_max(float v, int lane) {
#pragma unroll
    for (int o = 1; o < 64; o <<= 1) { const float t = __shfl_up(v, o); if (lane >= o) v = fmaxf(v, t); }
    return v;
}
#define WG_SYNC() do { asm volatile("s_waitcnt lgkmcnt(0)" ::: "memory"); __builtin_amdgcn_s_barrier(); asm volatile("" ::: "memory"); } while (0)
DI void scan_mlstm_mfma(const Ctx& F, int l, int unit) {
    constexpr int QP = 528, PP = 144, VP = 176, NE = 5;
    constexpr int O_QS = 0, O_KS = 33792, O_CB = 67584, O_PS = 109824, O_VS = 119040, O_GT = 130304;
    const int e4 = unit & 3, h = (unit >> 2) & 3, bl = unit >> 4;
    LAS unsigned char* Qs = F.lds + O_QS; LAS unsigned char* Ks = F.lds + O_KS; LAS unsigned char* Cb = F.lds + O_CB; LAS unsigned char* Ps = F.lds + O_PS; LAS unsigned char* Vs = F.lds + O_VS;
    LAS float* RT = (LAS float*)(F.lds + O_GT); LAS float* CS = RT + 64; LAS float* WI = RT + 128; LAS float* EM = RT + 192; LAS float* WS = RT + 256; LAS float* SC = RT + 320;
    const bf16* QKp = (const bf16*)(F.ws + WS_QK) + (size_t)bl * T * 2048 + h * 512;
    const bf16* Vp = (const bf16*)(F.ws + WS_Z) + (size_t)bl * T * NZ + ZC_MLX + h * 256 + e4 * 64;
    const float* SD = (const float*)(F.ws + WS_SIDE) + (size_t)bl * T * NSIDE;
    bf16* OUT = (bf16*)(F.ws + WS_RAW) + (size_t)bl * T * D + h * 256 + e4 * 64;
    const float ib = F.in[F.z + I_IB][l * 4 + h], fb = F.in[F.z + I_FB][l * 4 + h];
    const int tid = F.tid, lane = F.lane, w = F.wave, g = lane >> 4, r = lane & 15, q = r >> 2, p = lane & 3;
    const int srow = tid >> 3, scj = tid & 7, vrow = tid >> 3, vc = tid & 7;
    v4u pq[4], pk[4], pv; float pli = 0.f, plf = 0.f; float m_prev = 0.f;
    f32x4 C[2][NE];
#pragma unroll
    for (int a = 0; a < 2; ++a)
#pragma unroll
        for (int b = 0; b < NE; ++b) C[a][b] = (f32x4){0.f, 0.f, 0.f, 0.f};
    for (int i = tid; i < 42240 / 16; i += NTHREADS) *(LAS v4u*)(Cb + i * 16) = (v4u){0u, 0u, 0u, 0u};
    if (tid >= 256 && tid < 384) { const int rr = (tid - 256) >> 1, hh = tid & 1; unsigned one2 = 0x3F803F80u; asm volatile("" : "+v"(one2)); *(LAS v4u*)(Vs + rr * VP + 128 + hh * 16) = (v4u){one2, one2, one2, one2}; }
#define ML_LOAD(c) do { \
        _Pragma("unroll") for (int j = 0; j < 4; ++j) { pq[j] = *(const v4u*)(QKp + (size_t)((c) * 64 + srow) * 2048 + (scj + 8 * j) * 8); pk[j] = *(const v4u*)(QKp + (size_t)((c) * 64 + srow) * 2048 + 256 + (scj + 8 * j) * 8); } \
        pv = *(const v4u*)(Vp + (size_t)((c) * 64 + vrow) * NZ + vc * 8); \
        if (w == 0) { pli = SD[(size_t)((c) * 64 + lane) * NSIDE + h]; plf = SD[(size_t)((c) * 64 + lane) * NSIDE + 4 + h]; } } while (0)
#define ML_STORE() do { \
        _Pragma("unroll") for (int j = 0; j < 4; ++j) { *(LAS v4u*)(Qs + srow * QP + (scj + 8 * j) * 16) = pq[j]; *(LAS v4u*)(Ks + srow * QP + (scj + 8 * j) * 16) = pk[j]; } \
        *(LAS v4u*)(Vs + vrow * VP + vc * 16) = pv; \
        if (w == 0) { const float li = pli + ib, lf = -softplusf_(-(plf + fb)); const float bc = wave_incl_sum(lf, lane), cs = li - bc, pm = wave_incl_max(cs, lane), mx = fmaxf(m_prev, pm); \
            const float mx63 = __shfl(mx, 63), b63 = __shfl(bc, 63); \
            RT[lane] = -mx; CS[lane] = cs; WI[lane] = __expf(m_prev - mx); EM[lane] = __expf(-(bc + mx)); WS[lane] = __expf(cs - mx63); if (lane == 0) SC[0] = __expf(m_prev - mx63); m_prev = b63 + mx63; } } while (0)
    ML_LOAD(0); ML_STORE();
    WG_SYNC();
    const int tb = w >> 1, wh = w & 1;
    for (int c = 0; c < T / 64; ++c) {
        if (c + 1 < T / 64) ML_LOAD(c + 1);
#pragma unroll
        for (int si = 0; si < 2; ++si) {
            const int sb = wh * 2 + si; const int t = tb * 16 + r, s0 = sb * 16 + 4 * g;
            v2u pw = (v2u){0u, 0u};
            if (sb <= tb) {
                f32x4 acc = (f32x4){0.f, 0.f, 0.f, 0.f};
#pragma unroll
                for (int ks = 0; ks < 8; ++ks) { const bf16x8 a = *(const LAS bf16x8*)(Ks + (sb * 16 + r) * QP + (ks * 32 + 8 * g) * 2), b = *(const LAS bf16x8*)(Qs + (tb * 16 + r) * QP + (ks * 32 + 8 * g) * 2);
                    acc = __builtin_amdgcn_mfma_f32_16x16x32_bf16(a, b, acc, 0, 0, 0); }
                const float rt = RT[t]; const f32x4 cs4 = *(const LAS f32x4*)(CS + s0);
                float o[4];
#pragma unroll
                for (int i = 0; i < 4; ++i) o[i] = (s0 + i <= t) ? acc[i] * __expf(rt + cs4[i]) : 0.f;
                pw.x = pk2(o[0], o[1]); pw.y = pk2(o[2], o[3]);
            }
            *(LAS v2u*)(Ps + t * PP + s0 * 2) = pw;
        }
        { const float gm = SC[0];
#pragma unroll
            for (int a = 0; a < 2; ++a)
#pragma unroll
                for (int b = 0; b < NE; ++b) C[a][b] *= gm;
#pragma unroll
            for (int ks = 0; ks < 2; ++ks) {
                const f32x4 wsA = *(const LAS f32x4*)(WS + ks * 32 + 8 * g), wsB = *(const LAS f32x4*)(WS + ks * 32 + 8 * g + 4);
                bf16x8 bfr[NE], afr[2];
#pragma unroll
                for (int et = 0; et < NE; ++et) { const LAS unsigned char* pa = Vs + (ks * 32 + 8 * g + q) * VP + (et * 16 + 4 * p) * 2; const bf16x8 raw = tr8(pa, pa + 4 * VP);
                    const v4u rw = __builtin_bit_cast(v4u, raw); v4u sw;
                    sw.x = pk2(bflo(rw.x) * wsA[0], bfhi(rw.x) * wsA[1]); sw.y = pk2(bflo(rw.y) * wsA[2], bfhi(rw.y) * wsA[3]);
                    sw.z = pk2(bflo(rw.z) * wsB[0], bfhi(rw.z) * wsB[1]); sw.w = pk2(bflo(rw.w) * wsB[2], bfhi(rw.w) * wsB[3]);
                    bfr[et] = __builtin_bit_cast(bf16x8, sw); }
#pragma unroll
                for (int a = 0; a < 2; ++a) { const LAS unsigned char* pa = Ks + (ks * 32 + 8 * g + q) * QP + ((2 * w + a) * 16 + 4 * p) * 2; afr[a] = tr8(pa, pa + 4 * QP); }
#pragma unroll
                for (int a = 0; a < 2; ++a)
#pragma unroll
                    for (int et = 0; et < NE; ++et) C[a][et] = __builtin_amdgcn_mfma_f32_16x16x32_bf16(afr[a], bfr[et], C[a][et], 0, 0, 0);
            } }
        WG_SYNC();
        {
            f32x4 oi[3], oc[3];
#pragma unroll
            for (int j = 0; j < 3; ++j) { oi[j] = (f32x4){0.f, 0.f, 0.f, 0.f}; oc[j] = (f32x4){0.f, 0.f, 0.f, 0.f}; }
#pragma unroll
            for (int ks = 0; ks < 2; ++ks) { const bf16x8 a = *(const LAS bf16x8*)(Ps + (tb * 16 + r) * PP + (ks * 32 + 8 * g) * 2);
#pragma unroll
                for (int j = 0; j < 3; ++j) { const int et = j < 2 ? 2 * wh + j : 4; const LAS unsigned char* pa = Vs + (ks * 32 + 8 * g + q) * VP + (et * 16 + 4 * p) * 2;
                    oi[j] = __builtin_amdgcn_mfma_f32_16x16x32_bf16(a, tr8(pa, pa + 4 * VP), oi[j], 0, 0, 0); } }
#pragma unroll
            for (int ks = 0; ks < 8; ++ks) { const bf16x8 a = *(const LAS bf16x8*)(Qs + (tb * 16 + r) * QP + (ks * 32 + 8 * g) * 2);
#pragma unroll
                for (int j = 0; j < 3; ++j) { const int et = j < 2 ? 2 * wh + j : 4; const bf16x8 b = *(const LAS bf16x8*)(Cb + (et * 16 + r) * QP + (ks * 32 + 8 * g) * 2);
                    oc[j] = __builtin_amdgcn_mfma_f32_16x16x32_bf16(a, b, oc[j], 0, 0, 0); } }
            const f32x4 wi4 = *(const LAS f32x4*)(WI + tb * 16 + 4 * g), em4 = *(const LAS f32x4*)(EM + tb * 16 + 4 * g);
#pragma unroll
            for (int i = 0; i < 4; ++i) { const float den = oi[2][i] + wi4[i] * oc[2][i]; const float rd = 1.0f / fmaxf(fabsf(den), em4[i]);
#pragma unroll
                for (int j = 0; j < 2; ++j) OUT[(size_t)(c * 64 + tb * 16 + 4 * g + i) * D + (2 * wh + j) * 16 + r] = (bf16)f2bf((oi[j][i] + wi4[i] * oc[j][i]) * rd); }
        }
        WG_SYNC();
#pragma unroll
        for (int a = 0; a < 2; ++a)
#pragma unroll
            for (int et = 0; et < NE; ++et) { v2u cw; cw.x = pk2(C[a][et][0], C[a][et][1]); cw.y = pk2(C[a][et][2], C[a][et][3]);
                *(LAS v2u*)(Cb + (et * 16 + r) * QP + ((2 * w + a) * 16 + 4 * g) * 2) = cw; }
        if (c + 1 < T / 64) ML_STORE();
        WG_SYNC();
    }
#undef ML_LOAD
#undef ML_STORE
}


DI void scan_hgrn_mfma(const Ctx& F, int l, int unit) {
    constexpr int QP = 272, VP = 144, PP = 80;
    constexpr int O_QA = 0, O_KA = 8704, O_SB = 17408, O_V = 34816, O_P = 39424, O_QT = 41984, O_E15 = 44032, O_GM = 44544, O_HH = 45056;
    const int hf = unit & 1, h = (unit >> 1) & 7, bl = unit >> 4;
    LAS unsigned char* Qa = F.lds + O_QA; LAS unsigned char* Ka = F.lds + O_KA; LAS unsigned char* Sb = F.lds + O_SB; LAS unsigned char* Vs = F.lds + O_V; LAS unsigned char* Ps = F.lds + O_P;
    LAS float* QT = (LAS float*)(F.lds + O_QT); LAS float* E15 = (LAS float*)(F.lds + O_E15); LAS float* GM = (LAS float*)(F.lds + O_GM); LAS float* HH = (LAS float*)(F.lds + O_HH);
    const bf16* Zq = (const bf16*)(F.ws + WS_Z) + (size_t)bl * T * NZ + ZC_HGQ + h * 128;
    const bf16* Zf = (const bf16*)(F.ws + WS_Z) + (size_t)bl * T * NZ + ZC_HGF + h * 128;
    const bf16* Zv = (const bf16*)(F.ws + WS_Z) + (size_t)bl * T * NZ + ZC_HGI + h * 128 + hf * 64;
    bf16* OUT = (bf16*)(F.ws + WS_RAW) + (size_t)2 * MG * D + (size_t)bl * T * D + h * 128 + hf * 64;
    const int tid = F.tid, lane = F.lane, w = F.wave, g = lane >> 4, r = lane & 15, q = r >> 2, p = lane & 3;
    const int pd = tid & 127, tq = tid >> 7;
    const int vrow = tid >> 3, vc = tid & 7;
    bf16 rq[8], rf[8]; v4u pv;
    f32x4 S[4];
#pragma unroll
    for (int et = 0; et < 4; ++et) S[et] = (f32x4){0.f, 0.f, 0.f, 0.f};
#define HG_LOAD(c) do { _Pragma("unroll") for (int i = 0; i < 8; ++i) { rq[i] = Zq[(size_t)((c) * 32 + tq * 8 + i) * NZ + pd]; rf[i] = Zf[(size_t)((c) * 32 + tq * 8 + i) * NZ + pd]; } \
        if (tid < 256) pv = *(const v4u*)(Zv + (size_t)((c) * 32 + vrow) * NZ + vc * 8); } while (0)
    HG_LOAD(0);
    for (int c = 0; c < T / 32; ++c) {
        float qv[8], kv[8], cb[8]; float run = 0.f;
#pragma unroll
        for (int i = 0; i < 8; ++i) { qv[i] = bf1(rq[i]); const float lf = bf1(rf[i]); kv[i] = 1.0f - __expf(lf); run += lf; cb[i] = run; }
        QT[tq * 128 + pd] = run;
        if (tid < 256) *(LAS v4u*)(Vs + vrow * VP + vc * 16) = pv;
        if (c + 1 < T / 32) HG_LOAD(c + 1);
        WG_SYNC();
        { const float q0 = QT[pd], q1 = QT[128 + pd], q2 = QT[256 + pd], q3 = QT[384 + pd];
            const float off = (tq > 0 ? q0 : 0.f) + (tq > 1 ? q1 : 0.f) + (tq > 2 ? q2 : 0.f); const float b15 = q0 + q1, b31 = (q0 + q1) + (q2 + q3);
#pragma unroll
            for (int i = 0; i < 8; ++i) { const float bt = off + cb[i]; const float ea = __expf(fminf(bt - b15, 80.f)), ek = __expf(fminf(b15 - bt, 80.f));
                *(LAS bf16*)(Qa + (tq * 8 + i) * QP + pd * 2) = (bf16)f2bf(qv[i] * ea); *(LAS bf16*)(Ka + (tq * 8 + i) * QP + pd * 2) = (bf16)f2bf(kv[i] * ek); }
            if (tq == 0) { E15[pd] = __expf(b15); GM[pd] = __expf(b31); HH[pd] = __expf(b31 - b15); } }
        WG_SYNC();
        { const f32x4 e4 = *(const LAS f32x4*)(E15 + w * 16 + 4 * g), g4 = *(const LAS f32x4*)(GM + w * 16 + 4 * g), h4 = *(const LAS f32x4*)(HH + w * 16 + 4 * g);
            const LAS unsigned char* pa = Ka + (8 * g + q) * QP + (w * 16 + 4 * p) * 2; const bf16x8 afr = tr8(pa, pa + 4 * QP);
#pragma unroll
            for (int et = 0; et < 4; ++et) { v2u sw; sw.x = pk2(S[et][0] * e4[0], S[et][1] * e4[1]); sw.y = pk2(S[et][2] * e4[2], S[et][3] * e4[3]);
                *(LAS v2u*)(Sb + (et * 16 + r) * QP + (w * 16 + 4 * g) * 2) = sw;
                const LAS unsigned char* pb = Vs + (8 * g + q) * VP + (et * 16 + 4 * p) * 2;
                const f32x4 kvp = __builtin_amdgcn_mfma_f32_16x16x32_bf16(afr, tr8(pb, pb + 4 * VP), (f32x4){0.f, 0.f, 0.f, 0.f}, 0, 0, 0);
                S[et] = g4 * S[et] + h4 * kvp; } }
        if (w < 4) { const int sb = w >> 1, tb = (w & 1) ^ sb;
            const int t = tb * 16 + r, s0 = sb * 16 + 4 * g; v2u pw = (v2u){0u, 0u};
            if (sb <= tb) { f32x4 acc = (f32x4){0.f, 0.f, 0.f, 0.f};
#pragma unroll
                for (int ks = 0; ks < 4; ++ks) { const bf16x8 a = *(const LAS bf16x8*)(Ka + (sb * 16 + r) * QP + (ks * 32 + 8 * g) * 2), b = *(const LAS bf16x8*)(Qa + (tb * 16 + r) * QP + (ks * 32 + 8 * g) * 2);
                    acc = __builtin_amdgcn_mfma_f32_16x16x32_bf16(a, b, acc, 0, 0, 0); }
                pw.x = pk2(s0 + 0 <= t ? acc[0] : 0.f, s0 + 1 <= t ? acc[1] : 0.f); pw.y = pk2(s0 + 2 <= t ? acc[2] : 0.f, s0 + 3 <= t ? acc[3] : 0.f); }
            *(LAS v2u*)(Ps + t * PP + s0 * 2) = pw; }
        WG_SYNC();
        { const int tb = w >> 2, et = w & 3;
            const LAS unsigned char* pb = Vs + (8 * g + q) * VP + (et * 16 + 4 * p) * 2;
            f32x4 o = __builtin_amdgcn_mfma_f32_16x16x32_bf16(*(const LAS bf16x8*)(Ps + (tb * 16 + r) * PP + 8 * g * 2), tr8(pb, pb + 4 * VP), (f32x4){0.f, 0.f, 0.f, 0.f}, 0, 0, 0);
#pragma unroll
            for (int ks = 0; ks < 4; ++ks) { const bf16x8 a = *(const LAS bf16x8*)(Qa + (tb * 16 + r) * QP + (ks * 32 + 8 * g) * 2), b = *(const LAS bf16x8*)(Sb + (et * 16 + r) * QP + (ks * 32 + 8 * g) * 2);
                o = __builtin_amdgcn_mfma_f32_16x16x32_bf16(a, b, o, 0, 0, 0); }
#pragma unroll
            for (int i = 0; i < 4; ++i) OUT[(size_t)(c * 32 + tb * 16 + 4 * g + i) * D + et * 16 + r] = (bf16)f2bf(o[i]); }
        WG_SYNC();
    }
#undef HG_LOAD
}


DI void scan_rwkv_mfma3(const Ctx& F, int l, int g, int unit, bf16* OUTB, bool side_writes) {
    const int h = unit & 15, bl = unit >> 4;
    constexpr int PI = 144, PA = 80, PB = 48, IMGB = 19968, NBUF = 6;
    constexpr int O_IMG = 0, O_WL = NBUF * IMGB, O_STI = O_WL + NBUF * 256, O_RB = O_STI + 9216  , O_AKB = O_RB + 4 * 1536  , O_STG = O_AKB + 2 * 1024  , O_BS = O_STG + 4 * 4480  , O_S2 = O_BS + 2 * 64  , O_END = O_S2 + 2 * 64;
    static_assert(O_END <= MISC_OFF, "rwkv LDS map");
    LAS unsigned char* STI = F.lds + O_STI;
    const bf16* Z = (const bf16*)(F.ws + WS_Z); const bf16* LO = (const bf16*)(F.ws + WS_LO); bf16* VF = (bf16*)(F.ws + WS_VF); bf16* BON = (bf16*)(F.ws + WS_BON);
    bf16* OUT = OUTB + (size_t)bl * T * D + h * 64;
    const int tid = F.tid, lane = F.lane, w = F.wave, gq = lane >> 4, r = lane & 15, q = r >> 2, p = lane & 3;
    constexpr int NCH = T / 16, NPER = NCH + 5;
    for (int i = tid; i < O_END / 4; i += NTHREADS) ((LAS unsigned*)F.lds)[i] = 0u;
    WG_SYNC();
    if (w >= 4) {
        const int pw = w - 4, gc = h * 64 + lane;
        const float mu_r = F.in[F.z + I_MU][l * 3328 + gc], mu_k = F.in[F.z + I_MU][l * 3328 + 1024 + gc], mu_v = F.in[F.z + I_MU][l * 3328 + 2048 + gc];
        const float kkc = F.in[F.z + I_KK][l * D + gc], kac = F.in[F.z + I_KA][l * D + gc];
        float rz[4][3], rl[4][2], rv[4][2], rp[3]; float cum = 0.f;
#pragma unroll
        for (int j = 0; j < 4; ++j) { rz[j][0] = rz[j][1] = rz[j][2] = 0.f; rl[j][0] = rl[j][1] = 0.f; rv[j][0] = rv[j][1] = 0.f; }
        rp[0] = rp[1] = rp[2] = 0.f;
#define RW_LD16(dst, eoff) asm volatile("ds_read_u16_d16_hi %0, %1 offset:%2" : "+v"(dst) : "v"(sga_), "i"((eoff) * 2))
        LAS unsigned char* STG = F.lds + O_STG + pw * 4480;
#define RW_DMA(t0_) do { if (lane < 40) { const int row_ = lane >> 3, cb_ = lane & 7; const size_t lrow0_ = (size_t)bl * T + (t0_); \
            const size_t zrow_ = ((t0_) > 0 ? lrow0_ - 1 : lrow0_) + ((t0_) > 0 ? row_ : (row_ > 0 ? row_ - 1 : 0)); const size_t lrow_ = lrow0_ + (row_ < 3 ? row_ : 3); \
            const bf16* zp_ = Z + zrow_ * NZ + ZC_RW + h * 64 + cb_ * 8; const bf16* lp_ = LO + lrow_ * NLORA + h * 64 + cb_ * 8; \
            __builtin_amdgcn_global_load_lds((const unsigned*)zp_, (LAS unsigned*)(STG), 16, 0, 0); \
            __builtin_amdgcn_global_load_lds((const unsigned*)(zp_ + 1024), (LAS unsigned*)(STG + 640), 16, 0, 0); \
            __builtin_amdgcn_global_load_lds((const unsigned*)(zp_ + 2048), (LAS unsigned*)(STG + 1280), 16, 0, 0); \
            __builtin_amdgcn_global_load_lds((const unsigned*)lp_, (LAS unsigned*)(STG + 1920), 16, 0, 0); \
            __builtin_amdgcn_global_load_lds((const unsigned*)(lp_ + 1024), (LAS unsigned*)(STG + 2560), 16, 0, 0); \
            if (l == 1) { __builtin_amdgcn_global_load_lds((const unsigned*)(lp_ + 3072), (LAS unsigned*)(STG + 3200), 16, 0, 0); \
                __builtin_amdgcn_global_load_lds((const unsigned*)(VF + ((size_t)g * MG + lrow_) * D + h * 64 + cb_ * 8), (LAS unsigned*)(STG + 3840), 16, 0, 0); } } } while (0)
#define RW_READ(t0_) do { asm volatile("s_waitcnt vmcnt(0)" ::: "memory"); const unsigned sga_ = (unsigned)(unsigned long)(STG) + (unsigned)lane * 2u; \
        RW_LD16(rp[0], 0); RW_LD16(rp[1], 320); RW_LD16(rp[2], 640); \
        _Pragma("unroll") for (int j = 0; j < 4; ++j) { RW_LD16(rz[j][0], (j + 1) * 64); RW_LD16(rz[j][1], 320 + (j + 1) * 64); RW_LD16(rz[j][2], 640 + (j + 1) * 64); \
            RW_LD16(rl[j][0], 960 + j * 64); RW_LD16(rl[j][1], 1280 + j * 64); if (l == 1) { RW_LD16(rv[j][0], 1600 + j * 64); RW_LD16(rv[j][1], 1920 + j * 64); } } \
        asm volatile("s_waitcnt lgkmcnt(0)" ::: "memory"); if (!((t0_) > 0)) { rp[0] = 0.f; rp[1] = 0.f; rp[2] = 0.f; } } while (0)
        { const int k0 = pw; if (k0 < NCH) RW_DMA(k0 * 16); }
        const bf16* zpB; const bf16* lpB; const bf16* vfB;
        { const int row_ = lane >> 3, cb_ = lane & 7; const size_t t1_ = (size_t)bl * T + pw * 16 + 4;
          zpB = Z + (t1_ - 1 + row_) * NZ + ZC_RW + h * 64 + cb_ * 8 + 1024; lpB = LO + (t1_ + (row_ < 3 ? row_ : 3)) * NLORA + h * 64 + cb_ * 8;
          vfB = VF + ((size_t)g * MG + t1_ + (row_ < 3 ? row_ : 3)) * D + h * 64 + cb_ * 8; }
#define RW_DMA2() do { if (lane < 40) { \
            __builtin_amdgcn_global_load_lds((const unsigned*)(zpB - 1024), (LAS unsigned*)(STG), 16, 0, 0); \
            __builtin_amdgcn_global_load_lds((const unsigned*)zpB, (LAS unsigned*)(STG + 640), 16, 0, 0); \
            __builtin_amdgcn_global_load_lds((const unsigned*)(zpB + 1024), (LAS unsigned*)(STG + 1280), 16, 0, 0); \
            __builtin_amdgcn_global_load_lds((const unsigned*)lpB, (LAS unsigned*)(STG + 1920), 16, 0, 0); \
            __builtin_amdgcn_global_load_lds((const unsigned*)(lpB + 1024), (LAS unsigned*)(STG + 2560), 16, 0, 0); \
            if (l == 1) { __builtin_amdgcn_global_load_lds((const unsigned*)(lpB + 3072), (LAS unsigned*)(STG + 3200), 16, 0, 0); \
                __builtin_amdgcn_global_load_lds((const unsigned*)vfB, (LAS unsigned*)(STG + 3840), 16, 0, 0); } } } while (0)
        for (int k = 0; k < NPER; ++k) {
            const int qq = (k - pw) & 3, c = k - qq;
            if (k >= pw && c < NCH) {
                LAS unsigned char* RT = F.lds + O_IMG + (c % NBUF) * IMGB; LAS unsigned char* KT = RT + 2304; LAS unsigned char* KB = RT + 4608; LAS unsigned char* VU = RT + 9216;
                const size_t lrow0 = (size_t)bl * T + c * 16 + qq * 4;
                RW_READ(c * 16 + qq * 4);
                { const int tn = (qq < 3) ? c * 16 + (qq + 1) * 4 : (c + 4) * 16; if (tn < T) RW_DMA2();
                  const int adv = qq == 2 ? 52 : 4; zpB += (size_t)adv * NZ; lpB += (size_t)adv * NLORA; vfB += (size_t)adv * D; }
                if (qq == 0) cum = 0.f;
                float pr = rp[0], pk = rp[1], pv = rp[2];
#pragma unroll
                for (int j = 0; j < 4; ++j) { const size_t lrow = lrow0 + j; const int t = qq * 4 + j;
                    const float zr = rz[j][0], zk = rz[j][1], zv = rz[j][2];
                    const float rr = zr + mu_r * (pr - zr), kx = zk + mu_k * (pk - zk); float v = zv + mu_v * (pv - zv);
                    pr = zr; pk = zk; pv = zv;
                    const float lw = rl[j][0]; const float a = rl[j][1];
                    if (l != 0) { const float vf = rv[j][1]; v = v + (vf - v) * rv[j][0]; }
                    const float kk = kx * kkc;
                    const float kp = kx * (1.0f + (a - 1.0f) * kac);
                    const float wp = __expf(cum); cum += lw; const float wt = __expf(cum), iw = __expf(-cum);
                    const unsigned c1 = pk2(rr * wt, kk * wp), c2 = pk2(kp * iw, kk * a * iw), c3 = pk2(v, kk);
                    *(LAS bf16*)(RT + t * PI + lane * 2) = (bf16)c1; *(LAS bf16*)(KT + t * PI + lane * 2) = (bf16)(c1 >> 16);
                    *(LAS bf16*)(KB + t * PI + lane * 2) = (bf16)c2; *(LAS bf16*)(KB + (16 + t) * PI + lane * 2) = (bf16)(c2 >> 16);
                    *(LAS bf16*)(VU + t * PI + lane * 2) = (bf16)c3; *(LAS bf16*)(RT + 17664 + t * PI + lane * 2) = (bf16)(c3 >> 16);
                    if (t == 15) ((LAS float*)(F.lds + O_WL))[(c % NBUF) * 64 + lane] = wt; }
            }
            WG_SYNC();
        }
#undef RW_DMA
#undef RW_DMA2
#undef RW_READ
#undef RW_LD16
    } else if (w >= 2) {
        LAS float* AKB = (LAS float*)(F.lds + O_AKB) + (w - 2) * 256;
        LAS float* BSv = (LAS float*)(F.lds + O_BS) + (w - 2) * 16;
        LAS float* S2v = (LAS float*)(F.lds + O_S2) + (w - 2) * 16;
        float rkc[2][8];
#pragma unroll
        for (int ks = 0; ks < 2; ++ks)
#pragma unroll
            for (int e = 0; e < 8; ++e) rkc[ks][e] = F.in[F.z + I_RK][l * D + h * 64 + ks * 32 + 8 * gq + e];
        for (int k = 0; k < NPER; ++k) {
            const int c = k - 4;
            if (c >= 0 && c < NCH && (c & 1) == (w - 2)) {
                LAS unsigned char* RT = F.lds + O_IMG + (c % NBUF) * IMGB; const LAS unsigned char* KT = RT + 2304; const LAS unsigned char* KB = RT + 4608;
                LAS unsigned char* AR = RT + 13824; LAS unsigned char* AY = AR + 1280; LAS unsigned char* TI = AR + 2560;
                float s2t;
                { f32x4 accn = (f32x4){0.f, 0.f, 0.f, 0.f};
#pragma unroll
                    for (int ks = 0; ks < 2; ++ks) { const bf16x8 f = *(const LAS bf16x8*)(RT + 17664 + r * PI + (ks * 32 + 8 * gq) * 2); accn = __builtin_amdgcn_mfma_f32_16x16x32_bf16(f, f, accn, 0, 0, 0); }
                    const int jd = r & 3; const float dn = jd == 0 ? accn[0] : (jd == 1 ? accn[1] : (jd == 2 ? accn[2] : accn[3]));
                    if ((r >> 2) == gq) S2v[r] = __builtin_amdgcn_rcpf(fmaxf(dn, 1e-24f));
                    asm volatile("" ::: "memory");
                    s2t = S2v[r]; }
#pragma unroll
                for (int m = 0; m < 4; ++m) { f32x4 acc = (f32x4){0.f, 0.f, 0.f, 0.f};
                    const LAS unsigned char* ia = KB + ((m & 1) * 16 + r) * PI; const LAS unsigned char* ib_ = (m < 2 ? KT : (const LAS unsigned char*)RT) + r * PI;
#pragma unroll
                    for (int ks = 0; ks < 2; ++ks) acc = __builtin_amdgcn_mfma_f32_16x16x32_bf16(*(const LAS bf16x8*)(ia + (ks * 32 + 8 * gq) * 2), *(const LAS bf16x8*)(ib_ + (ks * 32 + 8 * gq) * 2), acc, 0, 0, 0);
                    const int t = r, i0 = 4 * gq; float o[4];
#pragma unroll
                    for (int j = 0; j < 4; ++j) o[j] = (m < 2 ? (i0 + j < t) : (i0 + j <= t)) ? acc[j] : 0.f;
                    if (m == 1) {
#pragma unroll
                        for (int j = 0; j < 4; ++j) AKB[(i0 + j) * 16 + t] = o[j] * s2t; }
                    else { v2u pw2; pw2.x = pk2(o[0], o[1]); pw2.y = pk2(o[2], o[3]); *(LAS v2u*)((m == 0 ? AR : AY) + t * PA + ((m == 3 ? 16 : 0) + i0) * 2) = pw2; } }
                asm volatile("" ::: "memory");
                if (lane < 16) { float u[16];
#pragma unroll
                    for (int t = 0; t < 16; ++t) u[t] = (t == lane) ? s2t : 0.f;
                    f32x4 col[15][4];
#pragma unroll
                    for (int i = 0; i < 15; ++i)
#pragma unroll
                        for (int t4 = 0; t4 < 4; ++t4) if (t4 * 4 + 3 > i) col[i][t4] = *(const LAS f32x4*)(AKB + i * 16 + t4 * 4);
                    asm volatile("s_waitcnt lgkmcnt(0)" ::: "memory");
#pragma unroll
                    for (int i = 0; i < 15; ++i) {
#pragma unroll
                        for (int t = i + 1; t < 16; ++t) u[t] -= col[i][t >> 2][t & 3] * u[i]; }
#pragma unroll
                    for (int t = 0; t < 16; ++t) *(LAS bf16*)(TI + t * PA + lane * 2) = (bf16)f2bf(u[t]); }
            }
            else { const int c2 = k - 5;
              if (c2 >= 0 && c2 < NCH && (c2 & 1) == (w - 2)) { const LAS unsigned char* RT = F.lds + O_IMG + (c2 % NBUF) * IMGB; const LAS unsigned char* KB = RT + 4608;
                if (side_writes) { f32x4 accd = (f32x4){0.f, 0.f, 0.f, 0.f};
#pragma unroll
                    for (int ks = 0; ks < 2; ++ks) { float o[8]; unpack8(*(const LAS v4u*)(RT + r * PI + (ks * 32 + 8 * gq) * 2), o);
#pragma unroll
                        for (int e = 0; e < 8; ++e) o[e] *= rkc[ks][e];
                        accd = __builtin_amdgcn_mfma_f32_16x16x32_bf16(*(const LAS bf16x8*)(KB + r * PI + (ks * 32 + 8 * gq) * 2), __builtin_bit_cast(bf16x8, pack8(o)), accd, 0, 0, 0); }
                    const int jd = r & 3; const float dv = jd == 0 ? accd[0] : (jd == 1 ? accd[1] : (jd == 2 ? accd[2] : accd[3]));
                    if ((r >> 2) == gq) BSv[r] = dv;
                    asm volatile("" ::: "memory");
                    const LAS unsigned char* VUi = RT + 9216;
#pragma unroll
                    for (int hh = 0; hh < 2; ++hh) { const int t = hh * 8 + (lane >> 3); float o[8]; const v4u vw = *(const LAS v4u*)(VUi + t * PI + (lane & 7) * 16); unpack8(vw, o); const float bs = BSv[t];
                        if (l == 0) *(v4u*)(VF + ((size_t)g * MG + (size_t)bl * T + c2 * 16 + t) * D + h * 64 + (lane & 7) * 8) = vw;
#pragma unroll
                        for (int e = 0; e < 8; ++e) o[e] *= bs;
                        *(v4u*)(BON + ((size_t)bl * T + c2 * 16 + t) * D + h * 64 + (lane & 7) * 8) = pack8(o); } }
              } }
            WG_SYNC();
        }
    } else {
        f32x4 S[2][4];
#pragma unroll
        for (int a = 0; a < 2; ++a)
#pragma unroll
            for (int i = 0; i < 4; ++i) S[a][i] = (f32x4){0.f, 0.f, 0.f, 0.f};
        for (int k = 0; k < NPER; ++k) {
            const int c = k - 5;
            if (c >= 0) {
                const LAS unsigned char* RT = F.lds + O_IMG + (c % NBUF) * IMGB; const LAS unsigned char* KT = RT + 2304; const LAS unsigned char* KB = RT + 4608; LAS unsigned char* VU = F.lds + O_IMG + (c % NBUF) * IMGB + 9216;
                const LAS unsigned char* AR = RT + 13824; const LAS unsigned char* AY = AR + 1280; const LAS unsigned char* TI = AR + 2560;
                const LAS float* WL = (const LAS float*)(F.lds + O_WL) + (c % NBUF) * 64;
                f32x4 accG[2], accR[2];
                const v2u tfr = *(const LAS v2u*)(TI + r * PA + 4 * gq * 2);
                const v2u ay0 = *(const LAS v2u*)(AY + r * PA + 4 * gq * 2), ay1 = *(const LAS v2u*)(AY + r * PA + (16 + 4 * gq) * 2);
                const bf16x8 tA = __builtin_bit_cast(bf16x8, (v4u){tfr.x, tfr.y, 0u, 0u}), yA = __builtin_bit_cast(bf16x8, (v4u){ay0.x, ay0.y, ay1.x, ay1.y});
#pragma unroll
                for (int a = 0; a < 2; ++a) { const int vt = 2 * w + a;
                    accG[a] = (f32x4){0.f, 0.f, 0.f, 0.f}; accR[a] = accG[a];
#pragma unroll
                    for (int ks = 0; ks < 2; ++ks) { const LAS unsigned char* pb = STI + (ks * 32 + 8 * gq + q) * PI + (vt * 16 + 4 * p) * 2; const bf16x8 bfr = tr8(pb, pb + 4 * PI);
                        accG[a] = __builtin_amdgcn_mfma_f32_16x16x32_bf16(*(const LAS bf16x8*)(KT + r * PI + (ks * 32 + 8 * gq) * 2), bfr, accG[a], 0, 0, 0);
                        accR[a] = __builtin_amdgcn_mfma_f32_16x16x32_bf16(*(const LAS bf16x8*)(RT + r * PI + (ks * 32 + 8 * gq) * 2), bfr, accR[a], 0, 0, 0); }
                    { const LAS unsigned char* pb = VU + (8 * gq + q) * PI + (vt * 16 + 4 * p) * 2;
                        accG[a] = __builtin_amdgcn_mfma_f32_16x16x32_bf16(*(const LAS bf16x8*)(AR + r * PA + 8 * gq * 2), tr8(pb, pb + 4 * PI), accG[a], 0, 0, 0); } }
                f32x4 accU[2];
#pragma unroll
                for (int a = 0; a < 2; ++a) {
                    const bf16x8 rB = __builtin_bit_cast(bf16x8, (v4u){pk2(accG[a][0], accG[a][1]), pk2(accG[a][2], accG[a][3]), 0u, 0u});
                    accU[a] = __builtin_amdgcn_mfma_f32_16x16x32_bf16(tA, rB, (f32x4){0.f, 0.f, 0.f, 0.f}, 0, 0, 0); }
#pragma unroll
                for (int a = 0; a < 2; ++a) { const int vt = 2 * w + a;
                    const s16x4 vlo = __builtin_amdgcn_ds_read_tr16_b64_v4i16((LAS s16x4*)(VU + (4 * gq + q) * PI + (vt * 16 + 4 * p) * 2));
                    const v2u vw = __builtin_bit_cast(v2u, vlo);
                    const bf16x8 vfr = __builtin_bit_cast(bf16x8, (v4u){vw.x, vw.y, pk2(-accU[a][0], -accU[a][1]), pk2(-accU[a][2], -accU[a][3])});
                    accR[a] = __builtin_amdgcn_mfma_f32_16x16x32_bf16(yA, vfr, accR[a], 0, 0, 0);
#pragma unroll
                    for (int j = 0; j < 4; ++j) OUT[(size_t)(c * 16 + 4 * gq + j) * D + vt * 16 + r] = (bf16)f2bf(accR[a][j]);
#pragma unroll
                    for (int kt = 0; kt < 4; ++kt) { const LAS unsigned char* pk_ = KB + (4 * gq + q) * PI + (kt * 16 + 4 * p) * 2;
                        S[a][kt] = __builtin_amdgcn_mfma_f32_16x16x32_bf16(vfr, tr8(pk_, pk_ + 16 * PI), S[a][kt], 0, 0, 0);
                        S[a][kt] *= WL[kt * 16 + r];
                        v2u sw; sw.x = pk2(S[a][kt][0], S[a][kt][1]); sw.y = pk2(S[a][kt][2], S[a][kt][3]);
                        *(LAS v2u*)(STI + (kt * 16 + r) * PI + (vt * 16 + 4 * gq) * 2) = sw; } }
            }
            WG_SYNC();
        }
    }
    WG_SYNC();
}

DI void phase_post(const Ctx& F, int l) {
    const int gw = F.bid * NWAVES + F.wave, NGW = F.G * NWAVES;
    const bf16* Z = (const bf16*)(F.ws + WS_Z); const bf16* XC = (const bf16*)(F.ws + WS_XC); const bf16* LO = (const bf16*)(F.ws + WS_LO); const bf16* BON = (const bf16*)(F.ws + WS_BON);
    bf16* RAW = (bf16*)(F.ws + WS_RAW);
    const int c0 = F.lane * 16;
    for (int row = gw; row < MG; row += NGW) {
        float a[16], b[16], c[16];
        { bf16* rp = RAW + (size_t)row * D + c0;
            unpack16(rp, a);
            unpack16(Z + (size_t)row * NZ + ZC_MLO + c0, b);
            unpack16(XC + (size_t)row * D + c0, c);
            float s = 0.f;
#pragma unroll
            for (int i = 0; i < 16; ++i) { a[i] *= sigmoidf_(b[i]); s += a[i]; }
            const float mean = sum16(s) * (1.f / 256.f); float q = 0.f;
#pragma unroll
            for (int i = 0; i < 16; ++i) { a[i] -= mean; q += a[i] * a[i]; }
            const float rstd = 1.0f / sqrtf(sum16(q) * (1.f / 256.f) + 1e-6f);
#pragma unroll
            for (int i = 0; i < 16; ++i) a[i] = a[i] * rstd * F.in[F.z + I_MLNW][l * D + c0 + i] + F.in[F.z + I_MLSKIP][l * D + c0 + i] * c[i];
            pack16(rp, a); }
        { bf16* rp = RAW + (size_t)(MG + row) * D + c0;
            unpack16(rp, a);

            unpack16(BON + (size_t)row * D + c0, b);
            unpack16(LO + (size_t)row * NLORA + 2048 + c0, c);
            float s = 0.f;
#pragma unroll
            for (int i = 0; i < 16; ++i) s += a[i];
            const float mean = sum4(s) * (1.f / 64.f); float q = 0.f;
#pragma unroll
            for (int i = 0; i < 16; ++i) { a[i] -= mean; q += a[i] * a[i]; }
            const float rstd = 1.0f / sqrtf(sum4(q) * (1.f / 64.f) + 64e-5f);
#pragma unroll
            for (int i = 0; i < 16; ++i) a[i] = (a[i] * rstd * F.in[F.z + I_LNW][l * D + c0 + i] + F.in[F.z + I_LNB][l * D + c0 + i] + b[i]) * c[i];
            pack16(rp, a); }
        { bf16* rp = RAW + (size_t)(2 * MG + row) * D + c0;
            unpack16(rp, a);
            unpack16(Z + (size_t)row * NZ + ZC_HGG + c0, b);
            float q = 0.f;
#pragma unroll
            for (int i = 0; i < 16; ++i) q += a[i] * a[i];
            const float rstd = 1.0f / sqrtf(sum8(q) * (1.f / 128.f) + 1e-6f);
#pragma unroll
            for (int i = 0; i < 16; ++i) a[i] = a[i] * rstd * F.in[F.z + I_HGNW][l * D + c0 + i] * sigmoidf_(b[i]);
            pack16(rp, a); }
    }
}

enum { PH_W = 0, PH_A1, PH_A2, PH_A3, PH_B1, PH_B2, PH_B3, PH_B4, PH_B5, PH_B6, PH_B7, PH_B8, PH_FIN, PH_N };

__global__ void __launch_bounds__(NTHREADS, 2) fwd_kernel(Args args) {
    extern __shared__ __attribute__((aligned(16))) unsigned char lds_raw[];
    Ctx F;
    F.lds = (LAS unsigned char*)lds_raw; F.in = args.in; F.out = args.out; F.ws = args.ws;
    F.z = 0; F.tid = threadIdx.x; F.lane = F.tid & 63; F.wave = __builtin_amdgcn_readfirstlane(F.tid >> 6); F.bid = blockIdx.x; F.G = gridDim.x;
    volatile LAS unsigned* MISC = (volatile LAS unsigned*)(F.lds + MISC_OFF);
    if (F.tid < 32) MISC[F.tid] = 0u;
    __syncthreads();
    XcdBarrier bar; bar.bar = (unsigned*)(F.ws + WS_CTL) + CW_BAR; bar.x = 0; bar.st = nullptr;
    if (args.use_bar) bar = xcd_barrier_post((unsigned*)(F.ws + WS_CTL) + CW_BAR, MISC + 8);
#ifndef PHMASK
#define PHMASK 0xFFFF
#endif
#define IN(k) (((PHMASK >> (k)) & 1) && args.ph_lo <= (k) && (k) < args.ph_hi)
#ifndef REPEAT_PH
#define REPEAT_PH -1
#endif
#define PHASE(k) if (IN(k)) for (int rep_ = 0; rep_ < ((k) == REPEAT_PH ? 2 : 1); ++rep_) if (refresh(F), true)
#define SEAM() do { if (args.use_bar) xcd_barrier(bar); } while (0)
    const float* MOD = (const float*)(F.ws + WS_MOD);
    for (int f = args.f_lo; f < args.f_hi; ++f) {
        const int l = f >> 1, fi = f & 1;
        const float* modl = MOD + (size_t)l * NB * NMOD;
        if (fi == 0) PHASE(PH_W) { phase_weights(F, l); if (l == 0) { __syncthreads(); phase_mod(F); SEAM(); } else __syncthreads(); }
        const int sub = fi ? 2 : 0;
        const float* xsrc = (f == 0) ? F.in[F.z + I_X] : F.out;
        PHASE(PH_A1) { phase_modulate<false>(F, xsrc, (bf16*)(F.ws + WS_H), F.in[F.z + I_NORMW] + (size_t)(l * 3 + sub) * D, modl, sub, 0, M, nullptr, 0, F.bid, F.G); SEAM(); }
        PHASE(PH_A2) {
            pg8::Gemm gm{(const bf16*)(F.ws + WS_H), (const bf16*)(F.ws + WS_WUP) + (size_t)fi * NUP * D, D, D, D, 0, 0};
            pg8::Order<0> S; S.init(M / 256, NUP / 256, F.G, F.bid);
            pg8::EpiSwiGLU E{(bf16*)(F.ws + WS_HID), DFF};
            pg8::gemm_phase(F.lds, gm, S, E, F.tid); SEAM(); }
        PHASE(PH_A3) {
            pg8::Gemm gm{(const bf16*)(F.ws + WS_HID), (const bf16*)(F.ws + WS_WDN) + (size_t)fi * D * DFF, DFF, DFF, DFF, 0, 0};
            pg8::Order<0> S; S.init(M / 256, D / 256, F.G, F.bid);
            pg8::EpiResid E{xsrc, F.out, modl + (sub * 3 + 2) * D, 0.5f, 0};
            pg8::gemm_phase(F.lds, gm, S, E, F.tid); SEAM(); }
        if (fi == 0) {
            for (int g = args.g_lo; g < args.g_hi; ++g) {
                float* xg = F.out + (size_t)g * MG * D;
                const bool fuse_b1 = args.use_bar && F.G == 256 && args.ph_lo <= PH_B1 && args.ph_hi > PH_B8;
                if (!(fuse_b1 && g > args.g_lo)) PHASE(PH_B1) { phase_modulate<true>(F, F.out, (bf16*)(F.ws + WS_HG), F.in[F.z + I_NORMW] + (size_t)(l * 3 + 1) * D, modl, 1, g * MG, MG, (float*)(F.ws + WS_SIDE), l == 0 ? 8 : NSIDE, F.bid, F.G); SEAM(); }
                PHASE(PH_B2) {
                    pg8::Gemm gm{(const bf16*)(F.ws + WS_HG), (const bf16*)(F.ws + WS_WIN), D, D, D, 0, 0};
                    pg8::EpiZ E{(bf16*)(F.ws + WS_Z), NZ, l == 0 ? nullptr : F.in[F.z + I_LBL]};
                    if (F.G == 256) { pg8::OrderEq4 S{F.bid}; pg8::gemm_phase(F.lds, gm, S, E, F.tid); }
                    else { pg8::Order<0> S; S.init(MG / 256, NZE / 256, F.G, F.bid); pg8::gemm_phase(F.lds, gm, S, E, F.tid); }
                    SEAM(); }
                PHASE(PH_B3) { phase_prep(F, l); SEAM(); }
                PHASE(PH_B4) {
                    { pg8::Gemm gm{(const bf16*)(F.ws + WS_XC), (const bf16*)(F.ws + WS_WQK), 256, D, 256, 256, (size_t)512 * 256};
                      pg8::Order<1> S; S.init(MG / 256, 8, F.G, F.bid);
                      pg8::EpiBf16 E{(bf16*)(F.ws + WS_QK), 2048, 512};
                      pg8::gemm_phase(F.lds, gm, S, E, F.tid); }
                    __syncthreads();
                    { pg8::Gemm gm{(const bf16*)(F.ws + WS_LA), (const bf16*)(F.ws + WS_WLORA), l == 0 ? 256 : 384, KLORA, KLORA, 0, 0};
                      pg8::Order<0> S; S.init(MG / 256, l == 0 ? 12 : 16, F.G, F.bid);
                      pg8::EpiLora E{(bf16*)(F.ws + WS_LO), NLORA, F.in[F.z + I_W0] + (size_t)l * D, F.in[F.z + I_A0] + (size_t)l * D, F.in[F.z + I_V0]};
                      pg8::gemm_phase(F.lds, gm, S, E, F.tid); }
                    SEAM(); }
                PHASE(PH_B5) {
                    { unsigned* hgdone = (unsigned*)(F.ws + WS_CTL) + CW_HGDONE + 64 * (l * NGRP + g);
                      const bool g256 = F.G == 256;
                      const int cls = !g256 ? 4 : (F.bid >> 6);
                      unsigned nhg = 0;
                      for (int i = g256 ? (cls == 0 ? F.bid : 64) : F.bid; i < 64; i += g256 ? 64 : F.G) { const int u_ = g256 ? ((((i & 7) * 4 + (i >> 4)) << 1) | ((i >> 3) & 1)) : i; scan_hgrn_mfma(F, l, u_); nhg += 2; }
                      if (nhg && F.tid == 0) __hip_atomic_fetch_add(hgdone, nhg, __ATOMIC_RELAXED, __HIP_MEMORY_SCOPE_AGENT);
                      for (int i = g256 ? (cls == 1 ? F.bid - 64 : 64) : F.bid; i < 64; i += g256 ? 64 : F.G) { const int u_ = g256 ? ((((i & 7) * 2 + (i >> 5)) << 2) | ((i >> 3) & 3)) : i; scan_mlstm_mfma(F, l, u_); }
                      for (int i = g256 ? (cls == 3 ? F.bid - 192 : 64) : F.bid; i < 64; i += g256 ? 64 : F.G) scan_rwkv_mfma3(F, l, g, i, (bf16*)(F.ws + WS_RAW) + (size_t)MG * D, true);
                      if (cls == 2 || cls == 4) {
                          const int nl2 = g256 ? 3 : 0;
                          pg8::Gemm gm{(const bf16*)(F.ws + WS_HG), (const bf16*)(F.ws + WS_WIN) + (size_t)(NZE + nl2 * 256) * D, D, D, D, 0, 0};
                          pg8::Order<0> S; S.init(MG / 256, 12 - nl2, g256 ? 64 : F.G, g256 ? F.bid - 128 : F.bid);
                          pg8::EpiBf16Split E{(bf16*)(F.ws + WS_Z) + ZC_MLO + nl2 * 256, NZ, (bf16*)(F.ws + WS_GB0), D, 8 - nl2};
                          pg8::gemm_phase(F.lds, gm, S, E, F.tid); __syncthreads(); }
                      {
                          if (F.tid == 0) { unsigned sp = 0; while (__hip_atomic_load(hgdone, __ATOMIC_RELAXED, __HIP_MEMORY_SCOPE_AGENT) < 128u) { __builtin_amdgcn_s_sleep(4); if (++sp > (1u << 22)) break; } }
                          __syncthreads();
                          pg8::Gemm gm{(const bf16*)(F.ws + WS_HG), (const bf16*)(F.ws + WS_WIN) + (size_t)(NZ + 1024) * D, D, D, D, 0, 0};
                          pg8::Order<0> S; S.init(MG / 256, 8, F.G, F.bid);
                          if (g256) { S.G = 64; S.c = F.bid & 63;
                                      if (cls == 0) { S.L0 = 0; S.imax = 2; }
                                      else if (cls == 2) { S.L0 = 128; S.imax = 2; }
                                      else S.imax = 0; }
                          pg8::EpiBf16 E{(bf16*)(F.ws + WS_Z) + ZC_GATE, NZ, 0};
                          pg8::gemm_phase(F.lds, gm, S, E, F.tid); } }
                    SEAM(); }
                PHASE(PH_B6) { phase_post(F, l); SEAM(); }
                PHASE(PH_B7) {
                    pg8::Gemm gm{(const bf16*)(F.ws + WS_RAW), (const bf16*)(F.ws + WS_WBR), D, D, D, (size_t)MG * D, (size_t)D * D};
                    pg8::Order<2> S; S.init(MG / 128, 4, F.G, F.bid);
                    pg8::EpiBranch E{(const bf16*)(F.ws + WS_Z) + ZC_GATE, NZ, (bf16*)(F.ws + WS_XC), (const bf16*)(F.ws + WS_GB0)};
                    pg8::gemm_phase_hm(F.lds, gm, S, E, F.tid);
                    SEAM(); }
                PHASE(PH_B8) {
                    pg8::Gemm gm{(const bf16*)(F.ws + WS_XC), (const bf16*)(F.ws + WS_WOUT), D, D, D, 0, 0};
                    pg8::Order<0> S; S.init(MG / 256, 4, F.G, F.bid);
                    pg8::EpiResid E{xg, xg, modl + (1 * 3 + 2) * D, 1.0f, g * GB};
                    pg8::gemm_phase(F.lds, gm, S, E, F.tid);
                    if (fuse_b1 && g + 1 < args.g_hi && F.bid >= 128)
                        phase_modulate<true>(F, F.out, (bf16*)(F.ws + WS_HG), F.in[F.z + I_NORMW] + (size_t)(l * 3 + 1) * D, modl, 1, (g + 1) * MG, MG, (float*)(F.ws + WS_SIDE), l == 0 ? 8 : NSIDE, F.bid - 128, 128);
                    SEAM(); }
            }
        }
    }
    PHASE(PH_FIN) phase_final_norm(F);
#undef IN
#undef PHASE
#undef SEAM
}

extern "C" void kernel_launch(void* const* d_in, const int* in_sizes, int n_in, void* d_out, int out_size, void* d_ws, size_t ws_size, hipStream_t stream) {
    static int grid = 0;
    if (grid == 0) {
        if (n_in != 36 || out_size != M * D || ws_size < WS_END) { fprintf(stderr, "kernel_launch: unexpected problem (n_in %d out %d ws %zu, need %zu)\n", n_in, out_size, ws_size, (size_t)WS_END); grid = -1; return; }
        int dev = 0, cus = 0;
        if (hipGetDevice(&dev) != hipSuccess || hipDeviceGetAttribute(&cus, hipDeviceAttributeMultiprocessorCount, dev) != hipSuccess) { grid = -1; return; }
        if (hipFuncSetAttribute((const void*)fwd_kernel, hipFuncAttributeMaxDynamicSharedMemorySize, LDS_BYTES) != hipSuccess) { fprintf(stderr, "kernel_launch: hipFuncSetAttribute failed\n"); grid = -1; return; }
        int per_cu = 0;
        if (hipOccupancyMaxActiveBlocksPerMultiprocessor(&per_cu, (const void*)fwd_kernel, NTHREADS, LDS_BYTES) != hipSuccess || per_cu < 1) { fprintf(stderr, "kernel_launch: occupancy query says %d\n", per_cu); }
        (void)hipGetLastError();
        grid = cus;
    }
    if (grid < 0) return;
    (void)hipMemsetAsync((char*)d_ws + WS_CTL, 0, CTL_BYTES, stream);
    Args a{};
    for (int i = 0; i < 36; ++i) a.in[i] = (const float*)d_in[i];
    a.out = (float*)d_out; a.ws = (unsigned char*)d_ws; a.pad = 0;
#if ONE_LAUNCH
    a.f_lo = 0; a.f_hi = 4; a.g_lo = 0; a.g_hi = NGRP; a.ph_lo = 0; a.ph_hi = PH_N; a.use_bar = 1;
    hipLaunchKernelGGL(fwd_kernel, dim3(grid), dim3(NTHREADS), LDS_BYTES, stream, a);
#else
    a.use_bar = 0;
    for (int f = 0; f < 4; ++f) {
        a.f_lo = f; a.f_hi = f + 1;
        for (int ph = PH_W; ph <= PH_A3; ++ph) {
            if (ph == PH_W && (f & 1)) continue;
            a.ph_lo = ph; a.ph_hi = ph + 1; a.g_lo = 0; a.g_hi = 0;
            hipLaunchKernelGGL(fwd_kernel, dim3(grid), dim3(NTHREADS), LDS_BYTES, stream, a);
        }
        if ((f & 1) == 0)
            for (int g = 0; g < NGRP; ++g)
                for (int ph = PH_B1; ph <= PH_B8; ++ph) { a.ph_lo = ph; a.ph_hi = ph + 1; a.g_lo = g; a.g_hi = g + 1;
                    hipLaunchKernelGGL(fwd_kernel, dim3(grid), dim3(NTHREADS), LDS_BYTES, stream, a); }
    }
    a.f_lo = 0; a.f_hi = 0; a.g_lo = 0; a.g_hi = 0; a.ph_lo = PH_FIN; a.ph_hi = PH_FIN + 1;
    hipLaunchKernelGGL(fwd_kernel, dim3(grid), dim3(NTHREADS), LDS_BYTES, stream, a);
#endif
}
```
